# Optimizing an MI355X kernel written in HIP

```python
import math
import jax, jax.numpy as jnp
from jax import lax
import numpy as np

D_MODEL = 1024
BATCH = 8
SEQ = 4096
DEPTH = 2

CHUNK = 64
Q_BLOCK = 128
EPS = 1e-6

RET_HEADS = 4
RET_DK = 128
RET_DV = 128
RET_W = RET_HEADS * RET_DV
SB_HEADS = 8
SB_DH = 64
SB_W = SB_HEADS * SB_DH
ROPE_BASE = 10000.0
EVEN_IN = 4 * RET_W + 3 * SB_W
EVEN_MIX = RET_W + SB_W

CONV_W = 512
CONV_K = 3
LRU_W = 512
LRU_HEADS = 8
LRU_BLK = LRU_W // LRU_HEADS
LRU_CONV_K = 4
LRU_C = 8.0
ODD_IN = 3 * CONV_W + 2 * LRU_W
ODD_MIX = CONV_W + LRU_W

D_FF = 2816
N_EXPERTS = 8
TOP_K = 2
D_EXPERT = 3584
EXPERT_BLOCK = 256

N_EVEN = (DEPTH + 1) // 2
N_ODD = DEPTH // 2

kernel_name = "hybrid_retention_stickbreak_shortconv_rglru_moe"


def rmsnorm(x, g):
    xf = x.astype(jnp.float32)
    y = xf * lax.rsqrt(jnp.mean(xf * xf, axis=-1, keepdims=True) + EPS)
    return y.astype(x.dtype) * g


def rotary(x, pos):
    d = x.shape[-1]
    inv_freq = 1.0 / (ROPE_BASE ** (jnp.arange(0, d, 2, dtype=jnp.float32) / d))
    ang = pos[:, None] * inv_freq[None, :]
    cos = jnp.cos(ang)[None, :, None, :].astype(x.dtype)
    sin = jnp.sin(ang)[None, :, None, :].astype(x.dtype)
    x1, x2 = jnp.split(x, 2, axis=-1)
    return jnp.concatenate([x1 * cos - x2 * sin, x1 * sin + x2 * cos], axis=-1)


def retention(q, k, v):
    B, T, H, dk = q.shape
    dv = v.shape[-1]
    n = T // CHUNK
    log_g = jnp.log(1.0 - 2.0 ** (-5.0 - jnp.arange(H, dtype=jnp.float32)))
    idx = jnp.arange(CHUNK, dtype=jnp.float32)
    intra = jnp.exp(log_g[:, None, None] * jnp.abs(idx[:, None] - idx[None, :]))
    q_decay = jnp.exp(log_g[None, :] * (idx + 1.0)[:, None])
    k_decay = jnp.exp(log_g[None, :] * (CHUNK - 1.0 - idx)[:, None])
    chunk_decay = jnp.exp(log_g * CHUNK)

    qc = q.reshape(B, n, CHUNK, H, dk)
    kc = k.reshape(B, n, CHUNK, H, dk)
    vc = v.reshape(B, n, CHUNK, H, dv)

    s = jnp.einsum('bnihd,bnjhd->bnhij', qc, kc) * intra.astype(q.dtype)
    o_intra = jnp.einsum('bnhij,bnjhe->bnihe', s, vc).astype(jnp.float32)

    kc_dec = kc * k_decay.astype(k.dtype)[None, None, :, :, None]
    kv = jnp.einsum('bnjhd,bnjhe->bnhde', kc_dec, vc).astype(jnp.float32)

    def step(state, kv_n):
        return chunk_decay[None, :, None, None] * state + kv_n, state

    _, prev = lax.scan(step, jnp.zeros((B, H, dk, dv), jnp.float32), jnp.moveaxis(kv, 1, 0))
    prev = jnp.moveaxis(prev, 0, 1)
    o_cross = jnp.einsum('bnihd,bnhde->bnihe', qc.astype(jnp.float32), prev) * q_decay[None, None, :, :, None]
    return (o_intra + o_cross).reshape(B, T, H, dv)


def stick_breaking(q, k, v):
    B, T, H, d = q.shape
    scale = d ** -0.5
    outs = []
    for qb in range(T // Q_BLOCK):
        q0 = qb * Q_BLOCK
        kl = q0 + Q_BLOCK
        z = jnp.einsum('bihd,bjhd->bhij', q[:, q0:kl], k[:, :kl]).astype(jnp.float32) * scale
        t_pos = q0 + jnp.arange(Q_BLOCK)
        mask = jnp.arange(kl)[None, :] < t_pos[:, None]
        log_stay = jnp.where(mask, jax.nn.log_sigmoid(-z), 0.0)
        after = lax.cumsum(log_stay, axis=3, reverse=True) - log_stay
        a = jnp.where(mask, jnp.exp(jax.nn.log_sigmoid(z) + after), 0.0)
        outs.append(jnp.einsum('bhij,bjhd->bihd', a.astype(v.dtype), v[:, :kl]))
    return jnp.concatenate(outs, axis=1)


def causal_depthwise_conv(x, w):
    K, C = w.shape
    return lax.conv_general_dilated(
        x, w[:, None, :].astype(x.dtype), window_strides=(1,), padding=[(K - 1, 0)],
        dimension_numbers=('NWC', 'WIO', 'NWC'), feature_group_count=C)


def _lin_rec_combine(left, right):
    a_l, b_l = left
    a_r, b_r = right
    return a_l * a_r, a_r * b_l + b_r


def rg_lru(xr, conv_w, conv_b, wa, ba, wx, bx, lam):
    B, T, W = xr.shape
    xr = causal_depthwise_conv(xr, conv_w) + conv_b
    xh = xr.reshape(B, T, LRU_HEADS, LRU_BLK)
    r = jax.nn.sigmoid(jnp.einsum('bthi,hij->bthj', xh, wa).reshape(B, T, W) + ba)
    ig = jax.nn.sigmoid(jnp.einsum('bthi,hij->bthj', xh, wx).reshape(B, T, W) + bx)
    log_a = (-LRU_C * r.astype(jnp.float32)) * jax.nn.softplus(-lam.astype(jnp.float32))
    a = jnp.exp(log_a)
    mult = jnp.sqrt(-jnp.expm1(2.0 * log_a))
    b = mult * (ig * xr).astype(jnp.float32)
    _, h = lax.associative_scan(_lin_rec_combine, (a, b), axis=1)
    return h


def even_mixer(h, w_in, gn_w, w_out):
    B, T, _ = h.shape
    proj = h @ w_in
    cuts = [RET_W, 2 * RET_W, 3 * RET_W, 4 * RET_W, 4 * RET_W + SB_W, 4 * RET_W + 2 * SB_W]
    rq, rk, rv, rg, sq, sk, sv = jnp.split(proj, cuts, axis=-1)
    pos = jnp.arange(T, dtype=jnp.float32)
    rq = rotary(rq.reshape(B, T, RET_HEADS, RET_DK), pos)
    rk = rotary(rk.reshape(B, T, RET_HEADS, RET_DK), pos) * (RET_DK ** -0.5)
    o = retention(rq, rk, rv.reshape(B, T, RET_HEADS, RET_DV))
    mu = jnp.mean(o, axis=-1, keepdims=True)
    var = jnp.mean(jnp.square(o - mu), axis=-1, keepdims=True)
    o = ((o - mu) * lax.rsqrt(var + EPS)).reshape(B, T, RET_W)
    y_ret = (o.astype(h.dtype) * gn_w) * jax.nn.silu(rg)
    y_sb = stick_breaking(sq.reshape(B, T, SB_HEADS, SB_DH), sk.reshape(B, T, SB_HEADS, SB_DH),
                          sv.reshape(B, T, SB_HEADS, SB_DH)).reshape(B, T, SB_W)
    return jnp.concatenate([y_ret, y_sb.astype(h.dtype)], axis=-1) @ w_out


def odd_mixer(h, w_in, conv_w, lru_conv_w, lru_conv_b, wa, ba, wx, bx, lam, w_out):
    proj = h @ w_in
    cuts = [CONV_W, 2 * CONV_W, 3 * CONV_W, 3 * CONV_W + LRU_W]
    gb, gc, u, xr, xg = jnp.split(proj, cuts, axis=-1)
    y_conv = gb * causal_depthwise_conv(gc * u, conv_w)
    y_lru = rg_lru(xr, lru_conv_w, lru_conv_b, wa, ba, wx, bx, lam).astype(h.dtype) * jax.nn.gelu(xg)
    return jnp.concatenate([y_conv, y_lru], axis=-1) @ w_out


def swiglu(h, w_gate, w_up, w_down):
    return (jax.nn.silu(h @ w_gate) * (h @ w_up)) @ w_down


def moe_swiglu(h, w_router, b_router, w_gate, w_up, w_down):
    B, T, D = h.shape
    xt = h.reshape(-1, D)
    N = xt.shape[0]
    logits = (xt @ w_router).astype(jnp.float32) + b_router.astype(jnp.float32)
    top_logit, top_idx = lax.top_k(logits, TOP_K)
    top_w = jax.nn.softmax(top_logit, axis=-1)
    flat_e = top_idx.reshape(-1)
    flat_tok = jnp.repeat(jnp.arange(N, dtype=jnp.int32), TOP_K)
    flat_w = top_w.reshape(-1)
    order = jnp.argsort(flat_e)
    sorted_e = flat_e[order]
    counts = jnp.bincount(flat_e, length=N_EXPERTS)
    start = jnp.cumsum(counts) - counts
    padded = (counts + EXPERT_BLOCK - 1) // EXPERT_BLOCK * EXPERT_BLOCK
    pad_end = jnp.cumsum(padded)
    pad_start = pad_end - padded
    rank = jnp.arange(N * TOP_K) - start[sorted_e]
    dest = pad_start[sorted_e] + rank
    n_slots = N * TOP_K + N_EXPERTS * EXPERT_BLOCK
    n_blocks = n_slots // EXPERT_BLOCK
    slot_tok = jnp.zeros((n_slots,), jnp.int32).at[dest].set(flat_tok[order])
    slot_w = jnp.zeros((n_slots,), jnp.float32).at[dest].set(flat_w[order])
    block_e = jnp.minimum(jnp.searchsorted(pad_end, jnp.arange(n_blocks) * EXPERT_BLOCK, side='right'),
                          N_EXPERTS - 1)
    xb = xt[slot_tok].reshape(n_blocks, EXPERT_BLOCK, D)

    def expert_block(args):
        xg, e = args
        return (jax.nn.silu(xg @ w_gate[e]) * (xg @ w_up[e])) @ w_down[e]

    yb = lax.map(expert_block, (xb, block_e)).reshape(n_slots, D)
    y = yb * slot_w[:, None].astype(yb.dtype)
    out = jnp.zeros_like(xt).at[slot_tok].add(y)
    return out.reshape(B, T, D)


def _normal(k, shape, scale):
    return jax.random.normal(k, shape, jnp.float32) * scale


def setup_inputs(seed: int = 0) -> dict:
    key = jax.random.key(seed)
    ks = jax.random.split(key, 32)
    D = D_MODEL
    u = jax.random.uniform(ks[18], (N_ODD, LRU_W), jnp.float32, 0.9, 0.999)
    a0 = u ** (1.0 / LRU_C)
    lam = jnp.log(a0) - jnp.log1p(-a0)
    return {
        "x": _normal(ks[0], (BATCH, SEQ, D), 1.0),
        "norm_mix": 1.0 + _normal(ks[1], (DEPTH, D), 0.02),
        "norm_ffn": 1.0 + _normal(ks[2], (DEPTH, D), 0.02),
        "norm_final": 1.0 + _normal(ks[3], (D,), 0.02),
        "ev_w_in": _normal(ks[4], (N_EVEN, D, EVEN_IN), D ** -0.5),
        "ev_ret_gn": 1.0 + _normal(ks[5], (N_EVEN, RET_W), 0.02),
        "ev_w_out": _normal(ks[6], (N_EVEN, EVEN_MIX, D), EVEN_MIX ** -0.5),
        "ev_ffn_gate": _normal(ks[7], (N_EVEN, D, D_FF), D ** -0.5),
        "ev_ffn_up": _normal(ks[8], (N_EVEN, D, D_FF), D ** -0.5),
        "ev_ffn_down": _normal(ks[9], (N_EVEN, D_FF, D), D_FF ** -0.5),
        "od_w_in": _normal(ks[10], (N_ODD, D, ODD_IN), D ** -0.5),
        "od_conv_w": _normal(ks[11], (N_ODD, CONV_K, CONV_W), CONV_K ** -0.5),
        "od_lru_conv_w": _normal(ks[12], (N_ODD, LRU_CONV_K, LRU_W), LRU_CONV_K ** -0.5),
        "od_lru_conv_b": _normal(ks[13], (N_ODD, LRU_W), 0.01),
        "od_lru_wa": _normal(ks[14], (N_ODD, LRU_HEADS, LRU_BLK, LRU_BLK), LRU_BLK ** -0.5),
        "od_lru_ba": _normal(ks[15], (N_ODD, LRU_W), 0.01),
        "od_lru_wx": _normal(ks[16], (N_ODD, LRU_HEADS, LRU_BLK, LRU_BLK), LRU_BLK ** -0.5),
        "od_lru_bx": _normal(ks[17], (N_ODD, LRU_W), 0.01),
        "od_lru_lambda": lam,
        "od_w_out": _normal(ks[19], (N_ODD, ODD_MIX, D), ODD_MIX ** -0.5),
        "od_router_w": _normal(ks[20], (N_ODD, D, N_EXPERTS), D ** -0.5),
        "od_router_b": _normal(ks[21], (N_ODD, N_EXPERTS), 0.01),
        "od_exp_gate": _normal(ks[22], (N_ODD, N_EXPERTS, D, D_EXPERT), D ** -0.5),
        "od_exp_up": _normal(ks[23], (N_ODD, N_EXPERTS, D, D_EXPERT), D ** -0.5),
        "od_exp_down": _normal(ks[24], (N_ODD, N_EXPERTS, D_EXPERT, D), D_EXPERT ** -0.5),
    }


def reference(x, norm_mix, norm_ffn, norm_final, ev_w_in, ev_ret_gn, ev_w_out,
              ev_ffn_gate, ev_ffn_up, ev_ffn_down, od_w_in, od_conv_w, od_lru_conv_w,
              od_lru_conv_b, od_lru_wa, od_lru_ba, od_lru_wx, od_lru_bx, od_lru_lambda,
              od_w_out, od_router_w, od_router_b, od_exp_gate, od_exp_up, od_exp_down):
    for layer in range(DEPTH):
        j = layer // 2
        h = rmsnorm(x, norm_mix[layer])
        if layer % 2 == 0:
            x = x + even_mixer(h, ev_w_in[j], ev_ret_gn[j], ev_w_out[j])
            h = rmsnorm(x, norm_ffn[layer])
            x = x + swiglu(h, ev_ffn_gate[j], ev_ffn_up[j], ev_ffn_down[j])
        else:
            x = x + odd_mixer(h, od_w_in[j], od_conv_w[j], od_lru_conv_w[j], od_lru_conv_b[j],
                              od_lru_wa[j], od_lru_ba[j], od_lru_wx[j], od_lru_bx[j],
                              od_lru_lambda[j], od_w_out[j])
            h = rmsnorm(x, norm_ffn[layer])
            x = x + moe_swiglu(h, od_router_w[j], od_router_b[j], od_exp_gate[j],
                               od_exp_up[j], od_exp_down[j])
    return rmsnorm(x, norm_final)
```

```cpp
#include <hip/hip_runtime.h>
#include <cstdio>
#include <cstdint>

#ifndef MK_N_LAUNCHES
#define MK_N_LAUNCHES 0
#endif

#define GAS __attribute__((address_space(1)))
#define LAS __attribute__((address_space(3)))
typedef unsigned short bf16;
typedef short bf16x8 __attribute__((ext_vector_type(8)));
typedef float f32x4 __attribute__((ext_vector_type(4)));
typedef float f32x2 __attribute__((ext_vector_type(2)));
typedef unsigned u32x4 __attribute__((ext_vector_type(4)));
typedef unsigned u32x2 __attribute__((ext_vector_type(2)));

constexpr int D = 1024, NB = 8, SEQ = 4096, M = NB * SEQ;
constexpr int EVEN_IN = 3584, ODD_IN = 2560, D_FF = 2816, D_EXP = 3584, NEXP = 8;
constexpr int RQ_OFF = 0, RK_OFF = 512, RV_OFF = 1024, RGATE_OFF = 1536, SQ_OFF = 2048, SK_OFF = 2560, SV_OFF = 3072;
constexpr int CB_OFF = 0, CC_OFF = 512, CU_OFF = 1024, XR_OFF = 1536, XG_OFF = 2048;
constexpr float EPS = 1e-6f;
constexpr int LIST_CAP = 32768;
constexpr int MAX_TILES = 135;

constexpr size_t MiB = 1u << 20;
constexpr size_t WS_CTL = 0, CTL_ZERO_BYTES = 1 * MiB;
constexpr size_t WS_ROT = 1 * MiB;
constexpr size_t WS_SCR = 3 * MiB;
constexpr size_t WS_WB = 19 * MiB;
constexpr size_t WT_IN0 = WS_WB;
constexpr size_t WT_OUT0 = WT_IN0 + (size_t)EVEN_IN * D * 2;
constexpr size_t WT_GU0 = WT_OUT0 + (size_t)D * D * 2;
constexpr size_t WT_DN0 = WT_GU0 + (size_t)2 * D_FF * D * 2;
constexpr size_t WT_IN1 = WT_DN0 + (size_t)D * D_FF * 2;
constexpr size_t WT_OUT1 = WT_IN1 + (size_t)ODD_IN * D * 2;
constexpr size_t WT_GU1 = WT_OUT1 + (size_t)D * D * 2;
constexpr size_t WT_DN1 = WT_GU1 + (size_t)NEXP * 2 * D_EXP * D * 2;
constexpr size_t WB_END = WT_DN1 + (size_t)NEXP * D * D_EXP * 2;
constexpr size_t WS_ACTA = 220 * MiB;
constexpr size_t WS_ACTB = 284 * MiB;
constexpr size_t WS_END = WS_ACTB + (size_t)MAX_TILES * 256 * D_EXP * 2;
static_assert(WB_END <= WS_ACTA, "weights overlap");
static_assert((size_t)M * EVEN_IN * 2 <= (size_t)MAX_TILES * 256 * D_EXP * 2, "ACTB size");
constexpr size_t SCR_LTOK = WS_SCR, SCR_LW = WS_SCR + 2 * MiB;
constexpr int CW_BAR = 4096;
constexpr int CW_CNT = 8192;

constexpr int LDS_MISC = 0;
constexpr int LDS_SCR = 256;
constexpr int LDS_BYTES = 147456;

#define RLX_AGENT __ATOMIC_RELAXED, __HIP_MEMORY_SCOPE_AGENT
#define LDS_WAIT() asm volatile("s_waitcnt lgkmcnt(0)" ::: "memory")
__device__ __forceinline__ unsigned f2bf(float f) { unsigned u = __builtin_bit_cast(unsigned, f); return (u + 0x7fffu + ((u >> 16) & 1u)) >> 16; }
__device__ __forceinline__ unsigned pk2(float lo, float hi) { return f2bf(lo) | (f2bf(hi) << 16); }
__device__ __forceinline__ float bf2f(unsigned b) { return __builtin_bit_cast(float, (b & 0xffffu) << 16); }
__device__ __forceinline__ float wave_sum(float v) {
#pragma unroll
    for (int o = 1; o < 64; o <<= 1) v += __shfl_xor(v, o);
    return v;
}
__device__ __forceinline__ float sigmoidf_(float x) { return 1.0f / (1.0f + __expf(-x)); }

#define XB_TMO      128
#define XB_XCNT(j)  (256  + 64 * (j))
#define XB_XSUB(j)  (1280 + 64 * (j))
#define XB_XGEN(j)  (2304 + 64 * (j))
#define XB_TOP      3328
#define XB_TOPGEN   3392
#define XCD_BAR_WORDS 3456
#define XB_SPIN_CAP (1u << 18)

__device__ __forceinline__ unsigned xb_ld(unsigned* p)              { return __hip_atomic_load(p, __ATOMIC_RELAXED, __HIP_MEMORY_SCOPE_AGENT); }
__device__ __forceinline__ unsigned xb_add(unsigned* p, unsigned v) { return __hip_atomic_fetch_add(p, v, __ATOMIC_RELAXED, __HIP_MEMORY_SCOPE_AGENT); }
__device__ __forceinline__ unsigned xb_xcc_id() { return (unsigned)__builtin_amdgcn_s_getreg((3 << 11) | 20) & 0xFu; }
#define XB_SPIN(cond, bar) do { unsigned _sp = 0; while (cond) { __builtin_amdgcn_s_sleep(1); \
    if ((++_sp & 255u) == 0u) { if (xb_ld(&(bar)[XB_TMO])) break; if (_sp > XB_SPIN_CAP) { atomicAdd(&(bar)[XB_TMO], 1u); break; } } } } while (0)

struct XcdBarrier { unsigned* bar; unsigned x; volatile LAS unsigned* st; };

__device__ __forceinline__ XcdBarrier xcd_barrier_post(unsigned* bar, volatile LAS unsigned* st) {
    XcdBarrier b; b.bar = bar; b.x = xb_xcc_id(); b.st = st;
    if (threadIdx.x == 0) (void)xb_add(&bar[XB_XCNT(b.x)], 1u);
    return b;
}
__device__ __forceinline__ void xcd_barrier_complete(unsigned* bar, unsigned x, unsigned& nloc, unsigned& nx) {
    const unsigned G = gridDim.x * gridDim.y * gridDim.z;
    unsigned sum, cnt, mine, sp = 0u;
    for (;;) {
        sum = 0u; cnt = 0u; mine = 0u;
#pragma unroll
        for (unsigned j = 0; j < 16; ++j) { const unsigned c = xb_ld(&bar[XB_XCNT(j)]); sum += c; cnt += (c > 0u) ? 1u : 0u; mine = (j == x) ? c : mine; }
        if (sum == G) break;
        __builtin_amdgcn_s_sleep(1);
        if ((++sp & 255u) == 0u) { if (xb_ld(&bar[XB_TMO])) break; if (sp > XB_SPIN_CAP) { atomicAdd(&bar[XB_TMO], 1u); break; } }
    }
    nloc = mine > 0u ? mine : 1u; nx = cnt > 0u ? cnt : 1u;
}
__device__ __forceinline__ void xcd_barrier(const XcdBarrier& b) {
    asm volatile("s_waitcnt vmcnt(0)" ::: "memory");
    __syncthreads();
    if (threadIdx.x == 0) {
        unsigned* bar = b.bar;
        __builtin_amdgcn_s_waitcnt(0);
        unsigned nloc = b.st[0], nx = b.st[1];
        if (nloc == 0u) { xcd_barrier_complete(bar, b.x, nloc, nx); b.st[0] = nloc; b.st[1] = nx; }
        const unsigned old = xb_add(&bar[XB_XSUB(b.x)], 1u);
        const unsigned gen = old / nloc;
        if (old + 1u == (gen + 1u) * nloc) {
            __builtin_amdgcn_fence(__ATOMIC_RELEASE, "agent");
            asm volatile("s_waitcnt vmcnt(0)" ::: "memory");
            const unsigned og = xb_add(&bar[XB_TOP], 1u);
            const unsigned tg = og / nx;
            if (og + 1u == (tg + 1u) * nx) xb_add(&bar[XB_TOPGEN], 1u);
            else XB_SPIN(xb_ld(&bar[XB_TOPGEN]) == tg, bar);
            __builtin_amdgcn_fence(__ATOMIC_ACQUIRE, "agent");
            xb_add(&bar[XB_XGEN(b.x)], 1u);
            asm volatile("s_waitcnt vmcnt(0)" ::: "memory");
        } else {
            XB_SPIN(xb_ld(&bar[XB_XGEN(b.x)]) == gen, bar);
            __builtin_amdgcn_fence(__ATOMIC_ACQUIRE, "agent");
            asm volatile("s_waitcnt vmcnt(0)" ::: "memory");
        }
    }
    __syncthreads();
}

namespace pg8 {
constexpr int BM = 256, BK = 64, HALF = 128, HTB = HALF * BK * 2, STAGE_BYTES = 8 * HTB, NXCD = 8, WGM = 8;
__device__ __forceinline__ int lds_byte(int r, int c) { const int st = (r >> 4) * 2 + (c >> 5), rr = r & 15, cc = c & 31, ob = rr * 64 + cc * 2; return st * 1024 + (ob ^ (((ob >> 9) & 1) << 5)); }
__device__ __forceinline__ void stage_rc(int b, int& R, int& C) { const int st = b / 1024, sb = b % 1024, swz = sb ^ (((sb >> 9) & 1) << 5); R = (st >> 1) * 16 + swz / 64; C = (st & 1) * 32 + (swz % 64) / 2; }
__device__ __forceinline__ int perm32(int rho) { const int n = rho >> 4, i = rho & 15; return 8 * (i >> 2) + 4 * n + (i & 3); }

struct Unit { int pm, pn, e, lt, cn; };

struct StaticOrder {
    int nM, nN, nwg, G, c;
    __device__ __forceinline__ void init_tiles(int nM_, int nN_, int G_, int c_) { nM = nM_; nN = nN_; nwg = nM * nN; G = G_; c = c_; }
    __device__ __forceinline__ bool next_tile(int i, int& pm, int& pn) const {
        const long L = (long)i * G + c; if (L >= nwg) return false;
        int wgid = (int)L; { const int q = nwg / NXCD, r = nwg % NXCD, xcd = wgid % NXCD, off = wgid / NXCD; wgid = (xcd < r ? xcd * (q + 1) : r * (q + 1) + (xcd - r) * q) + off; }
        const int nig = WGM * nN, gid = wgid / nig, fm = gid * WGM, gsz = (nM - fm) < WGM ? (nM - fm) : WGM;
        pm = fm + ((wgid % nig) % gsz); pn = (wgid % nig) / gsz; return true;
    }
};
struct DenseSched : StaticOrder {
    const char* A; const char* Bt; size_t tstep;
    __device__ __forceinline__ void init(const bf16* A_, const bf16* Bt_, int Mr, int N, int K, int G_, int c_) { A = (const char*)A_; Bt = (const char*)Bt_; tstep = (size_t)BM * K * 2; init_tiles(Mr / BM, N / BM, G_, c_); }
    __device__ __forceinline__ bool next(int i, Unit& u) const { u.e = 0; u.lt = 0; u.cn = 0; return next_tile(i, u.pm, u.pn); }
    __device__ __forceinline__ const char* a_base(const Unit& u) const { return A + (size_t)u.pm * tstep; }
    __device__ __forceinline__ const char* b_base(const Unit& u) const { return Bt + (size_t)u.pn * tstep; }
    __device__ __forceinline__ void a_rows(const Unit&, const int (&)[2], const int (&)[2], unsigned (&)[2][2]) const {}
};
struct MoeSched : StaticOrder {
    const char* A; const char* Bt; size_t a_tstep, b_estep, b_tstep; const int* ltok; int c0, c1, c2, c3, c4, c5, c6, c7, t1, t2, t3, t4, t5, t6, t7; int K;
    __device__ __forceinline__ static int ldc_(const unsigned* cntw, int e) { int c = (int)__builtin_amdgcn_readfirstlane(__hip_atomic_load(cntw + 64 * e, RLX_AGENT)); return c > LIST_CAP ? LIST_CAP : c; }
    __device__ __forceinline__ void init(const bf16* A_, const bf16* Bt_, const int* ltok_, const unsigned* cntw, int nN_, int K_, size_t a_tstep_, size_t b_estep_, int G_, int c_) {
        A = (const char*)A_; Bt = (const char*)Bt_; ltok = ltok_; K = K_; a_tstep = a_tstep_; b_estep = b_estep_; b_tstep = (size_t)BM * K_ * 2;
        c0 = ldc_(cntw, 0); c1 = ldc_(cntw, 1); c2 = ldc_(cntw, 2); c3 = ldc_(cntw, 3); c4 = ldc_(cntw, 4); c5 = ldc_(cntw, 5); c6 = ldc_(cntw, 6); c7 = ldc_(cntw, 7);
        t1 = (c0 + 255) >> 8; t2 = t1 + ((c1 + 255) >> 8); t3 = t2 + ((c2 + 255) >> 8); t4 = t3 + ((c3 + 255) >> 8); t5 = t4 + ((c4 + 255) >> 8); t6 = t5 + ((c5 + 255) >> 8); t7 = t6 + ((c6 + 255) >> 8);
        init_tiles(t7 + ((c7 + 255) >> 8), nN_, G_, c_);
    }
    __device__ __forceinline__ bool next(int i, Unit& u) const {
        if (!next_tile(i, u.pm, u.pn)) return false;
        const int pm = u.pm;
        const int m1 = pm >= t1, m2 = pm >= t2, m3 = pm >= t3, m4 = pm >= t4, m5 = pm >= t5, m6 = pm >= t6, m7 = pm >= t7;
        const int e = m1 + m2 + m3 + m4 + m5 + m6 + m7;
        const int base = m1 * t1 + m2 * (t2 - t1) + m3 * (t3 - t2) + m4 * (t4 - t3) + m5 * (t5 - t4) + m6 * (t6 - t5) + m7 * (t7 - t6);
        const int cn = c0 + m1 * (c1 - c0) + m2 * (c2 - c1) + m3 * (c3 - c2) + m4 * (c4 - c3) + m5 * (c5 - c4) + m6 * (c6 - c5) + m7 * (c7 - c6);
        u.e = e; u.lt = pm - base; u.cn = cn; return true;
    }
    __device__ __forceinline__ const char* a_base(const Unit& u) const { return A + (size_t)u.pm * a_tstep; }
    __device__ __forceinline__ const char* b_base(const Unit& u) const { return Bt + (size_t)u.e * b_estep + (size_t)u.pn * b_tstep; }
    __device__ __forceinline__ void a_rows(const Unit& u, const int (&R)[2], const int (&C)[2], unsigned (&off)[2][2]) const {
#pragma unroll
        for (int h = 0; h < 2; ++h)
#pragma unroll
            for (int i = 0; i < 2; ++i) { int rank = u.lt * 256 + h * HALF + R[i]; rank = rank < u.cn ? rank : u.cn - 1;
                const int tok = ltok[(size_t)u.e * LIST_CAP + rank]; off[h][i] = (unsigned)tok * (unsigned)(K * 2) + (unsigned)(C[i] * 2); }
    }
};

__device__ __forceinline__ unsigned cvt_pk_bf16(float lo, float hi) { unsigned r; asm volatile("v_cvt_pk_bf16_f32 %0, %1, %2" : "=v"(r) : "v"(lo), "v"(hi)); return r; }

struct EpiStoreBf16 {
    static constexpr bool PERM = true;
    bf16* O; int ldc;
    __device__ __forceinline__ void operator()(const f32x4 (&acc)[2][2][4][2], const Unit& u, int wr, int wc, int fr, int fq) const {
        const int row0 = u.pm * BM + wr * 64 + fr, col0 = u.pn * BM + wc * 32 + 8 * fq;
#pragma unroll
        for (int ai = 0; ai < 2; ++ai)
#pragma unroll
            for (int m = 0; m < 4; ++m) { bf16* rowp = O + (size_t)(row0 + ai * HALF + m * 16) * ldc + col0;
#pragma unroll
                for (int bj = 0; bj < 2; ++bj) { const f32x4 v0 = acc[ai][bj][m][0], v1 = acc[ai][bj][m][1];
                    u32x4 w; w.x = cvt_pk_bf16(v0[0], v0[1]); w.y = cvt_pk_bf16(v0[2], v0[3]); w.z = cvt_pk_bf16(v1[0], v1[1]); w.w = cvt_pk_bf16(v1[2], v1[3]);
                    *(u32x4*)(rowp + bj * HALF) = w; } }
    }
};
struct EpiResF32 {
    static constexpr bool PERM = false;
    const float* base; float* out; int ldc;
    __device__ __forceinline__ void operator()(const f32x4 (&acc)[2][2][4][2], const Unit& u, int wr, int wc, int fr, int fq) const {
        const int row0 = u.pm * BM + wr * 64 + fr, col0 = u.pn * BM + wc * 32 + 4 * fq;
#pragma unroll
        for (int ai = 0; ai < 2; ++ai)
#pragma unroll
            for (int m = 0; m < 4; ++m) { const size_t off = (size_t)(row0 + ai * HALF + m * 16) * ldc + col0;
#pragma unroll
                for (int bj = 0; bj < 2; ++bj)
#pragma unroll
                    for (int n = 0; n < 2; ++n) { const f32x4 bs = *(const f32x4*)(base + off + bj * HALF + n * 16); *(f32x4*)(out + off + bj * HALF + n * 16) = bs + acc[ai][bj][m][n]; } }
    }
};
struct EpiSwiGLU {
    static constexpr bool PERM = true;
    bf16* H; int ldh;
    __device__ __forceinline__ void operator()(const f32x4 (&acc)[2][2][4][2], const Unit& u, int wr, int wc, int fr, int fq) const {
        const int row0 = u.pm * BM + wr * 64 + fr, col0 = u.pn * HALF + wc * 32 + 8 * fq;
#pragma unroll
        for (int ai = 0; ai < 2; ++ai)
#pragma unroll
            for (int m = 0; m < 4; ++m) { bf16* rowp = H + (size_t)(row0 + ai * HALF + m * 16) * ldh + col0;
                float h[8];
#pragma unroll
                for (int n = 0; n < 2; ++n)
#pragma unroll
                    for (int x = 0; x < 4; ++x) { const float g = acc[ai][0][m][n][x], up = acc[ai][1][m][n][x]; h[4 * n + x] = g / (1.0f + __expf(-g)) * up; }
                u32x4 w; w.x = cvt_pk_bf16(h[0], h[1]); w.y = cvt_pk_bf16(h[2], h[3]); w.z = cvt_pk_bf16(h[4], h[5]); w.w = cvt_pk_bf16(h[6], h[7]);
                *(u32x4*)rowp = w; }
    }
};
struct EpiMoeDown {
    static constexpr bool PERM = false;
    float* out; const int* ltok; const float* lw;
    __device__ __forceinline__ void operator()(const f32x4 (&acc)[2][2][4][2], const Unit& u, int wr, int wc, int fr, int fq) const {
        const int col0 = u.pn * BM + wc * 32 + 4 * fq;
#pragma unroll
        for (int ai = 0; ai < 2; ++ai)
#pragma unroll
            for (int m = 0; m < 4; ++m) { const int rank = u.lt * 256 + ai * HALF + wr * 64 + m * 16 + fr;
                if (rank < u.cn) { const int tok = ltok[(size_t)u.e * LIST_CAP + rank]; const float w = lw[(size_t)u.e * LIST_CAP + rank]; float* rowp = out + (size_t)tok * D + col0;
#pragma unroll
                    for (int bj = 0; bj < 2; ++bj)
#pragma unroll
                        for (int n = 0; n < 2; ++n) { const f32x4 bs = *(const f32x4*)(rowp + bj * HALF + n * 16); *(f32x4*)(rowp + bj * HALF + n * 16) = bs + acc[ai][bj][m][n] * w; } } }
    }
};

template <class Epi, class Sched, bool GATHER>
__device__ __forceinline__ void gemm_phase(LAS unsigned char* lds, const int K, const Sched& S, const Epi& E) {
    const int tid = threadIdx.x, wid = __builtin_amdgcn_readfirstlane(tid >> 6), lane = tid & 63, wr = wid >> 2, wc = wid & 3, fr = lane & 15, fq = lane >> 4;
    const int nt = K / BK;
    unsigned voffA[2], voffB[2]; int Rr[2], Cc[2];
#pragma unroll
    for (int i = 0; i < 2; ++i) { int R, C; stage_rc(tid * 16 + i * 8192, R, C); const int Rb = Epi::PERM ? ((R & ~31) + perm32(R & 31)) : R;
        voffA[i] = (unsigned)(R * K + C) * 2u; voffB[i] = (unsigned)(Rb * K + C) * 2u; Rr[i] = R; Cc[i] = C; }
    const size_t kstep = (size_t)(BK * 2);
    const size_t hstep = (size_t)HALF * K * 2;
    const unsigned ldsw = (unsigned)wid * 1024u;
    const int aoff = lds_byte(wr * 64 + fr, fq * 8), boff = lds_byte(wc * 32 + fr, fq * 8);
#define PG8_SA(b, h) (((b) * 2 + (h)) * HTB)
#define PG8_SB(b, h) ((4 + (b) * 2 + (h)) * HTB)
#define PG8_STAGE(bufoff, gbase, voff) do { _Pragma("unroll") for (int _i = 0; _i < 2; ++_i) \
        __builtin_amdgcn_global_load_lds((const unsigned*)((const char*)(gbase) + (voff)[_i]), (LAS unsigned*)(lds + (bufoff) + ldsw + _i * 8192), 16, 0, 0); } while (0)
#define PG8_STAGE_A(bufoff, kptr, h) do { if constexpr (GATHER) PG8_STAGE(bufoff, kptr, gA[h]); else PG8_STAGE(bufoff, (kptr) + (h) * hstep, voffA); } while (0)
#define PG8_LDA(dst, b, h) do { _Pragma("unroll") for (int m = 0; m < 4; ++m) _Pragma("unroll") for (int k = 0; k < 2; ++k) dst[m][k] = *(const LAS bf16x8*)(lds + PG8_SA(b, h) + aoff + m * 2048 + k * 1024); } while (0)
#define PG8_LDB(dst, b, h) do { _Pragma("unroll") for (int n = 0; n < 2; ++n) _Pragma("unroll") for (int k = 0; k < 2; ++k) dst[n][k] = *(const LAS bf16x8*)(lds + PG8_SB(b, h) + boff + n * 2048 + k * 1024); } while (0)
#define PG8_MMA(ai, bj, At, Bt) do { __builtin_amdgcn_s_setprio(1); _Pragma("unroll") for (int m = 0; m < 4; ++m) _Pragma("unroll") for (int n = 0; n < 2; ++n) _Pragma("unroll") for (int k = 0; k < 2; ++k) \
        acc[ai][bj][m][n] = __builtin_amdgcn_mfma_f32_16x16x32_bf16(Bt[n][k], At[m][k], acc[ai][bj][m][n], 0, 0, 0); __builtin_amdgcn_s_setprio(0); } while (0)
#define PG8_WAIT_V(n) asm volatile("s_waitcnt vmcnt(" #n ")" ::: "memory")
#define PG8_WAIT_L(n) asm volatile("s_waitcnt lgkmcnt(" #n ")" ::: "memory")
#define PG8_BAR __builtin_amdgcn_s_barrier()
#define PG8_SCHED __builtin_amdgcn_sched_barrier(0)
    Unit cur, nxt; int ui = 0;
    if (!S.next(0, cur)) return;
    f32x4 acc[2][2][4][2];
#pragma unroll
    for (int a = 0; a < 2; ++a)
#pragma unroll
        for (int b = 0; b < 2; ++b)
#pragma unroll
            for (int m = 0; m < 4; ++m)
#pragma unroll
                for (int n = 0; n < 2; ++n) acc[a][b][m][n] = (f32x4){0.f, 0.f, 0.f, 0.f};
    bf16x8 At[4][2], B0[2][2], B1[2][2];
    const char* cA = S.a_base(cur); const char* cB = S.b_base(cur);
    unsigned gA[2][2] = {{0u, 0u}, {0u, 0u}}, gN[2][2] = {{0u, 0u}, {0u, 0u}};
    if constexpr (GATHER) S.a_rows(cur, Rr, Cc, gA);
    PG8_STAGE(PG8_SB(0, 0), cB, voffB); PG8_STAGE(PG8_SB(0, 1), cB + hstep, voffB); PG8_STAGE_A(PG8_SA(0, 0), cA, 0); PG8_STAGE_A(PG8_SA(0, 1), cA, 1);
    if (wr == 1) PG8_BAR;
    PG8_WAIT_V(2); PG8_BAR;
    PG8_STAGE(PG8_SB(1, 0), cB + kstep, voffB); PG8_STAGE_A(PG8_SA(1, 0), cA + kstep, 0); PG8_STAGE(PG8_SB(1, 1), cB + hstep + kstep, voffB);
    PG8_WAIT_V(6); PG8_BAR;
    for (;;) {
        const bool has_next = S.next(ui + 1, nxt);
        const char* nA = has_next ? S.a_base(nxt) : cA; const char* nB = has_next ? S.b_base(nxt) : cB;
        if constexpr (GATHER) { if (has_next) S.a_rows(nxt, Rr, Cc, gN); }
        for (int t = 0; t < nt; t += 2) {
            const bool last = (t == nt - 2);
            const char* a1 = cA + (size_t)(t + 1) * kstep;
            const char* a2 = last ? nA : cA + (size_t)(t + 2) * kstep; const char* b2 = last ? nB : cB + (size_t)(t + 2) * kstep;
            const char* a3 = a2 + kstep; const char* b3 = b2 + kstep;
            PG8_LDB(B0, 0, 0); PG8_LDB(B1, 0, 1); PG8_SCHED; PG8_LDA(At, 0, 0); PG8_STAGE_A(PG8_SA(1, 1), a1, 1);
            if constexpr (GATHER) { if (last && has_next) { asm volatile("" ::: "memory"); gA[0][0] = gN[0][0]; gA[0][1] = gN[0][1]; gA[1][0] = gN[1][0]; gA[1][1] = gN[1][1]; } }
            PG8_WAIT_V(8); PG8_WAIT_L(0); PG8_BAR; PG8_MMA(0, 0, At, B0); PG8_MMA(0, 1, At, B1); PG8_BAR; PG8_SCHED;
            PG8_LDA(At, 0, 1); PG8_STAGE(PG8_SB(0, 0), b2, voffB); PG8_STAGE(PG8_SB(0, 1), b2 + hstep, voffB); PG8_STAGE_A(PG8_SA(0, 0), a2, 0);
            PG8_WAIT_V(8); PG8_WAIT_L(0); PG8_BAR; PG8_MMA(1, 0, At, B0); PG8_MMA(1, 1, At, B1); PG8_BAR; PG8_SCHED;
            PG8_LDB(B0, 1, 0); PG8_LDB(B1, 1, 1); PG8_SCHED; PG8_LDA(At, 1, 0); PG8_STAGE_A(PG8_SA(0, 1), a2, 1);
            PG8_WAIT_V(8); PG8_WAIT_L(0); PG8_BAR; PG8_MMA(0, 0, At, B0); PG8_MMA(0, 1, At, B1); PG8_BAR; PG8_SCHED;
            PG8_LDA(At, 1, 1); PG8_STAGE(PG8_SB(1, 0), b3, voffB); PG8_STAGE(PG8_SB(1, 1), b3 + hstep, voffB); PG8_STAGE_A(PG8_SA(1, 0), a3, 0);
            PG8_WAIT_V(8); PG8_WAIT_L(0); PG8_BAR; PG8_MMA(1, 0, At, B0); PG8_MMA(1, 1, At, B1); PG8_BAR; PG8_SCHED;
        }
        if (wr == 0) PG8_BAR;
        E(acc, cur, wr, wc, fr, fq);
        if (!has_next) break;
#pragma unroll
        for (int a = 0; a < 2; ++a)
#pragma unroll
            for (int b = 0; b < 2; ++b)
#pragma unroll
                for (int m = 0; m < 4; ++m)
#pragma unroll
                    for (int n = 0; n < 2; ++n) acc[a][b][m][n] = (f32x4){0.f, 0.f, 0.f, 0.f};
        cur = nxt; cA = nA; cB = nB; ++ui;
        if (wr == 1) PG8_BAR;
    }
    PG8_WAIT_V(0);
    PG8_BAR;
#undef PG8_SA
#undef PG8_SB
#undef PG8_STAGE
#undef PG8_STAGE_A
#undef PG8_LDA
#undef PG8_LDB
#undef PG8_MMA
#undef PG8_WAIT_V
#undef PG8_WAIT_L
#undef PG8_BAR
#undef PG8_SCHED
}
}

template <int Mr, int Nc, int K, bool ACCUM>
__device__ __forceinline__ void mm_lds(const LAS bf16* A, int lda, const LAS bf16* Bt, int ldb, f32x4 (&acc)[(Mr / 16) * (Nc / 16) / 8], int wave, int lane) {
    constexpr int NT = Nc / 16, TPW = (Mr / 16) * NT / 8;
    const int fr = lane & 15, fq = lane >> 4;
#pragma unroll
    for (int q = 0; q < TPW; ++q) {
        const int t = wave + 8 * q, ti = t / NT, tj = t % NT;
        f32x4 c = ACCUM ? acc[q] : (f32x4){0.f, 0.f, 0.f, 0.f};
#pragma unroll
        for (int k0 = 0; k0 < K; k0 += 32) {
            const bf16x8 a = *(const LAS bf16x8*)(A + (16 * ti + fr) * lda + k0 + 8 * fq);
            const bf16x8 b = *(const LAS bf16x8*)(Bt + (16 * tj + fr) * ldb + k0 + 8 * fq);
            c = __builtin_amdgcn_mfma_f32_16x16x32_bf16(a, b, c, 0, 0, 0);
        }
        acc[q] = c;
    }
}
#define MM_ROW(NT, q, r) (16 * ((wave + 8 * (q)) / (NT)) + 4 * fq + (r))
#define MM_COL(NT, q)    (16 * ((wave + 8 * (q)) % (NT)) + fr)

struct Args { const float* in[25]; float* out; unsigned char* ws; int ph_lo, ph_hi; };
constexpr int NPHASE = 19;

__device__ __forceinline__ void p0_transpose_item(const float* W, int K, int N, bf16* WT, int mode, LAS float* scr, int item, int lane) {
    const int nblk = N / 32, kb = item / nblk, nb = item % nblk, k0 = 64 * kb, n0 = 32 * nb;
    const int row0 = mode == 0 ? n0 : ((n0 >> 7) << 8) + (n0 & 127) + (mode == 2 ? 128 : 0);
#pragma unroll 8
    for (int i = 0; i < 32; ++i) { const int kk = 2 * i + (lane >> 5); scr[kk * 33 + (lane & 31)] = W[(size_t)(k0 + kk) * N + n0 + (lane & 31)]; }
    LDS_WAIT(); asm volatile("" ::: "memory");
    const int c = lane & 7;
#pragma unroll
    for (int j = 0; j < 4; ++j) { const int n = (lane >> 3) + 8 * j; const LAS float* s = scr + (8 * c) * 33 + n;
        u32x4 o; o.x = pk2(s[0 * 33], s[1 * 33]); o.y = pk2(s[2 * 33], s[3 * 33]); o.z = pk2(s[4 * 33], s[5 * 33]); o.w = pk2(s[6 * 33], s[7 * 33]);
        *(u32x4*)(WT + (size_t)(row0 + n) * K + k0 + 8 * c) = o; }
    LDS_WAIT(); asm volatile("" ::: "memory");
}
__device__ __forceinline__ void rms_row_bf16(const float* xrow, const float* g, bf16* orow, int lane) {
    const f32x4* xr = (const f32x4*)xrow + lane; const f32x4* gr = (const f32x4*)g + lane;
    f32x4 v[4]; float s = 0.f;
#pragma unroll
    for (int j = 0; j < 4; ++j) { v[j] = xr[64 * j]; s += (v[j].x * v[j].x + v[j].y * v[j].y) + (v[j].z * v[j].z + v[j].w * v[j].w); }
    const float rstd = rsqrtf(wave_sum(s) * (1.f / D) + EPS);
    u32x2* o8 = (u32x2*)orow + lane;
#pragma unroll
    for (int j = 0; j < 4; ++j) { const f32x4 gv = gr[64 * j]; u32x2 w; w.x = pk2(v[j].x * rstd * gv.x, v[j].y * rstd * gv.y); w.y = pk2(v[j].z * rstd * gv.z, v[j].w * rstd * gv.w); o8[64 * j] = w; }
}

__global__ void __launch_bounds__(512, 2) fwd_kernel(Args args) {
    extern __shared__ __attribute__((aligned(16))) unsigned char lds_raw[];
    LAS unsigned char* lds = (LAS unsigned char*)lds_raw;
    volatile LAS unsigned* MISC = (volatile LAS unsigned*)(lds + LDS_MISC);
    LAS unsigned char* scrb = lds + LDS_SCR;
    const int tid = threadIdx.x, lane = tid & 63, wave = __builtin_amdgcn_readfirstlane(tid >> 6);
    const int G = gridDim.x, bid = blockIdx.x;
    const int fr = lane & 15, fq = lane >> 4;
    unsigned char* ws = args.ws;
    unsigned* ctl = (unsigned*)(ws + WS_CTL);
    float* out = args.out;
    const int lo = args.ph_lo, hi = args.ph_hi;

    if (tid < 64) MISC[tid] = 0u;
    __syncthreads();
    XcdBarrier bar; bar.bar = ctl + CW_BAR; bar.x = 0; bar.st = MISC;
    if (hi - lo > 1) bar = xcd_barrier_post(ctl + CW_BAR, MISC);
#ifndef PHASE_MASK
#define PHASE_MASK 0x7ffff
#endif
#define IN(k) ((((PHASE_MASK) >> (k)) & 1) && lo <= (k) && (k) < hi)
#define SEAM(k) do { if (IN(k) && IN((k) + 1)) xcd_barrier(bar); } while (0)

    bf16* const ACTA = (bf16*)(ws + WS_ACTA);
    bf16* const ACTB = (bf16*)(ws + WS_ACTB);
    const f32x2* const ROT = (const f32x2*)(ws + WS_ROT);
    const int gw = bid * 8 + wave, NGW = G * 8;

    if (IN(0)) {
        LAS float* scr = (LAS float*)(scrb + wave * 16384);
        constexpr int I_IN0 = 16 * 112, I_OUT = 16 * 32, I_FF = 16 * 88, I_DN0 = 44 * 32, I_IN1 = 16 * 80, I_EXP = 16 * 112, I_EDN = 56 * 32;
        constexpr int NITEMS = I_IN0 + I_OUT + 2 * I_FF + I_DN0 + I_IN1 + I_OUT + 2 * 8 * I_EXP + 8 * I_EDN;
        for (int it = gw; it < NITEMS; it += NGW) {
            int r = it;
            if (r < I_IN0) { p0_transpose_item(args.in[4], D, EVEN_IN, (bf16*)(ws + WT_IN0), 0, scr, r, lane); continue; } r -= I_IN0;
            if (r < I_OUT) { p0_transpose_item(args.in[6], D, D, (bf16*)(ws + WT_OUT0), 0, scr, r, lane); continue; } r -= I_OUT;
            if (r < I_FF) { p0_transpose_item(args.in[7], D, D_FF, (bf16*)(ws + WT_GU0), 1, scr, r, lane); continue; } r -= I_FF;
            if (r < I_FF) { p0_transpose_item(args.in[8], D, D_FF, (bf16*)(ws + WT_GU0), 2, scr, r, lane); continue; } r -= I_FF;
            if (r < I_DN0) { p0_transpose_item(args.in[9], D_FF, D, (bf16*)(ws + WT_DN0), 0, scr, r, lane); continue; } r -= I_DN0;
            if (r < I_IN1) { p0_transpose_item(args.in[10], D, ODD_IN, (bf16*)(ws + WT_IN1), 0, scr, r, lane); continue; } r -= I_IN1;
            if (r < I_OUT) { p0_transpose_item(args.in[19], D, D, (bf16*)(ws + WT_OUT1), 0, scr, r, lane); continue; } r -= I_OUT;
            if (r < 8 * I_EXP) { const int e = r / I_EXP; p0_transpose_item(args.in[22] + (size_t)e * D * D_EXP, D, D_EXP, (bf16*)(ws + WT_GU1) + (size_t)e * 2 * D_EXP * D, 1, scr, r % I_EXP, lane); continue; } r -= 8 * I_EXP;
            if (r < 8 * I_EXP) { const int e = r / I_EXP; p0_transpose_item(args.in[23] + (size_t)e * D * D_EXP, D, D_EXP, (bf16*)(ws + WT_GU1) + (size_t)e * 2 * D_EXP * D, 2, scr, r % I_EXP, lane); continue; } r -= 8 * I_EXP;
            { const int e = r / I_EDN; p0_transpose_item(args.in[24] + (size_t)e * D_EXP * D, D_EXP, D, (bf16*)(ws + WT_DN1) + (size_t)e * D * D_EXP, 0, scr, r % I_EDN, lane); }
        }
        for (int idx = bid * 512 + tid; idx < SEQ * 64; idx += G * 512) {
            const int t = idx >> 6, i = idx & 63;
            const float inv_freq = exp2f(-(float)i * (13.287712379549449f / 64.0f));
            double rev = (double)t * (double)inv_freq * 0.15915494309189535; rev -= floor(rev);
            const float rv = (float)rev;
            f32x2 cs; cs.x = __builtin_amdgcn_cosf(rv); cs.y = __builtin_amdgcn_sinf(rv);
            ((f32x2*)(ws + WS_ROT))[idx] = cs;
        }
        for (int m = gw; m < M; m += NGW) rms_row_bf16(args.in[0] + (size_t)m * D, args.in[1], ACTA + (size_t)m * D, lane);
    }
    SEAM(0);

    if (IN(1)) {
        pg8::DenseSched S; S.init(ACTA, (const bf16*)(ws + WT_IN0), M, EVEN_IN, D, G, bid);
        pg8::EpiStoreBf16 E{ACTB, EVEN_IN};
        pg8::gemm_phase<pg8::EpiStoreBf16, pg8::DenseSched, false>(scrb, D, S, E);
    }
    SEAM(1);

    constexpr int LQ = 136, LT = 72;
    LAS bf16* const rQ = (LAS bf16*)(scrb);
    LAS bf16* const rK = (LAS bf16*)(scrb + 17408);
    LAS bf16* const rKdT = (LAS bf16*)(scrb + 34816);
    LAS bf16* const rVT = (LAS bf16*)(scrb + 53248);
    LAS bf16* const rS = (LAS bf16*)(scrb + 71680);
    LAS bf16* const rStT = (LAS bf16*)(scrb + 80896);
    LAS float* const rStat = (LAS float*)(scrb + 115712);
    float* const RGS = (float*)(ws + WS_SCR);

    if (IN(2)) {
        for (int item = bid; item < 256; item += G) {
            const int b = item >> 5, h = (item >> 3) & 3, g = item & 7;
            const float l2g = log2f(1.0f - exp2f(-5.0f - (float)h));
            const float g64 = exp2f(64.0f * l2g);
            f32x4 st[8];
#pragma unroll
            for (int q = 0; q < 8; ++q) st[q] = (f32x4){0.f, 0.f, 0.f, 0.f};
            for (int n = 0; n < 8; ++n) {
                const int tpos0 = (g * 8 + n) * 64; const size_t row0 = (size_t)b * SEQ + tpos0;
                { const int i = lane;
#pragma unroll 2
                    for (int r = 0; r < 8; ++r) { const int j = wave + 8 * r; const bf16* prow = ACTB + (row0 + j) * EVEN_IN; const f32x2 cs = ROT[(tpos0 + j) * 64 + i];
                        const float k1 = bf2f(prow[RK_OFF + 128 * h + i]), k2 = bf2f(prow[RK_OFF + 128 * h + 64 + i]);
                        const float dec = exp2f((float)(63 - j) * l2g) * 0.08838834764831845f;
                        const float kr1 = (k1 * cs.x - k2 * cs.y) * dec, kr2 = (k1 * cs.y + k2 * cs.x) * dec;
                        rKdT[i * LT + j] = (bf16)f2bf(kr1); rKdT[(i + 64) * LT + j] = (bf16)f2bf(kr2);
                        rVT[i * LT + j] = prow[RV_OFF + 128 * h + i]; rVT[(i + 64) * LT + j] = prow[RV_OFF + 128 * h + 64 + i]; } }
                __syncthreads();
#pragma unroll
                for (int q = 0; q < 8; ++q) st[q] = st[q] * g64;
                mm_lds<128, 128, 64, true>(rVT, LT, rKdT, LT, st, wave, lane);
                __syncthreads();
            }
            float* gp = RGS + (size_t)item * 16384 + tid;
#pragma unroll
            for (int q = 0; q < 8; ++q)
#pragma unroll
                for (int r = 0; r < 4; ++r) gp[(q * 4 + r) * 512] = st[q][r];
        }
        {
            LAS bf16* const sQ = (LAS bf16*)(scrb);
            LAS bf16* const sK = (LAS bf16*)(scrb + 9216);
            LAS bf16* const sVT = (LAS bf16*)(scrb + 18432);
            LAS bf16* const sA = (LAS bf16*)(scrb + 27648);
            LAS float* const sZ = (LAS float*)(scrb + 36864);
            volatile LAS unsigned* sFlag = (volatile LAS unsigned*)(scrb + 54272);
            const int srow = tid >> 3, sseg = tid & 7;
            for (int item = bid; item < NB * 8 * 64; item += G) {
                const int qb = 63 - (item & 63), h = (item >> 6) & 7, b = item >> 9;
                const size_t qrow0 = (size_t)b * SEQ + 64 * qb;
                __syncthreads();
                *(u32x4*)(sQ + srow * LT + 8 * sseg) = *(const u32x4*)(ACTB + (qrow0 + srow) * EVEN_IN + SQ_OFF + 64 * h + 8 * sseg);
                f32x4 o[2]; o[0] = (f32x4){0.f, 0.f, 0.f, 0.f}; o[1] = o[0];
                float C = 1.0f;
                for (int kt = qb; kt >= 0; --kt) {
                    const size_t krow0 = (size_t)b * SEQ + 64 * kt;
                    { const bf16* prow = ACTB + (krow0 + srow) * EVEN_IN;
                      *(u32x4*)(sK + srow * LT + 8 * sseg) = *(const u32x4*)(prow + SK_OFF + 64 * h + 8 * sseg);
                      const u32x4 vv = *(const u32x4*)(prow + SV_OFF + 64 * h + 8 * sseg);
                      const unsigned vw[4] = {vv.x, vv.y, vv.z, vv.w};
#pragma unroll
                      for (int c = 0; c < 4; ++c) { sVT[(8 * sseg + 2 * c) * LT + srow] = (bf16)(vw[c] & 0xffffu); sVT[(8 * sseg + 2 * c + 1) * LT + srow] = (bf16)(vw[c] >> 16); } }
                    if (tid == 0) sFlag[0] = 0u;
                    __syncthreads();
                    { f32x4 z[2]; mm_lds<64, 64, 64, false>(sQ, LT, sK, LT, z, wave, lane);
#pragma unroll
                      for (int q = 0; q < 2; ++q)
#pragma unroll
                          for (int r = 0; r < 4; ++r) sZ[MM_ROW(4, q, r) * 68 + MM_COL(4, q)] = z[q][r] * 0.125f; }
                    __syncthreads();
                    {
                      const int tq = 64 * qb + srow, s0 = 64 * kt + 8 * sseg;
                      float p[8], a[8];
#pragma unroll
                      for (int c = 0; c < 8; ++c) { const float z = sZ[srow * 68 + 8 * sseg + c]; const bool valid = (s0 + c) < tq; const float pp = 1.0f / (1.0f + __expf(z)); p[c] = valid ? pp : 1.0f; a[c] = valid ? 1.0f - pp : 0.0f; }
                      float suf = 1.0f;
#pragma unroll
                      for (int c = 7; c >= 0; --c) { a[c] *= suf; suf *= p[c]; }
                      float Eo = 1.0f;
#pragma unroll
                      for (int k = 1; k < 8; ++k) { const float tv = __shfl_down(suf, k, 8); if (sseg + k < 8) Eo *= tv; }
                      const float ptot = __shfl(Eo * suf, 0, 8);
                      const float sc = Eo * C;
                      u32x4 w; w.x = pk2(a[0] * sc, a[1] * sc); w.y = pk2(a[2] * sc, a[3] * sc); w.z = pk2(a[4] * sc, a[5] * sc); w.w = pk2(a[6] * sc, a[7] * sc);
                      *(u32x4*)(sA + srow * LT + 8 * sseg) = w;
                      C *= ptot;
                      if (C >= 1e-30f) sFlag[0] = 1u; }
                    __syncthreads();
                    mm_lds<64, 64, 64, true>(sA, LT, sVT, LT, o, wave, lane);
                    const unsigned more = sFlag[0];
                    __syncthreads();
                    if (more == 0u) break;
                }
#pragma unroll
                for (int q = 0; q < 2; ++q)
#pragma unroll
                    for (int r = 0; r < 4; ++r) ACTA[(qrow0 + MM_ROW(4, q, r)) * D + 512 + 64 * h + MM_COL(4, q)] = (bf16)f2bf(o[q][r]);
            }
        }
    }
    SEAM(2);

    if (IN(3)) {
        for (int item = bid; item < 256; item += G) {
            const int b = item >> 5, h = (item >> 3) & 3, g = item & 7;
            const float l2g = log2f(1.0f - exp2f(-5.0f - (float)h));
            const float g64 = exp2f(64.0f * l2g), g512 = exp2f(512.0f * l2g);
            f32x4 st[8];
#pragma unroll
            for (int q = 0; q < 8; ++q) st[q] = (f32x4){0.f, 0.f, 0.f, 0.f};
            for (int gp_ = 0; gp_ < g; ++gp_) {
                const float* gp = RGS + (size_t)(item - g + gp_) * 16384 + tid;
#pragma unroll
                for (int q = 0; q < 8; ++q)
#pragma unroll
                    for (int r = 0; r < 4; ++r) st[q][r] = st[q][r] * g512 + gp[(q * 4 + r) * 512];
            }
            for (int n = 0; n < 8; ++n) {
                const int tpos0 = (g * 8 + n) * 64; const size_t row0 = (size_t)b * SEQ + tpos0;
                __syncthreads();
                { const int i = lane;
#pragma unroll 2
                    for (int r = 0; r < 8; ++r) { const int j = wave + 8 * r; const bf16* prow = ACTB + (row0 + j) * EVEN_IN; const f32x2 cs = ROT[(tpos0 + j) * 64 + i];
                        const float q1 = bf2f(prow[RQ_OFF + 128 * h + i]), q2 = bf2f(prow[RQ_OFF + 128 * h + 64 + i]);
                        const float k1 = bf2f(prow[RK_OFF + 128 * h + i]) * 0.08838834764831845f, k2 = bf2f(prow[RK_OFF + 128 * h + 64 + i]) * 0.08838834764831845f;
                        const float qr1 = q1 * cs.x - q2 * cs.y, qr2 = q1 * cs.y + q2 * cs.x;
                        const float kr1 = k1 * cs.x - k2 * cs.y, kr2 = k1 * cs.y + k2 * cs.x;
                        const float dec = exp2f((float)(63 - j) * l2g);
                        rQ[j * LQ + i] = (bf16)f2bf(qr1); rQ[j * LQ + 64 + i] = (bf16)f2bf(qr2);
                        rK[j * LQ + i] = (bf16)f2bf(kr1); rK[j * LQ + 64 + i] = (bf16)f2bf(kr2);
                        rKdT[i * LT + j] = (bf16)f2bf(kr1 * dec); rKdT[(i + 64) * LT + j] = (bf16)f2bf(kr2 * dec);
                        rVT[i * LT + j] = prow[RV_OFF + 128 * h + i]; rVT[(i + 64) * LT + j] = prow[RV_OFF + 128 * h + 64 + i]; } }
#pragma unroll
                for (int q = 0; q < 8; ++q)
#pragma unroll
                    for (int r = 0; r < 4; ++r) rStT[MM_ROW(8, q, r) * LQ + MM_COL(8, q)] = (bf16)f2bf(st[q][r]);
                __syncthreads();
                { f32x4 s[2]; mm_lds<64, 64, 128, false>(rQ, LQ, rK, LQ, s, wave, lane);
#pragma unroll
                  for (int q = 0; q < 2; ++q)
#pragma unroll
                      for (int r = 0; r < 4; ++r) { const int i = MM_ROW(4, q, r), j = MM_COL(4, q); const int dd = i > j ? i - j : j - i; rS[i * LT + j] = (bf16)f2bf(s[q][r] * exp2f((float)dd * l2g)); } }
                __syncthreads();
                f32x4 oi[4];
                mm_lds<64, 128, 128, false>(rQ, LQ, rStT, LQ, oi, wave, lane);
#pragma unroll
                for (int q = 0; q < 4; ++q)
#pragma unroll
                    for (int r = 0; r < 4; ++r) oi[q][r] *= exp2f((float)(MM_ROW(8, q, r) + 1) * l2g);
                mm_lds<64, 128, 64, true>(rS, LT, rVT, LT, oi, wave, lane);
#pragma unroll
                for (int q = 0; q < 4; ++q)
#pragma unroll
                    for (int r = 0; r < 4; ++r) { const int i = MM_ROW(8, q, r);
                        float s1 = oi[q][r], s2 = oi[q][r] * oi[q][r];
#pragma unroll
                        for (int o = 1; o < 16; o <<= 1) { s1 += __shfl_xor(s1, o); s2 += __shfl_xor(s2, o); }
                        if (fr == 0) { rStat[(i * 8 + wave) * 2] = s1; rStat[(i * 8 + wave) * 2 + 1] = s2; } }
                __syncthreads();
#pragma unroll
                for (int q = 0; q < 4; ++q)
#pragma unroll
                    for (int r = 0; r < 4; ++r) { const int i = MM_ROW(8, q, r), e = MM_COL(8, q);
                        float s1 = 0.f, s2 = 0.f;
#pragma unroll
                        for (int w = 0; w < 8; ++w) { s1 += rStat[(i * 8 + w) * 2]; s2 += rStat[(i * 8 + w) * 2 + 1]; }
                        const float mu = s1 * (1.0f / 128.0f); float var = s2 * (1.0f / 128.0f) - mu * mu; var = var < 0.f ? 0.f : var;
                        const float y = (oi[q][r] - mu) * rsqrtf(var + EPS);
                        const float gate = bf2f(ACTB[(row0 + i) * EVEN_IN + RGATE_OFF + 128 * h + e]);
                        const float yo = y * args.in[5][128 * h + e] * (gate / (1.0f + __expf(-gate)));
                        ACTA[(row0 + i) * D + 128 * h + e] = (bf16)f2bf(yo); }
#pragma unroll
                for (int q = 0; q < 8; ++q) st[q] = st[q] * g64;
                mm_lds<128, 128, 64, true>(rVT, LT, rKdT, LT, st, wave, lane);
            }
        }
    }
    SEAM(3);

    if (IN(4)) {
        pg8::DenseSched S; S.init(ACTA, (const bf16*)(ws + WT_OUT0), M, D, D, G, bid);
        pg8::EpiResF32 E{args.in[0], out, D};
        pg8::gemm_phase<pg8::EpiResF32, pg8::DenseSched, false>(scrb, D, S, E);
    }
    SEAM(4);
    if (IN(5)) { for (int m = gw; m < M; m += NGW) rms_row_bf16(out + (size_t)m * D, args.in[2], ACTA + (size_t)m * D, lane); }
    SEAM(5);
    if (IN(6)) {
        pg8::DenseSched S; S.init(ACTA, (const bf16*)(ws + WT_GU0), M, 2 * D_FF, D, G, bid);
        pg8::EpiSwiGLU E{ACTB, D_FF};
        pg8::gemm_phase<pg8::EpiSwiGLU, pg8::DenseSched, false>(scrb, D, S, E);
    }
    SEAM(6);
    if (IN(7)) {
        pg8::DenseSched S; S.init(ACTB, (const bf16*)(ws + WT_DN0), M, D, D_FF, G, bid);
        pg8::EpiResF32 E{out, out, D};
        pg8::gemm_phase<pg8::EpiResF32, pg8::DenseSched, false>(scrb, D_FF, S, E);
    }
    SEAM(7);
    if (IN(8)) { for (int m = gw; m < M; m += NGW) rms_row_bf16(out + (size_t)m * D, args.in[1] + D, ACTA + (size_t)m * D, lane); }
    SEAM(8);
    if (IN(9)) {
        pg8::DenseSched S; S.init(ACTA, (const bf16*)(ws + WT_IN1), M, ODD_IN, D, G, bid);
        pg8::EpiStoreBf16 E{ACTB, ODD_IN};
        pg8::gemm_phase<pg8::EpiStoreBf16, pg8::DenseSched, false>(scrb, D, S, E);
    }
    SEAM(9);

    float* const LSUM = (float*)(ws + WS_SCR);
#pragma unroll
    for (int pass = 0; pass < 2; ++pass) {
        if (IN(10 + pass)) {
            LAS bf16* const XR = (LAS bf16*)(scrb + wave * 17408);
            LAS float* const AB = (LAS float*)(scrb + wave * 17408 + 9216);
            const int head = wave, ch = 64 * head + lane;
            bf16x8 Bwa[4][2], Bwx[4][2];
#pragma unroll
            for (int tj = 0; tj < 4; ++tj)
#pragma unroll
                for (int ks = 0; ks < 2; ++ks) { bf16x8 va, vx;
#pragma unroll
                    for (int e = 0; e < 8; ++e) { const int i = 32 * ks + 8 * fq + e, j = 16 * tj + fr; va[e] = (short)f2bf(args.in[14][(size_t)(head * 64 + i) * 64 + j]); vx[e] = (short)f2bf(args.in[16][(size_t)(head * 64 + i) * 64 + j]); }
                    Bwa[tj][ks] = va; Bwx[tj][ks] = vx; }
            float cba[4], cbx[4], csp[4];
#pragma unroll
            for (int tj = 0; tj < 4; ++tj) { const int c = 64 * head + 16 * tj + fr; cba[tj] = args.in[15][c]; cbx[tj] = args.in[17][c]; csp[tj] = log1pf(__expf(-args.in[18][c])); }
            const float cw0 = args.in[12][ch], cw1 = args.in[12][512 + ch], cw2 = args.in[12][1024 + ch], cw3 = args.in[12][1536 + ch], cbias = args.in[13][ch];
            for (int it = bid; it < NB * 64; it += G) {
                const int b = it >> 6, c = it & 63; const size_t row0 = (size_t)b * SEQ + 64 * c;
                { float x0 = 0.f, x1 = 0.f, x2 = 0.f;
                  if (c > 0) { x0 = bf2f(ACTB[(row0 - 3) * ODD_IN + XR_OFF + ch]); x1 = bf2f(ACTB[(row0 - 2) * ODD_IN + XR_OFF + ch]); x2 = bf2f(ACTB[(row0 - 1) * ODD_IN + XR_OFF + ch]); }
                  for (int t = 0; t < 64; ++t) { const float x3 = bf2f(ACTB[(row0 + t) * ODD_IN + XR_OFF + ch]);
                      XR[t * LT + lane] = (bf16)f2bf(cw0 * x0 + cw1 * x1 + cw2 * x2 + cw3 * x3 + cbias); x0 = x1; x1 = x2; x2 = x3; } }
                float hst = 0.f, cum = 1.f;
                if (pass == 1) {
                    for (int c0 = 0; c0 < c; c0 += 8) {
                        f32x2 sv[8];
#pragma unroll
                        for (int k = 0; k < 8; ++k) { const int cc = (c0 + k < c) ? c0 + k : c0; sv[k] = ((const f32x2*)LSUM)[(size_t)(b * 64 + cc) * 512 + ch]; }
#pragma unroll
                        for (int k = 0; k < 8; ++k) if (c0 + k < c) hst = sv[k].x * hst + sv[k].y;
                    }
                }
                LDS_WAIT(); asm volatile("" ::: "memory");
                for (int sb = 0; sb < 4; ++sb) {
                    f32x4 aR[4], aX[4];
#pragma unroll
                    for (int tj = 0; tj < 4; ++tj) { aR[tj] = (f32x4){0.f, 0.f, 0.f, 0.f}; aX[tj] = aR[tj]; }
#pragma unroll
                    for (int ks = 0; ks < 2; ++ks) { const bf16x8 af = *(const LAS bf16x8*)(XR + (16 * sb + fr) * LT + 32 * ks + 8 * fq);
#pragma unroll
                        for (int tj = 0; tj < 4; ++tj) { aR[tj] = __builtin_amdgcn_mfma_f32_16x16x32_bf16(af, Bwa[tj][ks], aR[tj], 0, 0, 0); aX[tj] = __builtin_amdgcn_mfma_f32_16x16x32_bf16(af, Bwx[tj][ks], aX[tj], 0, 0, 0); } }
#pragma unroll
                    for (int tj = 0; tj < 4; ++tj)
#pragma unroll
                        for (int r = 0; r < 4; ++r) { const int tl = 4 * fq + r, j = 16 * tj + fr;
                            const float rg = sigmoidf_(aR[tj][r] + cba[tj]), ig = sigmoidf_(aX[tj][r] + cbx[tj]);
                            const float la = -8.0f * rg * csp[tj]; const float a = __expf(la); const float mult = sqrtf(-expm1f(2.0f * la));
                            const float xv = bf2f(XR[(16 * sb + tl) * LT + j]);
                            AB[tl * 64 + j] = a; AB[1024 + tl * 64 + j] = mult * ig * xv; }
                    LDS_WAIT(); asm volatile("" ::: "memory");
                    for (int tl = 0; tl < 16; ++tl) { const float a = AB[tl * 64 + lane], bb = AB[1024 + tl * 64 + lane]; hst = a * hst + bb; cum *= a;
                        if (pass == 1) { const size_t row = row0 + 16 * sb + tl; const float xg = bf2f(ACTB[row * ODD_IN + XG_OFF + ch]);
                            const float u3 = 0.7978845608028654f * (xg + 0.044715f * xg * xg * xg); const float th = 1.0f - 2.0f / (1.0f + __expf(2.0f * u3));
                            ACTA[row * D + 512 + ch] = (bf16)f2bf(hst * 0.5f * xg * (1.0f + th)); } }
                    LDS_WAIT(); asm volatile("" ::: "memory");
                }
                if (pass == 0) { f32x2 sv; sv.x = cum; sv.y = hst; ((f32x2*)LSUM)[(size_t)(b * 64 + c) * 512 + ch] = sv; }
            }
            if (pass == 1) {
                for (int idx = bid * 512 + tid; idx < M * 64; idx += G * 512) {
                    const int row = idx >> 6, c8 = (idx & 63) * 8; const int t = row & (SEQ - 1);
                    const bf16* p = ACTB + (size_t)row * ODD_IN;
                    float acc8[8];
#pragma unroll
                    for (int x = 0; x < 8; ++x) acc8[x] = 0.f;
#pragma unroll
                    for (int k = 0; k < 3; ++k) { const int dt = 2 - k; if (t - dt >= 0) { const bf16* pr = p - (size_t)dt * ODD_IN;
                            const u32x4 gc = *(const u32x4*)(pr + CC_OFF + c8), uu = *(const u32x4*)(pr + CU_OFF + c8); const unsigned gw_[4] = {gc.x, gc.y, gc.z, gc.w}, uw[4] = {uu.x, uu.y, uu.z, uu.w};
#pragma unroll
                            for (int x = 0; x < 4; ++x) { acc8[2 * x] += args.in[11][k * 512 + c8 + 2 * x] * bf2f(gw_[x]) * bf2f(uw[x]); acc8[2 * x + 1] += args.in[11][k * 512 + c8 + 2 * x + 1] * bf2f(gw_[x] >> 16) * bf2f(uw[x] >> 16); } } }
                    const u32x4 gb = *(const u32x4*)(p + CB_OFF + c8); const unsigned gbw[4] = {gb.x, gb.y, gb.z, gb.w};
                    u32x4 w; unsigned ww[4];
#pragma unroll
                    for (int x = 0; x < 4; ++x) ww[x] = pk2(bf2f(gbw[x]) * acc8[2 * x], bf2f(gbw[x] >> 16) * acc8[2 * x + 1]);
                    w.x = ww[0]; w.y = ww[1]; w.z = ww[2]; w.w = ww[3];
                    *(u32x4*)(ACTA + (size_t)row * D + c8) = w;
                }
            }
        }
        SEAM(10 + pass);
    }

    if (IN(12)) {
        pg8::DenseSched S; S.init(ACTA, (const bf16*)(ws + WT_OUT1), M, D, D, G, bid);
        pg8::EpiResF32 E{out, out, D};
        pg8::gemm_phase<pg8::EpiResF32, pg8::DenseSched, false>(scrb, D, S, E);
    }
    SEAM(12);

    int* const LTOK = (int*)(ws + SCR_LTOK); float* const LW = (float*)(ws + SCR_LW);
    if (IN(13)) {
        LAS int* const lcnt = (LAS int*)(scrb);
        LAS int* const lbase = (LAS int*)(scrb + 64);
        LAS int* const recE = (LAS int*)(scrb + 128);
        LAS int* const recR = (LAS int*)(scrb + 128 + 1024);
        LAS float* const recW = (LAS float*)(scrb + 128 + 2048);
        float wr_[4][4][8];
#pragma unroll
        for (int j = 0; j < 4; ++j)
#pragma unroll
            for (int x = 0; x < 4; ++x) { const int col = 4 * (lane + 64 * j) + x; const f32x4 w0 = *(const f32x4*)(args.in[20] + (size_t)col * 8), w1 = *(const f32x4*)(args.in[20] + (size_t)col * 8 + 4);
                wr_[j][x][0] = w0.x; wr_[j][x][1] = w0.y; wr_[j][x][2] = w0.z; wr_[j][x][3] = w0.w; wr_[j][x][4] = w1.x; wr_[j][x][5] = w1.y; wr_[j][x][6] = w1.z; wr_[j][x][7] = w1.w; }
        for (int base = bid * 128; base < M; base += G * 128) {
            if (tid < 16) lcnt[tid] = 0;
            __syncthreads();
            for (int rr = 0; rr < 16; ++rr) {
                const int lr = wave * 16 + rr, m = base + lr;
                const f32x4* xr = (const f32x4*)(out + (size_t)m * D) + lane; const f32x4* gr = (const f32x4*)(args.in[2] + D) + lane;
                f32x4 v[4]; float s = 0.f;
#pragma unroll
                for (int j = 0; j < 4; ++j) { v[j] = xr[64 * j]; s += (v[j].x * v[j].x + v[j].y * v[j].y) + (v[j].z * v[j].z + v[j].w * v[j].w); }
                const float rstd = rsqrtf(wave_sum(s) * (1.f / D) + EPS);
                float lg[8];
#pragma unroll
                for (int e = 0; e < 8; ++e) lg[e] = 0.f;
                u32x2* o8 = (u32x2*)(ACTA + (size_t)m * D) + lane;
#pragma unroll
                for (int j = 0; j < 4; ++j) { const f32x4 gv = gr[64 * j]; float y[4] = {v[j].x * rstd * gv.x, v[j].y * rstd * gv.y, v[j].z * rstd * gv.z, v[j].w * rstd * gv.w};
                    u32x2 w; w.x = pk2(y[0], y[1]); w.y = pk2(y[2], y[3]); o8[64 * j] = w;
#pragma unroll
                    for (int x = 0; x < 4; ++x)
#pragma unroll
                        for (int e = 0; e < 8; ++e) lg[e] += y[x] * wr_[j][x][e]; }
#pragma unroll
                for (int e = 0; e < 8; ++e) lg[e] = wave_sum(lg[e]) + args.in[21][e];
                int e1 = 0; float l1 = lg[0];
#pragma unroll
                for (int e = 1; e < 8; ++e) if (lg[e] > l1) { l1 = lg[e]; e1 = e; }
                int e2 = -1; float l2 = -3.0e38f;
#pragma unroll
                for (int e = 0; e < 8; ++e) if (e != e1 && lg[e] > l2) { l2 = lg[e]; e2 = e; }
                const float w2 = 1.0f / (1.0f + __expf(l1 - l2)), w1 = 1.0f - w2;
                if (lane == 0) { recE[lr * 2] = e1; recE[lr * 2 + 1] = e2; recW[lr * 2] = w1; recW[lr * 2 + 1] = w2;
                    recR[lr * 2] = __hip_atomic_fetch_add(&lcnt[e1], 1, __ATOMIC_RELAXED, __HIP_MEMORY_SCOPE_WORKGROUP); recR[lr * 2 + 1] = __hip_atomic_fetch_add(&lcnt[8 + e2], 1, __ATOMIC_RELAXED, __HIP_MEMORY_SCOPE_WORKGROUP); }
            }
            __syncthreads();
            if (tid < 16) lbase[tid] = (int)__hip_atomic_fetch_add(ctl + CW_CNT + 64 * tid, (unsigned)lcnt[tid], RLX_AGENT);
            __syncthreads();
            if (tid < 256) { const int lr = tid >> 1, k = tid & 1; const int e = recE[tid]; const int pos = lbase[k * 8 + e] + recR[tid];
                if (pos < LIST_CAP) { LTOK[(size_t)(k * 8 + e) * LIST_CAP + pos] = base + lr; LW[(size_t)(k * 8 + e) * LIST_CAP + pos] = recW[tid]; } }
            __syncthreads();
        }
    }
    SEAM(13);

#pragma unroll
    for (int k = 0; k < 2; ++k) {
        if (IN(14 + 2 * k)) {
            pg8::MoeSched S; S.init(ACTA, (const bf16*)(ws + WT_GU1), LTOK + (size_t)k * 8 * LIST_CAP, ctl + CW_CNT + 64 * 8 * k, 2 * D_EXP / 256, D, 0, (size_t)2 * D_EXP * D * 2, G, bid);
            pg8::EpiSwiGLU E{ACTB, D_EXP};
            pg8::gemm_phase<pg8::EpiSwiGLU, pg8::MoeSched, true>(scrb, D, S, E);
        }
        SEAM(14 + 2 * k);
        if (IN(15 + 2 * k)) {
            pg8::MoeSched S; S.init(ACTB, (const bf16*)(ws + WT_DN1), LTOK + (size_t)k * 8 * LIST_CAP, ctl + CW_CNT + 64 * 8 * k, D / 256, D_EXP, (size_t)256 * D_EXP * 2, (size_t)D * D_EXP * 2, G, bid);
            pg8::EpiMoeDown E{out, LTOK + (size_t)k * 8 * LIST_CAP, LW + (size_t)k * 8 * LIST_CAP};
            pg8::gemm_phase<pg8::EpiMoeDown, pg8::MoeSched, false>(scrb, D_EXP, S, E);
        }
        SEAM(15 + 2 * k);
    }

    if (IN(18)) {
        for (int m = gw; m < M; m += NGW) {
            f32x4* xr = (f32x4*)(out + (size_t)m * D) + lane; const f32x4* gr = (const f32x4*)args.in[3] + lane;
            f32x4 v[4]; float s = 0.f;
#pragma unroll
            for (int j = 0; j < 4; ++j) { v[j] = xr[64 * j]; s += (v[j].x * v[j].x + v[j].y * v[j].y) + (v[j].z * v[j].z + v[j].w * v[j].w); }
            const float rstd = rsqrtf(wave_sum(s) * (1.f / D) + EPS);
#pragma unroll
            for (int j = 0; j < 4; ++j) { const f32x4 gv = gr[64 * j]; xr[64 * j] = v[j] * rstd * gv; }
        }
    }
#undef IN
#undef SEAM
}

extern "C" void kernel_launch(void* const* d_in, const int* in_sizes, int n_in, void* d_out, int out_size, void* d_ws, size_t ws_size, hipStream_t stream) {
    static int grid = 0;
    if (grid == 0) {
        if (n_in != 25 || in_sizes[0] != M * D || out_size != M * D || ws_size < WS_END) { fprintf(stderr, "kernel_launch: unexpected shapes / workspace (n_in %d, ws %zu, need %zu)\n", n_in, ws_size, (size_t)WS_END); grid = -1; return; }
        int dev = 0, cus = 0, per_cu = 0;
        if (hipGetDevice(&dev) != hipSuccess || hipDeviceGetAttribute(&cus, hipDeviceAttributeMultiprocessorCount, dev) != hipSuccess) { grid = -1; return; }
        if (hipFuncSetAttribute((const void*)fwd_kernel, hipFuncAttributeMaxDynamicSharedMemorySize, LDS_BYTES) != hipSuccess) { fprintf(stderr, "kernel_launch: hipFuncSetAttribute failed\n"); grid = -1; return; }
        if (hipOccupancyMaxActiveBlocksPerMultiprocessor(&per_cu, (const void*)fwd_kernel, 512, LDS_BYTES) != hipSuccess || per_cu < 1) { fprintf(stderr, "kernel_launch: occupancy query says %d\n", per_cu); }
        (void)hipGetLastError();
        grid = cus;
    }
    if (grid < 0) return;
    if (hipMemsetAsync((char*)d_ws + WS_CTL, 0, CTL_ZERO_BYTES, stream) != hipSuccess) return;
    Args a{};
    for (int i = 0; i < 25; ++i) a.in[i] = (const float*)d_in[i];
    a.out = (float*)d_out; a.ws = (unsigned char*)d_ws;
#if MK_N_LAUNCHES == 1
    a.ph_lo = 0; a.ph_hi = NPHASE;
    hipLaunchKernelGGL(fwd_kernel, dim3(grid), dim3(512), LDS_BYTES, stream, a);
#else
    for (int p = 0; p < NPHASE; ++p) { a.ph_lo = p; a.ph_hi = p + 1; hipLaunchKernelGGL(fwd_kernel, dim3(grid), dim3(512), LDS_BYTES, stream, a); }
#endif
}
```

```cpp
#include <hip/hip_runtime.h>
#include <cstdio>
#include <cstdint>

#ifndef MK_N_LAUNCHES
#define MK_N_LAUNCHES 1
#endif

#define GAS __attribute__((address_space(1)))
#define LAS __attribute__((address_space(3)))
typedef unsigned short bf16;
typedef short bf16x8 __attribute__((ext_vector_type(8)));
typedef float f32x4 __attribute__((ext_vector_type(4)));
typedef float f32x2 __attribute__((ext_vector_type(2)));
typedef unsigned u32x4 __attribute__((ext_vector_type(4)));
typedef unsigned u32x2 __attribute__((ext_vector_type(2)));

constexpr int D = 1024, NB = 8, SEQ = 4096, M = NB * SEQ;
constexpr int EVEN_IN = 3584, ODD_IN = 2560, D_FF = 2816, D_EXP = 3584, NEXP = 8;
constexpr int RQ_OFF = 0, RK_OFF = 512, RV_OFF = 1024, RGATE_OFF = 1536, SQ_OFF = 2048, SK_OFF = 2560, SV_OFF = 3072;
constexpr int CB_OFF = 0, CC_OFF = 512, CU_OFF = 1024, XR_OFF = 1536, XG_OFF = 2048;
constexpr float EPS = 1e-6f;
constexpr int LIST_CAP = 32768;
constexpr int MAX_TILES = 135;

constexpr size_t MiB = 1u << 20;
constexpr size_t WS_CTL = 0, CTL_ZERO_BYTES = 1 * MiB;
constexpr size_t WS_ROT = 1 * MiB;
constexpr size_t WS_SCR = 3 * MiB;
constexpr size_t WS_WB = 19 * MiB;
constexpr size_t WT_IN0 = WS_WB;
constexpr size_t WT_OUT0 = WT_IN0 + (size_t)EVEN_IN * D * 2;
constexpr size_t WT_GU0 = WT_OUT0 + (size_t)D * D * 2;
constexpr size_t WT_DN0 = WT_GU0 + (size_t)2 * D_FF * D * 2;
constexpr size_t WT_IN1 = WT_DN0 + (size_t)D * D_FF * 2;
constexpr size_t WT_OUT1 = WT_IN1 + (size_t)ODD_IN * D * 2;
constexpr size_t WT_GU1 = WT_OUT1 + (size_t)D * D * 2;
constexpr size_t WT_DN1 = WT_GU1 + (size_t)NEXP * 2 * D_EXP * D * 2;
constexpr size_t WB_END = WT_DN1 + (size_t)NEXP * D * D_EXP * 2;
constexpr size_t WS_ACTA = 220 * MiB;
constexpr size_t WS_ACTB = 284 * MiB;
constexpr size_t WS_END = WS_ACTB + (size_t)MAX_TILES * 256 * D_EXP * 2;
static_assert(WB_END <= WS_ACTA, "weights overlap");
static_assert((size_t)M * EVEN_IN * 2 <= (size_t)MAX_TILES * 256 * D_EXP * 2, "ACTB size");
constexpr size_t SCR_LTOK = WS_SCR, SCR_LW = WS_SCR + 2 * MiB;
constexpr int CW_BAR = 4096;
constexpr int CW_CNT = 8192;

constexpr int LDS_MISC = 0;
constexpr int LDS_SCR = 256;
constexpr int LDS_BYTES = 147456;

#define RLX_AGENT __ATOMIC_RELAXED, __HIP_MEMORY_SCOPE_AGENT
#define LDS_WAIT() asm volatile("s_waitcnt lgkmcnt(0)" ::: "memory")
__device__ __forceinline__ unsigned f2bf(float f) { unsigned u = __builtin_bit_cast(unsigned, f); return (u + 0x7fffu + ((u >> 16) & 1u)) >> 16; }
__device__ __forceinline__ unsigned pk2(float lo, float hi) { return f2bf(lo) | (f2bf(hi) << 16); }
__device__ __forceinline__ float bf2f(unsigned b) { return __builtin_bit_cast(float, (b & 0xffffu) << 16); }
__device__ __forceinline__ float wave_sum(float v) {
#pragma unroll
    for (int o = 1; o < 64; o <<= 1) v += __shfl_xor(v, o);
    return v;
}
__device__ __forceinline__ float sigmoidf_(float x) { return 1.0f / (1.0f + __expf(-x)); }

#define XB_TMO      128
#define XB_XCNT(j)  (256  + 64 * (j))
#define XB_XSUB(j)  (1280 + 64 * (j))
#define XB_XGEN(j)  (2304 + 64 * (j))
#define XB_TOP      3328
#define XB_TOPGEN   3392
#define XCD_BAR_WORDS 3456
#define XB_SPIN_CAP (1u << 18)

__device__ __forceinline__ unsigned xb_ld(unsigned* p)              { return __hip_atomic_load(p, __ATOMIC_RELAXED, __HIP_MEMORY_SCOPE_AGENT); }
__device__ __forceinline__ unsigned xb_add(unsigned* p, unsigned v) { return __hip_atomic_fetch_add(p, v, __ATOMIC_RELAXED, __HIP_MEMORY_SCOPE_AGENT); }
__device__ __forceinline__ unsigned xb_xcc_id() { return (unsigned)__builtin_amdgcn_s_getreg((3 << 11) | 20) & 0xFu; }
#define XB_SPIN(cond, bar) do { unsigned _sp = 0; while (cond) { __builtin_amdgcn_s_sleep(1); \
    if ((++_sp & 255u) == 0u) { if (xb_ld(&(bar)[XB_TMO])) break; if (_sp > XB_SPIN_CAP) { atomicAdd(&(bar)[XB_TMO], 1u); break; } } } } while (0)

struct XcdBarrier { unsigned* bar; unsigned x; volatile LAS unsigned* st; };

__device__ __forceinline__ XcdBarrier xcd_barrier_post(unsigned* bar, volatile LAS unsigned* st) {
    XcdBarrier b; b.bar = bar; b.x = xb_xcc_id(); b.st = st;
    if (threadIdx.x == 0) (void)xb_add(&bar[XB_XCNT(b.x)], 1u);
    return b;
}
__device__ __forceinline__ void xcd_barrier_complete(unsigned* bar, unsigned x, unsigned& nloc, unsigned& nx) {
    const unsigned G = gridDim.x * gridDim.y * gridDim.z;
    unsigned sum, cnt, mine, sp = 0u;
    for (;;) {
        sum = 0u; cnt = 0u; mine = 0u;
#pragma unroll
        for (unsigned j = 0; j < 16; ++j) { const unsigned c = xb_ld(&bar[XB_XCNT(j)]); sum += c; cnt += (c > 0u) ? 1u : 0u; mine = (j == x) ? c : mine; }
        if (sum == G) break;
        __builtin_amdgcn_s_sleep(1);
        if ((++sp & 255u) == 0u) { if (xb_ld(&bar[XB_TMO])) break; if (sp > XB_SPIN_CAP) { atomicAdd(&bar[XB_TMO], 1u); break; } }
    }
    nloc = mine > 0u ? mine : 1u; nx = cnt > 0u ? cnt : 1u;
}
__device__ __forceinline__ void xcd_barrier(const XcdBarrier& b) {
    asm volatile("s_waitcnt vmcnt(0)" ::: "memory");
    __syncthreads();
    if (threadIdx.x == 0) {
        unsigned* bar = b.bar;
        __builtin_amdgcn_s_waitcnt(0);
        unsigned nloc = b.st[0], nx = b.st[1];
        if (nloc == 0u) { xcd_barrier_complete(bar, b.x, nloc, nx); b.st[0] = nloc; b.st[1] = nx; }
        const unsigned old = xb_add(&bar[XB_XSUB(b.x)], 1u);
        const unsigned gen = old / nloc;
        if (old + 1u == (gen + 1u) * nloc) {
            __builtin_amdgcn_fence(__ATOMIC_RELEASE, "agent");
            asm volatile("s_waitcnt vmcnt(0)" ::: "memory");
            const unsigned og = xb_add(&bar[XB_TOP], 1u);
            const unsigned tg = og / nx;
            if (og + 1u == (tg + 1u) * nx) xb_add(&bar[XB_TOPGEN], 1u);
            else XB_SPIN(xb_ld(&bar[XB_TOPGEN]) == tg, bar);
            __builtin_amdgcn_fence(__ATOMIC_ACQUIRE, "agent");
            xb_add(&bar[XB_XGEN(b.x)], 1u);
            asm volatile("s_waitcnt vmcnt(0)" ::: "memory");
        } else {
            XB_SPIN(xb_ld(&bar[XB_XGEN(b.x)]) == gen, bar);
            __builtin_amdgcn_fence(__ATOMIC_ACQUIRE, "agent");
            asm volatile("s_waitcnt vmcnt(0)" ::: "memory");
        }
    }
    __syncthreads();
}

namespace pg8 {
constexpr int BM = 256, BK = 64, HALF = 128, HTB = HALF * BK * 2, STAGE_BYTES = 8 * HTB, NXCD = 8, WGM = 8;
__device__ __forceinline__ int lds_byte(int r, int c) { const int st = (r >> 4) * 2 + (c >> 5), rr = r & 15, cc = c & 31, ob = rr * 64 + cc * 2; return st * 1024 + (ob ^ (((ob >> 9) & 1) << 5)); }
__device__ __forceinline__ void stage_rc(int b, int& R, int& C) { const int st = b / 1024, sb = b % 1024, swz = sb ^ (((sb >> 9) & 1) << 5); R = (st >> 1) * 16 + swz / 64; C = (st & 1) * 32 + (swz % 64) / 2; }
__device__ __forceinline__ int perm32(int rho) { const int n = rho >> 4, i = rho & 15; return 8 * (i >> 2) + 4 * n + (i & 3); }

struct Unit { int pm, pn, e, lt, cn; };

struct StaticOrder {
    int nM, nN, nwg, G, c;
    __device__ __forceinline__ void init_tiles(int nM_, int nN_, int G_, int c_) { nM = nM_; nN = nN_; nwg = nM * nN; G = G_; c = c_; }
    __device__ __forceinline__ bool next_tile(int i, int& pm, int& pn) const {
        const long L = (long)i * G + c; if (L >= nwg) return false;
        int wgid = (int)L; { const int q = nwg / NXCD, r = nwg % NXCD, xcd = wgid % NXCD, off = wgid / NXCD; wgid = (xcd < r ? xcd * (q + 1) : r * (q + 1) + (xcd - r) * q) + off; }
        const int nig = WGM * nN, gid = wgid / nig, fm = gid * WGM, gsz = (nM - fm) < WGM ? (nM - fm) : WGM;
        pm = fm + ((wgid % nig) % gsz); pn = (wgid % nig) / gsz; return true;
    }
};
struct DenseSched : StaticOrder {
    const char* A; const char* Bt; size_t tstep;
    __device__ __forceinline__ void init(const bf16* A_, const bf16* Bt_, int Mr, int N, int K, int G_, int c_) { A = (const char*)A_; Bt = (const char*)Bt_; tstep = (size_t)BM * K * 2; init_tiles(Mr / BM, N / BM, G_, c_); }
    __device__ __forceinline__ bool next(int i, Unit& u) const { u.e = 0; u.lt = 0; u.cn = 0; return next_tile(i, u.pm, u.pn); }
    __device__ __forceinline__ const char* a_base(const Unit& u) const { return A + (size_t)u.pm * tstep; }
    __device__ __forceinline__ const char* b_base(const Unit& u) const { return Bt + (size_t)u.pn * tstep; }
    __device__ __forceinline__ void a_rows(const Unit&, const int (&)[2], const int (&)[2], unsigned (&)[2][2]) const {}
};
struct MoeSched : StaticOrder {
    const char* A; const char* Bt; size_t a_tstep, b_estep, b_tstep; const int* ltok; int c0, c1, c2, c3, c4, c5, c6, c7, t1, t2, t3, t4, t5, t6, t7; int K;
    __device__ __forceinline__ static int ldc_(const unsigned* cntw, int e) { int c = (int)__builtin_amdgcn_readfirstlane(__hip_atomic_load(cntw + 64 * e, RLX_AGENT)); return c > LIST_CAP ? LIST_CAP : c; }
    __device__ __forceinline__ void init(const bf16* A_, const bf16* Bt_, const int* ltok_, const unsigned* cntw, int nN_, int K_, size_t a_tstep_, size_t b_estep_, int G_, int c_) {
        A = (const char*)A_; Bt = (const char*)Bt_; ltok = ltok_; K = K_; a_tstep = a_tstep_; b_estep = b_estep_; b_tstep = (size_t)BM * K_ * 2;
        c0 = ldc_(cntw, 0); c1 = ldc_(cntw, 1); c2 = ldc_(cntw, 2); c3 = ldc_(cntw, 3); c4 = ldc_(cntw, 4); c5 = ldc_(cntw, 5); c6 = ldc_(cntw, 6); c7 = ldc_(cntw, 7);
        t1 = (c0 + 255) >> 8; t2 = t1 + ((c1 + 255) >> 8); t3 = t2 + ((c2 + 255) >> 8); t4 = t3 + ((c3 + 255) >> 8); t5 = t4 + ((c4 + 255) >> 8); t6 = t5 + ((c5 + 255) >> 8); t7 = t6 + ((c6 + 255) >> 8);
        init_tiles(t7 + ((c7 + 255) >> 8), nN_, G_, c_);
    }
    __device__ __forceinline__ bool next(int i, Unit& u) const {
        if (!next_tile(i, u.pm, u.pn)) return false;
        const int pm = u.pm;
        const int m1 = pm >= t1, m2 = pm >= t2, m3 = pm >= t3, m4 = pm >= t4, m5 = pm >= t5, m6 = pm >= t6, m7 = pm >= t7;
        const int e = m1 + m2 + m3 + m4 + m5 + m6 + m7;
        const int base = m1 * t1 + m2 * (t2 - t1) + m3 * (t3 - t2) + m4 * (t4 - t3) + m5 * (t5 - t4) + m6 * (t6 - t5) + m7 * (t7 - t6);
        const int cn = c0 + m1 * (c1 - c0) + m2 * (c2 - c1) + m3 * (c3 - c2) + m4 * (c4 - c3) + m5 * (c5 - c4) + m6 * (c6 - c5) + m7 * (c7 - c6);
        u.e = e; u.lt = pm - base; u.cn = cn; return true;
    }
    __device__ __forceinline__ const char* a_base(const Unit& u) const { return A + (size_t)u.pm * a_tstep; }
    __device__ __forceinline__ const char* b_base(const Unit& u) const { return Bt + (size_t)u.e * b_estep + (size_t)u.pn * b_tstep; }
    __device__ __forceinline__ void a_rows(const Unit& u, const int (&R)[2], const int (&C)[2], unsigned (&off)[2][2]) const {
#pragma unroll
        for (int h = 0; h < 2; ++h)
#pragma unroll
            for (int i = 0; i < 2; ++i) { int rank = u.lt * 256 + h * HALF + R[i]; rank = rank < u.cn ? rank : u.cn - 1;
                const int tok = ltok[(size_t)u.e * LIST_CAP + rank]; off[h][i] = (unsigned)tok * (unsigned)(K * 2) + (unsigned)(C[i] * 2); }
    }
};

__device__ __forceinline__ unsigned cvt_pk_bf16(float lo, float hi) { unsigned r; asm volatile("v_cvt_pk_bf16_f32 %0, %1, %2" : "=v"(r) : "v"(lo), "v"(hi)); return r; }

struct EpiStoreBf16 {
    static constexpr bool PERM = true;
    bf16* O; int ldc;
    __device__ __forceinline__ void operator()(const f32x4 (&acc)[2][2][4][2], const Unit& u, int wr, int wc, int fr, int fq) const {
        const int row0 = u.pm * BM + wr * 64 + fr, col0 = u.pn * BM + wc * 32 + 8 * fq;
#pragma unroll
        for (int ai = 0; ai < 2; ++ai)
#pragma unroll
            for (int m = 0; m < 4; ++m) { bf16* rowp = O + (size_t)(row0 + ai * HALF + m * 16) * ldc + col0;
#pragma unroll
                for (int bj = 0; bj < 2; ++bj) { const f32x4 v0 = acc[ai][bj][m][0], v1 = acc[ai][bj][m][1];
                    u32x4 w; w.x = cvt_pk_bf16(v0[0], v0[1]); w.y = cvt_pk_bf16(v0[2], v0[3]); w.z = cvt_pk_bf16(v1[0], v1[1]); w.w = cvt_pk_bf16(v1[2], v1[3]);
                    *(u32x4*)(rowp + bj * HALF) = w; } }
    }
};
struct EpiResF32 {
    static constexpr bool PERM = false;
    const float* base; float* out; int ldc;
    __device__ __forceinline__ void operator()(const f32x4 (&acc)[2][2][4][2], const Unit& u, int wr, int wc, int fr, int fq) const {
        const int row0 = u.pm * BM + wr * 64 + fr, col0 = u.pn * BM + wc * 32 + 4 * fq;
#pragma unroll
        for (int ai = 0; ai < 2; ++ai)
#pragma unroll
            for (int m = 0; m < 4; ++m) { const size_t off = (size_t)(row0 + ai * HALF + m * 16) * ldc + col0;
#pragma unroll
                for (int bj = 0; bj < 2; ++bj)
#pragma unroll
                    for (int n = 0; n < 2; ++n) { const f32x4 bs = *(const f32x4*)(base + off + bj * HALF + n * 16); *(f32x4*)(out + off + bj * HALF + n * 16) = bs + acc[ai][bj][m][n]; } }
    }
};
struct EpiSwiGLU {
    static constexpr bool PERM = true;
    bf16* H; int ldh;
    __device__ __forceinline__ void operator()(const f32x4 (&acc)[2][2][4][2], const Unit& u, int wr, int wc, int fr, int fq) const {
        const int row0 = u.pm * BM + wr * 64 + fr, col0 = u.pn * HALF + wc * 32 + 8 * fq;
#pragma unroll
        for (int ai = 0; ai < 2; ++ai)
#pragma unroll
            for (int m = 0; m < 4; ++m) { bf16* rowp = H + (size_t)(row0 + ai * HALF + m * 16) * ldh + col0;
                float h[8];
#pragma unroll
                for (int n = 0; n < 2; ++n)
#pragma unroll
                    for (int x = 0; x < 4; ++x) { const float g = acc[ai][0][m][n][x], up = acc[ai][1][m][n][x]; h[4 * n + x] = g / (1.0f + __expf(-g)) * up; }
                u32x4 w; w.x = cvt_pk_bf16(h[0], h[1]); w.y = cvt_pk_bf16(h[2], h[3]); w.z = cvt_pk_bf16(h[4], h[5]); w.w = cvt_pk_bf16(h[6], h[7]);
                *(u32x4*)rowp = w; }
    }
};
struct EpiMoeDown {
    static constexpr bool PERM = false;
    float* out; const int* ltok; const float* lw;
    __device__ __forceinline__ void operator()(const f32x4 (&acc)[2][2][4][2], const Unit& u, int wr, int wc, int fr, int fq) const {
        const int col0 = u.pn * BM + wc * 32 + 4 * fq;
#pragma unroll
        for (int ai = 0; ai < 2; ++ai)
#pragma unroll
            for (int m = 0; m < 4; ++m) { const int rank = u.lt * 256 + ai * HALF + wr * 64 + m * 16 + fr;
                if (rank < u.cn) { const int tok = ltok[(size_t)u.e * LIST_CAP + rank]; const float w = lw[(size_t)u.e * LIST_CAP + rank]; float* rowp = out + (size_t)tok * D + col0;
#pragma unroll
                    for (int bj = 0; bj < 2; ++bj)
#pragma unroll
                        for (int n = 0; n < 2; ++n) { const f32x4 bs = *(const f32x4*)(rowp + bj * HALF + n * 16); *(f32x4*)(rowp + bj * HALF + n * 16) = bs + acc[ai][bj][m][n] * w; } } }
    }
};

template <class Epi, class Sched, bool GATHER>
__device__ __forceinline__ void gemm_phase(LAS unsigned char* lds, const int K, const Sched& S, const Epi& E) {
    const int tid = threadIdx.x, wid = __builtin_amdgcn_readfirstlane(tid >> 6), lane = tid & 63, wr = wid >> 2, wc = wid & 3, fr = lane & 15, fq = lane >> 4;
    const int nt = K / BK;
    unsigned voffA[2], voffB[2]; int Rr[2], Cc[2];
#pragma unroll
    for (int i = 0; i < 2; ++i) { int R, C; stage_rc(tid * 16 + i * 8192, R, C); const int Rb = Epi::PERM ? ((R & ~31) + perm32(R & 31)) : R;
        voffA[i] = (unsigned)(R * K + C) * 2u; voffB[i] = (unsigned)(Rb * K + C) * 2u; Rr[i] = R; Cc[i] = C; }
    const size_t kstep = (size_t)(BK * 2);
    const size_t hstep = (size_t)HALF * K * 2;
    const unsigned ldsw = (unsigned)wid * 1024u;
    const int aoff = lds_byte(wr * 64 + fr, fq * 8), boff = lds_byte(wc * 32 + fr, fq * 8);
#define PG8_SA(b, h) (((b) * 2 + (h)) * HTB)
#define PG8_SB(b, h) ((4 + (b) * 2 + (h)) * HTB)
#define PG8_STAGE(bufoff, gbase, voff) do { _Pragma("unroll") for (int _i = 0; _i < 2; ++_i) \
        __builtin_amdgcn_global_load_lds((const unsigned*)((const char*)(gbase) + (voff)[_i]), (LAS unsigned*)(lds + (bufoff) + ldsw + _i * 8192), 16, 0, 0); } while (0)
#define PG8_STAGE_A(bufoff, kptr, h) do { if constexpr (GATHER) PG8_STAGE(bufoff, kptr, gA[h]); else PG8_STAGE(bufoff, (kptr) + (h) * hstep, voffA); } while (0)
#define PG8_LDA(dst, b, h) do { _Pragma("unroll") for (int m = 0; m < 4; ++m) _Pragma("unroll") for (int k = 0; k < 2; ++k) dst[m][k] = *(const LAS bf16x8*)(lds + PG8_SA(b, h) + aoff + m * 2048 + k * 1024); } while (0)
#define PG8_LDB(dst, b, h) do { _Pragma("unroll") for (int n = 0; n < 2; ++n) _Pragma("unroll") for (int k = 0; k < 2; ++k) dst[n][k] = *(const LAS bf16x8*)(lds + PG8_SB(b, h) + boff + n * 2048 + k * 1024); } while (0)
#define PG8_MMA(ai, bj, At, Bt) do { __builtin_amdgcn_s_setprio(1); _Pragma("unroll") for (int m = 0; m < 4; ++m) _Pragma("unroll") for (int n = 0; n < 2; ++n) _Pragma("unroll") for (int k = 0; k < 2; ++k) \
        acc[ai][bj][m][n] = __builtin_amdgcn_mfma_f32_16x16x32_bf16(Bt[n][k], At[m][k], acc[ai][bj][m][n], 0, 0, 0); __builtin_amdgcn_s_setprio(0); } while (0)
#define PG8_WAIT_V(n) asm volatile("s_waitcnt vmcnt(" #n ")" ::: "memory")
#define PG8_WAIT_L(n) asm volatile("s_waitcnt lgkmcnt(" #n ")" ::: "memory")
#define PG8_BAR __builtin_amdgcn_s_barrier()
#define PG8_SCHED __builtin_amdgcn_sched_barrier(0)
    Unit cur, nxt; int ui = 0;
    if (!S.next(0, cur)) return;
    f32x4 acc[2][2][4][2];
#pragma unroll
    for (int a = 0; a < 2; ++a)
#pragma unroll
        for (int b = 0; b < 2; ++b)
#pragma unroll
            for (int m = 0; m < 4; ++m)
#pragma unroll
                for (int n = 0; n < 2; ++n) acc[a][b][m][n] = (f32x4){0.f, 0.f, 0.f, 0.f};
    bf16x8 At[4][2], B0[2][2], B1[2][2];
    const char* cA = S.a_base(cur); const char* cB = S.b_base(cur);
    unsigned gA[2][2] = {{0u, 0u}, {0u, 0u}}, gN[2][2] = {{0u, 0u}, {0u, 0u}};
    if constexpr (GATHER) S.a_rows(cur, Rr, Cc, gA);
    PG8_STAGE(PG8_SB(0, 0), cB, voffB); PG8_STAGE(PG8_SB(0, 1), cB + hstep, voffB); PG8_STAGE_A(PG8_SA(0, 0), cA, 0); PG8_STAGE_A(PG8_SA(0, 1), cA, 1);
    if (wr == 1) PG8_BAR;
    PG8_WAIT_V(2); PG8_BAR;
    PG8_STAGE(PG8_SB(1, 0), cB + kstep, voffB); PG8_STAGE_A(PG8_SA(1, 0), cA + kstep, 0); PG8_STAGE(PG8_SB(1, 1), cB + hstep + kstep, voffB);
    PG8_WAIT_V(6); PG8_BAR;
    for (;;) {
        const bool has_next = S.next(ui + 1, nxt);
        const char* nA = has_next ? S.a_base(nxt) : cA; const char* nB = has_next ? S.b_base(nxt) : cB;
        if constexpr (GATHER) { if (has_next) S.a_rows(nxt, Rr, Cc, gN); }
        for (int t = 0; t < nt; t += 2) {
            const bool last = (t == nt - 2);
            const char* a1 = cA + (size_t)(t + 1) * kstep;
            const char* a2 = last ? nA : cA + (size_t)(t + 2) * kstep; const char* b2 = last ? nB : cB + (size_t)(t + 2) * kstep;
            const char* a3 = a2 + kstep; const char* b3 = b2 + kstep;
            PG8_LDB(B0, 0, 0); PG8_LDB(B1, 0, 1); PG8_SCHED; PG8_LDA(At, 0, 0); PG8_STAGE_A(PG8_SA(1, 1), a1, 1);
            if constexpr (GATHER) { if (last && has_next) { asm volatile("" ::: "memory"); gA[0][0] = gN[0][0]; gA[0][1] = gN[0][1]; gA[1][0] = gN[1][0]; gA[1][1] = gN[1][1]; } }
            PG8_WAIT_V(8); PG8_WAIT_L(0); PG8_BAR; PG8_MMA(0, 0, At, B0); PG8_MMA(0, 1, At, B1); PG8_BAR; PG8_SCHED;
            PG8_LDA(At, 0, 1); PG8_STAGE(PG8_SB(0, 0), b2, voffB); PG8_STAGE(PG8_SB(0, 1), b2 + hstep, voffB); PG8_STAGE_A(PG8_SA(0, 0), a2, 0);
            PG8_WAIT_V(8); PG8_WAIT_L(0); PG8_BAR; PG8_MMA(1, 0, At, B0); PG8_MMA(1, 1, At, B1); PG8_BAR; PG8_SCHED;
            PG8_LDB(B0, 1, 0); PG8_LDB(B1, 1, 1); PG8_SCHED; PG8_LDA(At, 1, 0); PG8_STAGE_A(PG8_SA(0, 1), a2, 1);
            PG8_WAIT_V(8); PG8_WAIT_L(0); PG8_BAR; PG8_MMA(0, 0, At, B0); PG8_MMA(0, 1, At, B1); PG8_BAR; PG8_SCHED;
            PG8_LDA(At, 1, 1); PG8_STAGE(PG8_SB(1, 0), b3, voffB); PG8_STAGE(PG8_SB(1, 1), b3 + hstep, voffB); PG8_STAGE_A(PG8_SA(1, 0), a3, 0);
            PG8_WAIT_V(8); PG8_WAIT_L(0); PG8_BAR; PG8_MMA(1, 0, At, B0); PG8_MMA(1, 1, At, B1); PG8_BAR; PG8_SCHED;
        }
        if (wr == 0) PG8_BAR;
        E(acc, cur, wr, wc, fr, fq);
        if (!has_next) break;
#pragma unroll
        for (int a = 0; a < 2; ++a)
#pragma unroll
            for (int b = 0; b < 2; ++b)
#pragma unroll
                for (int m = 0; m < 4; ++m)
#pragma unroll
                    for (int n = 0; n < 2; ++n) acc[a][b][m][n] = (f32x4){0.f, 0.f, 0.f, 0.f};
        cur = nxt; cA = nA; cB = nB; ++ui;
        if (wr == 1) PG8_BAR;
    }
    PG8_WAIT_V(0);
    PG8_BAR;
#undef PG8_SA
#undef PG8_SB
#undef PG8_STAGE
#undef PG8_STAGE_A
#undef PG8_LDA
#undef PG8_LDB
#undef PG8_MMA
#undef PG8_WAIT_V
#undef PG8_WAIT_L
#undef PG8_BAR
#undef PG8_SCHED
}
}

template <int Mr, int Nc, int K, bool ACCUM>
__device__ __forceinline__ void mm_lds(const LAS bf16* A, int lda, const LAS bf16* Bt, int ldb, f32x4 (&acc)[(Mr / 16) * (Nc / 16) / 8], int wave, int lane) {
    constexpr int NT = Nc / 16, TPW = (Mr / 16) * NT / 8;
    const int fr = lane & 15, fq = lane >> 4;
#pragma unroll
    for (int q = 0; q < TPW; ++q) {
        const int t = wave + 8 * q, ti = t / NT, tj = t % NT;
        f32x4 c = ACCUM ? acc[q] : (f32x4){0.f, 0.f, 0.f, 0.f};
#pragma unroll
        for (int k0 = 0; k0 < K; k0 += 32) {
            const bf16x8 a = *(const LAS bf16x8*)(A + (16 * ti + fr) * lda + k0 + 8 * fq);
            const bf16x8 b = *(const LAS bf16x8*)(Bt + (16 * tj + fr) * ldb + k0 + 8 * fq);
            c = __builtin_amdgcn_mfma_f32_16x16x32_bf16(a, b, c, 0, 0, 0);
        }
        acc[q] = c;
    }
}
#define MM_ROW(NT, q, r) (16 * ((wave + 8 * (q)) / (NT)) + 4 * fq + (r))
#define MM_COL(NT, q)    (16 * ((wave + 8 * (q)) % (NT)) + fr)

struct Args { const float* in[25]; float* out; unsigned char* ws; int ph_lo, ph_hi; };
constexpr int NPHASE = 19;

__device__ __forceinline__ void p0_transpose_item(const float* W, int K, int N, bf16* WT, int mode, LAS float* scr, int item, int lane) {
    const int nblk = N / 32, kb = item / nblk, nb = item % nblk, k0 = 64 * kb, n0 = 32 * nb;
    const int row0 = mode == 0 ? n0 : ((n0 >> 7) << 8) + (n0 & 127) + (mode == 2 ? 128 : 0);
#pragma unroll 8
    for (int i = 0; i < 32; ++i) { const int kk = 2 * i + (lane >> 5); scr[kk * 33 + (lane & 31)] = W[(size_t)(k0 + kk) * N + n0 + (lane & 31)]; }
    LDS_WAIT(); asm volatile("" ::: "memory");
    const int c = lane & 7;
#pragma unroll
    for (int j = 0; j < 4; ++j) { const int n = (lane >> 3) + 8 * j; const LAS float* s = scr + (8 * c) * 33 + n;
        u32x4 o; o.x = pk2(s[0 * 33], s[1 * 33]); o.y = pk2(s[2 * 33], s[3 * 33]); o.z = pk2(s[4 * 33], s[5 * 33]); o.w = pk2(s[6 * 33], s[7 * 33]);
        *(u32x4*)(WT + (size_t)(row0 + n) * K + k0 + 8 * c) = o; }
    LDS_WAIT(); asm volatile("" ::: "memory");
}
__device__ __forceinline__ void rms_row_bf16(const float* xrow, const float* g, bf16* orow, int lane) {
    const f32x4* xr = (const f32x4*)xrow + lane; const f32x4* gr = (const f32x4*)g + lane;
    f32x4 v[4]; float s = 0.f;
#pragma unroll
    for (int j = 0; j < 4; ++j) { v[j] = xr[64 * j]; s += (v[j].x * v[j].x + v[j].y * v[j].y) + (v[j].z * v[j].z + v[j].w * v[j].w); }
    const float rstd = rsqrtf(wave_sum(s) * (1.f / D) + EPS);
    u32x2* o8 = (u32x2*)orow + lane;
#pragma unroll
    for (int j = 0; j < 4; ++j) { const f32x4 gv = gr[64 * j]; u32x2 w; w.x = pk2(v[j].x * rstd * gv.x, v[j].y * rstd * gv.y); w.y = pk2(v[j].z * rstd * gv.z, v[j].w * rstd * gv.w); o8[64 * j] = w; }
}

__global__ void __launch_bounds__(512, 2) fwd_kernel(Args args) {
    extern __shared__ __attribute__((aligned(16))) unsigned char lds_raw[];
    LAS unsigned char* lds = (LAS unsigned char*)lds_raw;
    volatile LAS unsigned* MISC = (volatile LAS unsigned*)(lds + LDS_MISC);
    LAS unsigned char* scrb = lds + LDS_SCR;
    const int tid = threadIdx.x, lane = tid & 63, wave = __builtin_amdgcn_readfirstlane(tid >> 6);
    const int G = gridDim.x, bid = blockIdx.x;
    const int fr = lane & 15, fq = lane >> 4;
    unsigned char* ws = args.ws;
    unsigned* ctl = (unsigned*)(ws + WS_CTL);
    float* out = args.out;
    const int lo = args.ph_lo, hi = args.ph_hi;

    if (tid < 64) MISC[tid] = 0u;
    __syncthreads();
    XcdBarrier bar; bar.bar = ctl + CW_BAR; bar.x = 0; bar.st = MISC;
    if (hi - lo > 1) bar = xcd_barrier_post(ctl + CW_BAR, MISC);
#ifndef PHASE_MASK
#define PHASE_MASK 0x7ffff
#endif
#define IN(k) ((((PHASE_MASK) >> (k)) & 1) && lo <= (k) && (k) < hi)
#define SEAM(k) do { if (IN(k) && IN((k) + 1)) xcd_barrier(bar); } while (0)

    bf16* const ACTA = (bf16*)(ws + WS_ACTA);
    bf16* const ACTB = (bf16*)(ws + WS_ACTB);
    const f32x2* const ROT = (const f32x2*)(ws + WS_ROT);
    const int gw = bid * 8 + wave, NGW = G * 8;

    if (IN(0)) {
        LAS float* scr = (LAS float*)(scrb + wave * 16384);
        constexpr int I_IN0 = 16 * 112, I_OUT = 16 * 32, I_FF = 16 * 88, I_DN0 = 44 * 32, I_IN1 = 16 * 80, I_EXP = 16 * 112, I_EDN = 56 * 32;
        constexpr int NITEMS = I_IN0 + I_OUT + 2 * I_FF + I_DN0 + I_IN1 + I_OUT + 2 * 8 * I_EXP + 8 * I_EDN;
        for (int it = gw; it < NITEMS; it += NGW) {
            int r = it;
            if (r < I_IN0) { p0_transpose_item(args.in[4], D, EVEN_IN, (bf16*)(ws + WT_IN0), 0, scr, r, lane); continue; } r -= I_IN0;
            if (r < I_OUT) { p0_transpose_item(args.in[6], D, D, (bf16*)(ws + WT_OUT0), 0, scr, r, lane); continue; } r -= I_OUT;
            if (r < I_FF) { p0_transpose_item(args.in[7], D, D_FF, (bf16*)(ws + WT_GU0), 1, scr, r, lane); continue; } r -= I_FF;
            if (r < I_FF) { p0_transpose_item(args.in[8], D, D_FF, (bf16*)(ws + WT_GU0), 2, scr, r, lane); continue; } r -= I_FF;
            if (r < I_DN0) { p0_transpose_item(args.in[9], D_FF, D, (bf16*)(ws + WT_DN0), 0, scr, r, lane); continue; } r -= I_DN0;
            if (r < I_IN1) { p0_transpose_item(args.in[10], D, ODD_IN, (bf16*)(ws + WT_IN1), 0, scr, r, lane); continue; } r -= I_IN1;
            if (r < I_OUT) { p0_transpose_item(args.in[19], D, D, (bf16*)(ws + WT_OUT1), 0, scr, r, lane); continue; } r -= I_OUT;
            if (r < 8 * I_EXP) { const int e = r / I_EXP; p0_transpose_item(args.in[22] + (size_t)e * D * D_EXP, D, D_EXP, (bf16*)(ws + WT_GU1) + (size_t)e * 2 * D_EXP * D, 1, scr, r % I_EXP, lane); continue; } r -= 8 * I_EXP;
            if (r < 8 * I_EXP) { const int e = r / I_EXP; p0_transpose_item(args.in[23] + (size_t)e * D * D_EXP, D, D_EXP, (bf16*)(ws + WT_GU1) + (size_t)e * 2 * D_EXP * D, 2, scr, r % I_EXP, lane); continue; } r -= 8 * I_EXP;
            { const int e = r / I_EDN; p0_transpose_item(args.in[24] + (size_t)e * D_EXP * D, D_EXP, D, (bf16*)(ws + WT_DN1) + (size_t)e * D * D_EXP, 0, scr, r % I_EDN, lane); }
        }
        for (int idx = bid * 512 + tid; idx < SEQ * 64; idx += G * 512) {
            const int t = idx >> 6, i = idx & 63;
            const float inv_freq = exp2f(-(float)i * (13.287712379549449f / 64.0f));
            double rev = (double)t * (double)inv_freq * 0.15915494309189535; rev -= floor(rev);
            const float rv = (float)rev;
            f32x2 cs; cs.x = __builtin_amdgcn_cosf(rv); cs.y = __builtin_amdgcn_sinf(rv);
            ((f32x2*)(ws + WS_ROT))[idx] = cs;
        }
        for (int m = gw; m < M; m += NGW) rms_row_bf16(args.in[0] + (size_t)m * D, args.in[1], ACTA + (size_t)m * D, lane);
    }
    SEAM(0);

    if (IN(1)) {
        pg8::DenseSched S; S.init(ACTA, (const bf16*)(ws + WT_IN0), M, EVEN_IN, D, G, bid);
        pg8::EpiStoreBf16 E{ACTB, EVEN_IN};
        pg8::gemm_phase<pg8::EpiStoreBf16, pg8::DenseSched, false>(scrb, D, S, E);
    }
    SEAM(1);

    constexpr int LQ = 136, LT = 72;
    LAS bf16* const rQ = (LAS bf16*)(scrb);
    LAS bf16* const rK = (LAS bf16*)(scrb + 17408);
    LAS bf16* const rKdT = (LAS bf16*)(scrb + 34816);
    LAS bf16* const rVT = (LAS bf16*)(scrb + 53248);
    LAS bf16* const rS = (LAS bf16*)(scrb + 71680);
    LAS bf16* const rStT = (LAS bf16*)(scrb + 80896);
    LAS float* const rStat = (LAS float*)(scrb + 115712);
    float* const RGS = (float*)(ws + WS_SCR);

    if (IN(2)) {
        for (int item = bid; item < 256; item += G) {
            const int b = item >> 5, h = (item >> 3) & 3, g = item & 7;
            const float l2g = log2f(1.0f - exp2f(-5.0f - (float)h));
            const float g64 = exp2f(64.0f * l2g);
            f32x4 st[8];
#pragma unroll
            for (int q = 0; q < 8; ++q) st[q] = (f32x4){0.f, 0.f, 0.f, 0.f};
            for (int n = 0; n < 8; ++n) {
                const int tpos0 = (g * 8 + n) * 64; const size_t row0 = (size_t)b * SEQ + tpos0;
                { const int i = lane;
#pragma unroll 2
                    for (int r = 0; r < 8; ++r) { const int j = wave + 8 * r; const bf16* prow = ACTB + (row0 + j) * EVEN_IN; const f32x2 cs = ROT[(tpos0 + j) * 64 + i];
                        const float k1 = bf2f(prow[RK_OFF + 128 * h + i]), k2 = bf2f(prow[RK_OFF + 128 * h + 64 + i]);
                        const float dec = exp2f((float)(63 - j) * l2g) * 0.08838834764831845f;
                        const float kr1 = (k1 * cs.x - k2 * cs.y) * dec, kr2 = (k1 * cs.y + k2 * cs.x) * dec;
                        rKdT[i * LT + j] = (bf16)f2bf(kr1); rKdT[(i + 64) * LT + j] = (bf16)f2bf(kr2);
                        rVT[i * LT + j] = prow[RV_OFF + 128 * h + i]; rVT[(i + 64) * LT + j] = prow[RV_OFF + 128 * h + 64 + i]; } }
                __syncthreads();
#pragma unroll
                for (int q = 0; q < 8; ++q) st[q] = st[q] * g64;
                mm_lds<128, 128, 64, true>(rVT, LT, rKdT, LT, st, wave, lane);
                __syncthreads();
            }
            float* gp = RGS + (size_t)item * 16384 + tid;
#pragma unroll
            for (int q = 0; q < 8; ++q)
#pragma unroll
                for (int r = 0; r < 4; ++r) gp[(q * 4 + r) * 512] = st[q][r];
        }
        {
            LAS bf16* const sQ = (LAS bf16*)(scrb);
            LAS bf16* const sK = (LAS bf16*)(scrb + 9216);
            LAS bf16* const sVT = (LAS bf16*)(scrb + 18432);
            LAS bf16* const sA = (LAS bf16*)(scrb + 27648);
            LAS float* const sZ = (LAS float*)(scrb + 36864);
            volatile LAS unsigned* sFlag = (volatile LAS unsigned*)(scrb + 54272);
            const int srow = tid >> 3, sseg = tid & 7;
            for (int item = bid; item < NB * 8 * 64; item += G) {
                const int qb = 63 - (item & 63), h = (item >> 6) & 7, b = item >> 9;
                const size_t qrow0 = (size_t)b * SEQ + 64 * qb;
                __syncthreads();
                *(u32x4*)(sQ + srow * LT + 8 * sseg) = *(const u32x4*)(ACTB + (qrow0 + srow) * EVEN_IN + SQ_OFF + 64 * h + 8 * sseg);
                f32x4 o[2]; o[0] = (f32x4){0.f, 0.f, 0.f, 0.f}; o[1] = o[0];
                float C = 1.0f;
                for (int kt = qb; kt >= 0; --kt) {
                    const size_t krow0 = (size_t)b * SEQ + 64 * kt;
                    { const bf16* prow = ACTB + (krow0 + srow) * EVEN_IN;
                      *(u32x4*)(sK + srow * LT + 8 * sseg) = *(const u32x4*)(prow + SK_OFF + 64 * h + 8 * sseg);
                      const u32x4 vv = *(const u32x4*)(prow + SV_OFF + 64 * h + 8 * sseg);
                      const unsigned vw[4] = {vv.x, vv.y, vv.z, vv.w};
#pragma unroll
                      for (int c = 0; c < 4; ++c) { sVT[(8 * sseg + 2 * c) * LT + srow] = (bf16)(vw[c] & 0xffffu); sVT[(8 * sseg + 2 * c + 1) * LT + srow] = (bf16)(vw[c] >> 16); } }
                    if (tid == 0) sFlag[0] = 0u;
                    __syncthreads();
                    { f32x4 z[2]; mm_lds<64, 64, 64, false>(sQ, LT, sK, LT, z, wave, lane);
#pragma unroll
                      for (int q = 0; q < 2; ++q)
#pragma unroll
                          for (int r = 0; r < 4; ++r) sZ[MM_ROW(4, q, r) * 68 + MM_COL(4, q)] = z[q][r] * 0.125f; }
                    __syncthreads();
                    {
                      const int tq = 64 * qb + srow, s0 = 64 * kt + 8 * sseg;
                      float p[8], a[8];
#pragma unroll
                      for (int c = 0; c < 8; ++c) { const float z = sZ[srow * 68 + 8 * sseg + c]; const bool valid = (s0 + c) < tq; const float pp = 1.0f / (1.0f + __expf(z)); p[c] = valid ? pp : 1.0f; a[c] = valid ? 1.0f - pp : 0.0f; }
                      float suf = 1.0f;
#pragma unroll
                      for (int c = 7; c >= 0; --c) { a[c] *= suf; suf *= p[c]; }
                      float Eo = 1.0f;
#pragma unroll
                      for (int k = 1; k < 8; ++k) { const float tv = __shfl_down(suf, k, 8); if (sseg + k < 8) Eo *= tv; }
                      const float ptot = __shfl(Eo * suf, 0, 8);
                      const float sc = Eo * C;
                      u32x4 w; w.x = pk2(a[0] * sc, a[1] * sc); w.y = pk2(a[2] * sc, a[3] * sc); w.z = pk2(a[4] * sc, a[5] * sc); w.w = pk2(a[6] * sc, a[7] * sc);
                      *(u32x4*)(sA + srow * LT + 8 * sseg) = w;
                      C *= ptot;
                      if (C >= 1e-30f) sFlag[0] = 1u; }
                    __syncthreads();
                    mm_lds<64, 64, 64, true>(sA, LT, sVT, LT, o, wave, lane);
                    const unsigned more = sFlag[0];
                    __syncthreads();
                    if (more == 0u) break;
                }
#pragma unroll
                for (int q = 0; q < 2; ++q)
#pragma unroll
                    for (int r = 0; r < 4; ++r) ACTA[(qrow0 + MM_ROW(4, q, r)) * D + 512 + 64 * h + MM_COL(4, q)] = (bf16)f2bf(o[q][r]);
            }
        }
    }
    SEAM(2);

    if (IN(3)) {
        for (int item = bid; item < 256; item += G) {
            const int b = item >> 5, h = (item >> 3) & 3, g = item & 7;
            const float l2g = log2f(1.0f - exp2f(-5.0f - (float)h));
            const float g64 = exp2f(64.0f * l2g), g512 = exp2f(512.0f * l2g);
            f32x4 st[8];
#pragma unroll
            for (int q = 0; q < 8; ++q) st[q] = (f32x4){0.f, 0.f, 0.f, 0.f};
            for (int gp_ = 0; gp_ < g; ++gp_) {
                const float* gp = RGS + (size_t)(item - g + gp_) * 16384 + tid;
#pragma unroll
                for (int q = 0; q < 8; ++q)
#pragma unroll
                    for (int r = 0; r < 4; ++r) st[q][r] = st[q][r] * g512 + gp[(q * 4 + r) * 512];
            }
            for (int n = 0; n < 8; ++n) {
                const int tpos0 = (g * 8 + n) * 64; const size_t row0 = (size_t)b * SEQ + tpos0;
                __syncthreads();
                { const int i = lane;
#pragma unroll 2
                    for (int r = 0; r < 8; ++r) { const int j = wave + 8 * r; const bf16* prow = ACTB + (row0 + j) * EVEN_IN; const f32x2 cs = ROT[(tpos0 + j) * 64 + i];
                        const float q1 = bf2f(prow[RQ_OFF + 128 * h + i]), q2 = bf2f(prow[RQ_OFF + 128 * h + 64 + i]);
                        const float k1 = bf2f(prow[RK_OFF + 128 * h + i]) * 0.08838834764831845f, k2 = bf2f(prow[RK_OFF + 128 * h + 64 + i]) * 0.08838834764831845f;
                        const float qr1 = q1 * cs.x - q2 * cs.y, qr2 = q1 * cs.y + q2 * cs.x;
                        const float kr1 = k1 * cs.x - k2 * cs.y, kr2 = k1 * cs.y + k2 * cs.x;
                        const float dec = exp2f((float)(63 - j) * l2g);
                        rQ[j * LQ + i] = (bf16)f2bf(qr1); rQ[j * LQ + 64 + i] = (bf16)f2bf(qr2);
                        rK[j * LQ + i] = (bf16)f2bf(kr1); rK[j * LQ + 64 + i] = (bf16)f2bf(kr2);
                        rKdT[i * LT + j] = (bf16)f2bf(kr1 * dec); rKdT[(i + 64) * LT + j] = (bf16)f2bf(kr2 * dec);
                        rVT[i * LT + j] = prow[RV_OFF + 128 * h + i]; rVT[(i + 64) * LT + j] = prow[RV_OFF + 128 * h + 64 + i]; } }
#pragma unroll
                for (int q = 0; q < 8; ++q)
#pragma unroll
                    for (int r = 0; r < 4; ++r) rStT[MM_ROW(8, q, r) * LQ + MM_COL(8, q)] = (bf16)f2bf(st[q][r]);
                __syncthreads();
                { f32x4 s[2]; mm_lds<64, 64, 128, false>(rQ, LQ, rK, LQ, s, wave, lane);
#pragma unroll
                  for (int q = 0; q < 2; ++q)
#pragma unroll
                      for (int r = 0; r < 4; ++r) { const int i = MM_ROW(4, q, r), j = MM_COL(4, q); const int dd = i > j ? i - j : j - i; rS[i * LT + j] = (bf16)f2bf(s[q][r] * exp2f((float)dd * l2g)); } }
                __syncthreads();
                f32x4 oi[4];
                mm_lds<64, 128, 128, false>(rQ, LQ, rStT, LQ, oi, wave, lane);
#pragma unroll
                for (int q = 0; q < 4; ++q)
#pragma unroll
                    for (int r = 0; r < 4; ++r) oi[q][r] *= exp2f((float)(MM_ROW(8, q, r) + 1) * l2g);
                mm_lds<64, 128, 64, true>(rS, LT, rVT, LT, oi, wave, lane);
#pragma unroll
                for (int q = 0; q < 4; ++q)
#pragma unroll
                    for (int r = 0; r < 4; ++r) { const int i = MM_ROW(8, q, r);
                        float s1 = oi[q][r], s2 = oi[q][r] * oi[q][r];
#pragma unroll
                        for (int o = 1; o < 16; o <<= 1) { s1 += __shfl_xor(s1, o); s2 += __shfl_xor(s2, o); }
                        if (fr == 0) { rStat[(i * 8 + wave) * 2] = s1; rStat[(i * 8 + wave) * 2 + 1] = s2; } }
                __syncthreads();
#pragma unroll
                for (int q = 0; q < 4; ++q)
#pragma unroll
                    for (int r = 0; r < 4; ++r) { const int i = MM_ROW(8, q, r), e = MM_COL(8, q);
                        float s1 = 0.f, s2 = 0.f;
#pragma unroll
                        for (int w = 0; w < 8; ++w) { s1 += rStat[(i * 8 + w) * 2]; s2 += rStat[(i * 8 + w) * 2 + 1]; }
                        const float mu = s1 * (1.0f / 128.0f); float var = s2 * (1.0f / 128.0f) - mu * mu; var = var < 0.f ? 0.f : var;
                        const float y = (oi[q][r] - mu) * rsqrtf(var + EPS);
                        const float gate = bf2f(ACTB[(row0 + i) * EVEN_IN + RGATE_OFF + 128 * h + e]);
                        const float yo = y * args.in[5][128 * h + e] * (gate / (1.0f + __expf(-gate)));
                        ACTA[(row0 + i) * D + 128 * h + e] = (bf16)f2bf(yo); }
#pragma unroll
                for (int q = 0; q < 8; ++q) st[q] = st[q] * g64;
                mm_lds<128, 128, 64, true>(rVT, LT, rKdT, LT, st, wave, lane);
            }
        }
    }
    SEAM(3);

    if (IN(4)) {
        pg8::DenseSched S; S.init(ACTA, (const bf16*)(ws + WT_OUT0), M, D, D, G, bid);
        pg8::EpiResF32 E{args.in[0], out, D};
        pg8::gemm_phase<pg8::EpiResF32, pg8::DenseSched, false>(scrb, D, S, E);
    }
    SEAM(4);
    if (IN(5)) { for (int m = gw; m < M; m += NGW) rms_row_bf16(out + (size_t)m * D, args.in[2], ACTA + (size_t)m * D, lane); }
    SEAM(5);
    if (IN(6)) {
        pg8::DenseSched S; S.init(ACTA, (const bf16*)(ws + WT_GU0), M, 2 * D_FF, D, G, bid);
        pg8::EpiSwiGLU E{ACTB, D_FF};
        pg8::gemm_phase<pg8::EpiSwiGLU, pg8::DenseSched, false>(scrb, D, S, E);
    }
    SEAM(6);
    if (IN(7)) {
        pg8::DenseSched S; S.init(ACTB, (const bf16*)(ws + WT_DN0), M, D, D_FF, G, bid);
        pg8::EpiResF32 E{out, out, D};
        pg8::gemm_phase<pg8::EpiResF32, pg8::DenseSched, false>(scrb, D_FF, S, E);
    }
    SEAM(7);
    if (IN(8)) { for (int m = gw; m < M; m += NGW) rms_row_bf16(out + (size_t)m * D, args.in[1] + D, ACTA + (size_t)m * D, lane); }
    SEAM(8);
    if (IN(9)) {
        pg8::DenseSched S; S.init(ACTA, (const bf16*)(ws + WT_IN1), M, ODD_IN, D, G, bid);
        pg8::EpiStoreBf16 E{ACTB, ODD_IN};
        pg8::gemm_phase<pg8::EpiStoreBf16, pg8::DenseSched, false>(scrb, D, S, E);
    }
    SEAM(9);

    float* const LSUM = (float*)(ws + WS_SCR);
#pragma unroll
    for (int pass = 0; pass < 2; ++pass) {
        if (IN(10 + pass)) {
            LAS bf16* const XR = (LAS bf16*)(scrb + wave * 17408);
            LAS float* const AB = (LAS float*)(scrb + wave * 17408 + 9216);
            const int head = wave, ch = 64 * head + lane;
            bf16x8 Bwa[4][2], Bwx[4][2];
#pragma unroll
            for (int tj = 0; tj < 4; ++tj)
#pragma unroll
                for (int ks = 0; ks < 2; ++ks) { bf16x8 va, vx;
#pragma unroll
                    for (int e = 0; e < 8; ++e) { const int i = 32 * ks + 8 * fq + e, j = 16 * tj + fr; va[e] = (short)f2bf(args.in[14][(size_t)(head * 64 + i) * 64 + j]); vx[e] = (short)f2bf(args.in[16][(size_t)(head * 64 + i) * 64 + j]); }
                    Bwa[tj][ks] = va; Bwx[tj][ks] = vx; }
            float cba[4], cbx[4], csp[4];
#pragma unroll
            for (int tj = 0; tj < 4; ++tj) { const int c = 64 * head + 16 * tj + fr; cba[tj] = args.in[15][c]; cbx[tj] = args.in[17][c]; csp[tj] = log1pf(__expf(-args.in[18][c])); }
            const float cw0 = args.in[12][ch], cw1 = args.in[12][512 + ch], cw2 = args.in[12][1024 + ch], cw3 = args.in[12][1536 + ch], cbias = args.in[13][ch];
            for (int it = bid; it < NB * 64; it += G) {
                const int b = it >> 6, c = it & 63; const size_t row0 = (size_t)b * SEQ + 64 * c;
                { float x0 = 0.f, x1 = 0.f, x2 = 0.f;
                  if (c > 0) { x0 = bf2f(ACTB[(row0 - 3) * ODD_IN + XR_OFF + ch]); x1 = bf2f(ACTB[(row0 - 2) * ODD_IN + XR_OFF + ch]); x2 = bf2f(ACTB[(row0 - 1) * ODD_IN + XR_OFF + ch]); }
                  for (int t = 0; t < 64; ++t) { const float x3 = bf2f(ACTB[(row0 + t) * ODD_IN + XR_OFF + ch]);
                      XR[t * LT + lane] = (bf16)f2bf(cw0 * x0 + cw1 * x1 + cw2 * x2 + cw3 * x3 + cbias); x0 = x1; x1 = x2; x2 = x3; } }
                float hst = 0.f, cum = 1.f;
                if (pass == 1) {
                    for (int c0 = 0; c0 < c; c0 += 8) {
                        f32x2 sv[8];
#pragma unroll
                        for (int k = 0; k < 8; ++k) { const int cc = (c0 + k < c) ? c0 + k : c0; sv[k] = ((const f32x2*)LSUM)[(size_t)(b * 64 + cc) * 512 + ch]; }
#pragma unroll
                        for (int k = 0; k < 8; ++k) if (c0 + k < c) hst = sv[k].x * hst + sv[k].y;
                    }
                }
                LDS_WAIT(); asm volatile("" ::: "memory");
                for (int sb = 0; sb < 4; ++sb) {
                    f32x4 aR[4], aX[4];
#pragma unroll
                    for (int tj = 0; tj < 4; ++tj) { aR[tj] = (f32x4){0.f, 0.f, 0.f, 0.f}; aX[tj] = aR[tj]; }
#pragma unroll
                    for (int ks = 0; ks < 2; ++ks) { const bf16x8 af = *(const LAS bf16x8*)(XR + (16 * sb + fr) * LT + 32 * ks + 8 * fq);
#pragma unroll
                        for (int tj = 0; tj < 4; ++tj) { aR[tj] = __builtin_amdgcn_mfma_f32_16x16x32_bf16(af, Bwa[tj][ks], aR[tj], 0, 0, 0); aX[tj] = __builtin_amdgcn_mfma_f32_16x16x32_bf16(af, Bwx[tj][ks], aX[tj], 0, 0, 0); } }
#pragma unroll
                    for (int tj = 0; tj < 4; ++tj)
#pragma unroll
                        for (int r = 0; r < 4; ++r) { const int tl = 4 * fq + r, j = 16 * tj + fr;
                            const float rg = sigmoidf_(aR[tj][r] + cba[tj]), ig = sigmoidf_(aX[tj][r] + cbx[tj]);
                            const float la = -8.0f * rg * csp[tj]; const float a = __expf(la); const float mult = sqrtf(-expm1f(2.0f * la));
                            const float xv = bf2f(XR[(16 * sb + tl) * LT + j]);
                            AB[tl * 64 + j] = a; AB[1024 + tl * 64 + j] = mult * ig * xv; }
                    LDS_WAIT(); asm volatile("" ::: "memory");
                    for (int tl = 0; tl < 16; ++tl) { const float a = AB[tl * 64 + lane], bb = AB[1024 + tl * 64 + lane]; hst = a * hst + bb; cum *= a;
                        if (pass == 1) { const size_t row = row0 + 16 * sb + tl; const float xg = bf2f(ACTB[row * ODD_IN + XG_OFF + ch]);
                            const float u3 = 0.7978845608028654f * (xg + 0.044715f * xg * xg * xg); const float th = 1.0f - 2.0f / (1.0f + __expf(2.0f * u3));
                            ACTA[row * D + 512 + ch] = (bf16)f2bf(hst * 0.5f * xg * (1.0f + th)); } }
                    LDS_WAIT(); asm volatile("" ::: "memory");
                }
                if (pass == 0) { f32x2 sv; sv.x = cum; sv.y = hst; ((f32x2*)LSUM)[(size_t)(b * 64 + c) * 512 + ch] = sv; }
            }
            if (pass == 1) {
                for (int idx = bid * 512 + tid; idx < M * 64; idx += G * 512) {
                    const int row = idx >> 6, c8 = (idx & 63) * 8; const int t = row & (SEQ - 1);
                    const bf16* p = ACTB + (size_t)row * ODD_IN;
                    float acc8[8];
#pragma unroll
                    for (int x = 0; x < 8; ++x) acc8[x] = 0.f;
#pragma unroll
                    for (int k = 0; k < 3; ++k) { const int dt = 2 - k; if (t - dt >= 0) { const bf16* pr = p - (size_t)dt * ODD_IN;
                            const u32x4 gc = *(const u32x4*)(pr + CC_OFF + c8), uu = *(const u32x4*)(pr + CU_OFF + c8); const unsigned gw_[4] = {gc.x, gc.y, gc.z, gc.w}, uw[4] = {uu.x, uu.y, uu.z, uu.w};
#pragma unroll
                            for (int x = 0; x < 4; ++x) { acc8[2 * x] += args.in[11][k * 512 + c8 + 2 * x] * bf2f(gw_[x]) * bf2f(uw[x]); acc8[2 * x + 1] += args.in[11][k * 512 + c8 + 2 * x + 1] * bf2f(gw_[x] >> 16) * bf2f(uw[x] >> 16); } } }
                    const u32x4 gb = *(const u32x4*)(p + CB_OFF + c8); const unsigned gbw[4] = {gb.x, gb.y, gb.z, gb.w};
                    u32x4 w; unsigned ww[4];
#pragma unroll
                    for (int x = 0; x < 4; ++x) ww[x] = pk2(bf2f(gbw[x]) * acc8[2 * x], bf2f(gbw[x] >> 16) * acc8[2 * x + 1]);
                    w.x = ww[0]; w.y = ww[1]; w.z = ww[2]; w.w = ww[3];
                    *(u32x4*)(ACTA + (size_t)row * D + c8) = w;
                }
            }
        }
        SEAM(10 + pass);
    }

    if (IN(12)) {
        pg8::DenseSched S; S.init(ACTA, (const bf16*)(ws + WT_OUT1), M, D, D, G, bid);
        pg8::EpiResF32 E{out, out, D};
        pg8::gemm_phase<pg8::EpiResF32, pg8::DenseSched, false>(scrb, D, S, E);
    }
    SEAM(12);

    int* const LTOK = (int*)(ws + SCR_LTOK); float* const LW = (float*)(ws + SCR_LW);
    if (IN(13)) {
        LAS int* const lcnt = (LAS int*)(scrb);
        LAS int* const lbase = (LAS int*)(scrb + 64);
        LAS int* const recE = (LAS int*)(scrb + 128);
        LAS int* const recR = (LAS int*)(scrb + 128 + 1024);
        LAS float* const recW = (LAS float*)(scrb + 128 + 2048);
        float wr_[4][4][8];
#pragma unroll
        for (int j = 0; j < 4; ++j)
#pragma unroll
            for (int x = 0; x < 4; ++x) { const int col = 4 * (lane + 64 * j) + x; const f32x4 w0 = *(const f32x4*)(args.in[20] + (size_t)col * 8), w1 = *(const f32x4*)(args.in[20] + (size_t)col * 8 + 4);
                wr_[j][x][0] = w0.x; wr_[j][x][1] = w0.y; wr_[j][x][2] = w0.z; wr_[j][x][3] = w0.w; wr_[j][x][4] = w1.x; wr_[j][x][5] = w1.y; wr_[j][x][6] = w1.z; wr_[j][x][7] = w1.w; }
        for (int base = bid * 128; base < M; base += G * 128) {
            if (tid < 16) lcnt[tid] = 0;
            __syncthreads();
            for (int rr = 0; rr < 16; ++rr) {
                const int lr = wave * 16 + rr, m = base + lr;
                const f32x4* xr = (const f32x4*)(out + (size_t)m * D) + lane; const f32x4* gr = (const f32x4*)(args.in[2] + D) + lane;
                f32x4 v[4]; float s = 0.f;
#pragma unroll
                for (int j = 0; j < 4; ++j) { v[j] = xr[64 * j]; s += (v[j].x * v[j].x + v[j].y * v[j].y) + (v[j].z * v[j].z + v[j].w * v[j].w); }
                const float rstd = rsqrtf(wave_sum(s) * (1.f / D) + EPS);
                float lg[8];
#pragma unroll
                for (int e = 0; e < 8; ++e) lg[e] = 0.f;
                u32x2* o8 = (u32x2*)(ACTA + (size_t)m * D) + lane;
#pragma unroll
                for (int j = 0; j < 4; ++j) { const f32x4 gv = gr[64 * j]; float y[4] = {v[j].x * rstd * gv.x, v[j].y * rstd * gv.y, v[j].z * rstd * gv.z, v[j].w * rstd * gv.w};
                    u32x2 w; w.x = pk2(y[0], y[1]); w.y = pk2(y[2], y[3]); o8[64 * j] = w;
#pragma unroll
                    for (int x = 0; x < 4; ++x)
#pragma unroll
                        for (int e = 0; e < 8; ++e) lg[e] += y[x] * wr_[j][x][e]; }
#pragma unroll
                for (int e = 0; e < 8; ++e) lg[e] = wave_sum(lg[e]) + args.in[21][e];
                int e1 = 0; float l1 = lg[0];
#pragma unroll
                for (int e = 1; e < 8; ++e) if (lg[e] > l1) { l1 = lg[e]; e1 = e; }
                int e2 = -1; float l2 = -3.0e38f;
#pragma unroll
                for (int e = 0; e < 8; ++e) if (e != e1 && lg[e] > l2) { l2 = lg[e]; e2 = e; }
                const float w2 = 1.0f / (1.0f + __expf(l1 - l2)), w1 = 1.0f - w2;
                if (lane == 0) { recE[lr * 2] = e1; recE[lr * 2 + 1] = e2; recW[lr * 2] = w1; recW[lr * 2 + 1] = w2;
                    recR[lr * 2] = __hip_atomic_fetch_add(&lcnt[e1], 1, __ATOMIC_RELAXED, __HIP_MEMORY_SCOPE_WORKGROUP); recR[lr * 2 + 1] = __hip_atomic_fetch_add(&lcnt[8 + e2], 1, __ATOMIC_RELAXED, __HIP_MEMORY_SCOPE_WORKGROUP); }
            }
            __syncthreads();
            if (tid < 16) lbase[tid] = (int)__hip_atomic_fetch_add(ctl + CW_CNT + 64 * tid, (unsigned)lcnt[tid], RLX_AGENT);
            __syncthreads();
            if (tid < 256) { const int lr = tid >> 1, k = tid & 1; const int e = recE[tid]; const int pos = lbase[k * 8 + e] + recR[tid];
                if (pos < LIST_CAP) { LTOK[(size_t)(k * 8 + e) * LIST_CAP + pos] = base + lr; LW[(size_t)(k * 8 + e) * LIST_CAP + pos] = recW[tid]; } }
            __syncthreads();
        }
    }
    SEAM(13);

#pragma unroll
    for (int k = 0; k < 2; ++k) {
        if (IN(14 + 2 * k)) {
            pg8::MoeSched S; S.init(ACTA, (const bf16*)(ws + WT_GU1), LTOK + (size_t)k * 8 * LIST_CAP, ctl + CW_CNT + 64 * 8 * k, 2 * D_EXP / 256, D, 0, (size_t)2 * D_EXP * D * 2, G, bid);
            pg8::EpiSwiGLU E{ACTB, D_EXP};
            pg8::gemm_phase<pg8::EpiSwiGLU, pg8::MoeSched, true>(scrb, D, S, E);
        }
        SEAM(14 + 2 * k);
        if (IN(15 + 2 * k)) {
            pg8::MoeSched S; S.init(ACTB, (const bf16*)(ws + WT_DN1), LTOK + (size_t)k * 8 * LIST_CAP, ctl + CW_CNT + 64 * 8 * k, D / 256, D_EXP, (size_t)256 * D_EXP * 2, (size_t)D * D_EXP * 2, G, bid);
            pg8::EpiMoeDown E{out, LTOK + (size_t)k * 8 * LIST_CAP, LW + (size_t)k * 8 * LIST_CAP};
            pg8::gemm_phase<pg8::EpiMoeDown, pg8::MoeSched, false>(scrb, D_EXP, S, E);
        }
        SEAM(15 + 2 * k);
    }

    if (IN(18)) {
        for (int m = gw; m < M; m += NGW) {
            f32x4* xr = (f32x4*)(out + (size_t)m * D) + lane; const f32x4* gr = (const f32x4*)args.in[3] + lane;
            f32x4 v[4]; float s = 0.f;
#pragma unroll
            for (int j = 0; j < 4; ++j) { v[j] = xr[64 * j]; s += (v[j].x * v[j].x + v[j].y * v[j].y) + (v[j].z * v[j].z + v[j].w * v[j].w); }
            const float rstd = rsqrtf(wave_sum(s) * (1.f / D) + EPS);
#pragma unroll
            for (int j = 0; j < 4; ++j) { const f32x4 gv = gr[64 * j]; xr[64 * j] = v[j] * rstd * gv; }
        }
    }
#undef IN
#undef SEAM
}

extern "C" void kernel_launch(void* const* d_in, const int* in_sizes, int n_in, void* d_out, int out_size, void* d_ws, size_t ws_size, hipStream_t stream) {
    static int grid = 0;
    if (grid == 0) {
        if (n_in != 25 || in_sizes[0] != M * D || out_size != M * D || ws_size < WS_END) { fprintf(stderr, "kernel_launch: unexpected shapes / workspace (n_in %d, ws %zu, need %zu)\n", n_in, ws_size, (size_t)WS_END); grid = -1; return; }
        int dev = 0, cus = 0, per_cu = 0;
        if (hipGetDevice(&dev) != hipSuccess || hipDeviceGetAttribute(&cus, hipDeviceAttributeMultiprocessorCount, dev) != hipSuccess) { grid = -1; return; }
        if (hipFuncSetAttribute((const void*)fwd_kernel, hipFuncAttributeMaxDynamicSharedMemorySize, LDS_BYTES) != hipSuccess) { fprintf(stderr, "kernel_launch: hipFuncSetAttribute failed\n"); grid = -1; return; }
        if (hipOccupancyMaxActiveBlocksPerMultiprocessor(&per_cu, (const void*)fwd_kernel, 512, LDS_BYTES) != hipSuccess || per_cu < 1) { fprintf(stderr, "kernel_launch: occupancy query says %d\n", per_cu); }
        (void)hipGetLastError();
        grid = cus;
    }
    if (grid < 0) return;
    if (hipMemsetAsync((char*)d_ws + WS_CTL, 0, CTL_ZERO_BYTES, stream) != hipSuccess) return;
    Args a{};
    for (int i = 0; i < 25; ++i) a.in[i] = (const float*)d_in[i];
    a.out = (float*)d_out; a.ws = (unsigned char*)d_ws;
#if MK_N_LAUNCHES == 1
    a.ph_lo = 0; a.ph_hi = NPHASE;
    hipLaunchKernelGGL(fwd_kernel, dim3(grid), dim3(512), LDS_BYTES, stream, a);
#else
    for (int p = 0; p < NPHASE; ++p) { a.ph_lo = p; a.ph_hi = p + 1; hipLaunchKernelGGL(fwd_kernel, dim3(grid), dim3(512), LDS_BYTES, stream, a); }
#endif
}
```

```cpp
#include <hip/hip_runtime.h>
#include <cstdio>
#include <cstdint>

#ifndef MK_N_LAUNCHES
#define MK_N_LAUNCHES 1
#endif

#ifndef PROBE_A_LO
#define PROBE_A_LO (-1)
#define PROBE_A_HI (-1)
#define PROBE_B_LO (-1)
#define PROBE_B_HI (-1)
#endif
#define GAS __attribute__((address_space(1)))
#define LAS __attribute__((address_space(3)))
typedef unsigned short bf16;
typedef short bf16x8 __attribute__((ext_vector_type(8)));
typedef float f32x4 __attribute__((ext_vector_type(4)));
typedef float f32x2 __attribute__((ext_vector_type(2)));
typedef unsigned u32x4 __attribute__((ext_vector_type(4)));
typedef unsigned u32x2 __attribute__((ext_vector_type(2)));
typedef int v4i_t __attribute__((ext_vector_type(4)));
typedef int v8i_t __attribute__((ext_vector_type(8)));

constexpr int D = 1024, NB = 8, SEQ = 4096, M = NB * SEQ;
constexpr int EVEN_IN = 3584, ODD_IN = 2560, D_FF = 2816, D_EXP = 3584, NEXP = 8;
constexpr int RQ_OFF = 0, RK_OFF = 512, RV_OFF = 1024, RGATE_OFF = 1536, SQ_OFF = 2048, SK_OFF = 2560, SV_OFF = 3072;
constexpr int CB_OFF = 0, CC_OFF = 512, CU_OFF = 1024, XR_OFF = 1536, XG_OFF = 2048;
constexpr float EPS = 1e-6f;
constexpr int LIST_CAP = 32768;
constexpr int MAX_TILES = 135;

constexpr size_t MiB = 1u << 20;
constexpr size_t WS_CTL = 0, CTL_ZERO_BYTES = 1 * MiB;
constexpr size_t WS_ROT = 1 * MiB;
constexpr size_t WS_SCR = 3 * MiB;
constexpr size_t WS_WB = 19 * MiB;
constexpr size_t WT_IN0 = WS_WB;
constexpr size_t WT_OUT0 = WT_IN0 + (size_t)EVEN_IN * D * 2;
constexpr size_t WT_GU0 = WT_OUT0 + (size_t)D * D * 2;
constexpr size_t WT_DN0 = WT_GU0 + (size_t)2 * D_FF * D * 2;
constexpr size_t WT_IN1 = WT_DN0 + (size_t)D * D_FF * 2;
constexpr size_t WT_OUT1 = WT_IN1 + (size_t)ODD_IN * D * 2;
constexpr size_t WT_GU1 = WT_OUT1 + (size_t)D * D * 2;
constexpr size_t WT_DN1 = WT_GU1 + (size_t)NEXP * 2 * D_EXP * D * 2;
constexpr size_t WB_END = WT_DN1 + (size_t)NEXP * D * D_EXP * 2;
constexpr size_t WS_ACTA = 220 * MiB;
constexpr size_t WS_ACTB = 284 * MiB;
constexpr size_t WS_END = WS_ACTB + (size_t)MAX_TILES * 256 * D_EXP * 2;
static_assert(WB_END <= WS_ACTA, "weights overlap");
static_assert((size_t)M * EVEN_IN * 2 <= (size_t)MAX_TILES * 256 * D_EXP * 2, "ACTB size");
constexpr size_t SCR_LTOK = WS_SCR, SCR_LW = WS_SCR + 2 * MiB;
constexpr int CW_BAR = 4096;
constexpr int CW_CNT = 8192;

constexpr int LDS_MISC = 0;
constexpr int LDS_SCR = 256;
constexpr int LDS_BYTES = 147456;

#define RLX_AGENT __ATOMIC_RELAXED, __HIP_MEMORY_SCOPE_AGENT
#define LDS_WAIT() asm volatile("s_waitcnt lgkmcnt(0)" ::: "memory")
__device__ __forceinline__ unsigned f2bf(float f) { unsigned u = __builtin_bit_cast(unsigned, f); return (u + 0x7fffu + ((u >> 16) & 1u)) >> 16; }
__device__ __forceinline__ unsigned pk2(float lo, float hi) { return f2bf(lo) | (f2bf(hi) << 16); }
__device__ __forceinline__ float bf2f(unsigned b) { return __builtin_bit_cast(float, (b & 0xffffu) << 16); }
__device__ __forceinline__ float wave_sum(float v) {
#pragma unroll
    for (int o = 1; o < 64; o <<= 1) v += __shfl_xor(v, o);
    return v;
}
__device__ __forceinline__ float sigmoidf_(float x) { return 1.0f / (1.0f + __expf(-x)); }

#define XB_TMO      128
#define XB_XCNT(j)  (256  + 64 * (j))
#define XB_XSUB(j)  (1280 + 64 * (j))
#define XB_XGEN(j)  (2304 + 64 * (j))
#define XB_TOP      3328
#define XB_TOPGEN   3392
#define XCD_BAR_WORDS 3456
#define XB_SPIN_CAP (1u << 18)

__device__ __forceinline__ unsigned xb_ld(unsigned* p)              { return __hip_atomic_load(p, __ATOMIC_RELAXED, __HIP_MEMORY_SCOPE_AGENT); }
__device__ __forceinline__ unsigned xb_add(unsigned* p, unsigned v) { return __hip_atomic_fetch_add(p, v, __ATOMIC_RELAXED, __HIP_MEMORY_SCOPE_AGENT); }
__device__ __forceinline__ unsigned xb_xcc_id() { return (unsigned)__builtin_amdgcn_s_getreg((3 << 11) | 20) & 0xFu; }
#define XB_SPIN(cond, bar) do { unsigned _sp = 0; while (cond) { __builtin_amdgcn_s_sleep(1); \
    if ((++_sp & 255u) == 0u) { if (xb_ld(&(bar)[XB_TMO])) break; if (_sp > XB_SPIN_CAP) { atomicAdd(&(bar)[XB_TMO], 1u); break; } } } } while (0)

struct XcdBarrier { unsigned* bar; unsigned x; volatile LAS unsigned* st; };

__device__ __forceinline__ XcdBarrier xcd_barrier_post(unsigned* bar, volatile LAS unsigned* st) {
    XcdBarrier b; b.bar = bar; b.x = xb_xcc_id(); b.st = st;
    if (threadIdx.x == 0) (void)xb_add(&bar[XB_XCNT(b.x)], 1u);
    return b;
}
__device__ __forceinline__ void xcd_barrier_complete(unsigned* bar, unsigned x, unsigned& nloc, unsigned& nx) {
    const unsigned G = gridDim.x * gridDim.y * gridDim.z;
    unsigned sum, cnt, mine, sp = 0u;
    for (;;) {
        sum = 0u; cnt = 0u; mine = 0u;
#pragma unroll
        for (unsigned j = 0; j < 16; ++j) { const unsigned c = xb_ld(&bar[XB_XCNT(j)]); sum += c; cnt += (c > 0u) ? 1u : 0u; mine = (j == x) ? c : mine; }
        if (sum == G) break;
        __builtin_amdgcn_s_sleep(1);
        if ((++sp & 255u) == 0u) { if (xb_ld(&bar[XB_TMO])) break; if (sp > XB_SPIN_CAP) { atomicAdd(&bar[XB_TMO], 1u); break; } }
    }
    nloc = mine > 0u ? mine : 1u; nx = cnt > 0u ? cnt : 1u;
}
__device__ __forceinline__ void xcd_barrier(const XcdBarrier& b) {
    asm volatile("s_waitcnt vmcnt(0)" ::: "memory");
    __syncthreads();
    if (threadIdx.x == 0) {
        unsigned* bar = b.bar;
        __builtin_amdgcn_s_waitcnt(0);
        unsigned nloc = b.st[0], nx = b.st[1];
        if (nloc == 0u) { xcd_barrier_complete(bar, b.x, nloc, nx); b.st[0] = nloc; b.st[1] = nx; }
        const unsigned old = xb_add(&bar[XB_XSUB(b.x)], 1u);
        const unsigned gen = old / nloc;
        if (old + 1u == (gen + 1u) * nloc) {
            __builtin_amdgcn_fence(__ATOMIC_RELEASE, "agent");
            asm volatile("s_waitcnt vmcnt(0)" ::: "memory");
            const unsigned og = xb_add(&bar[XB_TOP], 1u);
            const unsigned tg = og / nx;
            if (og + 1u == (tg + 1u) * nx) xb_add(&bar[XB_TOPGEN], 1u);
            else XB_SPIN(xb_ld(&bar[XB_TOPGEN]) == tg, bar);
            __builtin_amdgcn_fence(__ATOMIC_ACQUIRE, "agent");
            xb_add(&bar[XB_XGEN(b.x)], 1u);
            asm volatile("s_waitcnt vmcnt(0)" ::: "memory");
        } else {
            XB_SPIN(xb_ld(&bar[XB_XGEN(b.x)]) == gen, bar);
            __builtin_amdgcn_fence(__ATOMIC_ACQUIRE, "agent");
            asm volatile("s_waitcnt vmcnt(0)" ::: "memory");
        }
    }
    __syncthreads();
}

namespace pg8 {
constexpr int BM = 256, BK = 64, HALF = 128, HTB = HALF * BK * 2, STAGE_BYTES = 8 * HTB, NXCD = 8, WGM = 8;
__device__ __forceinline__ int lds_byte(int r, int c) { const int st = (r >> 4) * 2 + (c >> 5), rr = r & 15, cc = c & 31, ob = rr * 64 + cc * 2; return st * 1024 + (ob ^ (((ob >> 9) & 1) << 5)); }
__device__ __forceinline__ void stage_rc(int b, int& R, int& C) { const int st = b / 1024, sb = b % 1024, swz = sb ^ (((sb >> 9) & 1) << 5); R = (st >> 1) * 16 + swz / 64; C = (st & 1) * 32 + (swz % 64) / 2; }
__device__ __forceinline__ int perm32(int rho) { const int n = rho >> 4, i = rho & 15; return 8 * (i >> 2) + 4 * n + (i & 3); }

struct Unit { int pm, pn, e, lt, cn; };

struct StaticOrder {
    int nM, nN, nwg, G, c;
    __device__ __forceinline__ void init_tiles(int nM_, int nN_, int G_, int c_) { nM = nM_; nN = nN_; nwg = nM * nN; G = G_; c = c_; }
    __device__ __forceinline__ bool next_tile(int i, int& pm, int& pn) const {
        const long L = (long)i * G + c; if (L >= nwg) return false;
        int wgid = (int)L; { const int q = nwg / NXCD, r = nwg % NXCD, xcd = wgid % NXCD, off = wgid / NXCD; wgid = (xcd < r ? xcd * (q + 1) : r * (q + 1) + (xcd - r) * q) + off; }
        const int nig = WGM * nN, gid = wgid / nig, fm = gid * WGM, gsz = (nM - fm) < WGM ? (nM - fm) : WGM;
        pm = fm + ((wgid % nig) % gsz); pn = (wgid % nig) / gsz; return true;
    }
};
struct DenseSched : StaticOrder {
    const char* A; const char* Bt; size_t tstep;
    __device__ __forceinline__ void init(const bf16* A_, const bf16* Bt_, int Mr, int N, int K, int G_, int c_) { A = (const char*)A_; Bt = (const char*)Bt_; tstep = (size_t)BM * K * 2; init_tiles(Mr / BM, N / BM, G_, c_); }
    __device__ __forceinline__ bool next(int i, Unit& u) const { u.e = 0; u.lt = 0; u.cn = 0; return next_tile(i, u.pm, u.pn); }
    __device__ __forceinline__ const char* a_base(const Unit& u) const { return A + (size_t)u.pm * tstep; }
    __device__ __forceinline__ const char* b_base(const Unit& u) const { return Bt + (size_t)u.pn * tstep; }
    __device__ __forceinline__ void a_rows(const Unit&, const int (&)[2], const int (&)[2], unsigned (&)[2][2]) const {}
};
struct MoeSched : StaticOrder {
    const char* A; const char* Bt; size_t a_tstep, b_estep, b_tstep; const int* ltok; int rowb, toff;
    int c0, c1, c2, c3, c4, c5, c6, c7, c8, c9, c10, c11, c12, c13, c14, c15, t1, t2, t3, t4, t5, t6, t7, t8, t9, t10, t11, t12, t13, t14, t15, t16;
    __device__ __forceinline__ static int ldc_(const unsigned* cntw, int e) { int c = (int)__builtin_amdgcn_readfirstlane(__hip_atomic_load(cntw + 64 * e, RLX_AGENT)); return c > LIST_CAP ? LIST_CAP : c; }
    __device__ __forceinline__ void init(const void* A_, const void* Bt_, const int* ltok_, const unsigned* cntw, int which, int nN_, int rowb_, size_t a_tstep_, size_t b_estep_, int G_, int c_) {
        A = (const char*)A_; Bt = (const char*)Bt_; ltok = ltok_; rowb = rowb_; a_tstep = a_tstep_; b_estep = b_estep_; b_tstep = (size_t)BM * rowb_;
        c0 = ldc_(cntw, 0); c1 = ldc_(cntw, 1); c2 = ldc_(cntw, 2); c3 = ldc_(cntw, 3); c4 = ldc_(cntw, 4); c5 = ldc_(cntw, 5); c6 = ldc_(cntw, 6); c7 = ldc_(cntw, 7);
        c8 = ldc_(cntw, 8); c9 = ldc_(cntw, 9); c10 = ldc_(cntw, 10); c11 = ldc_(cntw, 11); c12 = ldc_(cntw, 12); c13 = ldc_(cntw, 13); c14 = ldc_(cntw, 14); c15 = ldc_(cntw, 15);
        t1 = (c0 + 255) >> 8; t2 = t1 + ((c1 + 255) >> 8); t3 = t2 + ((c2 + 255) >> 8); t4 = t3 + ((c3 + 255) >> 8); t5 = t4 + ((c4 + 255) >> 8); t6 = t5 + ((c5 + 255) >> 8); t7 = t6 + ((c6 + 255) >> 8); t8 = t7 + ((c7 + 255) >> 8);
        t9 = t8 + ((c8 + 255) >> 8); t10 = t9 + ((c9 + 255) >> 8); t11 = t10 + ((c10 + 255) >> 8); t12 = t11 + ((c11 + 255) >> 8); t13 = t12 + ((c12 + 255) >> 8); t14 = t13 + ((c13 + 255) >> 8); t15 = t14 + ((c14 + 255) >> 8); t16 = t15 + ((c15 + 255) >> 8);
        toff = which == 2 ? t8 : 0;
        init_tiles(which == 0 ? t16 : (which == 1 ? t8 : t16 - t8), nN_, G_, c_);
    }
    __device__ __forceinline__ bool next(int i, Unit& u) const {
        int pml; if (!next_tile(i, pml, u.pn)) return false;
        const int pm = pml + toff; u.pm = pm;
        const int m1 = pm >= t1, m2 = pm >= t2, m3 = pm >= t3, m4 = pm >= t4, m5 = pm >= t5, m6 = pm >= t6, m7 = pm >= t7, m8 = pm >= t8, m9 = pm >= t9, m10 = pm >= t10, m11 = pm >= t11, m12 = pm >= t12, m13 = pm >= t13, m14 = pm >= t14, m15 = pm >= t15;
        const int e = m1 + m2 + m3 + m4 + m5 + m6 + m7 + m8 + m9 + m10 + m11 + m12 + m13 + m14 + m15;
        const int base = m1 * t1 + m2 * (t2 - t1) + m3 * (t3 - t2) + m4 * (t4 - t3) + m5 * (t5 - t4) + m6 * (t6 - t5) + m7 * (t7 - t6) + m8 * (t8 - t7) + m9 * (t9 - t8) + m10 * (t10 - t9) + m11 * (t11 - t10) + m12 * (t12 - t11) + m13 * (t13 - t12) + m14 * (t14 - t13) + m15 * (t15 - t14);
        const int cn = c0 + m1 * (c1 - c0) + m2 * (c2 - c1) + m3 * (c3 - c2) + m4 * (c4 - c3) + m5 * (c5 - c4) + m6 * (c6 - c5) + m7 * (c7 - c6) + m8 * (c8 - c7) + m9 * (c9 - c8) + m10 * (c10 - c9) + m11 * (c11 - c10) + m12 * (c12 - c11) + m13 * (c13 - c12) + m14 * (c14 - c13) + m15 * (c15 - c14);
        u.e = e; u.lt = pm - base; u.cn = cn; return true;
    }
    __device__ __forceinline__ const char* a_base(const Unit& u) const { return A + (size_t)u.pm * a_tstep; }
    __device__ __forceinline__ const char* b_base(const Unit& u) const { return Bt + (size_t)(u.e & 7) * b_estep + (size_t)u.pn * b_tstep; }
    __device__ __forceinline__ void a_rows(const Unit& u, const int (&R)[2], const int (&C)[2], unsigned (&off)[2][2]) const {
#pragma unroll
        for (int h = 0; h < 2; ++h)
#pragma unroll
            for (int i = 0; i < 2; ++i) { int rank = u.lt * 256 + h * HALF + R[i]; rank = rank < u.cn ? rank : u.cn - 1;
                const int tok = ltok[(size_t)u.e * LIST_CAP + rank]; off[h][i] = (unsigned)tok * (unsigned)rowb + (unsigned)(C[i] * 2); }
    }
};

__device__ __forceinline__ unsigned cvt_pk_bf16(float lo, float hi) { unsigned r; asm volatile("v_cvt_pk_bf16_f32 %0, %1, %2" : "=v"(r) : "v"(lo), "v"(hi)); return r; }

struct EpiStoreBf16 {
    static constexpr bool PERM = true;
    bf16* O; int ldc;
    __device__ __forceinline__ void operator()(const f32x4 (&acc)[2][2][4][2], const Unit& u, int wr, int wc, int fr, int fq) const {
        const int row0 = u.pm * BM + wr * 64 + fr, col0 = u.pn * BM + wc * 32 + 8 * fq;
#pragma unroll
        for (int ai = 0; ai < 2; ++ai)
#pragma unroll
            for (int m = 0; m < 4; ++m) { bf16* rowp = O + (size_t)(row0 + ai * HALF + m * 16) * ldc + col0;
#pragma unroll
                for (int bj = 0; bj < 2; ++bj) { const f32x4 v0 = acc[ai][bj][m][0], v1 = acc[ai][bj][m][1];
                    u32x4 w; w.x = cvt_pk_bf16(v0[0], v0[1]); w.y = cvt_pk_bf16(v0[2], v0[3]); w.z = cvt_pk_bf16(v1[0], v1[1]); w.w = cvt_pk_bf16(v1[2], v1[3]);
                    *(u32x4*)(rowp + bj * HALF) = w; } }
    }
};
struct EpiResF32 {
    static constexpr bool PERM = false;
    const float* base; float* out; int ldc;
    __device__ __forceinline__ void operator()(const f32x4 (&acc)[2][2][4][2], const Unit& u, int wr, int wc, int fr, int fq) const {
        const int row0 = u.pm * BM + wr * 64 + fr, col0 = u.pn * BM + wc * 32 + 4 * fq;
#pragma unroll
        for (int ai = 0; ai < 2; ++ai)
#pragma unroll
            for (int m = 0; m < 4; ++m) { const size_t off = (size_t)(row0 + ai * HALF + m * 16) * ldc + col0;
#pragma unroll
                for (int bj = 0; bj < 2; ++bj)
#pragma unroll
                    for (int n = 0; n < 2; ++n) { const f32x4 bs = *(const f32x4*)(base + off + bj * HALF + n * 16); *(f32x4*)(out + off + bj * HALF + n * 16) = bs + acc[ai][bj][m][n]; } }
    }
};
struct EpiSwiGLU {
    static constexpr bool PERM = true;
    bf16* H; int ldh;
    __device__ __forceinline__ void operator()(const f32x4 (&acc)[2][2][4][2], const Unit& u, int wr, int wc, int fr, int fq) const {
        const int row0 = u.pm * BM + wr * 64 + fr, col0 = u.pn * HALF + wc * 32 + 8 * fq;
#pragma unroll
        for (int ai = 0; ai < 2; ++ai)
#pragma unroll
            for (int m = 0; m < 4; ++m) { bf16* rowp = H + (size_t)(row0 + ai * HALF + m * 16) * ldh + col0;
                float h[8];
#pragma unroll
                for (int n = 0; n < 2; ++n)
#pragma unroll
                    for (int x = 0; x < 4; ++x) { const float g = acc[ai][0][m][n][x], up = acc[ai][1][m][n][x]; h[4 * n + x] = g / (1.0f + __expf(-g)) * up; }
                u32x4 w; w.x = cvt_pk_bf16(h[0], h[1]); w.y = cvt_pk_bf16(h[2], h[3]); w.z = cvt_pk_bf16(h[4], h[5]); w.w = cvt_pk_bf16(h[6], h[7]);
                *(u32x4*)rowp = w; }
    }
};
struct EpiSwiGLU8 {
    static constexpr bool PERM = true;
    unsigned char* H; int ldh; float iscale, oscale;
    __device__ __forceinline__ void operator()(const f32x4 (&acc)[2][2][4][2], const Unit& u, int wr, int wc, int fr, int fq) const {
        const int row0 = u.pm * BM + wr * 64 + fr, col0 = u.pn * HALF + wc * 32 + 8 * fq;
#pragma unroll
        for (int ai = 0; ai < 2; ++ai)
#pragma unroll
            for (int m = 0; m < 4; ++m) { unsigned char* rowp = H + (size_t)(row0 + ai * HALF + m * 16) * ldh + col0;
                float h[8];
#pragma unroll
                for (int n = 0; n < 2; ++n)
#pragma unroll
                    for (int x = 0; x < 4; ++x) { const float g = acc[ai][0][m][n][x] * iscale, up = acc[ai][1][m][n][x] * iscale; h[4 * n + x] = __builtin_amdgcn_fmed3f(g / (1.0f + __expf(-g)) * up * oscale, -448.0f, 448.0f); }
                int w0 = __builtin_amdgcn_cvt_pk_fp8_f32(h[0], h[1], 0, false); w0 = __builtin_amdgcn_cvt_pk_fp8_f32(h[2], h[3], w0, true);
                int w1 = __builtin_amdgcn_cvt_pk_fp8_f32(h[4], h[5], 0, false); w1 = __builtin_amdgcn_cvt_pk_fp8_f32(h[6], h[7], w1, true);
                u32x2 w; w.x = (unsigned)w0; w.y = (unsigned)w1; *(u32x2*)rowp = w; }
    }
};
struct EpiMoeDown {
    static constexpr bool PERM = false;
    float* out; const int* ltok; const float* lw; float scale;
    __device__ __forceinline__ void operator()(const f32x4 (&acc)[2][2][4][2], const Unit& u, int wr, int wc, int fr, int fq) const {
        const int col0 = u.pn * BM + wc * 32 + 4 * fq;
#pragma unroll
        for (int ai = 0; ai < 2; ++ai)
#pragma unroll
            for (int m = 0; m < 4; ++m) { const int rank = u.lt * 256 + ai * HALF + wr * 64 + m * 16 + fr;
                if (rank < u.cn) { const int tok = ltok[(size_t)u.e * LIST_CAP + rank]; const float w = lw[(size_t)u.e * LIST_CAP + rank] * scale; float* rowp = out + (size_t)tok * D + col0;
#pragma unroll
                    for (int bj = 0; bj < 2; ++bj)
#pragma unroll
                        for (int n = 0; n < 2; ++n) { const f32x4 bs = *(const f32x4*)(rowp + bj * HALF + n * 16); *(f32x4*)(rowp + bj * HALF + n * 16) = bs + acc[ai][bj][m][n] * w; } } }
    }
};

template <class Epi, class Sched, bool GATHER, bool F8 = false>
__device__ __forceinline__ void gemm_phase(LAS unsigned char* lds, const int rowb, const Sched& S, const Epi& E) {
    const int tid = threadIdx.x, wid = __builtin_amdgcn_readfirstlane(tid >> 6), lane = tid & 63, wr = wid >> 2, wc = wid & 3, fr = lane & 15, fq = lane >> 4;
    const int nt = rowb / 128;
    unsigned voffA[2], voffB[2]; int Rr[2], Cc[2];
#pragma unroll
    for (int i = 0; i < 2; ++i) { int R, C; stage_rc(tid * 16 + i * 8192, R, C); const int Rb = Epi::PERM ? ((R & ~31) + perm32(R & 31)) : R;
        voffA[i] = (unsigned)(R * rowb + C * 2); voffB[i] = (unsigned)(Rb * rowb + C * 2); Rr[i] = R; Cc[i] = C; }
    const size_t kstep = (size_t)(BK * 2);
    const size_t hstep = (size_t)HALF * rowb;
    const unsigned ldsw = (unsigned)wid * 1024u;
    const int aoff = lds_byte(wr * 64 + fr, fq * 8), boff = lds_byte(wc * 32 + fr, fq * 8);
#define PG8_SA(b, h) (((b) * 2 + (h)) * HTB)
#define PG8_SB(b, h) ((4 + (b) * 2 + (h)) * HTB)
#define PG8_STAGE(bufoff, gbase, voff) do { _Pragma("unroll") for (int _i = 0; _i < 2; ++_i) \
        __builtin_amdgcn_global_load_lds((const unsigned*)((const char*)(gbase) + (voff)[_i]), (LAS unsigned*)(lds + (bufoff) + ldsw + _i * 8192), 16, 0, 0); } while (0)
#define PG8_STAGE_A(bufoff, kptr, h) do { if constexpr (GATHER) PG8_STAGE(bufoff, kptr, gA[h]); else PG8_STAGE(bufoff, (kptr) + (h) * hstep, voffA); } while (0)
#define PG8_LD8(base) __builtin_shufflevector(*(const LAS v4i_t*)(base), *(const LAS v4i_t*)((base) + 1024), 0, 1, 2, 3, 4, 5, 6, 7)
#define PG8_LDA(dst, b, h) do { _Pragma("unroll") for (int m = 0; m < 4; ++m) { if constexpr (F8) dst##8[m] = PG8_LD8(lds + PG8_SA(b, h) + aoff + m * 2048); else { _Pragma("unroll") for (int k = 0; k < 2; ++k) dst[m][k] = *(const LAS bf16x8*)(lds + PG8_SA(b, h) + aoff + m * 2048 + k * 1024); } } } while (0)
#define PG8_LDB(dst, b, h) do { _Pragma("unroll") for (int n = 0; n < 2; ++n) { if constexpr (F8) dst##8[n] = PG8_LD8(lds + PG8_SB(b, h) + boff + n * 2048); else { _Pragma("unroll") for (int k = 0; k < 2; ++k) dst[n][k] = *(const LAS bf16x8*)(lds + PG8_SB(b, h) + boff + n * 2048 + k * 1024); } } } while (0)
#define PG8_MMA(ai, bj, At, Bt) do { __builtin_amdgcn_s_setprio(1); _Pragma("unroll") for (int m = 0; m < 4; ++m) _Pragma("unroll") for (int n = 0; n < 2; ++n) { \
        if constexpr (F8) asm volatile("v_mfma_f32_16x16x128_f8f6f4 %0, %1, %2, %0" : "+v"(acc[ai][bj][m][n]) : "v"(Bt##8[n]), "v"(At##8[m])); \
        else { _Pragma("unroll") for (int k = 0; k < 2; ++k) acc[ai][bj][m][n] = __builtin_amdgcn_mfma_f32_16x16x32_bf16(Bt[n][k], At[m][k], acc[ai][bj][m][n], 0, 0, 0); } } \
        __builtin_amdgcn_s_setprio(0); } while (0)
#define PG8_WAIT_V(n) asm volatile("s_waitcnt vmcnt(" #n ")" ::: "memory")
#define PG8_WAIT_L(n) asm volatile("s_waitcnt lgkmcnt(" #n ")" ::: "memory")
#define PG8_BAR __builtin_amdgcn_s_barrier()
#define PG8_SCHED __builtin_amdgcn_sched_barrier(0)
    Unit cur, nxt; int ui = 0;
    if (!S.next(0, cur)) return;
    f32x4 acc[2][2][4][2];
#pragma unroll
    for (int a = 0; a < 2; ++a)
#pragma unroll
        for (int b = 0; b < 2; ++b)
#pragma unroll
            for (int m = 0; m < 4; ++m)
#pragma unroll
                for (int n = 0; n < 2; ++n) acc[a][b][m][n] = (f32x4){0.f, 0.f, 0.f, 0.f};
    bf16x8 At[4][2], B0[2][2], B1[2][2]; v8i_t At8[4], B08[2], B18[2];
    const char* cA = S.a_base(cur); const char* cB = S.b_base(cur);
    unsigned gA[2][2] = {{0u, 0u}, {0u, 0u}}, gN[2][2] = {{0u, 0u}, {0u, 0u}};
    if constexpr (GATHER) S.a_rows(cur, Rr, Cc, gA);
    PG8_STAGE(PG8_SB(0, 0), cB, voffB); PG8_STAGE(PG8_SB(0, 1), cB + hstep, voffB); PG8_STAGE_A(PG8_SA(0, 0), cA, 0); PG8_STAGE_A(PG8_SA(0, 1), cA, 1);
    if (wr == 1) PG8_BAR;
    PG8_WAIT_V(2); PG8_BAR;
    PG8_STAGE(PG8_SB(1, 0), cB + kstep, voffB); PG8_STAGE_A(PG8_SA(1, 0), cA + kstep, 0); PG8_STAGE(PG8_SB(1, 1), cB + hstep + kstep, voffB);
    PG8_WAIT_V(6); PG8_BAR;
    for (;;) {
        const bool has_next = S.next(ui + 1, nxt);
        const char* nA = has_next ? S.a_base(nxt) : cA; const char* nB = has_next ? S.b_base(nxt) : cB;
        if constexpr (GATHER) { if (has_next) S.a_rows(nxt, Rr, Cc, gN); }
        for (int t = 0; t < nt; t += 2) {
            const bool last = (t == nt - 2);
            const char* a1 = cA + (size_t)(t + 1) * kstep;
            const char* a2 = last ? nA : cA + (size_t)(t + 2) * kstep; const char* b2 = last ? nB : cB + (size_t)(t + 2) * kstep;
            const char* a3 = a2 + kstep; const char* b3 = b2 + kstep;
            PG8_LDB(B0, 0, 0); PG8_LDB(B1, 0, 1); PG8_SCHED; PG8_LDA(At, 0, 0); PG8_STAGE_A(PG8_SA(1, 1), a1, 1);
            if constexpr (GATHER) { if (last && has_next) { asm volatile("" ::: "memory"); gA[0][0] = gN[0][0]; gA[0][1] = gN[0][1]; gA[1][0] = gN[1][0]; gA[1][1] = gN[1][1]; } }
            PG8_WAIT_V(8); PG8_WAIT_L(0); PG8_BAR; PG8_MMA(0, 0, At, B0); PG8_MMA(0, 1, At, B1); PG8_BAR; PG8_SCHED;
            PG8_LDA(At, 0, 1); PG8_STAGE(PG8_SB(0, 0), b2, voffB); PG8_STAGE(PG8_SB(0, 1), b2 + hstep, voffB); PG8_STAGE_A(PG8_SA(0, 0), a2, 0);
            PG8_WAIT_V(8); PG8_WAIT_L(0); PG8_BAR; PG8_MMA(1, 0, At, B0); PG8_MMA(1, 1, At, B1); PG8_BAR; PG8_SCHED;
            PG8_LDB(B0, 1, 0); PG8_LDB(B1, 1, 1); PG8_SCHED; PG8_LDA(At, 1, 0); PG8_STAGE_A(PG8_SA(0, 1), a2, 1);
            PG8_WAIT_V(8); PG8_WAIT_L(0); PG8_BAR; PG8_MMA(0, 0, At, B0); PG8_MMA(0, 1, At, B1); PG8_BAR; PG8_SCHED;
            PG8_LDA(At, 1, 1); PG8_STAGE(PG8_SB(1, 0), b3, voffB); PG8_STAGE(PG8_SB(1, 1), b3 + hstep, voffB); PG8_STAGE_A(PG8_SA(1, 0), a3, 0);
            PG8_WAIT_V(8); PG8_WAIT_L(0); PG8_BAR; PG8_MMA(1, 0, At, B0); PG8_MMA(1, 1, At, B1); PG8_BAR; PG8_SCHED;
        }
        if (wr == 0) PG8_BAR;
        if constexpr (F8) asm volatile("s_nop 15\n\ts_nop 15" ::: "memory");
        E(acc, cur, wr, wc, fr, fq);
        if (!has_next) break;
#pragma unroll
        for (int a = 0; a < 2; ++a)
#pragma unroll
            for (int b = 0; b < 2; ++b)
#pragma unroll
                for (int m = 0; m < 4; ++m)
#pragma unroll
                    for (int n = 0; n < 2; ++n) acc[a][b][m][n] = (f32x4){0.f, 0.f, 0.f, 0.f};
        cur = nxt; cA = nA; cB = nB; ++ui;
        if (wr == 1) PG8_BAR;
    }
    PG8_WAIT_V(0);
    PG8_BAR;
#undef PG8_SA
#undef PG8_SB
#undef PG8_STAGE
#undef PG8_STAGE_A
#undef PG8_LDA
#undef PG8_LDB
#undef PG8_MMA
#undef PG8_LD8
#undef PG8_WAIT_V
#undef PG8_WAIT_L
#undef PG8_BAR
#undef PG8_SCHED
}
}

template <int Mr, int Nc, int K, bool ACCUM>
__device__ __forceinline__ void mm_lds(const LAS bf16* A, int lda, const LAS bf16* Bt, int ldb, f32x4 (&acc)[(Mr / 16) * (Nc / 16) / 8], int wave, int lane) {
    constexpr int NT = Nc / 16, TPW = (Mr / 16) * NT / 8;
    const int fr = lane & 15, fq = lane >> 4;
#pragma unroll
    for (int q = 0; q < TPW; ++q) {
        const int t = wave + 8 * q, ti = t / NT, tj = t % NT;
        f32x4 c = ACCUM ? acc[q] : (f32x4){0.f, 0.f, 0.f, 0.f};
#pragma unroll
        for (int k0 = 0; k0 < K; k0 += 32) {
            const bf16x8 a = *(const LAS bf16x8*)(A + (16 * ti + fr) * lda + k0 + 8 * fq);
            const bf16x8 b = *(const LAS bf16x8*)(Bt + (16 * tj + fr) * ldb + k0 + 8 * fq);
            c = __builtin_amdgcn_mfma_f32_16x16x32_bf16(a, b, c, 0, 0, 0);
        }
        acc[q] = c;
    }
}
#define MM_ROW(NT, q, r) (16 * ((wave + 8 * (q)) / (NT)) + 4 * fq + (r))
#define MM_COL(NT, q)    (16 * ((wave + 8 * (q)) % (NT)) + fr)

struct Args { const float* in[25]; float* out; unsigned char* ws; int ph_lo, ph_hi; };
constexpr int NPHASE = 18;

template <bool F8>
__device__ __forceinline__ void p0_tile(const float* W, int K, int N, void* WTv, int mode, float scale, LAS unsigned* T, int item, int lane) {
    const int nblk = N / 64, kb = item / nblk, nb = item % nblk, k0 = 64 * kb, n0 = 64 * nb;
    const int row0 = mode == 0 ? n0 : ((n0 >> 7) << 8) + (n0 & 127) + (mode == 2 ? 128 : 0);
    const int g = lane >> 4, m = lane & 15;
    constexpr int P = F8 ? 17 : 33;
    f32x4 v[16];
#pragma unroll
    for (int L = 0; L < 16; ++L) { const int kk = F8 ? (16 * (L >> 2) + 4 * g + (L & 3)) : (8 * (L >> 1) + 2 * g + (L & 1)); v[L] = *(const f32x4*)(W + (size_t)(k0 + kk) * N + n0 + 4 * m); }
    if constexpr (F8) {
#pragma unroll
        for (int i = 0; i < 4; ++i)
#pragma unroll
            for (int j = 0; j < 4; ++j) { const float q0 = __builtin_amdgcn_fmed3f(v[4 * i][j] * scale, -448.f, 448.f), q1 = __builtin_amdgcn_fmed3f(v[4 * i + 1][j] * scale, -448.f, 448.f), q2 = __builtin_amdgcn_fmed3f(v[4 * i + 2][j] * scale, -448.f, 448.f), q3 = __builtin_amdgcn_fmed3f(v[4 * i + 3][j] * scale, -448.f, 448.f);
                int w = __builtin_amdgcn_cvt_pk_fp8_f32(q0, q1, 0, false); w = __builtin_amdgcn_cvt_pk_fp8_f32(q2, q3, w, true);
                T[(4 * m + j) * P + 4 * i + g] = (unsigned)w; }
    } else {
#pragma unroll
        for (int i = 0; i < 8; ++i)
#pragma unroll
            for (int j = 0; j < 4; ++j) T[(4 * m + j) * P + 4 * i + g] = pk2(v[2 * i][j], v[2 * i + 1][j]);
    }
    LDS_WAIT(); asm volatile("" ::: "memory");
    if constexpr (F8) {
        unsigned char* WT = (unsigned char*)WTv;
#pragma unroll
        for (int p = 0; p < 4; ++p) { const int n = (lane >> 2) + 16 * p, c = lane & 3; const LAS unsigned* t = T + n * P + 4 * c; u32x4 o; o.x = t[0]; o.y = t[1]; o.z = t[2]; o.w = t[3];
            *(u32x4*)(WT + (size_t)(row0 + n) * K + k0 + 16 * c) = o; }
    } else {
        bf16* WT = (bf16*)WTv;
#pragma unroll
        for (int p = 0; p < 8; ++p) { const int n = (lane >> 3) + 8 * p, c = lane & 7; const LAS unsigned* t = T + n * P + 4 * c; u32x4 o; o.x = t[0]; o.y = t[1]; o.z = t[2]; o.w = t[3];
            *(u32x4*)(WT + (size_t)(row0 + n) * K + k0 + 8 * c) = o; }
    }
    LDS_WAIT(); asm volatile("" ::: "memory");
}
__device__ __forceinline__ void rms_row_bf16(const float* xrow, const float* g, bf16* orow, int lane) {
    const f32x4* xr = (const f32x4*)xrow + lane; const f32x4* gr = (const f32x4*)g + lane;
    f32x4 v[4]; float s = 0.f;
#pragma unroll
    for (int j = 0; j < 4; ++j) { v[j] = xr[64 * j]; s += (v[j].x * v[j].x + v[j].y * v[j].y) + (v[j].z * v[j].z + v[j].w * v[j].w); }
    const float rstd = rsqrtf(wave_sum(s) * (1.f / D) + EPS);
    u32x2* o8 = (u32x2*)orow + lane;
#pragma unroll
    for (int j = 0; j < 4; ++j) { const f32x4 gv = gr[64 * j]; u32x2 w; w.x = pk2(v[j].x * rstd * gv.x, v[j].y * rstd * gv.y); w.y = pk2(v[j].z * rstd * gv.z, v[j].w * rstd * gv.w); o8[64 * j] = w; }
}

__global__ void __launch_bounds__(512, 2) fwd_kernel(Args args) {
    extern __shared__ __attribute__((aligned(16))) unsigned char lds_raw[];
    LAS unsigned char* lds = (LAS unsigned char*)lds_raw;
    volatile LAS unsigned* MISC = (volatile LAS unsigned*)(lds + LDS_MISC);
    LAS unsigned char* scrb = lds + LDS_SCR;
    const int tid = threadIdx.x, lane = tid & 63, wave = __builtin_amdgcn_readfirstlane(tid >> 6);
    const int G = gridDim.x, bid = blockIdx.x;
    const int fr = lane & 15, fq = lane >> 4;
    unsigned char* ws = args.ws;
    unsigned* ctl = (unsigned*)(ws + WS_CTL);
    float* out = args.out;
    const int lo = args.ph_lo, hi = args.ph_hi;

    if (tid < 64) MISC[tid] = 0u;
    __syncthreads();
    XcdBarrier bar; bar.bar = ctl + CW_BAR; bar.x = 0; bar.st = MISC;
    if (hi - lo > 1) bar = xcd_barrier_post(ctl + CW_BAR, MISC);
#ifndef PHASE_MASK
#define PHASE_MASK 0x3ffff
#endif
#define IN(k) ((((PHASE_MASK) >> (k)) & 1) && lo <= (k) && (k) < hi)
#define SEAM(k) do { if (IN(k) && IN((k) + 1)) xcd_barrier(bar); PSTAMP((k) + 1); } while (0)
#define PSTAMP(k) do { if (PROBE_A_LO >= 0 && bid == 0 && tid == 0) { const unsigned _t = (unsigned)wall_clock64(); if ((k) == PROBE_A_LO) MISC[8] = _t; if ((k) == PROBE_A_HI + 1) MISC[9] = _t; if ((k) == PROBE_B_LO) MISC[10] = _t; if ((k) == PROBE_B_HI + 1) MISC[11] = _t; } } while (0)
    PSTAMP(0);

    bf16* const ACTA = (bf16*)(ws + WS_ACTA);
    bf16* const ACTB = (bf16*)(ws + WS_ACTB);
    const f32x2* const ROT = (const f32x2*)(ws + WS_ROT);
    const int gw = bid * 8 + wave, NGW = G * 8;

    if (IN(0)) {
        LAS unsigned* scr = (LAS unsigned*)(scrb + wave * 16384);
        constexpr int I_IN0 = 16 * 56, I_OUT = 16 * 16, I_FF = 16 * 44, I_DN0 = 44 * 16, I_IN1 = 16 * 40, I_EXP = 16 * 56, I_EDN = 56 * 16;
        constexpr int NITEMS = I_IN0 + I_OUT + 2 * I_FF + I_DN0 + I_IN1 + I_OUT + 2 * 8 * I_EXP + 8 * I_EDN;
        for (int it = gw; it < NITEMS; it += NGW) {
            int r = it;
            if (r < 8 * I_EXP) { const int e = r / I_EXP; p0_tile<true>(args.in[22] + (size_t)e * D * D_EXP, D, D_EXP, ws + WT_GU1 + (size_t)e * 2 * D_EXP * D, 1, 64.f, scr, r % I_EXP, lane); continue; } r -= 8 * I_EXP;
            if (r < 8 * I_EXP) { const int e = r / I_EXP; p0_tile<true>(args.in[23] + (size_t)e * D * D_EXP, D, D_EXP, ws + WT_GU1 + (size_t)e * 2 * D_EXP * D, 2, 64.f, scr, r % I_EXP, lane); continue; } r -= 8 * I_EXP;
            if (r < 8 * I_EDN) { const int e = r / I_EDN; p0_tile<true>(args.in[24] + (size_t)e * D_EXP * D, D_EXP, D, ws + WT_DN1 + (size_t)e * D * D_EXP, 0, 64.f, scr, r % I_EDN, lane); continue; } r -= 8 * I_EDN;
            if (r < I_IN0) { p0_tile<false>(args.in[4], D, EVEN_IN, (bf16*)(ws + WT_IN0), 0, 1.f, scr, r, lane); continue; } r -= I_IN0;
            if (r < I_OUT) { p0_tile<false>(args.in[6], D, D, (bf16*)(ws + WT_OUT0), 0, 1.f, scr, r, lane); continue; } r -= I_OUT;
            if (r < I_FF) { p0_tile<false>(args.in[7], D, D_FF, (bf16*)(ws + WT_GU0), 1, 1.f, scr, r, lane); continue; } r -= I_FF;
            if (r < I_FF) { p0_tile<false>(args.in[8], D, D_FF, (bf16*)(ws + WT_GU0), 2, 1.f, scr, r, lane); continue; } r -= I_FF;
            if (r < I_DN0) { p0_tile<false>(args.in[9], D_FF, D, (bf16*)(ws + WT_DN0), 0, 1.f, scr, r, lane); continue; } r -= I_DN0;
            if (r < I_IN1) { p0_tile<false>(args.in[10], D, ODD_IN, (bf16*)(ws + WT_IN1), 0, 1.f, scr, r, lane); continue; } r -= I_IN1;
            p0_tile<false>(args.in[19], D, D, (bf16*)(ws + WT_OUT1), 0, 1.f, scr, r, lane);
        }
        for (int idx = bid * 512 + tid; idx < SEQ * 64; idx += G * 512) {
            const int t = idx >> 6, i = idx & 63;
            const float inv_freq = exp2f(-(float)i * (13.287712379549449f / 64.0f));
            double rev = (double)t * (double)inv_freq * 0.15915494309189535; rev -= floor(rev);
            const float rv = (float)rev;
            f32x2 cs; cs.x = __builtin_amdgcn_cosf(rv); cs.y = __builtin_amdgcn_sinf(rv);
            ((f32x2*)(ws + WS_ROT))[idx] = cs;
        }
        for (int m = gw; m < M; m += NGW) rms_row_bf16(args.in[0] + (size_t)m * D, args.in[1], ACTA + (size_t)m * D, lane);
    }
    SEAM(0);

    if (IN(1)) {
        pg8::DenseSched S; S.init(ACTA, (const bf16*)(ws + WT_IN0), M, EVEN_IN, D, G, bid);
        pg8::EpiStoreBf16 E{ACTB, EVEN_IN};
        pg8::gemm_phase<pg8::EpiStoreBf16, pg8::DenseSched, false>(scrb, 2 * D, S, E);
    }
    SEAM(1);

    constexpr int LQ = 136, LT = 72;
    LAS bf16* const rQ = (LAS bf16*)(scrb);
    LAS bf16* const rK = (LAS bf16*)(scrb + 17408);
    LAS bf16* const rKdT = (LAS bf16*)(scrb + 34816);
    LAS bf16* const rVT = (LAS bf16*)(scrb + 53248);
    LAS bf16* const rS = (LAS bf16*)(scrb + 71680);
    LAS bf16* const rStT = (LAS bf16*)(scrb + 80896);
    LAS float* const rStat = (LAS float*)(scrb + 115712);
    float* const RGS = (float*)(ws + WS_SCR);

    if (IN(2)) {
        for (int item = bid; item < 256; item += G) {
            const int b = item >> 5, h = (item >> 3) & 3, g = item & 7;
            const float l2g = log2f(1.0f - exp2f(-5.0f - (float)h));
            const float g64 = exp2f(64.0f * l2g);
            f32x4 st[8];
#pragma unroll
            for (int q = 0; q < 8; ++q) st[q] = (f32x4){0.f, 0.f, 0.f, 0.f};
            for (int n = 0; n < 8; ++n) {
                const int tpos0 = (g * 8 + n) * 64; const size_t row0 = (size_t)b * SEQ + tpos0;
                { const int i = lane;
#pragma unroll 1
                    for (int r = 0; r < 8; ++r) { const int j = wave + 8 * r; const bf16* prow = ACTB + (row0 + j) * EVEN_IN; const f32x2 cs = ROT[(tpos0 + j) * 64 + i];
                        const float k1 = bf2f(prow[RK_OFF + 128 * h + i]), k2 = bf2f(prow[RK_OFF + 128 * h + 64 + i]);
                        const float dec = exp2f((float)(63 - j) * l2g) * 0.08838834764831845f;
                        const float kr1 = (k1 * cs.x - k2 * cs.y) * dec, kr2 = (k1 * cs.y + k2 * cs.x) * dec;
                        rKdT[i * LT + j] = (bf16)f2bf(kr1); rKdT[(i + 64) * LT + j] = (bf16)f2bf(kr2);
                        rVT[i * LT + j] = prow[RV_OFF + 128 * h + i]; rVT[(i + 64) * LT + j] = prow[RV_OFF + 128 * h + 64 + i]; } }
                __syncthreads();
#pragma unroll
                for (int q = 0; q < 8; ++q) st[q] = st[q] * g64;
                mm_lds<128, 128, 64, true>(rVT, LT, rKdT, LT, st, wave, lane);
                __syncthreads();
            }
            float* gp = RGS + (size_t)item * 16384 + tid;
#pragma unroll
            for (int q = 0; q < 8; ++q)
#pragma unroll
                for (int r = 0; r < 4; ++r) gp[(q * 4 + r) * 512] = st[q][r];
        }
        {
            LAS bf16* const sQ = (LAS bf16*)(scrb);
            LAS bf16* const sK = (LAS bf16*)(scrb + 9216);
            LAS bf16* const sVT = (LAS bf16*)(scrb + 18432);
            LAS bf16* const sA = (LAS bf16*)(scrb + 27648);
            LAS float* const sZ = (LAS float*)(scrb + 36864);
            volatile LAS unsigned* sFlag = (volatile LAS unsigned*)(scrb + 54272);
            const int srow = tid >> 3, sseg = tid & 7;
            for (int item = bid; item < NB * 8 * 64; item += G) {
                const int qb = 63 - (item & 63), h = (item >> 6) & 7, b = item >> 9;
                const size_t qrow0 = (size_t)b * SEQ + 64 * qb;
                __syncthreads();
                *(u32x4*)(sQ + srow * LT + 8 * sseg) = *(const u32x4*)(ACTB + (qrow0 + srow) * EVEN_IN + SQ_OFF + 64 * h + 8 * sseg);
                f32x4 o[2]; o[0] = (f32x4){0.f, 0.f, 0.f, 0.f}; o[1] = o[0];
                float C = 1.0f;
                for (int kt = qb; kt >= 0; --kt) {
                    const size_t krow0 = (size_t)b * SEQ + 64 * kt;
                    { const bf16* prow = ACTB + (krow0 + srow) * EVEN_IN;
                      *(u32x4*)(sK + srow * LT + 8 * sseg) = *(const u32x4*)(prow + SK_OFF + 64 * h + 8 * sseg);
                      const u32x4 vv = *(const u32x4*)(prow + SV_OFF + 64 * h + 8 * sseg);
                      const unsigned vw[4] = {vv.x, vv.y, vv.z, vv.w};
#pragma unroll
                      for (int c = 0; c < 4; ++c) { sVT[(8 * sseg + 2 * c) * LT + srow] = (bf16)(vw[c] & 0xffffu); sVT[(8 * sseg + 2 * c + 1) * LT + srow] = (bf16)(vw[c] >> 16); } }
                    if (tid == 0) sFlag[0] = 0u;
                    __syncthreads();
                    { f32x4 z[2]; mm_lds<64, 64, 64, false>(sQ, LT, sK, LT, z, wave, lane);
#pragma unroll
                      for (int q = 0; q < 2; ++q)
#pragma unroll
                          for (int r = 0; r < 4; ++r) sZ[MM_ROW(4, q, r) * 68 + MM_COL(4, q)] = z[q][r] * 0.125f; }
                    __syncthreads();
                    {
                      const int tq = 64 * qb + srow, s0 = 64 * kt + 8 * sseg;
                      float p[8], a[8];
#pragma unroll
                      for (int c = 0; c < 8; ++c) { const float z = sZ[srow * 68 + 8 * sseg + c]; const bool valid = (s0 + c) < tq; const float pp = 1.0f / (1.0f + __expf(z)); p[c] = valid ? pp : 1.0f; a[c] = valid ? 1.0f - pp : 0.0f; }
                      float suf = 1.0f;
#pragma unroll
                      for (int c = 7; c >= 0; --c) { a[c] *= suf; suf *= p[c]; }
                      float Eo = 1.0f;
#pragma unroll
                      for (int k = 1; k < 8; ++k) { const float tv = __shfl_down(suf, k, 8); if (sseg + k < 8) Eo *= tv; }
                      const float ptot = __shfl(Eo * suf, 0, 8);
                      const float sc = Eo * C;
                      u32x4 w; w.x = pk2(a[0] * sc, a[1] * sc); w.y = pk2(a[2] * sc, a[3] * sc); w.z = pk2(a[4] * sc, a[5] * sc); w.w = pk2(a[6] * sc, a[7] * sc);
                      *(u32x4*)(sA + srow * LT + 8 * sseg) = w;
                      C *= ptot;
                      if (C >= 1e-30f) sFlag[0] = 1u; }
                    __syncthreads();
                    mm_lds<64, 64, 64, true>(sA, LT, sVT, LT, o, wave, lane);
                    const unsigned more = sFlag[0];
                    __syncthreads();
                    if (more == 0u) break;
                }
#pragma unroll
                for (int q = 0; q < 2; ++q)
#pragma unroll
                    for (int r = 0; r < 4; ++r) ACTA[(qrow0 + MM_ROW(4, q, r)) * D + 512 + 64 * h + MM_COL(4, q)] = (bf16)f2bf(o[q][r]);
            }
        }
    }
    SEAM(2);

    if (IN(3)) {
        for (int item = bid; item < 256; item += G) {
            const int b = item >> 5, h = (item >> 3) & 3, g = item & 7;
            const float l2g = log2f(1.0f - exp2f(-5.0f - (float)h));
            const float g64 = exp2f(64.0f * l2g), g512 = exp2f(512.0f * l2g);
            f32x4 st[8];
#pragma unroll
            for (int q = 0; q < 8; ++q) st[q] = (f32x4){0.f, 0.f, 0.f, 0.f};
            for (int gp_ = 0; gp_ < g; ++gp_) {
                const float* gp = RGS + (size_t)(item - g + gp_) * 16384 + tid;
#pragma unroll
                for (int q = 0; q < 8; ++q)
#pragma unroll
                    for (int r = 0; r < 4; ++r) st[q][r] = st[q][r] * g512 + gp[(q * 4 + r) * 512];
            }
            for (int n = 0; n < 8; ++n) {
                const int tpos0 = (g * 8 + n) * 64; const size_t row0 = (size_t)b * SEQ + tpos0;
                __syncthreads();
                { const int i = lane;
#pragma unroll 1
                    for (int r = 0; r < 8; ++r) { const int j = wave + 8 * r; const bf16* prow = ACTB + (row0 + j) * EVEN_IN; const f32x2 cs = ROT[(tpos0 + j) * 64 + i];
                        const float q1 = bf2f(prow[RQ_OFF + 128 * h + i]), q2 = bf2f(prow[RQ_OFF + 128 * h + 64 + i]);
                        const float k1 = bf2f(prow[RK_OFF + 128 * h + i]) * 0.08838834764831845f, k2 = bf2f(prow[RK_OFF + 128 * h + 64 + i]) * 0.08838834764831845f;
                        const float qr1 = q1 * cs.x - q2 * cs.y, qr2 = q1 * cs.y + q2 * cs.x;
                        const float kr1 = k1 * cs.x - k2 * cs.y, kr2 = k1 * cs.y + k2 * cs.x;
                        const float dec = exp2f((float)(63 - j) * l2g);
                        rQ[j * LQ + i] = (bf16)f2bf(qr1); rQ[j * LQ + 64 + i] = (bf16)f2bf(qr2);
                        rK[j * LQ + i] = (bf16)f2bf(kr1); rK[j * LQ + 64 + i] = (bf16)f2bf(kr2);
                        rKdT[i * LT + j] = (bf16)f2bf(kr1 * dec); rKdT[(i + 64) * LT + j] = (bf16)f2bf(kr2 * dec);
                        rVT[i * LT + j] = prow[RV_OFF + 128 * h + i]; rVT[(i + 64) * LT + j] = prow[RV_OFF + 128 * h + 64 + i]; } }
#pragma unroll
                for (int q = 0; q < 8; ++q)
#pragma unroll
                    for (int r = 0; r < 4; ++r) rStT[MM_ROW(8, q, r) * LQ + MM_COL(8, q)] = (bf16)f2bf(st[q][r]);
                __syncthreads();
                { f32x4 s[2]; mm_lds<64, 64, 128, false>(rQ, LQ, rK, LQ, s, wave, lane);
#pragma unroll
                  for (int q = 0; q < 2; ++q)
#pragma unroll
                      for (int r = 0; r < 4; ++r) { const int i = MM_ROW(4, q, r), j = MM_COL(4, q); const int dd = i > j ? i - j : j - i; rS[i * LT + j] = (bf16)f2bf(s[q][r] * exp2f((float)dd * l2g)); } }
                __syncthreads();
                f32x4 oi[4];
                mm_lds<64, 128, 128, false>(rQ, LQ, rStT, LQ, oi, wave, lane);
#pragma unroll
                for (int q = 0; q < 4; ++q)
#pragma unroll
                    for (int r = 0; r < 4; ++r) oi[q][r] *= exp2f((float)(MM_ROW(8, q, r) + 1) * l2g);
                mm_lds<64, 128, 64, true>(rS, LT, rVT, LT, oi, wave, lane);
#pragma unroll
                for (int q = 0; q < 4; ++q)
#pragma unroll
                    for (int r = 0; r < 4; ++r) { const int i = MM_ROW(8, q, r);
                        float s1 = oi[q][r], s2 = oi[q][r] * oi[q][r];
#pragma unroll
                        for (int o = 1; o < 16; o <<= 1) { s1 += __shfl_xor(s1, o); s2 += __shfl_xor(s2, o); }
                        if (fr == 0) { rStat[(i * 8 + wave) * 2] = s1; rStat[(i * 8 + wave) * 2 + 1] = s2; } }
                __syncthreads();
                if (tid < 64) { float s1 = 0.f, s2 = 0.f;
#pragma unroll
                    for (int w = 0; w < 8; ++w) { s1 += rStat[(tid * 8 + w) * 2]; s2 += rStat[(tid * 8 + w) * 2 + 1]; }
                    const float mu = s1 * (1.0f / 128.0f); float var = s2 * (1.0f / 128.0f) - mu * mu; var = var < 0.f ? 0.f : var;
                    rStat[1024 + tid * 2] = mu; rStat[1024 + tid * 2 + 1] = var; }
                __syncthreads();
#pragma unroll
                for (int q = 0; q < 4; ++q)
#pragma unroll
                    for (int r = 0; r < 4; ++r) { const int i = MM_ROW(8, q, r), e = MM_COL(8, q);
                        const float mu = rStat[1024 + i * 2], var = rStat[1024 + i * 2 + 1];
                        const float y = (oi[q][r] - mu) * rsqrtf(var + EPS);
                        const float gate = bf2f(ACTB[(row0 + i) * EVEN_IN + RGATE_OFF + 128 * h + e]);
                        const float yo = y * args.in[5][128 * h + e] * (gate / (1.0f + __expf(-gate)));
                        ACTA[(row0 + i) * D + 128 * h + e] = (bf16)f2bf(yo); }
#pragma unroll
                for (int q = 0; q < 8; ++q) st[q] = st[q] * g64;
                mm_lds<128, 128, 64, true>(rVT, LT, rKdT, LT, st, wave, lane);
            }
        }
    }
    SEAM(3);

    if (IN(4)) {
        pg8::DenseSched S; S.init(ACTA, (const bf16*)(ws + WT_OUT0), M, D, D, G, bid);
        pg8::EpiResF32 E{args.in[0], out, D};
        pg8::gemm_phase<pg8::EpiResF32, pg8::DenseSched, false>(scrb, 2 * D, S, E);
    }
    SEAM(4);
    if (IN(5)) { for (int m = gw; m < M; m += NGW) rms_row_bf16(out + (size_t)m * D, args.in[2], ACTA + (size_t)m * D, lane); }
    SEAM(5);
    if (IN(6)) {
        pg8::DenseSched S; S.init(ACTA, (const bf16*)(ws + WT_GU0), M, 2 * D_FF, D, G, bid);
        pg8::EpiSwiGLU E{ACTB, D_FF};
        pg8::gemm_phase<pg8::EpiSwiGLU, pg8::DenseSched, false>(scrb, 2 * D, S, E);
    }
    SEAM(6);
    if (IN(7)) {
        pg8::DenseSched S; S.init(ACTB, (const bf16*)(ws + WT_DN0), M, D, D_FF, G, bid);
        pg8::EpiResF32 E{out, out, D};
        pg8::gemm_phase<pg8::EpiResF32, pg8::DenseSched, false>(scrb, 2 * D_FF, S, E);
    }
    SEAM(7);
    if (IN(8)) { for (int m = gw; m < M; m += NGW) rms_row_bf16(out + (size_t)m * D, args.in[1] + D, ACTA + (size_t)m * D, lane); }
    SEAM(8);
    if (IN(9)) {
        pg8::DenseSched S; S.init(ACTA, (const bf16*)(ws + WT_IN1), M, ODD_IN, D, G, bid);
        pg8::EpiStoreBf16 E{ACTB, ODD_IN};
        pg8::gemm_phase<pg8::EpiStoreBf16, pg8::DenseSched, false>(scrb, 2 * D, S, E);
    }
    SEAM(9);

    float* const LSUM = (float*)(ws + WS_SCR);
#pragma unroll
    for (int pass = 0; pass < 2; ++pass) {
        if (IN(10 + pass)) {
            LAS bf16* const XR = (LAS bf16*)(scrb + wave * 17408);
            LAS float* const AB = (LAS float*)(scrb + wave * 17408 + 9216);
            const int head = wave, ch = 64 * head + lane;
            bf16x8 Bwa[4][2], Bwx[4][2];
#pragma unroll
            for (int tj = 0; tj < 4; ++tj)
#pragma unroll
                for (int ks = 0; ks < 2; ++ks) { bf16x8 va, vx;
#pragma unroll
                    for (int e = 0; e < 8; ++e) { const int i = 32 * ks + 8 * fq + e, j = 16 * tj + fr; va[e] = (short)f2bf(args.in[14][(size_t)(head * 64 + i) * 64 + j]); vx[e] = (short)f2bf(args.in[16][(size_t)(head * 64 + i) * 64 + j]); }
                    Bwa[tj][ks] = va; Bwx[tj][ks] = vx; }
            float cba[4], cbx[4], csp[4];
#pragma unroll
            for (int tj = 0; tj < 4; ++tj) { const int c = 64 * head + 16 * tj + fr; cba[tj] = args.in[15][c]; cbx[tj] = args.in[17][c]; csp[tj] = log1pf(__expf(-args.in[18][c])); }
            const float cw0 = args.in[12][ch], cw1 = args.in[12][512 + ch], cw2 = args.in[12][1024 + ch], cw3 = args.in[12][1536 + ch], cbias = args.in[13][ch];
            for (int it = bid; it < NB * 64; it += G) {
                const int b = it >> 6, c = it & 63; const size_t row0 = (size_t)b * SEQ + 64 * c;
                { float x0 = 0.f, x1 = 0.f, x2 = 0.f;
                  if (c > 0) { x0 = bf2f(ACTB[(row0 - 3) * ODD_IN + XR_OFF + ch]); x1 = bf2f(ACTB[(row0 - 2) * ODD_IN + XR_OFF + ch]); x2 = bf2f(ACTB[(row0 - 1) * ODD_IN + XR_OFF + ch]); }
                  for (int t = 0; t < 64; ++t) { const float x3 = bf2f(ACTB[(row0 + t) * ODD_IN + XR_OFF + ch]);
                      XR[t * LT + lane] = (bf16)f2bf(cw0 * x0 + cw1 * x1 + cw2 * x2 + cw3 * x3 + cbias); x0 = x1; x1 = x2; x2 = x3; } }
                float hst = 0.f, cum = 1.f;
                if (pass == 1) {
                    for (int c0 = 0; c0 < c; c0 += 8) {
                        f32x2 sv[8];
#pragma unroll
                        for (int k = 0; k < 8; ++k) { const int cc = (c0 + k < c) ? c0 + k : c0; sv[k] = ((const f32x2*)LSUM)[(size_t)(b * 64 + cc) * 512 + ch]; }
#pragma unroll
                        for (int k = 0; k < 8; ++k) if (c0 + k < c) hst = sv[k].x * hst + sv[k].y;
                    }
                }
                LDS_WAIT(); asm volatile("" ::: "memory");
                for (int sb = 0; sb < 4; ++sb) {
                    f32x4 aR[4], aX[4];
#pragma unroll
                    for (int tj = 0; tj < 4; ++tj) { aR[tj] = (f32x4){0.f, 0.f, 0.f, 0.f}; aX[tj] = aR[tj]; }
#pragma unroll
                    for (int ks = 0; ks < 2; ++ks) { const bf16x8 af = *(const LAS bf16x8*)(XR + (16 * sb + fr) * LT + 32 * ks + 8 * fq);
#pragma unroll
                        for (int tj = 0; tj < 4; ++tj) { aR[tj] = __builtin_amdgcn_mfma_f32_16x16x32_bf16(af, Bwa[tj][ks], aR[tj], 0, 0, 0); aX[tj] = __builtin_amdgcn_mfma_f32_16x16x32_bf16(af, Bwx[tj][ks], aX[tj], 0, 0, 0); } }
#pragma unroll
                    for (int tj = 0; tj < 4; ++tj)
#pragma unroll
                        for (int r = 0; r < 4; ++r) { const int tl = 4 * fq + r, j = 16 * tj + fr;
                            const float rg = sigmoidf_(aR[tj][r] + cba[tj]), ig = sigmoidf_(aX[tj][r] + cbx[tj]);
                            const float la = -8.0f * rg * csp[tj]; const float a = __expf(la); const float mult = sqrtf(-expm1f(2.0f * la));
                            const float xv = bf2f(XR[(16 * sb + tl) * LT + j]);
                            AB[tl * 64 + j] = a; AB[1024 + tl * 64 + j] = mult * ig * xv; }
                    LDS_WAIT(); asm volatile("" ::: "memory");
                    for (int tl = 0; tl < 16; ++tl) { const float a = AB[tl * 64 + lane], bb = AB[1024 + tl * 64 + lane]; hst = a * hst + bb; cum *= a;
                        if (pass == 1) { const size_t row = row0 + 16 * sb + tl; const float xg = bf2f(ACTB[row * ODD_IN + XG_OFF + ch]);
                            const float u3 = 0.7978845608028654f * (xg + 0.044715f * xg * xg * xg); const float th = 1.0f - 2.0f / (1.0f + __expf(2.0f * u3));
                            ACTA[row * D + 512 + ch] = (bf16)f2bf(hst * 0.5f * xg * (1.0f + th)); } }
                    LDS_WAIT(); asm volatile("" ::: "memory");
                }
                if (pass == 0) { f32x2 sv; sv.x = cum; sv.y = hst; ((f32x2*)LSUM)[(size_t)(b * 64 + c) * 512 + ch] = sv; }
            }
            if (pass == 1) {
                for (int idx = bid * 512 + tid; idx < M * 64; idx += G * 512) {
                    const int row = idx >> 6, c8 = (idx & 63) * 8; const int t = row & (SEQ - 1);
                    const bf16* p = ACTB + (size_t)row * ODD_IN;
                    float acc8[8];
#pragma unroll
                    for (int x = 0; x < 8; ++x) acc8[x] = 0.f;
#pragma unroll
                    for (int k = 0; k < 3; ++k) { const int dt = 2 - k; if (t - dt >= 0) { const bf16* pr = p - (size_t)dt * ODD_IN;
                            const u32x4 gc = *(const u32x4*)(pr + CC_OFF + c8), uu = *(const u32x4*)(pr + CU_OFF + c8); const unsigned gw_[4] = {gc.x, gc.y, gc.z, gc.w}, uw[4] = {uu.x, uu.y, uu.z, uu.w};
#pragma unroll
                            for (int x = 0; x < 4; ++x) { acc8[2 * x] += args.in[11][k * 512 + c8 + 2 * x] * bf2f(gw_[x]) * bf2f(uw[x]); acc8[2 * x + 1] += args.in[11][k * 512 + c8 + 2 * x + 1] * bf2f(gw_[x] >> 16) * bf2f(uw[x] >> 16); } } }
                    const u32x4 gb = *(const u32x4*)(p + CB_OFF + c8); const unsigned gbw[4] = {gb.x, gb.y, gb.z, gb.w};
                    u32x4 w; unsigned ww[4];
#pragma unroll
                    for (int x = 0; x < 4; ++x) ww[x] = pk2(bf2f(gbw[x]) * acc8[2 * x], bf2f(gbw[x] >> 16) * acc8[2 * x + 1]);
                    w.x = ww[0]; w.y = ww[1]; w.z = ww[2]; w.w = ww[3];
                    *(u32x4*)(ACTA + (size_t)row * D + c8) = w;
                }
            }
        }
        SEAM(10 + pass);
    }

    if (IN(12)) {
        pg8::DenseSched S; S.init(ACTA, (const bf16*)(ws + WT_OUT1), M, D, D, G, bid);
        pg8::EpiResF32 E{out, out, D};
        pg8::gemm_phase<pg8::EpiResF32, pg8::DenseSched, false>(scrb, 2 * D, S, E);
    }
    SEAM(12);

    int* const LTOK = (int*)(ws + SCR_LTOK); float* const LW = (float*)(ws + SCR_LW);
    if (IN(13)) {
        LAS int* const lcnt = (LAS int*)(scrb);
        LAS int* const lbase = (LAS int*)(scrb + 64);
        LAS int* const recE = (LAS int*)(scrb + 128);
        LAS int* const recR = (LAS int*)(scrb + 128 + 1024);
        LAS float* const recW = (LAS float*)(scrb + 128 + 2048);
        float wr_[4][4][8];
#pragma unroll
        for (int j = 0; j < 4; ++j)
#pragma unroll
            for (int x = 0; x < 4; ++x) { const int col = 4 * (lane + 64 * j) + x; const f32x4 w0 = *(const f32x4*)(args.in[20] + (size_t)col * 8), w1 = *(const f32x4*)(args.in[20] + (size_t)col * 8 + 4);
                wr_[j][x][0] = w0.x; wr_[j][x][1] = w0.y; wr_[j][x][2] = w0.z; wr_[j][x][3] = w0.w; wr_[j][x][4] = w1.x; wr_[j][x][5] = w1.y; wr_[j][x][6] = w1.z; wr_[j][x][7] = w1.w; }
        for (int base = bid * 128; base < M; base += G * 128) {
            if (tid < 16) lcnt[tid] = 0;
            __syncthreads();
            for (int rr = 0; rr < 16; ++rr) {
                const int lr = wave * 16 + rr, m = base + lr;
                const f32x4* xr = (const f32x4*)(out + (size_t)m * D) + lane; const f32x4* gr = (const f32x4*)(args.in[2] + D) + lane;
                f32x4 v[4]; float s = 0.f;
#pragma unroll
                for (int j = 0; j < 4; ++j) { v[j] = xr[64 * j]; s += (v[j].x * v[j].x + v[j].y * v[j].y) + (v[j].z * v[j].z + v[j].w * v[j].w); }
                const float rstd = rsqrtf(wave_sum(s) * (1.f / D) + EPS);
                float lg[8];
#pragma unroll
                for (int e = 0; e < 8; ++e) lg[e] = 0.f;
                unsigned* o8 = (unsigned*)((unsigned char*)ACTA + (size_t)m * D) + lane;
#pragma unroll
                for (int j = 0; j < 4; ++j) { const f32x4 gv = gr[64 * j]; float y[4] = {v[j].x * rstd * gv.x, v[j].y * rstd * gv.y, v[j].z * rstd * gv.z, v[j].w * rstd * gv.w};
                    { int w = __builtin_amdgcn_cvt_pk_fp8_f32(__builtin_amdgcn_fmed3f(y[0], -448.f, 448.f), __builtin_amdgcn_fmed3f(y[1], -448.f, 448.f), 0, false);
                      w = __builtin_amdgcn_cvt_pk_fp8_f32(__builtin_amdgcn_fmed3f(y[2], -448.f, 448.f), __builtin_amdgcn_fmed3f(y[3], -448.f, 448.f), w, true); o8[64 * j] = (unsigned)w; }
#pragma unroll
                    for (int x = 0; x < 4; ++x)
#pragma unroll
                        for (int e = 0; e < 8; ++e) lg[e] += y[x] * wr_[j][x][e]; }
#pragma unroll
                for (int e = 0; e < 8; ++e) lg[e] = wave_sum(lg[e]) + args.in[21][e];
                int e1 = 0; float l1 = lg[0];
#pragma unroll
                for (int e = 1; e < 8; ++e) if (lg[e] > l1) { l1 = lg[e]; e1 = e; }
                int e2 = -1; float l2 = -3.0e38f;
#pragma unroll
                for (int e = 0; e < 8; ++e) if (e != e1 && lg[e] > l2) { l2 = lg[e]; e2 = e; }
                const float w2 = 1.0f / (1.0f + __expf(l1 - l2)), w1 = 1.0f - w2;
                if (lane == 0) { recE[lr * 2] = e1; recE[lr * 2 + 1] = e2; recW[lr * 2] = w1; recW[lr * 2 + 1] = w2;
                    recR[lr * 2] = __hip_atomic_fetch_add(&lcnt[e1], 1, __ATOMIC_RELAXED, __HIP_MEMORY_SCOPE_WORKGROUP); recR[lr * 2 + 1] = __hip_atomic_fetch_add(&lcnt[8 + e2], 1, __ATOMIC_RELAXED, __HIP_MEMORY_SCOPE_WORKGROUP); }
            }
            __syncthreads();
            if (tid < 16) lbase[tid] = (int)__hip_atomic_fetch_add(ctl + CW_CNT + 64 * tid, (unsigned)lcnt[tid], RLX_AGENT);
            __syncthreads();
            if (tid < 256) { const int lr = tid >> 1, k = tid & 1; const int e = recE[tid]; const int pos = lbase[k * 8 + e] + recR[tid];
                if (pos < LIST_CAP) { LTOK[(size_t)(k * 8 + e) * LIST_CAP + pos] = base + lr; LW[(size_t)(k * 8 + e) * LIST_CAP + pos] = recW[tid]; } }
            __syncthreads();
        }
    }
    SEAM(13);

    if (IN(14)) {
        pg8::MoeSched S; S.init(ACTA, ws + WT_GU1, LTOK, ctl + CW_CNT, 0, 2 * D_EXP / 256, D, 0, (size_t)2 * D_EXP * D, G, bid);
        pg8::EpiSwiGLU8 E{(unsigned char*)ACTB, D_EXP, 1.0f / 64.0f, 4.0f};
        pg8::gemm_phase<pg8::EpiSwiGLU8, pg8::MoeSched, true, true>(scrb, D, S, E);
    }
    SEAM(14);
#pragma unroll
    for (int k = 0; k < 2; ++k) {
        if (IN(15 + k)) {
            pg8::MoeSched S; S.init(ACTB, ws + WT_DN1, LTOK, ctl + CW_CNT, 1 + k, D / 256, D_EXP, (size_t)256 * D_EXP, (size_t)D * D_EXP, G, bid);
            pg8::EpiMoeDown E{out, LTOK, LW, 1.0f / 256.0f};
            pg8::gemm_phase<pg8::EpiMoeDown, pg8::MoeSched, false, true>(scrb, D_EXP, S, E);
        }
        SEAM(15 + k);
    }

    if (IN(17)) {
        for (int m = gw; m < M; m += NGW) {
            f32x4* xr = (f32x4*)(out + (size_t)m * D) + lane; const f32x4* gr = (const f32x4*)args.in[3] + lane;
            f32x4 v[4]; float s = 0.f;
#pragma unroll
            for (int j = 0; j < 4; ++j) { v[j] = xr[64 * j]; s += (v[j].x * v[j].x + v[j].y * v[j].y) + (v[j].z * v[j].z + v[j].w * v[j].w); }
            const float rstd = rsqrtf(wave_sum(s) * (1.f / D) + EPS);
#pragma unroll
            for (int j = 0; j < 4; ++j) { const f32x4 gv = gr[64 * j]; xr[64 * j] = v[j] * rstd * gv; }
        }
    }
    if (PROBE_A_LO >= 0 && bid == 0 && tid == 0) {
        const unsigned long long t_end = wall_clock64();
        const unsigned long long qa = (unsigned long long)((MISC[9] - MISC[8] + 800u) / 1600u), qb = (PROBE_B_LO >= 0) ? (unsigned long long)((MISC[11] - MISC[10] + 800u) / 1600u) : 0ull;
        const unsigned long long wait = qa * 1600ull + qb * 409600ull;
        while (wall_clock64() - t_end < wait) __builtin_amdgcn_s_sleep(32);
    }
#undef IN
#undef SEAM
#undef PSTAMP
}

extern "C" void kernel_launch(void* const* d_in, const int* in_sizes, int n_in, void* d_out, int out_size, void* d_ws, size_t ws_size, hipStream_t stream) {
    static int grid = 0;
    if (grid == 0) {
        if (n_in != 25 || in_sizes[0] != M * D || out_size != M * D || ws_size < WS_END) { fprintf(stderr, "kernel_launch: unexpected shapes / workspace (n_in %d, ws %zu, need %zu)\n", n_in, ws_size, (size_t)WS_END); grid = -1; return; }
        int dev = 0, cus = 0, per_cu = 0;
        if (hipGetDevice(&dev) != hipSuccess || hipDeviceGetAttribute(&cus, hipDeviceAttributeMultiprocessorCount, dev) != hipSuccess) { grid = -1; return; }
        if (hipFuncSetAttribute((const void*)fwd_kernel, hipFuncAttributeMaxDynamicSharedMemorySize, LDS_BYTES) != hipSuccess) { fprintf(stderr, "kernel_launch: hipFuncSetAttribute failed\n"); grid = -1; return; }
        if (hipOccupancyMaxActiveBlocksPerMultiprocessor(&per_cu, (const void*)fwd_kernel, 512, LDS_BYTES) != hipSuccess || per_cu < 1) { fprintf(stderr, "kernel_launch: occupancy query says %d\n", per_cu); }
        (void)hipGetLastError();
        grid = cus;
    }
    if (grid < 0) return;
    if (hipMemsetAsync((char*)d_ws + WS_CTL, 0, CTL_ZERO_BYTES, stream) != hipSuccess) return;
    Args a{};
    for (int i = 0; i < 25; ++i) a.in[i] = (const float*)d_in[i];
    a.out = (float*)d_out; a.ws = (unsigned char*)d_ws;
#if MK_N_LAUNCHES == 1
    a.ph_lo = 0; a.ph_hi = NPHASE;
    hipLaunchKernelGGL(fwd_kernel, dim3(grid), dim3(512), LDS_BYTES, stream, a);
#else
    for (int p = 0; p < NPHASE; ++p) { a.ph_lo = p; a.ph_hi = p + 1; hipLaunchKernelGGL(fwd_kernel, dim3(grid), dim3(512), LDS_BYTES, stream, a); }
#endif
}
```

```cpp
#include <hip/hip_runtime.h>
#include <cstdio>
#include <cstdint>

#ifndef OLD_DENSE
#define OLD_DENSE 0
#endif
#ifndef MK_N_LAUNCHES
#define MK_N_LAUNCHES 1
#endif

#ifndef PROBE_A_LO
#define PROBE_A_LO (-1)
#define PROBE_A_HI (-1)
#define PROBE_B_LO (-1)
#define PROBE_B_HI (-1)
#endif
#define GAS __attribute__((address_space(1)))
#define LAS __attribute__((address_space(3)))
typedef unsigned short bf16;
typedef short bf16x8 __attribute__((ext_vector_type(8)));
typedef float f32x4 __attribute__((ext_vector_type(4)));
typedef float f32x2 __attribute__((ext_vector_type(2)));
typedef unsigned u32x4 __attribute__((ext_vector_type(4)));
typedef unsigned u32x2 __attribute__((ext_vector_type(2)));
typedef int v4i_t __attribute__((ext_vector_type(4)));
typedef int v8i_t __attribute__((ext_vector_type(8)));

constexpr int D = 1024, NB = 8, SEQ = 4096, M = NB * SEQ;
constexpr int EVEN_IN = 3584, ODD_IN = 2560, D_FF = 2816, D_EXP = 3584, NEXP = 8;
constexpr int RQ_OFF = 0, RK_OFF = 512, RV_OFF = 1024, RGATE_OFF = 1536, SQ_OFF = 2048, SK_OFF = 2560, SV_OFF = 3072;
constexpr int CB_OFF = 0, CC_OFF = 512, CU_OFF = 1024, XR_OFF = 1536, XG_OFF = 2048;
constexpr float EPS = 1e-6f;
constexpr int LIST_CAP = 32768;
constexpr int MAX_TILES = 135;

constexpr size_t MiB = 1u << 20;
constexpr size_t WS_CTL = 0, CTL_ZERO_BYTES = 1 * MiB;
constexpr size_t WS_ROT = 1 * MiB;
constexpr size_t WS_SCR = 3 * MiB;
constexpr size_t WS_WB = 19 * MiB;
constexpr size_t WT_DN1 = WS_WB;
constexpr size_t WT_IN0 = 47 * MiB;
constexpr size_t WT_OUT0 = WT_IN0 + (size_t)EVEN_IN * D * 2;
constexpr size_t WT_GU0 = WT_OUT0 + (size_t)D * D * 2;
constexpr size_t WT_DN0 = WT_GU0 + (size_t)2 * D_FF * D * 2;
constexpr size_t WT_IN1 = WT_DN0 + (size_t)D * D_FF * 2;
constexpr size_t WT_OUT1 = WT_IN1 + (size_t)ODD_IN * D * 2;
constexpr size_t WT_GU1 = WT_OUT1 + (size_t)D * D * 2;
constexpr size_t WB_END = WT_GU1 + (size_t)NEXP * 2 * D_EXP * D;
constexpr size_t WS_ACTA = 136 * MiB;
constexpr size_t WS_ACTB = 200 * MiB;
constexpr size_t WS_END = WS_ACTB + (size_t)MAX_TILES * 256 * D_EXP * 2;
constexpr size_t WS_Y = WT_IN0;
static_assert(WT_DN1 + (size_t)NEXP * D * D_EXP <= WT_IN0 && WB_END <= WS_ACTA && WS_ACTA + (size_t)M * D * 2 <= WS_ACTB, "weights overlap");
static_assert(WS_Y + (size_t)2 * MAX_TILES * 256 * D * 2 <= WS_ACTB, "y overlay");
static_assert((size_t)M * EVEN_IN * 2 <= (size_t)MAX_TILES * 256 * D_EXP * 2, "ACTB size");
constexpr size_t SCR_LTOK = WS_SCR, SCR_REC = WS_SCR + 4 * MiB;
constexpr int CW_BAR = 4096;
constexpr int CW_TB = 16384;
constexpr int CW_CNT = 8192;

constexpr int LDS_MISC = 0;
constexpr int LDS_SCR = 256;
constexpr int LDS_BYTES = 147456;

#define RLX_AGENT __ATOMIC_RELAXED, __HIP_MEMORY_SCOPE_AGENT
#define LDS_WAIT() asm volatile("s_waitcnt lgkmcnt(0)" ::: "memory")
__device__ __forceinline__ unsigned f2bf(float f) { unsigned u = __builtin_bit_cast(unsigned, f); return (u + 0x7fffu + ((u >> 16) & 1u)) >> 16; }
__device__ __forceinline__ unsigned pk2(float lo, float hi) { return f2bf(lo) | (f2bf(hi) << 16); }
__device__ __forceinline__ float bf2f(unsigned b) { return __builtin_bit_cast(float, (b & 0xffffu) << 16); }
__device__ __forceinline__ float wave_sum(float v) {
#pragma unroll
    for (int o = 1; o < 64; o <<= 1) v += __shfl_xor(v, o);
    return v;
}
__device__ __forceinline__ float sigmoidf_(float x) { return __builtin_amdgcn_rcpf(1.0f + __builtin_amdgcn_exp2f(x * -1.4426950408889634f)); }

#define XB_TMO      128
#define XB_XCNT(j)  (256  + 64 * (j))
#define XB_XSUB(j)  (1280 + 64 * (j))
#define XB_XGEN(j)  (2304 + 64 * (j))
#define XB_TOP      3328
#define XB_TOPGEN   3392
#define XCD_BAR_WORDS 3456
#define XB_SPIN_CAP (1u << 18)

__device__ __forceinline__ unsigned xb_ld(unsigned* p)              { return __hip_atomic_load(p, __ATOMIC_RELAXED, __HIP_MEMORY_SCOPE_AGENT); }
__device__ __forceinline__ unsigned xb_add(unsigned* p, unsigned v) { return __hip_atomic_fetch_add(p, v, __ATOMIC_RELAXED, __HIP_MEMORY_SCOPE_AGENT); }
__device__ __forceinline__ unsigned xb_xcc_id() { return (unsigned)__builtin_amdgcn_s_getreg((3 << 11) | 20) & 0xFu; }
#define XB_SPIN(cond, bar) do { unsigned _sp = 0; while (cond) { __builtin_amdgcn_s_sleep(1); \
    if ((++_sp & 255u) == 0u) { if (xb_ld(&(bar)[XB_TMO])) break; if (_sp > XB_SPIN_CAP) { atomicAdd(&(bar)[XB_TMO], 1u); break; } } } } while (0)

struct XcdBarrier { unsigned* bar; unsigned x; volatile LAS unsigned* st; };

__device__ __forceinline__ XcdBarrier xcd_barrier_post(unsigned* bar, volatile LAS unsigned* st) {
    XcdBarrier b; b.bar = bar; b.x = xb_xcc_id(); b.st = st;
    if (threadIdx.x == 0) (void)xb_add(&bar[XB_XCNT(b.x)], 1u);
    return b;
}
__device__ __forceinline__ void xcd_barrier_complete(unsigned* bar, unsigned x, unsigned& nloc, unsigned& nx) {
    const unsigned G = gridDim.x * gridDim.y * gridDim.z;
    unsigned sum, cnt, mine, sp = 0u;
    for (;;) {
        sum = 0u; cnt = 0u; mine = 0u;
#pragma unroll
        for (unsigned j = 0; j < 16; ++j) { const unsigned c = xb_ld(&bar[XB_XCNT(j)]); sum += c; cnt += (c > 0u) ? 1u : 0u; mine = (j == x) ? c : mine; }
        if (sum == G) break;
        __builtin_amdgcn_s_sleep(1);
        if ((++sp & 255u) == 0u) { if (xb_ld(&bar[XB_TMO])) break; if (sp > XB_SPIN_CAP) { atomicAdd(&bar[XB_TMO], 1u); break; } }
    }
    nloc = mine > 0u ? mine : 1u; nx = cnt > 0u ? cnt : 1u;
}
__device__ __forceinline__ void xcd_barrier(const XcdBarrier& b) {
    asm volatile("s_waitcnt vmcnt(0)" ::: "memory");
    __syncthreads();
    if (threadIdx.x == 0) {
        unsigned* bar = b.bar;
        __builtin_amdgcn_s_waitcnt(0);
        unsigned nloc = b.st[0], nx = b.st[1];
        if (nloc == 0u) { xcd_barrier_complete(bar, b.x, nloc, nx); b.st[0] = nloc; b.st[1] = nx; }
        const unsigned old = xb_add(&bar[XB_XSUB(b.x)], 1u);
        const unsigned gen = old / nloc;
        if (old + 1u == (gen + 1u) * nloc) {
            __builtin_amdgcn_fence(__ATOMIC_RELEASE, "agent");
            asm volatile("s_waitcnt vmcnt(0)" ::: "memory");
            const unsigned og = xb_add(&bar[XB_TOP], 1u);
            const unsigned tg = og / nx;
            if (og + 1u == (tg + 1u) * nx) xb_add(&bar[XB_TOPGEN], 1u);
            else XB_SPIN(xb_ld(&bar[XB_TOPGEN]) == tg, bar);
            __builtin_amdgcn_fence(__ATOMIC_ACQUIRE, "agent");
            xb_add(&bar[XB_XGEN(b.x)], 1u);
            asm volatile("s_waitcnt vmcnt(0)" ::: "memory");
        } else {
            XB_SPIN(xb_ld(&bar[XB_XGEN(b.x)]) == gen, bar);
            __builtin_amdgcn_fence(__ATOMIC_ACQUIRE, "agent");
            asm volatile("s_waitcnt vmcnt(0)" ::: "memory");
        }
    }
    __syncthreads();
}

namespace pg8 {
constexpr int BM = 256, BK = 64, HALF = 128, HTB = HALF * BK * 2, STAGE_BYTES = 8 * HTB, NXCD = 8, WGM = 8;
__device__ __forceinline__ int lds_byte(int r, int c) { const int st = (r >> 4) * 2 + (c >> 5), rr = r & 15, cc = c & 31, ob = rr * 64 + cc * 2; return st * 1024 + (ob ^ (((ob >> 9) & 1) << 5)); }
__device__ __forceinline__ void stage_rc(int b, int& R, int& C) { const int st = b / 1024, sb = b % 1024, swz = sb ^ (((sb >> 9) & 1) << 5); R = (st >> 1) * 16 + swz / 64; C = (st & 1) * 32 + (swz % 64) / 2; }
__device__ __forceinline__ int perm32(int rho) { const int n = rho >> 4, i = rho & 15; return 8 * (i >> 2) + 4 * n + (i & 3); }

struct Unit { int pm, pn, e, lt, cn; };

struct StaticOrder {
    int nM, nN, nwg, G, c;
    __device__ __forceinline__ void init_tiles(int nM_, int nN_, int G_, int c_) { nM = nM_; nN = nN_; nwg = nM * nN; G = G_; c = c_; }
    __device__ __forceinline__ bool next_tile(int i, int& pm, int& pn) const {
        const long L = (long)i * G + c; if (L >= nwg) return false;
        int wgid = (int)L; { const int q = nwg / NXCD, r = nwg % NXCD, xcd = wgid % NXCD, off = wgid / NXCD; wgid = (xcd < r ? xcd * (q + 1) : r * (q + 1) + (xcd - r) * q) + off; }
        const int nig = WGM * nN, gid = wgid / nig, fm = gid * WGM, gsz = (nM - fm) < WGM ? (nM - fm) : WGM;
        pm = fm + ((wgid % nig) % gsz); pn = (wgid % nig) / gsz; return true;
    }
};
struct DenseSched : StaticOrder {
    const char* A; const char* Bt; size_t tstep;
    __device__ __forceinline__ void init(const bf16* A_, const bf16* Bt_, int Mr, int N, int K, int G_, int c_) { A = (const char*)A_; Bt = (const char*)Bt_; tstep = (size_t)BM * K * 2; init_tiles(Mr / BM, N / BM, G_, c_); }
    __device__ __forceinline__ bool next(int i, Unit& u) const { u.e = 0; u.lt = 0; u.cn = 0; return next_tile(i, u.pm, u.pn); }
    __device__ __forceinline__ const char* a_base(const Unit& u) const { return A + (size_t)u.pm * tstep; }
    __device__ __forceinline__ const char* b_base(const Unit& u) const { return Bt + (size_t)u.pn * tstep; }
    __device__ __forceinline__ void a_rows(const Unit&, const int (&)[2], const int (&)[2], unsigned (&)[2][2]) const {}
};
struct MoeSched : StaticOrder {
    const char* A; const char* Bt; size_t a_tstep, b_estep, b_tstep; const int* ltok; int rowb, toff;
    int c0, c1, c2, c3, c4, c5, c6, c7, c8, c9, c10, c11, c12, c13, c14, c15, t1, t2, t3, t4, t5, t6, t7, t8, t9, t10, t11, t12, t13, t14, t15, t16;
    __device__ __forceinline__ static int ldc_(const unsigned* cntw, int e) { int c = (int)__builtin_amdgcn_readfirstlane(__hip_atomic_load(cntw + 64 * e, RLX_AGENT)); return c > LIST_CAP ? LIST_CAP : c; }
    __device__ __forceinline__ void init(const void* A_, const void* Bt_, const int* ltok_, const unsigned* cntw, int which, int nN_, int rowb_, size_t a_tstep_, size_t b_estep_, int G_, int c_) {
        A = (const char*)A_; Bt = (const char*)Bt_; ltok = ltok_; rowb = rowb_; a_tstep = a_tstep_; b_estep = b_estep_; b_tstep = (size_t)BM * rowb_;
        c0 = ldc_(cntw, 0); c1 = ldc_(cntw, 1); c2 = ldc_(cntw, 2); c3 = ldc_(cntw, 3); c4 = ldc_(cntw, 4); c5 = ldc_(cntw, 5); c6 = ldc_(cntw, 6); c7 = ldc_(cntw, 7);
        c8 = ldc_(cntw, 8); c9 = ldc_(cntw, 9); c10 = ldc_(cntw, 10); c11 = ldc_(cntw, 11); c12 = ldc_(cntw, 12); c13 = ldc_(cntw, 13); c14 = ldc_(cntw, 14); c15 = ldc_(cntw, 15);
        t1 = (c0 + 255) >> 8; t2 = t1 + ((c1 + 255) >> 8); t3 = t2 + ((c2 + 255) >> 8); t4 = t3 + ((c3 + 255) >> 8); t5 = t4 + ((c4 + 255) >> 8); t6 = t5 + ((c5 + 255) >> 8); t7 = t6 + ((c6 + 255) >> 8); t8 = t7 + ((c7 + 255) >> 8);
        t9 = t8 + ((c8 + 255) >> 8); t10 = t9 + ((c9 + 255) >> 8); t11 = t10 + ((c10 + 255) >> 8); t12 = t11 + ((c11 + 255) >> 8); t13 = t12 + ((c12 + 255) >> 8); t14 = t13 + ((c13 + 255) >> 8); t15 = t14 + ((c14 + 255) >> 8); t16 = t15 + ((c15 + 255) >> 8);
        toff = which == 2 ? t8 : 0;
        init_tiles(which == 0 ? t16 : (which == 1 ? t8 : t16 - t8), nN_, G_, c_);
    }
    __device__ __forceinline__ bool next(int i, Unit& u) const {
        int pml; if (!next_tile(i, pml, u.pn)) return false;
        const int pm = pml + toff; u.pm = pm;
        const int m1 = pm >= t1, m2 = pm >= t2, m3 = pm >= t3, m4 = pm >= t4, m5 = pm >= t5, m6 = pm >= t6, m7 = pm >= t7, m8 = pm >= t8, m9 = pm >= t9, m10 = pm >= t10, m11 = pm >= t11, m12 = pm >= t12, m13 = pm >= t13, m14 = pm >= t14, m15 = pm >= t15;
        const int e = m1 + m2 + m3 + m4 + m5 + m6 + m7 + m8 + m9 + m10 + m11 + m12 + m13 + m14 + m15;
        const int base = m1 * t1 + m2 * (t2 - t1) + m3 * (t3 - t2) + m4 * (t4 - t3) + m5 * (t5 - t4) + m6 * (t6 - t5) + m7 * (t7 - t6) + m8 * (t8 - t7) + m9 * (t9 - t8) + m10 * (t10 - t9) + m11 * (t11 - t10) + m12 * (t12 - t11) + m13 * (t13 - t12) + m14 * (t14 - t13) + m15 * (t15 - t14);
        const int cn = c0 + m1 * (c1 - c0) + m2 * (c2 - c1) + m3 * (c3 - c2) + m4 * (c4 - c3) + m5 * (c5 - c4) + m6 * (c6 - c5) + m7 * (c7 - c6) + m8 * (c8 - c7) + m9 * (c9 - c8) + m10 * (c10 - c9) + m11 * (c11 - c10) + m12 * (c12 - c11) + m13 * (c13 - c12) + m14 * (c14 - c13) + m15 * (c15 - c14);
        u.e = e; u.lt = pm - base; u.cn = cn; return true;
    }
    __device__ __forceinline__ const char* a_base(const Unit& u) const { return A + (size_t)u.pm * a_tstep; }
    __device__ __forceinline__ const char* b_base(const Unit& u) const { return Bt + (size_t)(u.e & 7) * b_estep + (size_t)u.pn * b_tstep; }
    __device__ __forceinline__ void a_rows(const Unit& u, const int (&R)[2], const int (&C)[2], unsigned (&off)[2][2]) const {
#pragma unroll
        for (int h = 0; h < 2; ++h)
#pragma unroll
            for (int i = 0; i < 2; ++i) { int rank = u.lt * 256 + h * HALF + R[i]; rank = rank < u.cn ? rank : u.cn - 1;
                const int tok = ltok[(size_t)u.e * LIST_CAP + rank]; off[h][i] = (unsigned)tok * (unsigned)rowb + (unsigned)(C[i] * 2); }
    }
};

__device__ __forceinline__ unsigned cvt_pk_bf16(float lo, float hi) { unsigned r; asm volatile("v_cvt_pk_bf16_f32 %0, %1, %2" : "=v"(r) : "v"(lo), "v"(hi)); return r; }

struct EpiStoreBf16 {
    static constexpr bool PERM = true;
    bf16* O; int ldc;
    __device__ __forceinline__ void operator()(const f32x4 (&acc)[2][2][4][2], const Unit& u, int wr, int wc, int fr, int fq) const {
        const int row0 = u.pm * BM + wr * 64 + fr, col0 = u.pn * BM + wc * 32 + 8 * fq;
#pragma unroll
        for (int ai = 0; ai < 2; ++ai)
#pragma unroll
            for (int m = 0; m < 4; ++m) { bf16* rowp = O + (size_t)(row0 + ai * HALF + m * 16) * ldc + col0;
#pragma unroll
                for (int bj = 0; bj < 2; ++bj) { const f32x4 v0 = acc[ai][bj][m][0], v1 = acc[ai][bj][m][1];
                    u32x4 w; w.x = cvt_pk_bf16(v0[0], v0[1]); w.y = cvt_pk_bf16(v0[2], v0[3]); w.z = cvt_pk_bf16(v1[0], v1[1]); w.w = cvt_pk_bf16(v1[2], v1[3]);
                    *(u32x4*)(rowp + bj * HALF) = w; } }
    }
};
struct EpiResF32 {
    static constexpr bool PERM = false;
    const float* base; float* out; int ldc;
    __device__ __forceinline__ void operator()(const f32x4 (&acc)[2][2][4][2], const Unit& u, int wr, int wc, int fr, int fq) const {
        const int row0 = u.pm * BM + wr * 64 + fr, col0 = u.pn * BM + wc * 32 + 4 * fq;
#pragma unroll
        for (int ai = 0; ai < 2; ++ai)
#pragma unroll
            for (int m = 0; m < 4; ++m) { const size_t off = (size_t)(row0 + ai * HALF + m * 16) * ldc + col0;
#pragma unroll
                for (int bj = 0; bj < 2; ++bj)
#pragma unroll
                    for (int n = 0; n < 2; ++n) { const f32x4 bs = *(const f32x4*)(base + off + bj * HALF + n * 16); *(f32x4*)(out + off + bj * HALF + n * 16) = bs + acc[ai][bj][m][n]; } }
    }
};
struct EpiSwiGLU {
    static constexpr bool PERM = true;
    bf16* H; int ldh;
    __device__ __forceinline__ void operator()(const f32x4 (&acc)[2][2][4][2], const Unit& u, int wr, int wc, int fr, int fq) const {
        const int row0 = u.pm * BM + wr * 64 + fr, col0 = u.pn * HALF + wc * 32 + 8 * fq;
#pragma unroll
        for (int ai = 0; ai < 2; ++ai)
#pragma unroll
            for (int m = 0; m < 4; ++m) { bf16* rowp = H + (size_t)(row0 + ai * HALF + m * 16) * ldh + col0;
                float h[8];
#pragma unroll
                for (int n = 0; n < 2; ++n)
#pragma unroll
                    for (int x = 0; x < 4; ++x) { const float g = acc[ai][0][m][n][x], up = acc[ai][1][m][n][x]; h[4 * n + x] = g * up * __builtin_amdgcn_rcpf(1.0f + __builtin_amdgcn_exp2f(g * -1.4426950408889634f)); }
                u32x4 w; w.x = cvt_pk_bf16(h[0], h[1]); w.y = cvt_pk_bf16(h[2], h[3]); w.z = cvt_pk_bf16(h[4], h[5]); w.w = cvt_pk_bf16(h[6], h[7]);
                *(u32x4*)rowp = w; }
    }
};
struct EpiSwiGLU8 {
    static constexpr bool PERM = true;
    unsigned char* H; int ldh; float iscale, oscale;
    __device__ __forceinline__ void operator()(const f32x4 (&acc)[2][2][4][2], const Unit& u, int wr, int wc, int fr, int fq) const {
        const int row0 = u.pm * BM + wr * 64 + fr, col0 = u.pn * HALF + wc * 32 + 8 * fq;
#pragma unroll
        for (int ai = 0; ai < 2; ++ai)
#pragma unroll
            for (int m = 0; m < 4; ++m) { unsigned char* rowp = H + (size_t)(row0 + ai * HALF + m * 16) * ldh + col0;
                float h[8];
#pragma unroll
                for (int n = 0; n < 2; ++n)
#pragma unroll
                    for (int x = 0; x < 4; ++x) { const float ga = acc[ai][0][m][n][x], ua = acc[ai][1][m][n][x];
                        h[4 * n + x] = __builtin_amdgcn_fmed3f(ga * ua * (iscale * iscale * oscale) * __builtin_amdgcn_rcpf(1.0f + __builtin_amdgcn_exp2f(ga * (-1.4426950408889634f * iscale))), -448.0f, 448.0f); }
                int w0 = __builtin_amdgcn_cvt_pk_fp8_f32(h[0], h[1], 0, false); w0 = __builtin_amdgcn_cvt_pk_fp8_f32(h[2], h[3], w0, true);
                int w1 = __builtin_amdgcn_cvt_pk_fp8_f32(h[4], h[5], 0, false); w1 = __builtin_amdgcn_cvt_pk_fp8_f32(h[6], h[7], w1, true);
                u32x2 w; w.x = (unsigned)w0; w.y = (unsigned)w1; *(u32x2*)rowp = w; }
    }
};
struct EpiMoeDown {
    static constexpr bool PERM = false;
    float* out; const int* ltok; const float* lw; float scale;
    __device__ __forceinline__ void operator()(const f32x4 (&acc)[2][2][4][2], const Unit& u, int wr, int wc, int fr, int fq) const {
        const int col0 = u.pn * BM + wc * 32 + 4 * fq;
#pragma unroll
        for (int ai = 0; ai < 2; ++ai)
#pragma unroll
            for (int m = 0; m < 4; ++m) { const int rank = u.lt * 256 + ai * HALF + wr * 64 + m * 16 + fr;
                if (rank < u.cn) { const int tok = ltok[(size_t)u.e * LIST_CAP + rank]; const float w = lw[(size_t)u.e * LIST_CAP + rank] * scale; float* rowp = out + (size_t)tok * D + col0;
#pragma unroll
                    for (int bj = 0; bj < 2; ++bj)
#pragma unroll
                        for (int n = 0; n < 2; ++n) { const f32x4 bs = *(const f32x4*)(rowp + bj * HALF + n * 16); *(f32x4*)(rowp + bj * HALF + n * 16) = bs + acc[ai][bj][m][n] * w; } } }
    }
};

template <class Epi, class Sched, bool GATHER, bool F8 = false>
__device__ __forceinline__ void gemm_phase(LAS unsigned char* lds, const int rowb, const Sched& S, const Epi& E) {
    const int tid = threadIdx.x, wid = __builtin_amdgcn_readfirstlane(tid >> 6), lane = tid & 63, wr = wid >> 2, wc = wid & 3, fr = lane & 15, fq = lane >> 4;
    const int nt = rowb / 128;
    unsigned voffA[2], voffB[2]; int Rr[2], Cc[2];
#pragma unroll
    for (int i = 0; i < 2; ++i) { int R, C; stage_rc(tid * 16 + i * 8192, R, C); const int Rb = Epi::PERM ? ((R & ~31) + perm32(R & 31)) : R;
        voffA[i] = (unsigned)(R * rowb + C * 2); voffB[i] = (unsigned)(Rb * rowb + C * 2); Rr[i] = R; Cc[i] = C; }
    const size_t kstep = (size_t)(BK * 2);
    const size_t hstep = (size_t)HALF * rowb;
    const unsigned ldsw = (unsigned)wid * 1024u;
    const int aoff = lds_byte(wr * 64 + fr, fq * 8), boff = lds_byte(wc * 32 + fr, fq * 8);
#define PG8_SA(b, h) (((b) * 2 + (h)) * HTB)
#define PG8_SB(b, h) ((4 + (b) * 2 + (h)) * HTB)
#define PG8_STAGE(bufoff, gbase, voff) do { _Pragma("unroll") for (int _i = 0; _i < 2; ++_i) \
        __builtin_amdgcn_global_load_lds((const unsigned*)((const char*)(gbase) + (voff)[_i]), (LAS unsigned*)(lds + (bufoff) + ldsw + _i * 8192), 16, 0, 0); } while (0)
#define PG8_STAGE_A(bufoff, kptr, h) do { if constexpr (GATHER) PG8_STAGE(bufoff, kptr, gA[h]); else PG8_STAGE(bufoff, (kptr) + (h) * hstep, voffA); } while (0)
#define PG8_LD8(base) __builtin_shufflevector(*(const LAS v4i_t*)(base), *(const LAS v4i_t*)((base) + 1024), 0, 1, 2, 3, 4, 5, 6, 7)
#define PG8_LDA(dst, b, h) do { _Pragma("unroll") for (int m = 0; m < 4; ++m) { if constexpr (F8) dst##8[m] = PG8_LD8(lds + PG8_SA(b, h) + aoff + m * 2048); else { _Pragma("unroll") for (int k = 0; k < 2; ++k) dst[m][k] = *(const LAS bf16x8*)(lds + PG8_SA(b, h) + aoff + m * 2048 + k * 1024); } } } while (0)
#define PG8_LDB(dst, b, h) do { _Pragma("unroll") for (int n = 0; n < 2; ++n) { if constexpr (F8) dst##8[n] = PG8_LD8(lds + PG8_SB(b, h) + boff + n * 2048); else { _Pragma("unroll") for (int k = 0; k < 2; ++k) dst[n][k] = *(const LAS bf16x8*)(lds + PG8_SB(b, h) + boff + n * 2048 + k * 1024); } } } while (0)
#define PG8_MMA(ai, bj, At, Bt) do { __builtin_amdgcn_s_setprio(1); _Pragma("unroll") for (int m = 0; m < 4; ++m) _Pragma("unroll") for (int n = 0; n < 2; ++n) { \
        if constexpr (F8) asm volatile("v_mfma_f32_16x16x128_f8f6f4 %0, %1, %2, %0" : "+v"(acc[ai][bj][m][n]) : "v"(Bt##8[n]), "v"(At##8[m])); \
        else { _Pragma("unroll") for (int k = 0; k < 2; ++k) acc[ai][bj][m][n] = __builtin_amdgcn_mfma_f32_16x16x32_bf16(Bt[n][k], At[m][k], acc[ai][bj][m][n], 0, 0, 0); } } \
        __builtin_amdgcn_s_setprio(0); } while (0)
#define PG8_WAIT_V(n) asm volatile("s_waitcnt vmcnt(" #n ")" ::: "memory")
#define PG8_WAIT_L(n) asm volatile("s_waitcnt lgkmcnt(" #n ")" ::: "memory")
#define PG8_BAR __builtin_amdgcn_s_barrier()
#define PG8_SCHED __builtin_amdgcn_sched_barrier(0)
    Unit cur, nxt; int ui = 0;
    if (!S.next(0, cur)) return;
    f32x4 acc[2][2][4][2];
#pragma unroll
    for (int a = 0; a < 2; ++a)
#pragma unroll
        for (int b = 0; b < 2; ++b)
#pragma unroll
            for (int m = 0; m < 4; ++m)
#pragma unroll
                for (int n = 0; n < 2; ++n) acc[a][b][m][n] = (f32x4){0.f, 0.f, 0.f, 0.f};
    bf16x8 At[4][2], B0[2][2], B1[2][2]; v8i_t At8[4], B08[2], B18[2];
    const char* cA = S.a_base(cur); const char* cB = S.b_base(cur);
    unsigned gA[2][2] = {{0u, 0u}, {0u, 0u}}, gN[2][2] = {{0u, 0u}, {0u, 0u}};
    if constexpr (GATHER) S.a_rows(cur, Rr, Cc, gA);
    PG8_STAGE(PG8_SB(0, 0), cB, voffB); PG8_STAGE(PG8_SB(0, 1), cB + hstep, voffB); PG8_STAGE_A(PG8_SA(0, 0), cA, 0); PG8_STAGE_A(PG8_SA(0, 1), cA, 1);
    if (wr == 1) PG8_BAR;
    PG8_WAIT_V(2); PG8_BAR;
    PG8_STAGE(PG8_SB(1, 0), cB + kstep, voffB); PG8_STAGE_A(PG8_SA(1, 0), cA + kstep, 0); PG8_STAGE(PG8_SB(1, 1), cB + hstep + kstep, voffB);
    PG8_WAIT_V(6); PG8_BAR;
    for (;;) {
        const bool has_next = S.next(ui + 1, nxt);
        const char* nA = has_next ? S.a_base(nxt) : cA; const char* nB = has_next ? S.b_base(nxt) : cB;
        if constexpr (GATHER) { if (has_next) S.a_rows(nxt, Rr, Cc, gN); }
        for (int t = 0; t < nt; t += 2) {
            const bool last = (t == nt - 2);
            const char* a1 = cA + (size_t)(t + 1) * kstep;
            const char* a2 = last ? nA : cA + (size_t)(t + 2) * kstep; const char* b2 = last ? nB : cB + (size_t)(t + 2) * kstep;
            const char* a3 = a2 + kstep; const char* b3 = b2 + kstep;
            PG8_LDB(B0, 0, 0); PG8_LDB(B1, 0, 1); PG8_SCHED; PG8_LDA(At, 0, 0); PG8_STAGE_A(PG8_SA(1, 1), a1, 1);
            if constexpr (GATHER) { if (last && has_next) { asm volatile("" ::: "memory"); gA[0][0] = gN[0][0]; gA[0][1] = gN[0][1]; gA[1][0] = gN[1][0]; gA[1][1] = gN[1][1]; } }
            PG8_WAIT_V(8); PG8_WAIT_L(0); PG8_BAR; PG8_MMA(0, 0, At, B0); PG8_MMA(0, 1, At, B1); PG8_BAR; PG8_SCHED;
            PG8_LDA(At, 0, 1); PG8_STAGE(PG8_SB(0, 0), b2, voffB); PG8_STAGE(PG8_SB(0, 1), b2 + hstep, voffB); PG8_STAGE_A(PG8_SA(0, 0), a2, 0);
            PG8_WAIT_V(8); PG8_WAIT_L(0); PG8_BAR; PG8_MMA(1, 0, At, B0); PG8_MMA(1, 1, At, B1); PG8_BAR; PG8_SCHED;
            PG8_LDB(B0, 1, 0); PG8_LDB(B1, 1, 1); PG8_SCHED; PG8_LDA(At, 1, 0); PG8_STAGE_A(PG8_SA(0, 1), a2, 1);
            PG8_WAIT_V(8); PG8_WAIT_L(0); PG8_BAR; PG8_MMA(0, 0, At, B0); PG8_MMA(0, 1, At, B1); PG8_BAR; PG8_SCHED;
            PG8_LDA(At, 1, 1); PG8_STAGE(PG8_SB(1, 0), b3, voffB); PG8_STAGE(PG8_SB(1, 1), b3 + hstep, voffB); PG8_STAGE_A(PG8_SA(1, 0), a3, 0);
            PG8_WAIT_V(8); PG8_WAIT_L(0); PG8_BAR; PG8_MMA(1, 0, At, B0); PG8_MMA(1, 1, At, B1); PG8_BAR; PG8_SCHED;
        }
        if (wr == 0) PG8_BAR;
        if constexpr (F8) asm volatile("s_nop 15\n\ts_nop 15" ::: "memory");
        E(acc, cur, wr, wc, fr, fq);
        if (!has_next) break;
#pragma unroll
        for (int a = 0; a < 2; ++a)
#pragma unroll
            for (int b = 0; b < 2; ++b)
#pragma unroll
                for (int m = 0; m < 4; ++m)
#pragma unroll
                    for (int n = 0; n < 2; ++n) acc[a][b][m][n] = (f32x4){0.f, 0.f, 0.f, 0.f};
        cur = nxt; cA = nA; cB = nB; ++ui;
        if (wr == 1) PG8_BAR;
    }
    PG8_WAIT_V(0);
    PG8_BAR;
#undef PG8_SA
#undef PG8_SB
#undef PG8_STAGE
#undef PG8_STAGE_A
#undef PG8_LDA
#undef PG8_LDB
#undef PG8_MMA
#undef PG8_LD8
#undef PG8_WAIT_V
#undef PG8_WAIT_L
#undef PG8_BAR
#undef PG8_SCHED
}
}

template <int Mr, int Nc, int K, bool ACCUM>
__device__ __forceinline__ void mm_lds(const LAS bf16* A, int lda, const LAS bf16* Bt, int ldb, f32x4 (&acc)[(Mr / 16) * (Nc / 16) / 8], int wave, int lane) {
    constexpr int NT = Nc / 16, TPW = (Mr / 16) * NT / 8;
    const int fr = lane & 15, fq = lane >> 4;
#pragma unroll
    for (int q = 0; q < TPW; ++q) {
        const int t = wave + 8 * q, ti = t / NT, tj = t % NT;
        f32x4 c = ACCUM ? acc[q] : (f32x4){0.f, 0.f, 0.f, 0.f};
#pragma unroll
        for (int k0 = 0; k0 < K; k0 += 32) {
            const bf16x8 a = *(const LAS bf16x8*)(A + (16 * ti + fr) * lda + k0 + 8 * fq);
            const bf16x8 b = *(const LAS bf16x8*)(Bt + (16 * tj + fr) * ldb + k0 + 8 * fq);
            c = __builtin_amdgcn_mfma_f32_16x16x32_bf16(a, b, c, 0, 0, 0);
        }
        acc[q] = c;
    }
}
#define MM_ROW(NT, q, r) (16 * ((wave + 8 * (q)) / (NT)) + 4 * fq + (r))
#define MM_COL(NT, q)    (16 * ((wave + 8 * (q)) % (NT)) + fr)

struct Args { const float* in[25]; float* out; unsigned char* ws; int ph_lo, ph_hi; };
constexpr int NPHASE = 17;

template <bool F8>
__device__ __forceinline__ void p0_tile(const float* W, int K, int N, void* WTv, int mode, float scale, LAS unsigned* T, int item, int lane) {
    const int nblk = N / 64, kb = item / nblk, nb = item % nblk, k0 = 64 * kb, n0 = 64 * nb;
    const int row0 = mode == 0 ? n0 : ((n0 >> 7) << 8) + (n0 & 127) + (mode == 2 ? 128 : 0);
    const int g = lane >> 4, m = lane & 15;
    constexpr int P = F8 ? 17 : 33;
    f32x4 v[16];
#pragma unroll
    for (int L = 0; L < 16; ++L) { const int kk = F8 ? (16 * (L >> 2) + 4 * g + (L & 3)) : (8 * (L >> 1) + 2 * g + (L & 1)); v[L] = *(const f32x4*)(W + (size_t)(k0 + kk) * N + n0 + 4 * m); }
    if constexpr (F8) {
#pragma unroll
        for (int i = 0; i < 4; ++i)
#pragma unroll
            for (int j = 0; j < 4; ++j) { const float q0 = __builtin_amdgcn_fmed3f(v[4 * i][j] * scale, -448.f, 448.f), q1 = __builtin_amdgcn_fmed3f(v[4 * i + 1][j] * scale, -448.f, 448.f), q2 = __builtin_amdgcn_fmed3f(v[4 * i + 2][j] * scale, -448.f, 448.f), q3 = __builtin_amdgcn_fmed3f(v[4 * i + 3][j] * scale, -448.f, 448.f);
                int w = __builtin_amdgcn_cvt_pk_fp8_f32(q0, q1, 0, false); w = __builtin_amdgcn_cvt_pk_fp8_f32(q2, q3, w, true);
                T[(4 * m + j) * P + 4 * i + g] = (unsigned)w; }
    } else {
#pragma unroll
        for (int i = 0; i < 8; ++i)
#pragma unroll
            for (int j = 0; j < 4; ++j) T[(4 * m + j) * P + 4 * i + g] = pk2(v[2 * i][j], v[2 * i + 1][j]);
    }
    LDS_WAIT(); asm volatile("" ::: "memory");
    if constexpr (F8) {
        unsigned char* WT = (unsigned char*)WTv;
#pragma unroll
        for (int p = 0; p < 4; ++p) { const int n = (lane >> 2) + 16 * p, c = lane & 3; const LAS unsigned* t = T + n * P + 4 * c; u32x4 o; o.x = t[0]; o.y = t[1]; o.z = t[2]; o.w = t[3];
            *(u32x4*)(WT + (size_t)(row0 + n) * K + k0 + 16 * c) = o; }
    } else {
        bf16* WT = (bf16*)WTv;
#pragma unroll
        for (int p = 0; p < 8; ++p) { const int n = (lane >> 3) + 8 * p, c = lane & 7; const LAS unsigned* t = T + n * P + 4 * c; u32x4 o; o.x = t[0]; o.y = t[1]; o.z = t[2]; o.w = t[3];
            *(u32x4*)(WT + (size_t)(row0 + n) * K + k0 + 8 * c) = o; }
    }
    LDS_WAIT(); asm volatile("" ::: "memory");
}
__device__ __forceinline__ void rms_row_bf16(const float* xrow, const float* g, bf16* orow, int lane) {
    const f32x4* xr = (const f32x4*)xrow + lane; const f32x4* gr = (const f32x4*)g + lane;
    f32x4 v[4]; float s = 0.f;
#pragma unroll
    for (int j = 0; j < 4; ++j) { v[j] = xr[64 * j]; s += (v[j].x * v[j].x + v[j].y * v[j].y) + (v[j].z * v[j].z + v[j].w * v[j].w); }
    const float rstd = rsqrtf(wave_sum(s) * (1.f / D) + EPS);
    u32x2* o8 = (u32x2*)orow + lane;
#pragma unroll
    for (int j = 0; j < 4; ++j) { const f32x4 gv = gr[64 * j]; u32x2 w; w.x = pk2(v[j].x * rstd * gv.x, v[j].y * rstd * gv.y); w.y = pk2(v[j].z * rstd * gv.z, v[j].w * rstd * gv.w); o8[64 * j] = w; }
}

__device__ __forceinline__ void rms_res_row_bf16(const float* xin, const bf16* drow, float* xout, const float* g, bf16* orow, int lane) {
    const f32x4* xr = (const f32x4*)xin + lane; const f32x4* gr = (const f32x4*)g + lane; const u32x2* dr = (const u32x2*)drow + lane;
    f32x4 v[4]; u32x2 dv[4]; float s = 0.f;
#pragma unroll
    for (int j = 0; j < 4; ++j) { v[j] = xr[64 * j]; dv[j] = dr[64 * j]; }
#pragma unroll
    for (int j = 0; j < 4; ++j) { v[j].x += bf2f(dv[j].x); v[j].y += bf2f(dv[j].x >> 16); v[j].z += bf2f(dv[j].y); v[j].w += bf2f(dv[j].y >> 16);
        ((f32x4*)xout + lane)[64 * j] = v[j]; s += (v[j].x * v[j].x + v[j].y * v[j].y) + (v[j].z * v[j].z + v[j].w * v[j].w); }
    const float rstd = rsqrtf(wave_sum(s) * (1.f / D) + EPS);
    u32x2* o8 = (u32x2*)orow + lane;
#pragma unroll
    for (int j = 0; j < 4; ++j) { const f32x4 gv = gr[64 * j]; u32x2 w; w.x = pk2(v[j].x * rstd * gv.x, v[j].y * rstd * gv.y); w.y = pk2(v[j].z * rstd * gv.z, v[j].w * rstd * gv.w); o8[64 * j] = w; }
}

__global__ void __launch_bounds__(512, 2) fwd_kernel(Args args) {
    extern __shared__ __attribute__((aligned(16))) unsigned char lds_raw[];
    LAS unsigned char* lds = (LAS unsigned char*)lds_raw;
    volatile LAS unsigned* MISC = (volatile LAS unsigned*)(lds + LDS_MISC);
    LAS unsigned char* scrb = lds + LDS_SCR;
    const int tid = threadIdx.x, lane = tid & 63, wave = __builtin_amdgcn_readfirstlane(tid >> 6);
    const int G = gridDim.x, bid = blockIdx.x;
    const int fr = lane & 15, fq = lane >> 4;
    unsigned char* ws = args.ws;
    unsigned* ctl = (unsigned*)(ws + WS_CTL);
    float* out = args.out;
    const int lo = args.ph_lo, hi = args.ph_hi;

    if (tid < 64) MISC[tid] = 0u;
    __syncthreads();
    XcdBarrier bar; bar.bar = ctl + CW_BAR; bar.x = 0; bar.st = MISC;
    if (hi - lo > 1) bar = xcd_barrier_post(ctl + CW_BAR, MISC);
#ifndef PHASE_MASK
#define PHASE_MASK 0x1ffff
#endif
#define IN(k) ((((PHASE_MASK) >> (k)) & 1) && lo <= (k) && (k) < hi)
#define SEAM(k) do { if (IN(k) && IN((k) + 1)) xcd_barrier(bar); PSTAMP((k) + 1); } while (0)
#define PSTAMP(k) do { if (PROBE_A_LO >= 0 && bid == 0 && tid == 0) { const unsigned _t = (unsigned)wall_clock64(); if ((k) == PROBE_A_LO) MISC[8] = _t; if ((k) == PROBE_A_HI + 1) MISC[9] = _t; if ((k) == PROBE_B_LO) MISC[10] = _t; if ((k) == PROBE_B_HI + 1) MISC[11] = _t; } } while (0)
    PSTAMP(0);

    bf16* const ACTA = (bf16*)(ws + WS_ACTA);
    bf16* const ACTB = (bf16*)(ws + WS_ACTB);
    const f32x2* const ROT = (const f32x2*)(ws + WS_ROT);
    const int gw = bid * 8 + wave, NGW = G * 8;

    if (IN(0)) {
        LAS unsigned* scr = (LAS unsigned*)(scrb + wave * 16384);
        constexpr int I_IN0 = 16 * 56, I_OUT = 16 * 16, I_FF = 16 * 44, I_DN0 = 44 * 16, I_IN1 = 16 * 40, I_EXP = 16 * 56, I_EDN = 56 * 16;
        constexpr int NITEMS = I_IN0 + I_OUT + 2 * I_FF + I_DN0 + I_IN1 + I_OUT + 2 * 8 * I_EXP + 8 * I_EDN;
        for (int it = gw; it < NITEMS; it += NGW) {
            int r = it;
            if (r < 8 * I_EXP) { const int e = r / I_EXP; p0_tile<true>(args.in[22] + (size_t)e * D * D_EXP, D, D_EXP, ws + WT_GU1 + (size_t)e * 2 * D_EXP * D, 1, 64.f, scr, r % I_EXP, lane); continue; } r -= 8 * I_EXP;
            if (r < 8 * I_EXP) { const int e = r / I_EXP; p0_tile<true>(args.in[23] + (size_t)e * D * D_EXP, D, D_EXP, ws + WT_GU1 + (size_t)e * 2 * D_EXP * D, 2, 64.f, scr, r % I_EXP, lane); continue; } r -= 8 * I_EXP;
            if (r < 8 * I_EDN) { const int e = r / I_EDN; p0_tile<true>(args.in[24] + (size_t)e * D_EXP * D, D_EXP, D, ws + WT_DN1 + (size_t)e * D * D_EXP, 0, 64.f, scr, r % I_EDN, lane); continue; } r -= 8 * I_EDN;
            if (r < I_IN0) { p0_tile<false>(args.in[4], D, EVEN_IN, (bf16*)(ws + WT_IN0), 0, 1.f, scr, r, lane); continue; } r -= I_IN0;
            if (r < I_OUT) { p0_tile<false>(args.in[6], D, D, (bf16*)(ws + WT_OUT0), 0, 1.f, scr, r, lane); continue; } r -= I_OUT;
            if (r < I_FF) { p0_tile<false>(args.in[7], D, D_FF, (bf16*)(ws + WT_GU0), 1, 1.f, scr, r, lane); continue; } r -= I_FF;
            if (r < I_FF) { p0_tile<false>(args.in[8], D, D_FF, (bf16*)(ws + WT_GU0), 2, 1.f, scr, r, lane); continue; } r -= I_FF;
            if (r < I_DN0) { p0_tile<false>(args.in[9], D_FF, D, (bf16*)(ws + WT_DN0), 0, 1.f, scr, r, lane); continue; } r -= I_DN0;
            if (r < I_IN1) { p0_tile<false>(args.in[10], D, ODD_IN, (bf16*)(ws + WT_IN1), 0, 1.f, scr, r, lane); continue; } r -= I_IN1;
            p0_tile<false>(args.in[19], D, D, (bf16*)(ws + WT_OUT1), 0, 1.f, scr, r, lane);
        }
        for (int idx = bid * 512 + tid; idx < SEQ * 64; idx += G * 512) {
            const int t = idx >> 6, i = idx & 63;
            const float inv_freq = exp2f(-(float)i * (13.287712379549449f / 64.0f));
            double rev = (double)t * (double)inv_freq * 0.15915494309189535; rev -= floor(rev);
            const float rv = (float)rev;
            f32x2 cs; cs.x = __builtin_amdgcn_cosf(rv); cs.y = __builtin_amdgcn_sinf(rv);
            ((f32x2*)(ws + WS_ROT))[idx] = cs;
        }
        for (int m = gw; m < M; m += NGW) rms_row_bf16(args.in[0] + (size_t)m * D, args.in[1], ACTA + (size_t)m * D, lane);
    }
    SEAM(0);

    if (IN(1)) {
        pg8::DenseSched S; S.init(ACTA, (const bf16*)(ws + WT_IN0), M, EVEN_IN, D, G, bid);
        pg8::EpiStoreBf16 E{ACTB, EVEN_IN};
        pg8::gemm_phase<pg8::EpiStoreBf16, pg8::DenseSched, false>(scrb, 2 * D, S, E);
    }
    SEAM(1);

    constexpr int LQ = 136, LT = 72;
    LAS bf16* const rQ = (LAS bf16*)(scrb);
    LAS bf16* const rK = (LAS bf16*)(scrb + 17408);
    LAS bf16* const rKdT = (LAS bf16*)(scrb + 34816);
    LAS bf16* const rVT = (LAS bf16*)(scrb + 53248);
    LAS bf16* const rS = (LAS bf16*)(scrb + 71680);
    LAS bf16* const rStT = (LAS bf16*)(scrb + 80896);
    LAS float* const rStat = (LAS float*)(scrb + 115712);
    float* const RGS = (float*)(ws + WS_SCR);

    if (IN(2)) {
        for (int item = bid; item < 256; item += G) {
            const int b = item >> 5, h = (item >> 3) & 3, g = item & 7;
            const float l2g = log2f(1.0f - exp2f(-5.0f - (float)h));
            const float g64 = exp2f(64.0f * l2g);
            f32x4 st[8];
#pragma unroll
            for (int q = 0; q < 8; ++q) st[q] = (f32x4){0.f, 0.f, 0.f, 0.f};
            for (int n = 0; n < 8; ++n) {
                const int tpos0 = (g * 8 + n) * 64; const size_t row0 = (size_t)b * SEQ + tpos0;
                { const int i = lane;
#pragma unroll 1
                    for (int r = 0; r < 8; ++r) { const int j = wave + 8 * r; const bf16* prow = ACTB + (row0 + j) * EVEN_IN; const f32x2 cs = ROT[(tpos0 + j) * 64 + i];
                        const float k1 = bf2f(prow[RK_OFF + 128 * h + i]), k2 = bf2f(prow[RK_OFF + 128 * h + 64 + i]);
                        const float dec = exp2f((float)(63 - j) * l2g) * 0.08838834764831845f;
                        const float kr1 = (k1 * cs.x - k2 * cs.y) * dec, kr2 = (k1 * cs.y + k2 * cs.x) * dec;
                        rKdT[i * LT + j] = (bf16)f2bf(kr1); rKdT[(i + 64) * LT + j] = (bf16)f2bf(kr2);
                        rVT[i * LT + j] = prow[RV_OFF + 128 * h + i]; rVT[(i + 64) * LT + j] = prow[RV_OFF + 128 * h + 64 + i]; } }
                __syncthreads();
#pragma unroll
                for (int q = 0; q < 8; ++q) st[q] = st[q] * g64;
                mm_lds<128, 128, 64, true>(rVT, LT, rKdT, LT, st, wave, lane);
                __syncthreads();
            }
            float* gp = RGS + (size_t)item * 16384 + tid;
#pragma unroll
            for (int q = 0; q < 8; ++q)
#pragma unroll
                for (int r = 0; r < 4; ++r) gp[(q * 4 + r) * 512] = st[q][r];
        }
        {
            LAS bf16* const sQ = (LAS bf16*)(scrb);
            LAS bf16* const sK = (LAS bf16*)(scrb + 9216);
            LAS bf16* const sVT = (LAS bf16*)(scrb + 18432);
            LAS bf16* const sA = (LAS bf16*)(scrb + 27648);
            LAS float* const sZ = (LAS float*)(scrb + 36864);
            volatile LAS unsigned* sFlag = (volatile LAS unsigned*)(scrb + 54272);
            const int srow = tid >> 3, sseg = tid & 7;
            for (int item = bid; item < NB * 8 * 64; item += G) {
                const int qb = 63 - (item & 63), h = (item >> 6) & 7, b = item >> 9;
                const size_t qrow0 = (size_t)b * SEQ + 64 * qb;
                __syncthreads();
                *(u32x4*)(sQ + srow * LT + 8 * sseg) = *(const u32x4*)(ACTB + (qrow0 + srow) * EVEN_IN + SQ_OFF + 64 * h + 8 * sseg);
                f32x4 o[2]; o[0] = (f32x4){0.f, 0.f, 0.f, 0.f}; o[1] = o[0];
                float C = 1.0f;
                for (int kt = qb; kt >= 0; --kt) {
                    const size_t krow0 = (size_t)b * SEQ + 64 * kt;
                    { const bf16* prow = ACTB + (krow0 + srow) * EVEN_IN;
                      *(u32x4*)(sK + srow * LT + 8 * sseg) = *(const u32x4*)(prow + SK_OFF + 64 * h + 8 * sseg);
                      const u32x4 vv = *(const u32x4*)(prow + SV_OFF + 64 * h + 8 * sseg);
                      const unsigned vw[4] = {vv.x, vv.y, vv.z, vv.w};
#pragma unroll
                      for (int c = 0; c < 4; ++c) { sVT[(8 * sseg + 2 * c) * LT + srow] = (bf16)(vw[c] & 0xffffu); sVT[(8 * sseg + 2 * c + 1) * LT + srow] = (bf16)(vw[c] >> 16); } }
                    if (tid == 0) sFlag[0] = 0u;
                    __syncthreads();
                    { f32x4 z[2]; mm_lds<64, 64, 64, false>(sQ, LT, sK, LT, z, wave, lane);
#pragma unroll
                      for (int q = 0; q < 2; ++q)
#pragma unroll
                          for (int r = 0; r < 4; ++r) sZ[MM_ROW(4, q, r) * 68 + MM_COL(4, q)] = z[q][r] * 0.125f; }
                    __syncthreads();
                    {
                      const int tq = 64 * qb + srow, s0 = 64 * kt + 8 * sseg;
                      float p[8], a[8];
#pragma unroll
                      for (int c = 0; c < 8; ++c) { const float z = sZ[srow * 68 + 8 * sseg + c]; const bool valid = (s0 + c) < tq; const float pp = __builtin_amdgcn_rcpf(1.0f + __builtin_amdgcn_exp2f(z * 1.4426950408889634f)); p[c] = valid ? pp : 1.0f; a[c] = valid ? 1.0f - pp : 0.0f; }
                      float suf = 1.0f;
#pragma unroll
                      for (int c = 7; c >= 0; --c) { a[c] *= suf; suf *= p[c]; }
                      float Eo = 1.0f;
#pragma unroll
                      for (int k = 1; k < 8; ++k) { const float tv = __shfl_down(suf, k, 8); if (sseg + k < 8) Eo *= tv; }
                      const float ptot = __shfl(Eo * suf, 0, 8);
                      const float sc = Eo * C;
                      u32x4 w; w.x = pk2(a[0] * sc, a[1] * sc); w.y = pk2(a[2] * sc, a[3] * sc); w.z = pk2(a[4] * sc, a[5] * sc); w.w = pk2(a[6] * sc, a[7] * sc);
                      *(u32x4*)(sA + srow * LT + 8 * sseg) = w;
                      C *= ptot;
                      if (C >= 1e-30f) sFlag[0] = 1u; }
                    __syncthreads();
                    mm_lds<64, 64, 64, true>(sA, LT, sVT, LT, o, wave, lane);
                    const unsigned more = sFlag[0];
                    __syncthreads();
                    if (more == 0u) break;
                }
#pragma unroll
                for (int q = 0; q < 2; ++q)
#pragma unroll
                    for (int r = 0; r < 4; ++r) ACTA[(qrow0 + MM_ROW(4, q, r)) * D + 512 + 64 * h + MM_COL(4, q)] = (bf16)f2bf(o[q][r]);
            }
        }
    }
    SEAM(2);

    if (IN(3)) {
        for (int item = bid; item < 256; item += G) {
            const int b = item >> 5, h = (item >> 3) & 3, g = item & 7;
            const float l2g = log2f(1.0f - exp2f(-5.0f - (float)h));
            const float g64 = exp2f(64.0f * l2g), g512 = exp2f(512.0f * l2g);
            f32x4 st[8];
#pragma unroll
            for (int q = 0; q < 8; ++q) st[q] = (f32x4){0.f, 0.f, 0.f, 0.f};
            for (int gp_ = 0; gp_ < g; ++gp_) {
                const float* gp = RGS + (size_t)(item - g + gp_) * 16384 + tid;
#pragma unroll
                for (int q = 0; q < 8; ++q)
#pragma unroll
                    for (int r = 0; r < 4; ++r) st[q][r] = st[q][r] * g512 + gp[(q * 4 + r) * 512];
            }
            for (int n = 0; n < 8; ++n) {
                const int tpos0 = (g * 8 + n) * 64; const size_t row0 = (size_t)b * SEQ + tpos0;
                __syncthreads();
                { const int i = lane;
#pragma unroll 1
                    for (int r = 0; r < 8; ++r) { const int j = wave + 8 * r; const bf16* prow = ACTB + (row0 + j) * EVEN_IN; const f32x2 cs = ROT[(tpos0 + j) * 64 + i];
                        const float q1 = bf2f(prow[RQ_OFF + 128 * h + i]), q2 = bf2f(prow[RQ_OFF + 128 * h + 64 + i]);
                        const float k1 = bf2f(prow[RK_OFF + 128 * h + i]) * 0.08838834764831845f, k2 = bf2f(prow[RK_OFF + 128 * h + 64 + i]) * 0.08838834764831845f;
                        const float qr1 = q1 * cs.x - q2 * cs.y, qr2 = q1 * cs.y + q2 * cs.x;
                        const float kr1 = k1 * cs.x - k2 * cs.y, kr2 = k1 * cs.y + k2 * cs.x;
                        const float dec = exp2f((float)(63 - j) * l2g);
                        rQ[j * LQ + i] = (bf16)f2bf(qr1); rQ[j * LQ + 64 + i] = (bf16)f2bf(qr2);
                        rK[j * LQ + i] = (bf16)f2bf(kr1); rK[j * LQ + 64 + i] = (bf16)f2bf(kr2);
                        rKdT[i * LT + j] = (bf16)f2bf(kr1 * dec); rKdT[(i + 64) * LT + j] = (bf16)f2bf(kr2 * dec);
                        rVT[i * LT + j] = prow[RV_OFF + 128 * h + i]; rVT[(i + 64) * LT + j] = prow[RV_OFF + 128 * h + 64 + i]; } }
#pragma unroll
                for (int q = 0; q < 8; ++q)
#pragma unroll
                    for (int r = 0; r < 4; ++r) rStT[MM_ROW(8, q, r) * LQ + MM_COL(8, q)] = (bf16)f2bf(st[q][r]);
                __syncthreads();
                { f32x4 s[2]; mm_lds<64, 64, 128, false>(rQ, LQ, rK, LQ, s, wave, lane);
#pragma unroll
                  for (int q = 0; q < 2; ++q)
#pragma unroll
                      for (int r = 0; r < 4; ++r) { const int i = MM_ROW(4, q, r), j = MM_COL(4, q); const int dd = i > j ? i - j : j - i; rS[i * LT + j] = (bf16)f2bf(s[q][r] * exp2f((float)dd * l2g)); } }
                __syncthreads();
                f32x4 oi[4];
                mm_lds<64, 128, 128, false>(rQ, LQ, rStT, LQ, oi, wave, lane);
#pragma unroll
                for (int q = 0; q < 4; ++q)
#pragma unroll
                    for (int r = 0; r < 4; ++r) oi[q][r] *= exp2f((float)(MM_ROW(8, q, r) + 1) * l2g);
                mm_lds<64, 128, 64, true>(rS, LT, rVT, LT, oi, wave, lane);
#pragma unroll
                for (int q = 0; q < 4; ++q)
#pragma unroll
                    for (int r = 0; r < 4; ++r) { const int i = MM_ROW(8, q, r);
                        float s1 = oi[q][r], s2 = oi[q][r] * oi[q][r];
#pragma unroll
                        for (int o = 1; o < 16; o <<= 1) { s1 += __shfl_xor(s1, o); s2 += __shfl_xor(s2, o); }
                        if (fr == 0) { rStat[(i * 8 + wave) * 2] = s1; rStat[(i * 8 + wave) * 2 + 1] = s2; } }
                __syncthreads();
                if (tid < 64) { float s1 = 0.f, s2 = 0.f;
#pragma unroll
                    for (int w = 0; w < 8; ++w) { s1 += rStat[(tid * 8 + w) * 2]; s2 += rStat[(tid * 8 + w) * 2 + 1]; }
                    const float mu = s1 * (1.0f / 128.0f); float var = s2 * (1.0f / 128.0f) - mu * mu; var = var < 0.f ? 0.f : var;
                    rStat[1024 + tid * 2] = mu; rStat[1024 + tid * 2 + 1] = var; }
                __syncthreads();
#pragma unroll
                for (int q = 0; q < 4; ++q)
#pragma unroll
                    for (int r = 0; r < 4; ++r) { const int i = MM_ROW(8, q, r), e = MM_COL(8, q);
                        const float mu = rStat[1024 + i * 2], var = rStat[1024 + i * 2 + 1];
                        const float y = (oi[q][r] - mu) * rsqrtf(var + EPS);
                        const float gate = bf2f(ACTB[(row0 + i) * EVEN_IN + RGATE_OFF + 128 * h + e]);
                        const float yo = y * args.in[5][128 * h + e] * gate * sigmoidf_(gate);
                        ACTA[(row0 + i) * D + 128 * h + e] = (bf16)f2bf(yo); }
#pragma unroll
                for (int q = 0; q < 8; ++q) st[q] = st[q] * g64;
                mm_lds<128, 128, 64, true>(rVT, LT, rKdT, LT, st, wave, lane);
            }
        }
    }
    SEAM(3);

    if (IN(4)) {
        pg8::DenseSched S; S.init(ACTA, (const bf16*)(ws + WT_OUT0), M, D, D, G, bid);
#if OLD_DENSE
        pg8::EpiResF32 E{args.in[0], out, D};
        pg8::gemm_phase<pg8::EpiResF32, pg8::DenseSched, false>(scrb, 2 * D, S, E);
#else
        pg8::EpiStoreBf16 E{ACTB, D};
        pg8::gemm_phase<pg8::EpiStoreBf16, pg8::DenseSched, false>(scrb, 2 * D, S, E);
#endif
    }
    SEAM(4);
#if OLD_DENSE
    if (IN(5)) { for (int m = gw; m < M; m += NGW) rms_row_bf16(out + (size_t)m * D, args.in[2], ACTA + (size_t)m * D, lane); }
#else
    if (IN(5)) { for (int m = gw; m < M; m += NGW) rms_res_row_bf16(args.in[0] + (size_t)m * D, ACTB + (size_t)m * D, out + (size_t)m * D, args.in[2], ACTA + (size_t)m * D, lane); }
#endif
    SEAM(5);
    if (IN(6)) {
        pg8::DenseSched S; S.init(ACTA, (const bf16*)(ws + WT_GU0), M, 2 * D_FF, D, G, bid);
        pg8::EpiSwiGLU E{ACTB, D_FF};
        pg8::gemm_phase<pg8::EpiSwiGLU, pg8::DenseSched, false>(scrb, 2 * D, S, E);
    }
    SEAM(6);
    if (IN(7)) {
        pg8::DenseSched S; S.init(ACTB, (const bf16*)(ws + WT_DN0), M, D, D_FF, G, bid);
#if OLD_DENSE
        pg8::EpiResF32 E{out, out, D};
        pg8::gemm_phase<pg8::EpiResF32, pg8::DenseSched, false>(scrb, 2 * D_FF, S, E);
#else
        pg8::EpiStoreBf16 E{ACTA, D};
        pg8::gemm_phase<pg8::EpiStoreBf16, pg8::DenseSched, false>(scrb, 2 * D_FF, S, E);
#endif
    }
    SEAM(7);
#if OLD_DENSE
    if (IN(8)) { for (int m = gw; m < M; m += NGW) rms_row_bf16(out + (size_t)m * D, args.in[1] + D, ACTA + (size_t)m * D, lane); }
#else
    if (IN(8)) { for (int m = gw; m < M; m += NGW) rms_res_row_bf16(out + (size_t)m * D, ACTA + (size_t)m * D, out + (size_t)m * D, args.in[1] + D, ACTA + (size_t)m * D, lane); }
#endif
    SEAM(8);
    if (IN(9)) {
        pg8::DenseSched S; S.init(ACTA, (const bf16*)(ws + WT_IN1), M, ODD_IN, D, G, bid);
        pg8::EpiStoreBf16 E{ACTB, ODD_IN};
        pg8::gemm_phase<pg8::EpiStoreBf16, pg8::DenseSched, false>(scrb, 2 * D, S, E);
    }
    SEAM(9);

    float* const LSUM = (float*)(ws + WS_SCR);
#pragma unroll
    for (int pass = 0; pass < 2; ++pass) {
        if (IN(10 + pass)) {
            LAS bf16* const XR = (LAS bf16*)(scrb + wave * 17408);
            LAS float* const AB = (LAS float*)(scrb + wave * 17408 + 9216);
            const int head = wave, ch = 64 * head + lane;
            bf16x8 Bwa[4][2], Bwx[4][2];
#pragma unroll
            for (int tj = 0; tj < 4; ++tj)
#pragma unroll
                for (int ks = 0; ks < 2; ++ks) { bf16x8 va, vx;
#pragma unroll
                    for (int e = 0; e < 8; ++e) { const int i = 32 * ks + 8 * fq + e, j = 16 * tj + fr; va[e] = (short)f2bf(args.in[14][(size_t)(head * 64 + i) * 64 + j]); vx[e] = (short)f2bf(args.in[16][(size_t)(head * 64 + i) * 64 + j]); }
                    Bwa[tj][ks] = va; Bwx[tj][ks] = vx; }
            float cba[4], cbx[4], csp[4];
#pragma unroll
            for (int tj = 0; tj < 4; ++tj) { const int c = 64 * head + 16 * tj + fr; cba[tj] = args.in[15][c]; cbx[tj] = args.in[17][c]; csp[tj] = log1pf(__expf(-args.in[18][c])); }
            const float cw0 = args.in[12][ch], cw1 = args.in[12][512 + ch], cw2 = args.in[12][1024 + ch], cw3 = args.in[12][1536 + ch], cbias = args.in[13][ch];
            for (int it = bid; it < NB * 64; it += G) {
                const int b = it >> 6, c = it & 63; const size_t row0 = (size_t)b * SEQ + 64 * c;
                { float x0 = 0.f, x1 = 0.f, x2 = 0.f;
                  if (c > 0) { x0 = bf2f(ACTB[(row0 - 3) * ODD_IN + XR_OFF + ch]); x1 = bf2f(ACTB[(row0 - 2) * ODD_IN + XR_OFF + ch]); x2 = bf2f(ACTB[(row0 - 1) * ODD_IN + XR_OFF + ch]); }
                  for (int t = 0; t < 64; ++t) { const float x3 = bf2f(ACTB[(row0 + t) * ODD_IN + XR_OFF + ch]);
                      XR[t * LT + lane] = (bf16)f2bf(cw0 * x0 + cw1 * x1 + cw2 * x2 + cw3 * x3 + cbias); x0 = x1; x1 = x2; x2 = x3; } }
                float hst = 0.f, cum = 1.f;
                if (pass == 1) {
                    for (int c0 = 0; c0 < c; c0 += 8) {
                        f32x2 sv[8];
#pragma unroll
                        for (int k = 0; k < 8; ++k) { const int cc = (c0 + k < c) ? c0 + k : c0; sv[k] = ((const f32x2*)LSUM)[(size_t)(b * 64 + cc) * 512 + ch]; }
#pragma unroll
                        for (int k = 0; k < 8; ++k) if (c0 + k < c) hst = sv[k].x * hst + sv[k].y;
                    }
                }
                LDS_WAIT(); asm volatile("" ::: "memory");
                for (int sb = 0; sb < 4; ++sb) {
                    f32x4 aR[4], aX[4];
#pragma unroll
                    for (int tj = 0; tj < 4; ++tj) { aR[tj] = (f32x4){0.f, 0.f, 0.f, 0.f}; aX[tj] = aR[tj]; }
#pragma unroll
                    for (int ks = 0; ks < 2; ++ks) { const bf16x8 af = *(const LAS bf16x8*)(XR + (16 * sb + fr) * LT + 32 * ks + 8 * fq);
#pragma unroll
                        for (int tj = 0; tj < 4; ++tj) { aR[tj] = __builtin_amdgcn_mfma_f32_16x16x32_bf16(af, Bwa[tj][ks], aR[tj], 0, 0, 0); aX[tj] = __builtin_amdgcn_mfma_f32_16x16x32_bf16(af, Bwx[tj][ks], aX[tj], 0, 0, 0); } }
#pragma unroll
                    for (int tj = 0; tj < 4; ++tj)
#pragma unroll
                        for (int r = 0; r < 4; ++r) { const int tl = 4 * fq + r, j = 16 * tj + fr;
                            const float rg = sigmoidf_(aR[tj][r] + cba[tj]), ig = sigmoidf_(aX[tj][r] + cbx[tj]);
                            const float la = -8.0f * rg * csp[tj]; const float a = __expf(la); const float mult = sqrtf(-expm1f(2.0f * la));
                            const float xv = bf2f(XR[(16 * sb + tl) * LT + j]);
                            AB[tl * 64 + j] = a; AB[1024 + tl * 64 + j] = mult * ig * xv; }
                    LDS_WAIT(); asm volatile("" ::: "memory");
                    for (int tl = 0; tl < 16; ++tl) { const float a = AB[tl * 64 + lane], bb = AB[1024 + tl * 64 + lane]; hst = a * hst + bb; cum *= a;
                        if (pass == 1) { const size_t row = row0 + 16 * sb + tl; const float xg = bf2f(ACTB[row * ODD_IN + XG_OFF + ch]);
                            const float u3 = 0.7978845608028654f * (xg + 0.044715f * xg * xg * xg); const float th = 1.0f - 2.0f * __builtin_amdgcn_rcpf(1.0f + __builtin_amdgcn_exp2f(u3 * 2.8853900817779268f));
                            ACTA[row * D + 512 + ch] = (bf16)f2bf(hst * 0.5f * xg * (1.0f + th)); } }
                    LDS_WAIT(); asm volatile("" ::: "memory");
                }
                if (pass == 0) { f32x2 sv; sv.x = cum; sv.y = hst; ((f32x2*)LSUM)[(size_t)(b * 64 + c) * 512 + ch] = sv; }
            }
            if (pass == 1) {
                for (int idx = bid * 512 + tid; idx < M * 64; idx += G * 512) {
                    const int row = idx >> 6, c8 = (idx & 63) * 8; const int t = row & (SEQ - 1);
                    const bf16* p = ACTB + (size_t)row * ODD_IN;
                    float acc8[8];
#pragma unroll
                    for (int x = 0; x < 8; ++x) acc8[x] = 0.f;
#pragma unroll
                    for (int k = 0; k < 3; ++k) { const int dt = 2 - k; if (t - dt >= 0) { const bf16* pr = p - (size_t)dt * ODD_IN;
                            const u32x4 gc = *(const u32x4*)(pr + CC_OFF + c8), uu = *(const u32x4*)(pr + CU_OFF + c8); const unsigned gw_[4] = {gc.x, gc.y, gc.z, gc.w}, uw[4] = {uu.x, uu.y, uu.z, uu.w};
#pragma unroll
                            for (int x = 0; x < 4; ++x) { acc8[2 * x] += args.in[11][k * 512 + c8 + 2 * x] * bf2f(gw_[x]) * bf2f(uw[x]); acc8[2 * x + 1] += args.in[11][k * 512 + c8 + 2 * x + 1] * bf2f(gw_[x] >> 16) * bf2f(uw[x] >> 16); } } }
                    const u32x4 gb = *(const u32x4*)(p + CB_OFF + c8); const unsigned gbw[4] = {gb.x, gb.y, gb.z, gb.w};
                    u32x4 w; unsigned ww[4];
#pragma unroll
                    for (int x = 0; x < 4; ++x) ww[x] = pk2(bf2f(gbw[x]) * acc8[2 * x], bf2f(gbw[x] >> 16) * acc8[2 * x + 1]);
                    w.x = ww[0]; w.y = ww[1]; w.z = ww[2]; w.w = ww[3];
                    *(u32x4*)(ACTA + (size_t)row * D + c8) = w;
                }
            }
        }
        SEAM(10 + pass);
    }

    if (IN(12)) {
        pg8::DenseSched S; S.init(ACTA, (const bf16*)(ws + WT_OUT1), M, D, D, G, bid);
#if OLD_DENSE
        pg8::EpiResF32 E{out, out, D};
        pg8::gemm_phase<pg8::EpiResF32, pg8::DenseSched, false>(scrb, 2 * D, S, E);
#else
        pg8::EpiStoreBf16 E{ACTB, D};
        pg8::gemm_phase<pg8::EpiStoreBf16, pg8::DenseSched, false>(scrb, 2 * D, S, E);
#endif
    }
    SEAM(12);

    int* const LTOK = (int*)(ws + SCR_LTOK); unsigned* const REC = (unsigned*)(ws + SCR_REC);
    if (IN(13)) {
        LAS int* const lcnt = (LAS int*)(scrb);
        LAS int* const lbase = (LAS int*)(scrb + 64);
        LAS int* const recE = (LAS int*)(scrb + 128);
        LAS int* const recR = (LAS int*)(scrb + 128 + 1024);
        LAS float* const recW = (LAS float*)(scrb + 128 + 2048);
        float wr_[4][4][8];
#pragma unroll
        for (int j = 0; j < 4; ++j)
#pragma unroll
            for (int x = 0; x < 4; ++x) { const int col = 4 * (lane + 64 * j) + x; const f32x4 w0 = *(const f32x4*)(args.in[20] + (size_t)col * 8), w1 = *(const f32x4*)(args.in[20] + (size_t)col * 8 + 4);
                wr_[j][x][0] = w0.x; wr_[j][x][1] = w0.y; wr_[j][x][2] = w0.z; wr_[j][x][3] = w0.w; wr_[j][x][4] = w1.x; wr_[j][x][5] = w1.y; wr_[j][x][6] = w1.z; wr_[j][x][7] = w1.w; }
        for (int base = bid * 128; base < M; base += G * 128) {
            if (tid < 16) lcnt[tid] = 0;
            __syncthreads();
            for (int rr = 0; rr < 16; ++rr) {
                const int lr = wave * 16 + rr, m = base + lr;
                f32x4* xr = (f32x4*)(out + (size_t)m * D) + lane; const f32x4* gr = (const f32x4*)(args.in[2] + D) + lane; const u32x2* dr = (const u32x2*)(ACTB + (size_t)m * D) + lane;
                f32x4 v[4]; float s = 0.f;
#pragma unroll
                for (int j = 0; j < 4; ++j) { v[j] = xr[64 * j];
#if !OLD_DENSE
                    const u32x2 dv = dr[64 * j]; v[j].x += bf2f(dv.x); v[j].y += bf2f(dv.x >> 16); v[j].z += bf2f(dv.y); v[j].w += bf2f(dv.y >> 16); xr[64 * j] = v[j];
#endif
                    s += (v[j].x * v[j].x + v[j].y * v[j].y) + (v[j].z * v[j].z + v[j].w * v[j].w); }
                const float rstd = rsqrtf(wave_sum(s) * (1.f / D) + EPS);
                float lg[8];
#pragma unroll
                for (int e = 0; e < 8; ++e) lg[e] = 0.f;
                unsigned* o8 = (unsigned*)((unsigned char*)ACTA + (size_t)m * D) + lane;
#pragma unroll
                for (int j = 0; j < 4; ++j) { const f32x4 gv = gr[64 * j]; float y[4] = {v[j].x * rstd * gv.x, v[j].y * rstd * gv.y, v[j].z * rstd * gv.z, v[j].w * rstd * gv.w};
                    { int w = __builtin_amdgcn_cvt_pk_fp8_f32(__builtin_amdgcn_fmed3f(y[0], -448.f, 448.f), __builtin_amdgcn_fmed3f(y[1], -448.f, 448.f), 0, false);
                      w = __builtin_amdgcn_cvt_pk_fp8_f32(__builtin_amdgcn_fmed3f(y[2], -448.f, 448.f), __builtin_amdgcn_fmed3f(y[3], -448.f, 448.f), w, true); o8[64 * j] = (unsigned)w; }
#pragma unroll
                    for (int x = 0; x < 4; ++x)
#pragma unroll
                        for (int e = 0; e < 8; ++e) lg[e] += y[x] * wr_[j][x][e]; }
#pragma unroll
                for (int e = 0; e < 8; ++e) lg[e] = wave_sum(lg[e]) + args.in[21][e];
                int e1 = 0; float l1 = lg[0];
#pragma unroll
                for (int e = 1; e < 8; ++e) if (lg[e] > l1) { l1 = lg[e]; e1 = e; }
                int e2 = -1; float l2 = -3.0e38f;
#pragma unroll
                for (int e = 0; e < 8; ++e) if (e != e1 && lg[e] > l2) { l2 = lg[e]; e2 = e; }
                const float w2 = 1.0f / (1.0f + __expf(l1 - l2)), w1 = 1.0f - w2;
                if (lane == 0) { recE[lr * 2] = e1; recE[lr * 2 + 1] = e2; recW[lr * 2] = w1; recW[lr * 2 + 1] = w2;
                    recR[lr * 2] = __hip_atomic_fetch_add(&lcnt[e1], 1, __ATOMIC_RELAXED, __HIP_MEMORY_SCOPE_WORKGROUP); recR[lr * 2 + 1] = __hip_atomic_fetch_add(&lcnt[8 + e2], 1, __ATOMIC_RELAXED, __HIP_MEMORY_SCOPE_WORKGROUP); }
            }
            __syncthreads();
            if (tid < 16) lbase[tid] = (int)__hip_atomic_fetch_add(ctl + CW_CNT + 64 * tid, (unsigned)lcnt[tid], RLX_AGENT);
            __syncthreads();
            if (tid < 256) { const int lr = tid >> 1, k = tid & 1; const int e = recE[tid]; const int pos = lbase[k * 8 + e] + recR[tid];
                if (pos < LIST_CAP) LTOK[(size_t)(k * 8 + e) * LIST_CAP + pos] = base + lr;
                unsigned* rec = REC + (size_t)(base + lr) * 8 + 3 * k; rec[0] = (unsigned)(k * 8 + e); rec[1] = (unsigned)pos; rec[2] = __builtin_bit_cast(unsigned, recW[tid]); }
            __syncthreads();
        }
    }
    SEAM(13);

    if (IN(14)) {
        pg8::MoeSched S; S.init(ACTA, ws + WT_GU1, LTOK, ctl + CW_CNT, 0, 2 * D_EXP / 256, D, 0, (size_t)2 * D_EXP * D, G, bid);
        if (bid == 0 && tid == 0) { unsigned* tbw = ctl + CW_TB; tbw[0] = 0u; tbw[1] = S.t1; tbw[2] = S.t2; tbw[3] = S.t3; tbw[4] = S.t4; tbw[5] = S.t5; tbw[6] = S.t6; tbw[7] = S.t7; tbw[8] = S.t8;
            tbw[9] = S.t9; tbw[10] = S.t10; tbw[11] = S.t11; tbw[12] = S.t12; tbw[13] = S.t13; tbw[14] = S.t14; tbw[15] = S.t15; }
        pg8::EpiSwiGLU8 E{(unsigned char*)ACTB, D_EXP, 1.0f / 64.0f, 4.0f};
        pg8::gemm_phase<pg8::EpiSwiGLU8, pg8::MoeSched, true, true>(scrb, D, S, E);
    }
    SEAM(14);
    bf16* const YB = (bf16*)(ws + WS_Y);
    if (IN(15)) {
        pg8::MoeSched S; S.init(ACTB, ws + WT_DN1, LTOK, ctl + CW_CNT, 0, D / 256, D_EXP, (size_t)256 * D_EXP, (size_t)D * D_EXP, G, bid);
        pg8::EpiStoreBf16 E{YB, D};
        pg8::gemm_phase<pg8::EpiStoreBf16, pg8::MoeSched, false, true>(scrb, D_EXP, S, E);
    }
    SEAM(15);

    if (IN(16)) {
        for (int m = gw; m < M; m += NGW) {
            const u32x4 r0 = *(const u32x4*)(REC + (size_t)m * 8), r1 = *(const u32x4*)(REC + (size_t)m * 8 + 4);
            const unsigned tb0 = ctl[CW_TB + r0.x], tb1 = ctl[CW_TB + r0.w];
            const unsigned w0b = r0.z, w1b = r1.y;
            const float w0 = __uint_as_float(w0b) * (1.0f / 256.0f), w1 = __uint_as_float(w1b) * (1.0f / 256.0f);
            const u32x2* y0 = (const u32x2*)(YB + ((size_t)tb0 * 256 + r0.y) * D) + lane; const u32x2* y1 = (const u32x2*)(YB + ((size_t)tb1 * 256 + r1.x) * D) + lane;
            f32x4* xr = (f32x4*)(out + (size_t)m * D) + lane; const f32x4* gr = (const f32x4*)args.in[3] + lane;
            f32x4 v[4]; float s = 0.f;
#pragma unroll
            for (int j = 0; j < 4; ++j) { v[j] = xr[64 * j]; const u32x2 a = y0[64 * j], b = y1[64 * j];
                v[j].x += w0 * bf2f(a.x) + w1 * bf2f(b.x); v[j].y += w0 * bf2f(a.x >> 16) + w1 * bf2f(b.x >> 16); v[j].z += w0 * bf2f(a.y) + w1 * bf2f(b.y); v[j].w += w0 * bf2f(a.y >> 16) + w1 * bf2f(b.y >> 16);
                s += (v[j].x * v[j].x + v[j].y * v[j].y) + (v[j].z * v[j].z + v[j].w * v[j].w); }
            const float rstd = rsqrtf(wave_sum(s) * (1.f / D) + EPS);
#pragma unroll
            for (int j = 0; j < 4; ++j) { const f32x4 gv = gr[64 * j]; xr[64 * j] = v[j] * rstd * gv; }
        }
    }
    if (PROBE_A_LO >= 0 && bid == 0 && tid == 0) {
        const unsigned long long t_end = wall_clock64();
        const unsigned long long wait = (unsigned long long)(MISC[9] - MISC[8]) * 4ull + ((PROBE_B_LO >= 0) ? (unsigned long long)(MISC[11] - MISC[10]) * 4ull : 0ull);
        while (wall_clock64() - t_end < wait) __builtin_amdgcn_s_sleep(32);
    }
#undef IN
#undef SEAM
#undef PSTAMP
}

extern "C" void kernel_launch(void* const* d_in, const int* in_sizes, int n_in, void* d_out, int out_size, void* d_ws, size_t ws_size, hipStream_t stream) {
    static int grid = 0;
    if (grid == 0) {
        if (n_in != 25 || in_sizes[0] != M * D || out_size != M * D || ws_size < WS_END) { fprintf(stderr, "kernel_launch: unexpected shapes / workspace (n_in %d, ws %zu, need %zu)\n", n_in, ws_size, (size_t)WS_END); grid = -1; return; }
        int dev = 0, cus = 0, per_cu = 0;
        if (hipGetDevice(&dev) != hipSuccess || hipDeviceGetAttribute(&cus, hipDeviceAttributeMultiprocessorCount, dev) != hipSuccess) { grid = -1; return; }
        if (hipFuncSetAttribute((const void*)fwd_kernel, hipFuncAttributeMaxDynamicSharedMemorySize, LDS_BYTES) != hipSuccess) { fprintf(stderr, "kernel_launch: hipFuncSetAttribute failed\n"); grid = -1; return; }
        if (hipOccupancyMaxActiveBlocksPerMultiprocessor(&per_cu, (const void*)fwd_kernel, 512, LDS_BYTES) != hipSuccess || per_cu < 1) { fprintf(stderr, "kernel_launch: occupancy query says %d\n", per_cu); }
        (void)hipGetLastError();
        grid = cus;
    }
    if (grid < 0) return;
    if (hipMemsetAsync((char*)d_ws + WS_CTL, 0, CTL_ZERO_BYTES, stream) != hipSuccess) return;
    Args a{};
    for (int i = 0; i < 25; ++i) a.in[i] = (const float*)d_in[i];
    a.out = (float*)d_out; a.ws = (unsigned char*)d_ws;
#if MK_N_LAUNCHES == 1
    a.ph_lo = 0; a.ph_hi = NPHASE;
    hipLaunchKernelGGL(fwd_kernel, dim3(grid), dim3(512), LDS_BYTES, stream, a);
#else
    for (int p = 0; p < NPHASE; ++p) { a.ph_lo = p; a.ph_hi = p + 1; hipLaunchKernelGGL(fwd_kernel, dim3(grid), dim3(512), LDS_BYTES, stream, a); }
#endif
}
```

```cpp
#include <hip/hip_runtime.h>
#include <cstdio>
#include <cstdint>

#ifndef OLD_DENSE
#define OLD_DENSE 0
#endif
#ifndef MK_N_LAUNCHES
#define MK_N_LAUNCHES 1
#endif

#ifndef PROBE_A_LO
#define PROBE_A_LO (-1)
#define PROBE_A_HI (-1)
#define PROBE_B_LO (-1)
#define PROBE_B_HI (-1)
#endif
#define GAS __attribute__((address_space(1)))
#define LAS __attribute__((address_space(3)))
typedef unsigned short bf16;
typedef short bf16x8 __attribute__((ext_vector_type(8)));
typedef float f32x4 __attribute__((ext_vector_type(4)));
typedef float f32x2 __attribute__((ext_vector_type(2)));
typedef unsigned u32x4 __attribute__((ext_vector_type(4)));
typedef unsigned u32x2 __attribute__((ext_vector_type(2)));
typedef int v4i_t __attribute__((ext_vector_type(4)));
typedef int v8i_t __attribute__((ext_vector_type(8)));

constexpr int D = 1024, NB = 8, SEQ = 4096, M = NB * SEQ;
constexpr int EVEN_IN = 3584, ODD_IN = 2560, D_FF = 2816, D_EXP = 3584, NEXP = 8;
constexpr int RQ_OFF = 0, RK_OFF = 512, RV_OFF = 1024, RGATE_OFF = 1536, SQ_OFF = 2048, SK_OFF = 2560, SV_OFF = 3072;
constexpr int CB_OFF = 0, CC_OFF = 512, CU_OFF = 1024, XR_OFF = 1536, XG_OFF = 2048;
constexpr float EPS = 1e-6f;
constexpr int LIST_CAP = 32768;
constexpr int MAX_TILES = 135;

constexpr size_t MiB = 1u << 20;
constexpr size_t WS_CTL = 0, CTL_ZERO_BYTES = 1 * MiB;
constexpr size_t WS_ROT = 1 * MiB;
constexpr size_t WS_SCR = 3 * MiB;
constexpr size_t WS_WB = 19 * MiB;
constexpr size_t WT_DN1 = WS_WB;
constexpr size_t WT_IN0 = 47 * MiB;
constexpr size_t WT_OUT0 = WT_IN0 + (size_t)EVEN_IN * D * 2;
constexpr size_t WT_GU0 = WT_OUT0 + (size_t)D * D * 2;
constexpr size_t WT_DN0 = WT_GU0 + (size_t)2 * D_FF * D * 2;
constexpr size_t WT_IN1 = WT_DN0 + (size_t)D * D_FF * 2;
constexpr size_t WT_OUT1 = WT_IN1 + (size_t)ODD_IN * D * 2;
constexpr size_t WT_GU1 = WT_OUT1 + (size_t)D * D * 2;
constexpr size_t WB_END = WT_GU1 + (size_t)NEXP * 2 * D_EXP * D;
constexpr size_t WS_ACTA = 136 * MiB;
constexpr size_t WS_ACTB = 200 * MiB;
constexpr size_t WS_END = WS_ACTB + (size_t)MAX_TILES * 256 * D_EXP * 2;
constexpr size_t WS_Y = WT_IN0;
static_assert(WT_DN1 + (size_t)NEXP * D * D_EXP <= WT_IN0 && WB_END <= WS_ACTA && WS_ACTA + (size_t)M * D * 2 <= WS_ACTB, "weights overlap");
static_assert(WS_Y + (size_t)2 * MAX_TILES * 256 * D * 2 <= WS_ACTB, "y overlay");
static_assert((size_t)M * EVEN_IN * 2 <= (size_t)MAX_TILES * 256 * D_EXP * 2, "ACTB size");
constexpr size_t SCR_LTOK = WS_SCR, SCR_REC = WS_SCR + 4 * MiB;
constexpr int CW_BAR = 4096;
constexpr int CW_TB = 16384;
constexpr int CW_CNT = 8192;

constexpr int LDS_MISC = 0;
constexpr int LDS_SCR = 256;
constexpr int LDS_BYTES = 147456;

#define RLX_AGENT __ATOMIC_RELAXED, __HIP_MEMORY_SCOPE_AGENT
#define LDS_WAIT() asm volatile("s_waitcnt lgkmcnt(0)" ::: "memory")
__device__ __forceinline__ unsigned f2bf(float f) { unsigned u = __builtin_bit_cast(unsigned, f); return (u + 0x7fffu + ((u >> 16) & 1u)) >> 16; }
__device__ __forceinline__ unsigned pk2(float lo, float hi) { return f2bf(lo) | (f2bf(hi) << 16); }
__device__ __forceinline__ float bf2f(unsigned b) { return __builtin_bit_cast(float, (b & 0xffffu) << 16); }
__device__ __forceinline__ float wave_sum(float v) {
#pragma unroll
    for (int o = 1; o < 64; o <<= 1) v += __shfl_xor(v, o);
    return v;
}
__device__ __forceinline__ float sigmoidf_(float x) { return __builtin_amdgcn_rcpf(1.0f + __builtin_amdgcn_exp2f(x * -1.4426950408889634f)); }

#define XB_TMO      128
#define XB_XCNT(j)  (256  + 64 * (j))
#define XB_XSUB(j)  (1280 + 64 * (j))
#define XB_XGEN(j)  (2304 + 64 * (j))
#define XB_TOP      3328
#define XB_TOPGEN   3392
#define XCD_BAR_WORDS 3456
#define XB_SPIN_CAP (1u << 18)

__device__ __forceinline__ unsigned xb_ld(unsigned* p)              { return __hip_atomic_load(p, __ATOMIC_RELAXED, __HIP_MEMORY_SCOPE_AGENT); }
__device__ __forceinline__ unsigned xb_add(unsigned* p, unsigned v) { return __hip_atomic_fetch_add(p, v, __ATOMIC_RELAXED, __HIP_MEMORY_SCOPE_AGENT); }
__device__ __forceinline__ unsigned xb_xcc_id() { return (unsigned)__builtin_amdgcn_s_getreg((3 << 11) | 20) & 0xFu; }
#define XB_SPIN(cond, bar) do { unsigned _sp = 0; while (cond) { __builtin_amdgcn_s_sleep(1); \
    if ((++_sp & 255u) == 0u) { if (xb_ld(&(bar)[XB_TMO])) break; if (_sp > XB_SPIN_CAP) { atomicAdd(&(bar)[XB_TMO], 1u); break; } } } } while (0)

struct XcdBarrier { unsigned* bar; unsigned x; volatile LAS unsigned* st; };

__device__ __forceinline__ XcdBarrier xcd_barrier_post(unsigned* bar, volatile LAS unsigned* st) {
    XcdBarrier b; b.bar = bar; b.x = xb_xcc_id(); b.st = st;
    if (threadIdx.x == 0) (void)xb_add(&bar[XB_XCNT(b.x)], 1u);
    return b;
}
__device__ __forceinline__ void xcd_barrier_complete(unsigned* bar, unsigned x, unsigned& nloc, unsigned& nx) {
    const unsigned G = gridDim.x * gridDim.y * gridDim.z;
    unsigned sum, cnt, mine, sp = 0u;
    for (;;) {
        sum = 0u; cnt = 0u; mine = 0u;
#pragma unroll
        for (unsigned j = 0; j < 16; ++j) { const unsigned c = xb_ld(&bar[XB_XCNT(j)]); sum += c; cnt += (c > 0u) ? 1u : 0u; mine = (j == x) ? c : mine; }
        if (sum == G) break;
        __builtin_amdgcn_s_sleep(1);
        if ((++sp & 255u) == 0u) { if (xb_ld(&bar[XB_TMO])) break; if (sp > XB_SPIN_CAP) { atomicAdd(&bar[XB_TMO], 1u); break; } }
    }
    nloc = mine > 0u ? mine : 1u; nx = cnt > 0u ? cnt : 1u;
}
__device__ __forceinline__ void xcd_barrier(const XcdBarrier& b) {
    asm volatile("s_waitcnt vmcnt(0)" ::: "memory");
    __syncthreads();
    if (threadIdx.x == 0) {
        unsigned* bar = b.bar;
        __builtin_amdgcn_s_waitcnt(0);
        unsigned nloc = b.st[0], nx = b.st[1];
        if (nloc == 0u) { xcd_barrier_complete(bar, b.x, nloc, nx); b.st[0] = nloc; b.st[1] = nx; }
        const unsigned old = xb_add(&bar[XB_XSUB(b.x)], 1u);
        const unsigned gen = old / nloc;
        if (old + 1u == (gen + 1u) * nloc) {
            __builtin_amdgcn_fence(__ATOMIC_RELEASE, "agent");
            asm volatile("s_waitcnt vmcnt(0)" ::: "memory");
            const unsigned og = xb_add(&bar[XB_TOP], 1u);
            const unsigned tg = og / nx;
            if (og + 1u == (tg + 1u) * nx) xb_add(&bar[XB_TOPGEN], 1u);
            else XB_SPIN(xb_ld(&bar[XB_TOPGEN]) == tg, bar);
            __builtin_amdgcn_fence(__ATOMIC_ACQUIRE, "agent");
            xb_add(&bar[XB_XGEN(b.x)], 1u);
            asm volatile("s_waitcnt vmcnt(0)" ::: "memory");
        } else {
            XB_SPIN(xb_ld(&bar[XB_XGEN(b.x)]) == gen, bar);
            __builtin_amdgcn_fence(__ATOMIC_ACQUIRE, "agent");
            asm volatile("s_waitcnt vmcnt(0)" ::: "memory");
        }
    }
    __syncthreads();
}

namespace pg8 {
constexpr int BM = 256, BK = 64, HALF = 128, HTB = HALF * BK * 2, STAGE_BYTES = 8 * HTB, NXCD = 8, WGM = 8;
__device__ __forceinline__ int lds_byte(int r, int c) { const int st = (r >> 4) * 2 + (c >> 5), rr = r & 15, cc = c & 31, ob = rr * 64 + cc * 2; return st * 1024 + (ob ^ (((ob >> 9) & 1) << 5)); }
__device__ __forceinline__ void stage_rc(int b, int& R, int& C) { const int st = b / 1024, sb = b % 1024, swz = sb ^ (((sb >> 9) & 1) << 5); R = (st >> 1) * 16 + swz / 64; C = (st & 1) * 32 + (swz % 64) / 2; }
__device__ __forceinline__ int perm32(int rho) { const int n = rho >> 4, i = rho & 15; return 8 * (i >> 2) + 4 * n + (i & 3); }

struct Unit { int pm, pn, e, lt, cn; };

struct StaticOrder {
    int nM, nN, nwg, G, c;
    __device__ __forceinline__ void init_tiles(int nM_, int nN_, int G_, int c_) { nM = nM_; nN = nN_; nwg = nM * nN; G = G_; c = c_; }
    __device__ __forceinline__ bool next_tile(int i, int& pm, int& pn) const {
        const long L = (long)i * G + c; if (L >= nwg) return false;
        int wgid = (int)L; { const int q = nwg / NXCD, r = nwg % NXCD, xcd = wgid % NXCD, off = wgid / NXCD; wgid = (xcd < r ? xcd * (q + 1) : r * (q + 1) + (xcd - r) * q) + off; }
        const int nig = WGM * nN, gid = wgid / nig, fm = gid * WGM, gsz = (nM - fm) < WGM ? (nM - fm) : WGM;
        pm = fm + ((wgid % nig) % gsz); pn = (wgid % nig) / gsz; return true;
    }
};
struct DenseSched : StaticOrder {
    const char* A; const char* Bt; size_t tstep;
    __device__ __forceinline__ void init(const bf16* A_, const bf16* Bt_, int Mr, int N, int K, int G_, int c_) { A = (const char*)A_; Bt = (const char*)Bt_; tstep = (size_t)BM * K * 2; init_tiles(Mr / BM, N / BM, G_, c_); }
    __device__ __forceinline__ bool next(int i, Unit& u) const { u.e = 0; u.lt = 0; u.cn = 0; return next_tile(i, u.pm, u.pn); }
    __device__ __forceinline__ const char* a_base(const Unit& u) const { return A + (size_t)u.pm * tstep; }
    __device__ __forceinline__ const char* b_base(const Unit& u) const { return Bt + (size_t)u.pn * tstep; }
    __device__ __forceinline__ void a_rows(const Unit&, const int (&)[2], const int (&)[2], unsigned (&)[2][2]) const {}
    __device__ __forceinline__ const int* tok_src(const Unit&) const { return nullptr; }
};
struct MoeSched : StaticOrder {
    const char* A; const char* Bt; size_t a_tstep, b_estep, b_tstep; const int* ltok; int rowb, toff;
    int c0, c1, c2, c3, c4, c5, c6, c7, c8, c9, c10, c11, c12, c13, c14, c15, t1, t2, t3, t4, t5, t6, t7, t8, t9, t10, t11, t12, t13, t14, t15, t16;
    __device__ __forceinline__ static int ldc_(const unsigned* cntw, int e) { int c = (int)__builtin_amdgcn_readfirstlane(__hip_atomic_load(cntw + 64 * e, RLX_AGENT)); return c > LIST_CAP ? LIST_CAP : c; }
    __device__ __forceinline__ void init(const void* A_, const void* Bt_, const int* ltok_, const unsigned* cntw, int which, int nN_, int rowb_, size_t a_tstep_, size_t b_estep_, int G_, int c_) {
        A = (const char*)A_; Bt = (const char*)Bt_; ltok = ltok_; rowb = rowb_; a_tstep = a_tstep_; b_estep = b_estep_; b_tstep = (size_t)BM * rowb_;
        c0 = ldc_(cntw, 0); c1 = ldc_(cntw, 1); c2 = ldc_(cntw, 2); c3 = ldc_(cntw, 3); c4 = ldc_(cntw, 4); c5 = ldc_(cntw, 5); c6 = ldc_(cntw, 6); c7 = ldc_(cntw, 7);
        c8 = ldc_(cntw, 8); c9 = ldc_(cntw, 9); c10 = ldc_(cntw, 10); c11 = ldc_(cntw, 11); c12 = ldc_(cntw, 12); c13 = ldc_(cntw, 13); c14 = ldc_(cntw, 14); c15 = ldc_(cntw, 15);
        t1 = (c0 + 255) >> 8; t2 = t1 + ((c1 + 255) >> 8); t3 = t2 + ((c2 + 255) >> 8); t4 = t3 + ((c3 + 255) >> 8); t5 = t4 + ((c4 + 255) >> 8); t6 = t5 + ((c5 + 255) >> 8); t7 = t6 + ((c6 + 255) >> 8); t8 = t7 + ((c7 + 255) >> 8);
        t9 = t8 + ((c8 + 255) >> 8); t10 = t9 + ((c9 + 255) >> 8); t11 = t10 + ((c10 + 255) >> 8); t12 = t11 + ((c11 + 255) >> 8); t13 = t12 + ((c12 + 255) >> 8); t14 = t13 + ((c13 + 255) >> 8); t15 = t14 + ((c14 + 255) >> 8); t16 = t15 + ((c15 + 255) >> 8);
        toff = which == 2 ? t8 : 0;
        init_tiles(which == 0 ? t16 : (which == 1 ? t8 : t16 - t8), nN_, G_, c_);
    }
    __device__ __forceinline__ bool next(int i, Unit& u) const {
        int pml; if (!next_tile(i, pml, u.pn)) return false;
        const int pm = pml + toff; u.pm = pm;
        const int m1 = pm >= t1, m2 = pm >= t2, m3 = pm >= t3, m4 = pm >= t4, m5 = pm >= t5, m6 = pm >= t6, m7 = pm >= t7, m8 = pm >= t8, m9 = pm >= t9, m10 = pm >= t10, m11 = pm >= t11, m12 = pm >= t12, m13 = pm >= t13, m14 = pm >= t14, m15 = pm >= t15;
        const int e = m1 + m2 + m3 + m4 + m5 + m6 + m7 + m8 + m9 + m10 + m11 + m12 + m13 + m14 + m15;
        const int base = m1 * t1 + m2 * (t2 - t1) + m3 * (t3 - t2) + m4 * (t4 - t3) + m5 * (t5 - t4) + m6 * (t6 - t5) + m7 * (t7 - t6) + m8 * (t8 - t7) + m9 * (t9 - t8) + m10 * (t10 - t9) + m11 * (t11 - t10) + m12 * (t12 - t11) + m13 * (t13 - t12) + m14 * (t14 - t13) + m15 * (t15 - t14);
        const int cn = c0 + m1 * (c1 - c0) + m2 * (c2 - c1) + m3 * (c3 - c2) + m4 * (c4 - c3) + m5 * (c5 - c4) + m6 * (c6 - c5) + m7 * (c7 - c6) + m8 * (c8 - c7) + m9 * (c9 - c8) + m10 * (c10 - c9) + m11 * (c11 - c10) + m12 * (c12 - c11) + m13 * (c13 - c12) + m14 * (c14 - c13) + m15 * (c15 - c14);
        u.e = e; u.lt = pm - base; u.cn = cn; return true;
    }
    __device__ __forceinline__ const char* a_base(const Unit& u) const { return A + (size_t)u.pm * a_tstep; }
    __device__ __forceinline__ const char* b_base(const Unit& u) const { return Bt + (size_t)(u.e & 7) * b_estep + (size_t)u.pn * b_tstep; }
    __device__ __forceinline__ const int* tok_src(const Unit& u) const { return ltok + (size_t)u.e * LIST_CAP + u.lt * 256; }
    __device__ __forceinline__ void a_rows(const Unit& u, const int (&R)[2], const int (&C)[2], unsigned (&off)[2][2]) const {
#pragma unroll
        for (int h = 0; h < 2; ++h)
#pragma unroll
            for (int i = 0; i < 2; ++i) { int rank = u.lt * 256 + h * HALF + R[i]; rank = rank < u.cn ? rank : u.cn - 1;
                const int tok = ltok[(size_t)u.e * LIST_CAP + rank]; off[h][i] = (unsigned)tok * (unsigned)rowb + (unsigned)(C[i] * 2); }
    }
};

__device__ __forceinline__ unsigned cvt_pk_bf16(float lo, float hi) { unsigned r; asm volatile("v_cvt_pk_bf16_f32 %0, %1, %2" : "=v"(r) : "v"(lo), "v"(hi)); return r; }

struct EpiStoreBf16 {
    static constexpr bool PERM = true;
    bf16* O; int ldc;
    __device__ __forceinline__ void operator()(const f32x4 (&acc)[2][2][4][2], const Unit& u, int wr, int wc, int fr, int fq) const {
        const int row0 = u.pm * BM + wr * 64 + fr, col0 = u.pn * BM + wc * 32 + 8 * fq;
#pragma unroll
        for (int ai = 0; ai < 2; ++ai)
#pragma unroll
            for (int m = 0; m < 4; ++m) { bf16* rowp = O + (size_t)(row0 + ai * HALF + m * 16) * ldc + col0;
#pragma unroll
                for (int bj = 0; bj < 2; ++bj) { const f32x4 v0 = acc[ai][bj][m][0], v1 = acc[ai][bj][m][1];
                    u32x4 w; w.x = cvt_pk_bf16(v0[0], v0[1]); w.y = cvt_pk_bf16(v0[2], v0[3]); w.z = cvt_pk_bf16(v1[0], v1[1]); w.w = cvt_pk_bf16(v1[2], v1[3]);
                    *(u32x4*)(rowp + bj * HALF) = w; } }
    }
};
struct EpiResF32 {
    static constexpr bool PERM = false;
    const float* base; float* out; int ldc;
    __device__ __forceinline__ void operator()(const f32x4 (&acc)[2][2][4][2], const Unit& u, int wr, int wc, int fr, int fq) const {
        const int row0 = u.pm * BM + wr * 64 + fr, col0 = u.pn * BM + wc * 32 + 4 * fq;
#pragma unroll
        for (int ai = 0; ai < 2; ++ai)
#pragma unroll
            for (int m = 0; m < 4; ++m) { const size_t off = (size_t)(row0 + ai * HALF + m * 16) * ldc + col0;
#pragma unroll
                for (int bj = 0; bj < 2; ++bj)
#pragma unroll
                    for (int n = 0; n < 2; ++n) { const f32x4 bs = *(const f32x4*)(base + off + bj * HALF + n * 16); *(f32x4*)(out + off + bj * HALF + n * 16) = bs + acc[ai][bj][m][n]; } }
    }
};
struct EpiSwiGLU {
    static constexpr bool PERM = true;
    bf16* H; int ldh;
    __device__ __forceinline__ void operator()(const f32x4 (&acc)[2][2][4][2], const Unit& u, int wr, int wc, int fr, int fq) const {
        const int row0 = u.pm * BM + wr * 64 + fr, col0 = u.pn * HALF + wc * 32 + 8 * fq;
#pragma unroll
        for (int ai = 0; ai < 2; ++ai)
#pragma unroll
            for (int m = 0; m < 4; ++m) { bf16* rowp = H + (size_t)(row0 + ai * HALF + m * 16) * ldh + col0;
                float h[8];
#pragma unroll
                for (int n = 0; n < 2; ++n)
#pragma unroll
                    for (int x = 0; x < 2; ++x) { const f32x2 g = {acc[ai][0][m][n][2 * x], acc[ai][0][m][n][2 * x + 1]}, up = {acc[ai][1][m][n][2 * x], acc[ai][1][m][n][2 * x + 1]};
                        const f32x2 t = g * -1.4426950408889634f; f32x2 e; e.x = __builtin_amdgcn_exp2f(t.x); e.y = __builtin_amdgcn_exp2f(t.y);
                        const f32x2 d = e + 1.0f; f32x2 r; r.x = __builtin_amdgcn_rcpf(d.x); r.y = __builtin_amdgcn_rcpf(d.y);
                        const f32x2 hh = (g * up) * r; h[4 * n + 2 * x] = hh.x; h[4 * n + 2 * x + 1] = hh.y; }
                u32x4 w; w.x = cvt_pk_bf16(h[0], h[1]); w.y = cvt_pk_bf16(h[2], h[3]); w.z = cvt_pk_bf16(h[4], h[5]); w.w = cvt_pk_bf16(h[6], h[7]);
                *(u32x4*)rowp = w; }
    }
};
struct EpiSwiGLU8 {
    static constexpr bool PERM = true;
    unsigned char* H; int ldh; float iscale, oscale;
    __device__ __forceinline__ void operator()(const f32x4 (&acc)[2][2][4][2], const Unit& u, int wr, int wc, int fr, int fq) const {
        const int row0 = u.pm * BM + wr * 64 + fr, col0 = u.pn * HALF + wc * 32 + 8 * fq;
#pragma unroll
        for (int ai = 0; ai < 2; ++ai)
#pragma unroll
            for (int m = 0; m < 4; ++m) { unsigned char* rowp = H + (size_t)(row0 + ai * HALF + m * 16) * ldh + col0;
                float h[8];
#pragma unroll
                for (int n = 0; n < 2; ++n)
#pragma unroll
                    for (int x = 0; x < 2; ++x) { const f32x2 ga = {acc[ai][0][m][n][2 * x], acc[ai][0][m][n][2 * x + 1]}, ua = {acc[ai][1][m][n][2 * x], acc[ai][1][m][n][2 * x + 1]};
                        const f32x2 t = ga * (-1.4426950408889634f * iscale); f32x2 e; e.x = __builtin_amdgcn_exp2f(t.x); e.y = __builtin_amdgcn_exp2f(t.y);
                        const f32x2 d = e + 1.0f; f32x2 r; r.x = __builtin_amdgcn_rcpf(d.x); r.y = __builtin_amdgcn_rcpf(d.y);
                        const f32x2 hh = ((ga * ua) * (iscale * iscale * oscale)) * r;
                        h[4 * n + 2 * x] = __builtin_amdgcn_fmed3f(hh.x, -448.0f, 448.0f); h[4 * n + 2 * x + 1] = __builtin_amdgcn_fmed3f(hh.y, -448.0f, 448.0f); }
                int w0 = __builtin_amdgcn_cvt_pk_fp8_f32(h[0], h[1], 0, false); w0 = __builtin_amdgcn_cvt_pk_fp8_f32(h[2], h[3], w0, true);
                int w1 = __builtin_amdgcn_cvt_pk_fp8_f32(h[4], h[5], 0, false); w1 = __builtin_amdgcn_cvt_pk_fp8_f32(h[6], h[7], w1, true);
                u32x2 w; w.x = (unsigned)w0; w.y = (unsigned)w1; *(u32x2*)rowp = w; }
    }
};
struct EpiMoeDown {
    static constexpr bool PERM = false;
    float* out; const int* ltok; const float* lw; float scale;
    __device__ __forceinline__ void operator()(const f32x4 (&acc)[2][2][4][2], const Unit& u, int wr, int wc, int fr, int fq) const {
        const int col0 = u.pn * BM + wc * 32 + 4 * fq;
#pragma unroll
        for (int ai = 0; ai < 2; ++ai)
#pragma unroll
            for (int m = 0; m < 4; ++m) { const int rank = u.lt * 256 + ai * HALF + wr * 64 + m * 16 + fr;
                if (rank < u.cn) { const int tok = ltok[(size_t)u.e * LIST_CAP + rank]; const float w = lw[(size_t)u.e * LIST_CAP + rank] * scale; float* rowp = out + (size_t)tok * D + col0;
#pragma unroll
                    for (int bj = 0; bj < 2; ++bj)
#pragma unroll
                        for (int n = 0; n < 2; ++n) { const f32x4 bs = *(const f32x4*)(rowp + bj * HALF + n * 16); *(f32x4*)(rowp + bj * HALF + n * 16) = bs + acc[ai][bj][m][n] * w; } } }
    }
};

template <class Epi, class Sched, bool GATHER, bool F8 = false>
__device__ __forceinline__ void gemm_phase(LAS unsigned char* lds, const int rowb, const Sched& S, const Epi& E) {
    const int tid = threadIdx.x, wid = __builtin_amdgcn_readfirstlane(tid >> 6), lane = tid & 63, wr = wid >> 2, wc = wid & 3, fr = lane & 15, fq = lane >> 4;
    const int nt = rowb / 128;
    unsigned voffA[2], voffB[2]; int Rr[2], Cc[2];
#pragma unroll
    for (int i = 0; i < 2; ++i) { int R, C; stage_rc(tid * 16 + i * 8192, R, C); const int Rb = Epi::PERM ? ((R & ~31) + perm32(R & 31)) : R;
        voffA[i] = (unsigned)(R * rowb + C * 2); voffB[i] = (unsigned)(Rb * rowb + C * 2); Rr[i] = R; Cc[i] = C; }
    const size_t kstep = (size_t)(BK * 2);
    const size_t hstep = (size_t)HALF * rowb;
    const unsigned ldsw = (unsigned)wid * 1024u;
    const int aoff = lds_byte(wr * 64 + fr, fq * 8), boff = lds_byte(wc * 32 + fr, fq * 8);
#define PG8_SA(b, h) (((b) * 2 + (h)) * HTB)
#define PG8_SB(b, h) ((4 + (b) * 2 + (h)) * HTB)
#define PG8_STAGE(bufoff, gbase, voff) do { _Pragma("unroll") for (int _i = 0; _i < 2; ++_i) \
        __builtin_amdgcn_global_load_lds((const unsigned*)((const char*)(gbase) + (voff)[_i]), (LAS unsigned*)(lds + (bufoff) + ldsw + _i * 8192), 16, 0, 0); } while (0)
#define PG8_STAGE_A(bufoff, kptr, h) do { if constexpr (GATHER) PG8_STAGE(bufoff, kptr, gA[h]); else PG8_STAGE(bufoff, (kptr) + (h) * hstep, voffA); } while (0)
#define PG8_LD8(base) __builtin_shufflevector(*(const LAS v4i_t*)(base), *(const LAS v4i_t*)((base) + 1024), 0, 1, 2, 3, 4, 5, 6, 7)
#define PG8_LDA(dst, b, h) do { _Pragma("unroll") for (int m = 0; m < 4; ++m) { if constexpr (F8) dst##8[m] = PG8_LD8(lds + PG8_SA(b, h) + aoff + m * 2048); else { _Pragma("unroll") for (int k = 0; k < 2; ++k) dst[m][k] = *(const LAS bf16x8*)(lds + PG8_SA(b, h) + aoff + m * 2048 + k * 1024); } } } while (0)
#define PG8_LDB(dst, b, h) do { _Pragma("unroll") for (int n = 0; n < 2; ++n) { if constexpr (F8) dst##8[n] = PG8_LD8(lds + PG8_SB(b, h) + boff + n * 2048); else { _Pragma("unroll") for (int k = 0; k < 2; ++k) dst[n][k] = *(const LAS bf16x8*)(lds + PG8_SB(b, h) + boff + n * 2048 + k * 1024); } } } while (0)
#define PG8_MMA(ai, bj, At, Bt) do { __builtin_amdgcn_s_setprio(1); _Pragma("unroll") for (int m = 0; m < 4; ++m) _Pragma("unroll") for (int n = 0; n < 2; ++n) { \
        if constexpr (F8) asm volatile("v_mfma_f32_16x16x128_f8f6f4 %0, %1, %2, %0" : "+v"(acc[ai][bj][m][n]) : "v"(Bt##8[n]), "v"(At##8[m])); \
        else { _Pragma("unroll") for (int k = 0; k < 2; ++k) acc[ai][bj][m][n] = __builtin_amdgcn_mfma_f32_16x16x32_bf16(Bt[n][k], At[m][k], acc[ai][bj][m][n], 0, 0, 0); } } \
        __builtin_amdgcn_s_setprio(0); } while (0)
#define PG8_WAIT_V(n) asm volatile("s_waitcnt vmcnt(" #n ")" ::: "memory")
#define PG8_WAIT_L(n) asm volatile("s_waitcnt lgkmcnt(" #n ")" ::: "memory")
#define PG8_BAR __builtin_amdgcn_s_barrier()
#define PG8_SCHED __builtin_amdgcn_sched_barrier(0)
    Unit cur, nxt; int ui = 0;
    if (!S.next(0, cur)) return;
    f32x4 acc[2][2][4][2];
#pragma unroll
    for (int a = 0; a < 2; ++a)
#pragma unroll
        for (int b = 0; b < 2; ++b)
#pragma unroll
            for (int m = 0; m < 4; ++m)
#pragma unroll
                for (int n = 0; n < 2; ++n) acc[a][b][m][n] = (f32x4){0.f, 0.f, 0.f, 0.f};
    bf16x8 At[4][2], B0[2][2], B1[2][2]; v8i_t At8[4], B08[2], B18[2];
    const char* cA = S.a_base(cur); const char* cB = S.b_base(cur);
    unsigned gA[2][2] = {{0u, 0u}, {0u, 0u}};
    if constexpr (GATHER) S.a_rows(cur, Rr, Cc, gA);
    constexpr int TOKTAB = STAGE_BYTES;
    PG8_STAGE(PG8_SB(0, 0), cB, voffB); PG8_STAGE(PG8_SB(0, 1), cB + hstep, voffB); PG8_STAGE_A(PG8_SA(0, 0), cA, 0); PG8_STAGE_A(PG8_SA(0, 1), cA, 1);
    if (wr == 1) PG8_BAR;
    PG8_WAIT_V(2); PG8_BAR;
    PG8_STAGE(PG8_SB(1, 0), cB + kstep, voffB); PG8_STAGE_A(PG8_SA(1, 0), cA + kstep, 0); PG8_STAGE(PG8_SB(1, 1), cB + hstep + kstep, voffB);
    PG8_WAIT_V(6); PG8_BAR;
    for (;;) {
        const bool has_next = S.next(ui + 1, nxt);
        const char* nA = has_next ? S.a_base(nxt) : cA; const char* nB = has_next ? S.b_base(nxt) : cB;
        if constexpr (GATHER) { if (has_next && wid == 0) __builtin_amdgcn_global_load_lds((const unsigned*)(S.tok_src(nxt) + lane * 4), (LAS unsigned*)(lds + TOKTAB), 16, 0, 0); }
        for (int t = 0; t < nt; t += 2) {
            const bool last = (t == nt - 2);
            const char* a1 = cA + (size_t)(t + 1) * kstep;
            const char* a2 = last ? nA : cA + (size_t)(t + 2) * kstep; const char* b2 = last ? nB : cB + (size_t)(t + 2) * kstep;
            const char* a3 = a2 + kstep; const char* b3 = b2 + kstep;
            PG8_LDB(B0, 0, 0); PG8_LDB(B1, 0, 1); PG8_SCHED; PG8_LDA(At, 0, 0); PG8_STAGE_A(PG8_SA(1, 1), a1, 1);
            if constexpr (GATHER) { if (last && has_next) { asm volatile("" ::: "memory");
#pragma unroll
                for (int h = 0; h < 2; ++h)
#pragma unroll
                    for (int i = 0; i < 2; ++i) { unsigned tk = *(const LAS unsigned*)(lds + TOKTAB + 4 * (h * HALF + Rr[i])); tk = tk < (unsigned)(M - 1) ? tk : (unsigned)(M - 1); gA[h][i] = tk * (unsigned)rowb + (unsigned)(Cc[i] * 2); } } }
            PG8_WAIT_V(8); PG8_WAIT_L(0); PG8_BAR; PG8_MMA(0, 0, At, B0); PG8_MMA(0, 1, At, B1); PG8_BAR; PG8_SCHED;
            PG8_LDA(At, 0, 1); PG8_STAGE(PG8_SB(0, 0), b2, voffB); PG8_STAGE(PG8_SB(0, 1), b2 + hstep, voffB); PG8_STAGE_A(PG8_SA(0, 0), a2, 0);
            PG8_WAIT_V(8); PG8_WAIT_L(0); PG8_BAR; PG8_MMA(1, 0, At, B0); PG8_MMA(1, 1, At, B1); PG8_BAR; PG8_SCHED;
            PG8_LDB(B0, 1, 0); PG8_LDB(B1, 1, 1); PG8_SCHED; PG8_LDA(At, 1, 0); PG8_STAGE_A(PG8_SA(0, 1), a2, 1);
            PG8_WAIT_V(8); PG8_WAIT_L(0); PG8_BAR; PG8_MMA(0, 0, At, B0); PG8_MMA(0, 1, At, B1); PG8_BAR; PG8_SCHED;
            PG8_LDA(At, 1, 1); PG8_STAGE(PG8_SB(1, 0), b3, voffB); PG8_STAGE(PG8_SB(1, 1), b3 + hstep, voffB); PG8_STAGE_A(PG8_SA(1, 0), a3, 0);
            PG8_WAIT_V(8); PG8_WAIT_L(0); PG8_BAR; PG8_MMA(1, 0, At, B0); PG8_MMA(1, 1, At, B1); PG8_BAR; PG8_SCHED;
        }
        if (wr == 0) PG8_BAR;
        if constexpr (F8) asm volatile("s_nop 15\n\ts_nop 15" ::: "memory");
        E(acc, cur, wr, wc, fr, fq);
        if (!has_next) break;
#pragma unroll
        for (int a = 0; a < 2; ++a)
#pragma unroll
            for (int b = 0; b < 2; ++b)
#pragma unroll
                for (int m = 0; m < 4; ++m)
#pragma unroll
                    for (int n = 0; n < 2; ++n) acc[a][b][m][n] = (f32x4){0.f, 0.f, 0.f, 0.f};
        cur = nxt; cA = nA; cB = nB; ++ui;
        if (wr == 1) PG8_BAR;
    }
    PG8_WAIT_V(0);
    PG8_BAR;
#undef PG8_SA
#undef PG8_SB
#undef PG8_STAGE
#undef PG8_STAGE_A
#undef PG8_LDA
#undef PG8_LDB
#undef PG8_MMA
#undef PG8_LD8
#undef PG8_WAIT_V
#undef PG8_WAIT_L
#undef PG8_BAR
#undef PG8_SCHED
}
}

template <int Mr, int Nc, int K, bool ACCUM>
__device__ __forceinline__ void mm_lds(const LAS bf16* A, int lda, const LAS bf16* Bt, int ldb, f32x4 (&acc)[(Mr / 16) * (Nc / 16) / 8], int wave, int lane) {
    constexpr int NT = Nc / 16, TPW = (Mr / 16) * NT / 8;
    const int fr = lane & 15, fq = lane >> 4;
#pragma unroll
    for (int q = 0; q < TPW; ++q) {
        const int t = wave + 8 * q, ti = t / NT, tj = t % NT;
        f32x4 c = ACCUM ? acc[q] : (f32x4){0.f, 0.f, 0.f, 0.f};
#pragma unroll
        for (int k0 = 0; k0 < K; k0 += 32) {
            const bf16x8 a = *(const LAS bf16x8*)(A + (16 * ti + fr) * lda + k0 + 8 * fq);
            const bf16x8 b = *(const LAS bf16x8*)(Bt + (16 * tj + fr) * ldb + k0 + 8 * fq);
            c = __builtin_amdgcn_mfma_f32_16x16x32_bf16(a, b, c, 0, 0, 0);
        }
        acc[q] = c;
        if (TPW > 2) asm volatile("" ::: "memory");
    }
}
#define MM_ROW(NT, q, r) (16 * ((wave + 8 * (q)) / (NT)) + 4 * fq + (r))
#define MM_COL(NT, q)    (16 * ((wave + 8 * (q)) % (NT)) + fr)

struct Args { const float* in[25]; float* out; unsigned char* ws; int ph_lo, ph_hi; };
constexpr int NPHASE = 17;

template <bool F8>
__device__ __forceinline__ void p0_tile(const float* W, int K, int N, void* WTv, int mode, float scale, LAS unsigned* T, int item, int lane) {
    const int nblk = N / 64, kb = item / nblk, nb = item % nblk, k0 = 64 * kb, n0 = 64 * nb;
    const int row0 = mode == 0 ? n0 : ((n0 >> 7) << 8) + (n0 & 127) + (mode == 2 ? 128 : 0);
    const int g = lane >> 4, m = lane & 15;
    constexpr int P = F8 ? 17 : 33;
    f32x4 v[16];
#pragma unroll
    for (int L = 0; L < 16; ++L) { const int kk = F8 ? (16 * (L >> 2) + 4 * g + (L & 3)) : (8 * (L >> 1) + 2 * g + (L & 1)); v[L] = *(const f32x4*)(W + (size_t)(k0 + kk) * N + n0 + 4 * m); }
    if constexpr (F8) {
#pragma unroll
        for (int i = 0; i < 4; ++i)
#pragma unroll
            for (int j = 0; j < 4; ++j) { const float q0 = __builtin_amdgcn_fmed3f(v[4 * i][j] * scale, -448.f, 448.f), q1 = __builtin_amdgcn_fmed3f(v[4 * i + 1][j] * scale, -448.f, 448.f), q2 = __builtin_amdgcn_fmed3f(v[4 * i + 2][j] * scale, -448.f, 448.f), q3 = __builtin_amdgcn_fmed3f(v[4 * i + 3][j] * scale, -448.f, 448.f);
                int w = __builtin_amdgcn_cvt_pk_fp8_f32(q0, q1, 0, false); w = __builtin_amdgcn_cvt_pk_fp8_f32(q2, q3, w, true);
                T[(4 * m + j) * P + 4 * i + g] = (unsigned)w; }
    } else {
#pragma unroll
        for (int i = 0; i < 8; ++i)
#pragma unroll
            for (int j = 0; j < 4; ++j) T[(4 * m + j) * P + 4 * i + g] = pk2(v[2 * i][j], v[2 * i + 1][j]);
    }
    LDS_WAIT(); asm volatile("" ::: "memory");
    if constexpr (F8) {
        unsigned char* WT = (unsigned char*)WTv;
#pragma unroll
        for (int p = 0; p < 4; ++p) { const int n = (lane >> 2) + 16 * p, c = lane & 3; const LAS unsigned* t = T + n * P + 4 * c; u32x4 o; o.x = t[0]; o.y = t[1]; o.z = t[2]; o.w = t[3];
            *(u32x4*)(WT + (size_t)(row0 + n) * K + k0 + 16 * c) = o; }
    } else {
        bf16* WT = (bf16*)WTv;
#pragma unroll
        for (int p = 0; p < 8; ++p) { const int n = (lane >> 3) + 8 * p, c = lane & 7; const LAS unsigned* t = T + n * P + 4 * c; u32x4 o; o.x = t[0]; o.y = t[1]; o.z = t[2]; o.w = t[3];
            *(u32x4*)(WT + (size_t)(row0 + n) * K + k0 + 8 * c) = o; }
    }
    LDS_WAIT(); asm volatile("" ::: "memory");
}
__device__ __forceinline__ void rms_row_bf16(const float* xrow, const float* g, bf16* orow, int lane) {
    const f32x4* xr = (const f32x4*)xrow + lane; const f32x4* gr = (const f32x4*)g + lane;
    f32x4 v[4]; float s = 0.f;
#pragma unroll
    for (int j = 0; j < 4; ++j) { v[j] = xr[64 * j]; s += (v[j].x * v[j].x + v[j].y * v[j].y) + (v[j].z * v[j].z + v[j].w * v[j].w); }
    const float rstd = rsqrtf(wave_sum(s) * (1.f / D) + EPS);
    u32x2* o8 = (u32x2*)orow + lane;
#pragma unroll
    for (int j = 0; j < 4; ++j) { const f32x4 gv = gr[64 * j]; u32x2 w; w.x = pk2(v[j].x * rstd * gv.x, v[j].y * rstd * gv.y); w.y = pk2(v[j].z * rstd * gv.z, v[j].w * rstd * gv.w); o8[64 * j] = w; }
}

__device__ __forceinline__ void rms_res_row_bf16(const float* xin, const bf16* drow, float* xout, const float* g, bf16* orow, int lane) {
    const f32x4* xr = (const f32x4*)xin + lane; const f32x4* gr = (const f32x4*)g + lane; const u32x2* dr = (const u32x2*)drow + lane;
    f32x4 v[4]; u32x2 dv[4]; float s = 0.f;
#pragma unroll
    for (int j = 0; j < 4; ++j) { v[j] = xr[64 * j]; dv[j] = dr[64 * j]; }
#pragma unroll
    for (int j = 0; j < 4; ++j) { v[j].x += bf2f(dv[j].x); v[j].y += bf2f(dv[j].x >> 16); v[j].z += bf2f(dv[j].y); v[j].w += bf2f(dv[j].y >> 16);
        ((f32x4*)xout + lane)[64 * j] = v[j]; s += (v[j].x * v[j].x + v[j].y * v[j].y) + (v[j].z * v[j].z + v[j].w * v[j].w); }
    const float rstd = rsqrtf(wave_sum(s) * (1.f / D) + EPS);
    u32x2* o8 = (u32x2*)orow + lane;
#pragma unroll
    for (int j = 0; j < 4; ++j) { const f32x4 gv = gr[64 * j]; u32x2 w; w.x = pk2(v[j].x * rstd * gv.x, v[j].y * rstd * gv.y); w.y = pk2(v[j].z * rstd * gv.z, v[j].w * rstd * gv.w); o8[64 * j] = w; }
}

struct RetPf { u32x4 q1, q2, k1, k2, v1, v2, g1, g2; f32x4 r0, r1, r2, r3; };
template <bool NEEDQ>
__device__ __forceinline__ void ret_load(RetPf& pf, const bf16* proj, const f32x2* ROT, size_t row0, int tpos0, int h, int tid) {
    const int j = tid >> 3, seg = tid & 7;
    const bf16* prow = proj + (row0 + j) * EVEN_IN + 128 * h;
    pf.k1 = *(const u32x4*)(prow + RK_OFF + 8 * seg); pf.k2 = *(const u32x4*)(prow + RK_OFF + 64 + 8 * seg);
    pf.v1 = *(const u32x4*)(prow + RV_OFF + 16 * seg); pf.v2 = *(const u32x4*)(prow + RV_OFF + 16 * seg + 8);
    if constexpr (NEEDQ) { pf.q1 = *(const u32x4*)(prow + RQ_OFF + 8 * seg); pf.q2 = *(const u32x4*)(prow + RQ_OFF + 64 + 8 * seg);
        pf.g1 = *(const u32x4*)(prow + RGATE_OFF + 16 * seg); pf.g2 = *(const u32x4*)(prow + RGATE_OFF + 16 * seg + 8); }
    const f32x4* rp = (const f32x4*)(ROT + (size_t)(tpos0 + j) * 64 + 8 * seg);
    pf.r0 = rp[0]; pf.r1 = rp[1]; pf.r2 = rp[2]; pf.r3 = rp[3];
}
template <bool NEEDQ>
__device__ __forceinline__ void ret_write(const RetPf& pf, float l2g, LAS bf16* rQ, LAS bf16* rK, LAS bf16* rKdT, LAS bf16* rVT, LAS bf16* rG, int tid) {
    constexpr int LQ = 136, LT = 72;
    const int j = tid >> 3, seg = tid & 7;
    const float cs[16] = {pf.r0.x, pf.r0.y, pf.r0.z, pf.r0.w, pf.r1.x, pf.r1.y, pf.r1.z, pf.r1.w, pf.r2.x, pf.r2.y, pf.r2.z, pf.r2.w, pf.r3.x, pf.r3.y, pf.r3.z, pf.r3.w};
    const unsigned k1w[4] = {pf.k1.x, pf.k1.y, pf.k1.z, pf.k1.w}, k2w[4] = {pf.k2.x, pf.k2.y, pf.k2.z, pf.k2.w}, v1w[4] = {pf.v1.x, pf.v1.y, pf.v1.z, pf.v1.w}, v2w[4] = {pf.v2.x, pf.v2.y, pf.v2.z, pf.v2.w};
    const float dec = exp2f((float)(63 - j) * l2g);
    unsigned qa[4], qb[4], ka[4], kb[4];
#pragma unroll
    for (int w = 0; w < 4; ++w) {
        float kr1[2], kr2[2], qr1[2] = {0.f, 0.f}, qr2[2] = {0.f, 0.f};
#pragma unroll
        for (int x = 0; x < 2; ++x) { const int c = 2 * w + x; const float co = cs[2 * c], si = cs[2 * c + 1];
            const float a = bf2f(k1w[w] >> (16 * x)) * 0.08838834764831845f, b = bf2f(k2w[w] >> (16 * x)) * 0.08838834764831845f;
            kr1[x] = a * co - b * si; kr2[x] = a * si + b * co;
            rKdT[(8 * seg + c) * LT + j] = (bf16)f2bf(kr1[x] * dec); rKdT[(64 + 8 * seg + c) * LT + j] = (bf16)f2bf(kr2[x] * dec);
            if constexpr (NEEDQ) { const unsigned q1w = w == 0 ? pf.q1.x : (w == 1 ? pf.q1.y : (w == 2 ? pf.q1.z : pf.q1.w)), q2w = w == 0 ? pf.q2.x : (w == 1 ? pf.q2.y : (w == 2 ? pf.q2.z : pf.q2.w));
                const float qa_ = bf2f(q1w >> (16 * x)), qb_ = bf2f(q2w >> (16 * x)); qr1[x] = qa_ * co - qb_ * si; qr2[x] = qa_ * si + qb_ * co; }
            rVT[(16 * seg + c) * LT + j] = (bf16)((v1w[w] >> (16 * x)) & 0xffffu); rVT[(16 * seg + 8 + c) * LT + j] = (bf16)((v2w[w] >> (16 * x)) & 0xffffu); }
        if constexpr (NEEDQ) { ka[w] = pk2(kr1[0], kr1[1]); kb[w] = pk2(kr2[0], kr2[1]); qa[w] = pk2(qr1[0], qr1[1]); qb[w] = pk2(qr2[0], qr2[1]); }
    }
    if constexpr (NEEDQ) {
        u32x4 t; t.x = qa[0]; t.y = qa[1]; t.z = qa[2]; t.w = qa[3]; *(LAS u32x4*)(rQ + j * LQ + 8 * seg) = t;
        t.x = qb[0]; t.y = qb[1]; t.z = qb[2]; t.w = qb[3]; *(LAS u32x4*)(rQ + j * LQ + 64 + 8 * seg) = t;
        t.x = ka[0]; t.y = ka[1]; t.z = ka[2]; t.w = ka[3]; *(LAS u32x4*)(rK + j * LQ + 8 * seg) = t;
        t.x = kb[0]; t.y = kb[1]; t.z = kb[2]; t.w = kb[3]; *(LAS u32x4*)(rK + j * LQ + 64 + 8 * seg) = t;
        *(LAS u32x4*)(rG + j * LQ + 16 * seg) = pf.g1; *(LAS u32x4*)(rG + j * LQ + 16 * seg + 8) = pf.g2;
    }
}

__global__ void __launch_bounds__(512, 2) fwd_kernel(Args args) {
    extern __shared__ __attribute__((aligned(16))) unsigned char lds_raw[];
    LAS unsigned char* lds = (LAS unsigned char*)lds_raw;
    volatile LAS unsigned* MISC = (volatile LAS unsigned*)(lds + LDS_MISC);
    LAS unsigned char* scrb = lds + LDS_SCR;
    const int tid = threadIdx.x, lane = tid & 63, wave = __builtin_amdgcn_readfirstlane(tid >> 6);
    const int G = gridDim.x, bid = blockIdx.x;
    const int fr = lane & 15, fq = lane >> 4;
    unsigned char* ws = args.ws;
    unsigned* ctl = (unsigned*)(ws + WS_CTL);
    float* out = args.out;
    const int lo = args.ph_lo, hi = args.ph_hi;

    if (tid < 64) MISC[tid] = 0u;
    __syncthreads();
    XcdBarrier bar; bar.bar = ctl + CW_BAR; bar.x = 0; bar.st = MISC;
    if (hi - lo > 1) bar = xcd_barrier_post(ctl + CW_BAR, MISC);
#ifndef PHASE_MASK
#define PHASE_MASK 0x1ffff
#endif
#define IN(k) ((((PHASE_MASK) >> (k)) & 1) && lo <= (k) && (k) < hi)
#define SEAM(k) do { if (IN(k) && IN((k) + 1)) xcd_barrier(bar); PSTAMP((k) + 1); } while (0)
#define PSTAMP(k) do { if (PROBE_A_LO >= 0 && bid == 0 && tid == 0) { const unsigned _t = (unsigned)wall_clock64(); if ((k) == PROBE_A_LO) MISC[8] = _t; if ((k) == PROBE_A_HI + 1) MISC[9] = _t; if ((k) == PROBE_B_LO) MISC[10] = _t; if ((k) == PROBE_B_HI + 1) MISC[11] = _t; } } while (0)
    PSTAMP(0);

    bf16* const ACTA = (bf16*)(ws + WS_ACTA);
    bf16* const ACTB = (bf16*)(ws + WS_ACTB);
    const f32x2* const ROT = (const f32x2*)(ws + WS_ROT);
    const int gw = bid * 8 + wave, NGW = G * 8;

    if (IN(0)) {
        LAS unsigned* scr = (LAS unsigned*)(scrb + wave * 16384);
        constexpr int I_IN0 = 16 * 56, I_OUT = 16 * 16, I_FF = 16 * 44, I_DN0 = 44 * 16, I_IN1 = 16 * 40, I_EXP = 16 * 56, I_EDN = 56 * 16;
        constexpr int NITEMS = I_IN0 + I_OUT + 2 * I_FF + I_DN0 + I_IN1 + I_OUT + 2 * 8 * I_EXP + 8 * I_EDN;
        for (int it = gw; it < NITEMS; it += NGW) {
            int r = it;
            if (r < 8 * I_EXP) { const int e = r / I_EXP; p0_tile<true>(args.in[22] + (size_t)e * D * D_EXP, D, D_EXP, ws + WT_GU1 + (size_t)e * 2 * D_EXP * D, 1, 64.f, scr, r % I_EXP, lane); continue; } r -= 8 * I_EXP;
            if (r < 8 * I_EXP) { const int e = r / I_EXP; p0_tile<true>(args.in[23] + (size_t)e * D * D_EXP, D, D_EXP, ws + WT_GU1 + (size_t)e * 2 * D_EXP * D, 2, 64.f, scr, r % I_EXP, lane); continue; } r -= 8 * I_EXP;
            if (r < 8 * I_EDN) { const int e = r / I_EDN; p0_tile<true>(args.in[24] + (size_t)e * D_EXP * D, D_EXP, D, ws + WT_DN1 + (size_t)e * D * D_EXP, 0, 64.f, scr, r % I_EDN, lane); continue; } r -= 8 * I_EDN;
            if (r < I_IN0) { p0_tile<false>(args.in[4], D, EVEN_IN, (bf16*)(ws + WT_IN0), 0, 1.f, scr, r, lane); continue; } r -= I_IN0;
            if (r < I_OUT) { p0_tile<false>(args.in[6], D, D, (bf16*)(ws + WT_OUT0), 0, 1.f, scr, r, lane); continue; } r -= I_OUT;
            if (r < I_FF) { p0_tile<false>(args.in[7], D, D_FF, (bf16*)(ws + WT_GU0), 1, 1.f, scr, r, lane); continue; } r -= I_FF;
            if (r < I_FF) { p0_tile<false>(args.in[8], D, D_FF, (bf16*)(ws + WT_GU0), 2, 1.f, scr, r, lane); continue; } r -= I_FF;
            if (r < I_DN0) { p0_tile<false>(args.in[9], D_FF, D, (bf16*)(ws + WT_DN0), 0, 1.f, scr, r, lane); continue; } r -= I_DN0;
            if (r < I_IN1) { p0_tile<false>(args.in[10], D, ODD_IN, (bf16*)(ws + WT_IN1), 0, 1.f, scr, r, lane); continue; } r -= I_IN1;
            p0_tile<false>(args.in[19], D, D, (bf16*)(ws + WT_OUT1), 0, 1.f, scr, r, lane);
        }
        for (int idx = bid * 512 + tid; idx < SEQ * 64; idx += G * 512) {
            const int t = idx >> 6, i = idx & 63;
            const float inv_freq = exp2f(-(float)i * (13.287712379549449f / 64.0f));
            double rev = (double)t * (double)inv_freq * 0.15915494309189535; rev -= floor(rev);
            const float rv = (float)rev;
            f32x2 cs; cs.x = __builtin_amdgcn_cosf(rv); cs.y = __builtin_amdgcn_sinf(rv);
            ((f32x2*)(ws + WS_ROT))[idx] = cs;
        }
        for (int m = gw; m < M; m += NGW) rms_row_bf16(args.in[0] + (size_t)m * D, args.in[1], ACTA + (size_t)m * D, lane);
    }
    SEAM(0);

    if (IN(1)) {
        pg8::DenseSched S; S.init(ACTA, (const bf16*)(ws + WT_IN0), M, EVEN_IN, D, G, bid);
        pg8::EpiStoreBf16 E{ACTB, EVEN_IN};
        pg8::gemm_phase<pg8::EpiStoreBf16, pg8::DenseSched, false>(scrb, 2 * D, S, E);
    }
    SEAM(1);

    constexpr int LQ = 136, LT = 72;
    LAS bf16* const rQ = (LAS bf16*)(scrb);
    LAS bf16* const rK = (LAS bf16*)(scrb + 17408);
    LAS bf16* const rKdT = (LAS bf16*)(scrb + 34816);
    LAS bf16* const rVT = (LAS bf16*)(scrb + 53248);
    LAS bf16* const rS = (LAS bf16*)(scrb + 71680);
    LAS bf16* const rStT = (LAS bf16*)(scrb + 80896);
    LAS float* const rStat = (LAS float*)(scrb + 115712);
    LAS bf16* const rG = (LAS bf16*)(scrb + 120320);
    float* const RGS = (float*)(ws + WS_SCR);

    if (IN(2)) {
        for (int item = bid; item < 256; item += G) {
            const int b = item >> 5, h = (item >> 3) & 3, g = item & 7;
            const float l2g = log2f(1.0f - exp2f(-5.0f - (float)h));
            const float g64 = exp2f(64.0f * l2g);
            f32x4 st[8];
#pragma unroll
            for (int q = 0; q < 8; ++q) st[q] = (f32x4){0.f, 0.f, 0.f, 0.f};
            RetPf pf;
            ret_load<false>(pf, ACTB, ROT, (size_t)b * SEQ + (g * 8) * 64, (g * 8) * 64, h, tid);
            for (int n = 0; n < 8; ++n) {
                ret_write<false>(pf, l2g, rQ, rK, rKdT, rVT, rG, tid);
                if (n < 7) { const int tposn = (g * 8 + n + 1) * 64; ret_load<false>(pf, ACTB, ROT, (size_t)b * SEQ + tposn, tposn, h, tid); }
                __syncthreads();
#pragma unroll
                for (int q = 0; q < 8; ++q) st[q] = st[q] * g64;
                mm_lds<128, 128, 64, true>(rVT, LT, rKdT, LT, st, wave, lane);
                __syncthreads();
            }
            float* gp = RGS + (size_t)item * 16384 + tid;
#pragma unroll
            for (int q = 0; q < 8; ++q)
#pragma unroll
                for (int r = 0; r < 4; ++r) gp[(q * 4 + r) * 512] = st[q][r];
        }
        {
            __syncthreads();
            constexpr int PV = 68;
            LAS bf16* const sV = (LAS bf16*)(scrb + wave * 8704);
            const int vkey = lane >> 3, vpc = lane & 7;
            for (int wi = bid * 8 + wave; wi < NB * 8 * 256; wi += G * 8) {
                const int qt = 255 - (wi & 255), h = (wi >> 8) & 7, b = wi >> 11;
                const size_t brow = (size_t)b * SEQ;
                const int tq = 16 * qt + fr;
                bf16x8 qf[2];
#pragma unroll
                for (int ks = 0; ks < 2; ++ks) qf[ks] = *(const bf16x8*)(ACTB + (brow + tq) * EVEN_IN + SQ_OFF + 64 * h + 32 * ks + 8 * fq);
                f32x4 ot[4];
#pragma unroll
                for (int dt = 0; dt < 4; ++dt) ot[dt] = (f32x4){0.f, 0.f, 0.f, 0.f};
                float C = 1.0f;
                int kt = qt >> 2;
                bf16x8 kf[4][2]; u32x4 vr[8];
#pragma unroll
                for (int tj = 0; tj < 4; ++tj)
#pragma unroll
                    for (int ks = 0; ks < 2; ++ks) kf[tj][ks] = *(const bf16x8*)(ACTB + (brow + 64 * kt + 16 * tj + fr) * EVEN_IN + SK_OFF + 64 * h + 32 * ks + 8 * fq);
#pragma unroll
                for (int i = 0; i < 8; ++i) vr[i] = *(const u32x4*)(ACTB + (brow + 64 * kt + 8 * i + vkey) * EVEN_IN + SV_OFF + 64 * h + 8 * vpc);
                for (;;) {
#pragma unroll
                    for (int i = 0; i < 8; ++i) { LAS u32x2* d = (LAS u32x2*)(sV + (8 * i + vkey) * PV + 8 * vpc); u32x2 lo, hi; lo.x = vr[i].x; lo.y = vr[i].y; hi.x = vr[i].z; hi.y = vr[i].w; d[0] = lo; d[1] = hi; }
                    f32x4 zt[4];
#pragma unroll
                    for (int tj = 0; tj < 4; ++tj) { zt[tj] = __builtin_amdgcn_mfma_f32_16x16x32_bf16(kf[tj][0], qf[0], (f32x4){0.f, 0.f, 0.f, 0.f}, 0, 0, 0); zt[tj] = __builtin_amdgcn_mfma_f32_16x16x32_bf16(kf[tj][1], qf[1], zt[tj], 0, 0, 0); }
                    const int ktn = kt - 1;
                    if (ktn >= 0) {
#pragma unroll
                        for (int tj = 0; tj < 4; ++tj)
#pragma unroll
                            for (int ks = 0; ks < 2; ++ks) kf[tj][ks] = *(const bf16x8*)(ACTB + (brow + 64 * ktn + 16 * tj + fr) * EVEN_IN + SK_OFF + 64 * h + 32 * ks + 8 * fq);
#pragma unroll
                        for (int i = 0; i < 8; ++i) vr[i] = *(const u32x4*)(ACTB + (brow + 64 * ktn + 8 * i + vkey) * EVEN_IN + SV_OFF + 64 * h + 8 * vpc);
                    }
                    float a[4][4], pseg[4];
#pragma unroll
                    for (int tj = 0; tj < 4; ++tj) { float suf = 1.0f;
#pragma unroll
                        for (int r = 3; r >= 0; --r) { const int sk = 64 * kt + 16 * tj + 4 * fq + r; const bool valid = sk < tq;
                            const float pp = __builtin_amdgcn_rcpf(1.0f + __builtin_amdgcn_exp2f(zt[tj][r] * (0.125f * 1.4426950408889634f)));
                            const float p = valid ? pp : 1.0f, be = valid ? 1.0f - pp : 0.0f; a[tj][r] = be * suf; suf *= p; }
                        pseg[tj] = suf; }
                    float run = C;
#pragma unroll
                    for (int tj = 3; tj >= 0; --tj) { const float y = __shfl_xor(pseg[tj], 16); const float pair = pseg[tj] * y; const float zz = __shfl_xor(pair, 32);
                        const float S = ((fq & 1) ? 1.0f : y) * ((fq & 2) ? 1.0f : zz); const float sc = S * run;
#pragma unroll
                        for (int r = 0; r < 4; ++r) a[tj][r] *= sc;
                        run *= pair * zz; }
                    C = run;
                    bf16x8 af[2];
#pragma unroll
                    for (int ks = 0; ks < 2; ++ks) { u32x4 w; w.x = pk2(a[2 * ks][0], a[2 * ks][1]); w.y = pk2(a[2 * ks][2], a[2 * ks][3]); w.z = pk2(a[2 * ks + 1][0], a[2 * ks + 1][1]); w.w = pk2(a[2 * ks + 1][2], a[2 * ks + 1][3]); af[ks] = __builtin_bit_cast(bf16x8, w); }
                    LDS_WAIT(); asm volatile("" ::: "memory");
#pragma unroll
                    for (int dt = 0; dt < 4; ++dt)
#pragma unroll
                        for (int ks = 0; ks < 2; ++ks) { bf16x8 vf;
#pragma unroll
                            for (int j = 0; j < 8; ++j) vf[j] = (short)sV[(32 * ks + 16 * (j >> 2) + 4 * fq + (j & 3)) * PV + 16 * dt + fr];
                            ot[dt] = __builtin_amdgcn_mfma_f32_16x16x32_bf16(vf, af[ks], ot[dt], 0, 0, 0); }
                    LDS_WAIT(); asm volatile("" ::: "memory");
                    if (ktn < 0 || __all(C < 1e-30f)) break;
                    kt = ktn;
                }
#pragma unroll
                for (int dt = 0; dt < 4; ++dt) { u32x2 w; w.x = pk2(ot[dt][0], ot[dt][1]); w.y = pk2(ot[dt][2], ot[dt][3]);
                    *(u32x2*)(ACTA + (brow + tq) * D + 512 + 64 * h + 16 * dt + 4 * fq) = w; }
            }
        }
    }
    SEAM(2);

    if (IN(3)) {
        const int fr0 = fr, fq0 = fq;
        for (int item = bid; item < 256; item += G) {
            const int b = item >> 5, h = (item >> 3) & 3, g = item & 7;
            const float l2g = log2f(1.0f - exp2f(-5.0f - (float)h));
            const float g64 = exp2f(64.0f * l2g), g512 = exp2f(512.0f * l2g);
            f32x4 st[8];
#pragma unroll
            for (int q = 0; q < 8; ++q) st[q] = (f32x4){0.f, 0.f, 0.f, 0.f};
            for (int gp_ = 0; gp_ < g; ++gp_) {
                const float* gp = RGS + (size_t)(item - g + gp_) * 16384 + tid;
#pragma unroll
                for (int q = 0; q < 8; ++q)
#pragma unroll
                    for (int r = 0; r < 4; ++r) st[q][r] = st[q][r] * g512 + gp[(q * 4 + r) * 512];
            }
            RetPf pf;
            ret_load<true>(pf, ACTB, ROT, (size_t)b * SEQ + (g * 8) * 64, (g * 8) * 64, h, tid);
            for (int n = 0; n < 8; ++n) {
                int tid_l = tid, fr_l = fr0, fq_l = fq0;
                asm volatile("" : "+v"(tid_l), "+v"(fr_l), "+v"(fq_l));
                { const int fr = fr_l, fq = fq_l, lane = (fq_l << 4) | fr_l;
                const int tpos0 = (g * 8 + n) * 64; const size_t row0 = (size_t)b * SEQ + tpos0;
                __syncthreads();
                ret_write<true>(pf, l2g, rQ, rK, rKdT, rVT, rG, tid_l);
                if (n < 7) { const int tposn = tpos0 + 64; ret_load<true>(pf, ACTB, ROT, (size_t)b * SEQ + tposn, tposn, h, tid_l); }
#pragma unroll
                for (int q = 0; q < 8; ++q)
#pragma unroll
                    for (int r = 0; r < 4; ++r) rStT[MM_ROW(8, q, r) * LQ + MM_COL(8, q)] = (bf16)f2bf(st[q][r]);
                __syncthreads();
                { f32x4 s[2]; mm_lds<64, 64, 128, false>(rQ, LQ, rK, LQ, s, wave, lane);
#pragma unroll
                  for (int q = 0; q < 2; ++q)
#pragma unroll
                      for (int r = 0; r < 4; ++r) { const int i = MM_ROW(4, q, r), j = MM_COL(4, q); const int dd = i > j ? i - j : j - i; rS[i * LT + j] = (bf16)f2bf(s[q][r] * exp2f((float)dd * l2g)); } }
                __syncthreads();
                f32x4 oi[4];
                mm_lds<64, 128, 128, false>(rQ, LQ, rStT, LQ, oi, wave, lane);
#pragma unroll
                for (int q = 0; q < 4; ++q)
#pragma unroll
                    for (int r = 0; r < 4; ++r) oi[q][r] *= exp2f((float)(MM_ROW(8, q, r) + 1) * l2g);
                mm_lds<64, 128, 64, true>(rS, LT, rVT, LT, oi, wave, lane);
#pragma unroll
                for (int q = 0; q < 4; ++q)
#pragma unroll
                    for (int r = 0; r < 4; ++r) { const int i = MM_ROW(8, q, r);
                        float s1 = oi[q][r], s2 = oi[q][r] * oi[q][r];
#pragma unroll
                        for (int o = 1; o < 16; o <<= 1) { s1 += __shfl_xor(s1, o); s2 += __shfl_xor(s2, o); }
                        if (fr == 0) { rStat[(i * 8 + wave) * 2] = s1; rStat[(i * 8 + wave) * 2 + 1] = s2; } }
                __syncthreads();
                if (tid_l < 64) { const int tid = tid_l; float s1 = 0.f, s2 = 0.f;
#pragma unroll
                    for (int w = 0; w < 8; ++w) { s1 += rStat[(tid * 8 + w) * 2]; s2 += rStat[(tid * 8 + w) * 2 + 1]; }
                    const float mu = s1 * (1.0f / 128.0f); float var = s2 * (1.0f / 128.0f) - mu * mu; var = var < 0.f ? 0.f : var;
                    rStat[1024 + tid * 2] = mu; rStat[1024 + tid * 2 + 1] = var; }
                __syncthreads();
                { const int e = MM_COL(8, 0); const float gnw = args.in[5][128 * h + e];
#pragma unroll
                for (int q = 0; q < 4; ++q) {
#pragma unroll
                    for (int r = 0; r < 4; ++r) { const int i = MM_ROW(8, q, r);
                        const float mu = rStat[1024 + i * 2], var = rStat[1024 + i * 2 + 1];
                        const float y = (oi[q][r] - mu) * rsqrtf(var + EPS);
                        const float gate = bf2f(rG[i * LQ + e]);
                        rQ[i * LQ + e] = (bf16)f2bf(y * gnw * gate * sigmoidf_(gate)); }
                } }
#pragma unroll
                for (int q = 0; q < 8; ++q) st[q] = st[q] * g64;
                mm_lds<128, 128, 64, true>(rVT, LT, rKdT, LT, st, wave, lane);
                __syncthreads();
                { const int j = tid_l >> 3, seg = tid_l & 7; bf16* yp = ACTA + (row0 + j) * D + 128 * h + 16 * seg;
                  *(u32x4*)yp = *(const LAS u32x4*)(rQ + j * LQ + 16 * seg); *(u32x4*)(yp + 8) = *(const LAS u32x4*)(rQ + j * LQ + 16 * seg + 8); }
                }
            }
        }
    }
    SEAM(3);

    if (IN(4)) {
        pg8::DenseSched S; S.init(ACTA, (const bf16*)(ws + WT_OUT0), M, D, D, G, bid);
#if OLD_DENSE
        pg8::EpiResF32 E{args.in[0], out, D};
        pg8::gemm_phase<pg8::EpiResF32, pg8::DenseSched, false>(scrb, 2 * D, S, E);
#else
        pg8::EpiStoreBf16 E{ACTB, D};
        pg8::gemm_phase<pg8::EpiStoreBf16, pg8::DenseSched, false>(scrb, 2 * D, S, E);
#endif
    }
    SEAM(4);
#if OLD_DENSE
    if (IN(5)) { for (int m = gw; m < M; m += NGW) rms_row_bf16(out + (size_t)m * D, args.in[2], ACTA + (size_t)m * D, lane); }
#else
    if (IN(5)) { for (int m = gw; m < M; m += NGW) rms_res_row_bf16(args.in[0] + (size_t)m * D, ACTB + (size_t)m * D, out + (size_t)m * D, args.in[2], ACTA + (size_t)m * D, lane); }
#endif
    SEAM(5);
    if (IN(6)) {
        pg8::DenseSched S; S.init(ACTA, (const bf16*)(ws + WT_GU0), M, 2 * D_FF, D, G, bid);
        pg8::EpiSwiGLU E{ACTB, D_FF};
        pg8::gemm_phase<pg8::EpiSwiGLU, pg8::DenseSched, false>(scrb, 2 * D, S, E);
    }
    SEAM(6);
    if (IN(7)) {
        pg8::DenseSched S; S.init(ACTB, (const bf16*)(ws + WT_DN0), M, D, D_FF, G, bid);
#if OLD_DENSE
        pg8::EpiResF32 E{out, out, D};
        pg8::gemm_phase<pg8::EpiResF32, pg8::DenseSched, false>(scrb, 2 * D_FF, S, E);
#else
        pg8::EpiStoreBf16 E{ACTA, D};
        pg8::gemm_phase<pg8::EpiStoreBf16, pg8::DenseSched, false>(scrb, 2 * D_FF, S, E);
#endif
    }
    SEAM(7);
#if OLD_DENSE
    if (IN(8)) { for (int m = gw; m < M; m += NGW) rms_row_bf16(out + (size_t)m * D, args.in[1] + D, ACTA + (size_t)m * D, lane); }
#else
    if (IN(8)) { for (int m = gw; m < M; m += NGW) rms_res_row_bf16(out + (size_t)m * D, ACTA + (size_t)m * D, out + (size_t)m * D, args.in[1] + D, ACTA + (size_t)m * D, lane); }
#endif
    SEAM(8);
    if (IN(9)) {
        pg8::DenseSched S; S.init(ACTA, (const bf16*)(ws + WT_IN1), M, ODD_IN, D, G, bid);
        pg8::EpiStoreBf16 E{ACTB, ODD_IN};
        pg8::gemm_phase<pg8::EpiStoreBf16, pg8::DenseSched, false>(scrb, 2 * D, S, E);
    }
    SEAM(9);

    float* const LSUM = (float*)(ws + WS_SCR);
#pragma unroll
    for (int pass = 0; pass < 2; ++pass) {
        if (IN(10 + pass)) {
            LAS bf16* const XR = (LAS bf16*)(scrb + wave * 17408);
            LAS float* const AB = (LAS float*)(scrb + wave * 17408 + 9216);
            const int head = wave, ch = 64 * head + lane;
            bf16x8 Bwa[4][2], Bwx[4][2];
#pragma unroll
            for (int tj = 0; tj < 4; ++tj)
#pragma unroll
                for (int ks = 0; ks < 2; ++ks) { bf16x8 va, vx;
#pragma unroll
                    for (int e = 0; e < 8; ++e) { const int i = 32 * ks + 8 * fq + e, j = 16 * tj + fr; va[e] = (short)f2bf(args.in[14][(size_t)(head * 64 + i) * 64 + j]); vx[e] = (short)f2bf(args.in[16][(size_t)(head * 64 + i) * 64 + j]); }
                    Bwa[tj][ks] = va; Bwx[tj][ks] = vx; }
            float cba[4], cbx[4], csp[4];
#pragma unroll
            for (int tj = 0; tj < 4; ++tj) { const int c = 64 * head + 16 * tj + fr; cba[tj] = args.in[15][c]; cbx[tj] = args.in[17][c]; csp[tj] = log1pf(__expf(-args.in[18][c])); }
            const float cw0 = args.in[12][ch], cw1 = args.in[12][512 + ch], cw2 = args.in[12][1024 + ch], cw3 = args.in[12][1536 + ch], cbias = args.in[13][ch];
            for (int it = bid; it < NB * 64; it += G) {
                const int b = it >> 6, c = it & 63; const size_t row0 = (size_t)b * SEQ + 64 * c;
                { float x0 = 0.f, x1 = 0.f, x2 = 0.f;
                  if (c > 0) { x0 = bf2f(ACTB[(row0 - 3) * ODD_IN + XR_OFF + ch]); x1 = bf2f(ACTB[(row0 - 2) * ODD_IN + XR_OFF + ch]); x2 = bf2f(ACTB[(row0 - 1) * ODD_IN + XR_OFF + ch]); }
                  for (int t = 0; t < 64; ++t) { const float x3 = bf2f(ACTB[(row0 + t) * ODD_IN + XR_OFF + ch]);
                      XR[t * LT + lane] = (bf16)f2bf(cw0 * x0 + cw1 * x1 + cw2 * x2 + cw3 * x3 + cbias); x0 = x1; x1 = x2; x2 = x3; } }
                float hst = 0.f, cum = 1.f;
                if (pass == 1) {
                    for (int c0 = 0; c0 < c; c0 += 8) {
                        f32x2 sv[8];
#pragma unroll
                        for (int k = 0; k < 8; ++k) { const int cc = (c0 + k < c) ? c0 + k : c0; sv[k] = ((const f32x2*)LSUM)[(size_t)(b * 64 + cc) * 512 + ch]; }
#pragma unroll
                        for (int k = 0; k < 8; ++k) if (c0 + k < c) hst = sv[k].x * hst + sv[k].y;
                    }
                }
                LDS_WAIT(); asm volatile("" ::: "memory");
                for (int sb = 0; sb < 4; ++sb) {
                    f32x4 aR[4], aX[4];
#pragma unroll
                    for (int tj = 0; tj < 4; ++tj) { aR[tj] = (f32x4){0.f, 0.f, 0.f, 0.f}; aX[tj] = aR[tj]; }
#pragma unroll
                    for (int ks = 0; ks < 2; ++ks) { const bf16x8 af = *(const LAS bf16x8*)(XR + (16 * sb + fr) * LT + 32 * ks + 8 * fq);
#pragma unroll
                        for (int tj = 0; tj < 4; ++tj) { aR[tj] = __builtin_amdgcn_mfma_f32_16x16x32_bf16(af, Bwa[tj][ks], aR[tj], 0, 0, 0); aX[tj] = __builtin_amdgcn_mfma_f32_16x16x32_bf16(af, Bwx[tj][ks], aX[tj], 0, 0, 0); } }
#pragma unroll
                    for (int tj = 0; tj < 4; ++tj)
#pragma unroll
                        for (int r = 0; r < 4; ++r) { const int tl = 4 * fq + r, j = 16 * tj + fr;
                            const float rg = sigmoidf_(aR[tj][r] + cba[tj]), ig = sigmoidf_(aX[tj][r] + cbx[tj]);
                            const float la = -8.0f * rg * csp[tj]; const float a = __expf(la); const float mult = sqrtf(-expm1f(2.0f * la));
                            const float xv = bf2f(XR[(16 * sb + tl) * LT + j]);
                            AB[tl * 64 + j] = a; AB[1024 + tl * 64 + j] = mult * ig * xv; }
                    LDS_WAIT(); asm volatile("" ::: "memory");
                    for (int tl = 0; tl < 16; ++tl) { const float a = AB[tl * 64 + lane], bb = AB[1024 + tl * 64 + lane]; hst = a * hst + bb; cum *= a;
                        if (pass == 1) { const size_t row = row0 + 16 * sb + tl; const float xg = bf2f(ACTB[row * ODD_IN + XG_OFF + ch]);
                            const float u3 = 0.7978845608028654f * (xg + 0.044715f * xg * xg * xg); const float th = 1.0f - 2.0f * __builtin_amdgcn_rcpf(1.0f + __builtin_amdgcn_exp2f(u3 * 2.8853900817779268f));
                            ACTA[row * D + 512 + ch] = (bf16)f2bf(hst * 0.5f * xg * (1.0f + th)); } }
                    LDS_WAIT(); asm volatile("" ::: "memory");
                }
                if (pass == 0) { f32x2 sv; sv.x = cum; sv.y = hst; ((f32x2*)LSUM)[(size_t)(b * 64 + c) * 512 + ch] = sv; }
            }
            if (pass == 1) {
                for (int idx = bid * 512 + tid; idx < M * 64; idx += G * 512) {
                    const int row = idx >> 6, c8 = (idx & 63) * 8; const int t = row & (SEQ - 1);
                    const bf16* p = ACTB + (size_t)row * ODD_IN;
                    float acc8[8];
#pragma unroll
                    for (int x = 0; x < 8; ++x) acc8[x] = 0.f;
#pragma unroll
                    for (int k = 0; k < 3; ++k) { const int dt = 2 - k; if (t - dt >= 0) { const bf16* pr = p - (size_t)dt * ODD_IN;
                            const u32x4 gc = *(const u32x4*)(pr + CC_OFF + c8), uu = *(const u32x4*)(pr + CU_OFF + c8); const unsigned gw_[4] = {gc.x, gc.y, gc.z, gc.w}, uw[4] = {uu.x, uu.y, uu.z, uu.w};
#pragma unroll
                            for (int x = 0; x < 4; ++x) { acc8[2 * x] += args.in[11][k * 512 + c8 + 2 * x] * bf2f(gw_[x]) * bf2f(uw[x]); acc8[2 * x + 1] += args.in[11][k * 512 + c8 + 2 * x + 1] * bf2f(gw_[x] >> 16) * bf2f(uw[x] >> 16); } } }
                    const u32x4 gb = *(const u32x4*)(p + CB_OFF + c8); const unsigned gbw[4] = {gb.x, gb.y, gb.z, gb.w};
                    u32x4 w; unsigned ww[4];
#pragma unroll
                    for (int x = 0; x < 4; ++x) ww[x] = pk2(bf2f(gbw[x]) * acc8[2 * x], bf2f(gbw[x] >> 16) * acc8[2 * x + 1]);
                    w.x = ww[0]; w.y = ww[1]; w.z = ww[2]; w.w = ww[3];
                    *(u32x4*)(ACTA + (size_t)row * D + c8) = w;
                }
            }
        }
        SEAM(10 + pass);
    }

    if (IN(12)) {
        pg8::DenseSched S; S.init(ACTA, (const bf16*)(ws + WT_OUT1), M, D, D, G, bid);
#if OLD_DENSE
        pg8::EpiResF32 E{out, out, D};
        pg8::gemm_phase<pg8::EpiResF32, pg8::DenseSched, false>(scrb, 2 * D, S, E);
#else
        pg8::EpiStoreBf16 E{ACTB, D};
        pg8::gemm_phase<pg8::EpiStoreBf16, pg8::DenseSched, false>(scrb, 2 * D, S, E);
#endif
    }
    SEAM(12);

    int* const LTOK = (int*)(ws + SCR_LTOK); unsigned* const REC = (unsigned*)(ws + SCR_REC);
    if (IN(13)) {
        LAS int* const lcnt = (LAS int*)(scrb);
        LAS int* const lbase = (LAS int*)(scrb + 64);
        LAS int* const recE = (LAS int*)(scrb + 128);
        LAS int* const recR = (LAS int*)(scrb + 128 + 1024);
        LAS float* const recW = (LAS float*)(scrb + 128 + 2048);
        float wr_[4][4][8];
#pragma unroll
        for (int j = 0; j < 4; ++j)
#pragma unroll
            for (int x = 0; x < 4; ++x) { const int col = 4 * (lane + 64 * j) + x; const f32x4 w0 = *(const f32x4*)(args.in[20] + (size_t)col * 8), w1 = *(const f32x4*)(args.in[20] + (size_t)col * 8 + 4);
                wr_[j][x][0] = w0.x; wr_[j][x][1] = w0.y; wr_[j][x][2] = w0.z; wr_[j][x][3] = w0.w; wr_[j][x][4] = w1.x; wr_[j][x][5] = w1.y; wr_[j][x][6] = w1.z; wr_[j][x][7] = w1.w; }
        for (int base = bid * 128; base < M; base += G * 128) {
            if (tid < 16) lcnt[tid] = 0;
            __syncthreads();
            for (int rr = 0; rr < 16; ++rr) {
                const int lr = wave * 16 + rr, m = base + lr;
                f32x4* xr = (f32x4*)(out + (size_t)m * D) + lane; const f32x4* gr = (const f32x4*)(args.in[2] + D) + lane; const u32x2* dr = (const u32x2*)(ACTB + (size_t)m * D) + lane;
                f32x4 v[4]; float s = 0.f;
#pragma unroll
                for (int j = 0; j < 4; ++j) { v[j] = xr[64 * j];
#if !OLD_DENSE
                    const u32x2 dv = dr[64 * j]; v[j].x += bf2f(dv.x); v[j].y += bf2f(dv.x >> 16); v[j].z += bf2f(dv.y); v[j].w += bf2f(dv.y >> 16); xr[64 * j] = v[j];
#endif
                    s += (v[j].x * v[j].x + v[j].y * v[j].y) + (v[j].z * v[j].z + v[j].w * v[j].w); }
                const float rstd = rsqrtf(wave_sum(s) * (1.f / D) + EPS);
                float lg[8];
#pragma unroll
                for (int e = 0; e < 8; ++e) lg[e] = 0.f;
                unsigned* o8 = (unsigned*)((unsigned char*)ACTA + (size_t)m * D) + lane;
#pragma unroll
                for (int j = 0; j < 4; ++j) { const f32x4 gv = gr[64 * j]; float y[4] = {v[j].x * rstd * gv.x, v[j].y * rstd * gv.y, v[j].z * rstd * gv.z, v[j].w * rstd * gv.w};
                    { int w = __builtin_amdgcn_cvt_pk_fp8_f32(__builtin_amdgcn_fmed3f(y[0], -448.f, 448.f), __builtin_amdgcn_fmed3f(y[1], -448.f, 448.f), 0, false);
                      w = __builtin_amdgcn_cvt_pk_fp8_f32(__builtin_amdgcn_fmed3f(y[2], -448.f, 448.f), __builtin_amdgcn_fmed3f(y[3], -448.f, 448.f), w, true); o8[64 * j] = (unsigned)w; }
#pragma unroll
                    for (int x = 0; x < 4; ++x)
#pragma unroll
                        for (int e = 0; e < 8; ++e) lg[e] += y[x] * wr_[j][x][e]; }
#pragma unroll
                for (int e = 0; e < 8; ++e) lg[e] = wave_sum(lg[e]) + args.in[21][e];
                int e1 = 0; float l1 = lg[0];
#pragma unroll
                for (int e = 1; e < 8; ++e) if (lg[e] > l1) { l1 = lg[e]; e1 = e; }
                int e2 = -1; float l2 = -3.0e38f;
#pragma unroll
                for (int e = 0; e < 8; ++e) if (e != e1 && lg[e] > l2) { l2 = lg[e]; e2 = e; }
                const float w2 = 1.0f / (1.0f + __expf(l1 - l2)), w1 = 1.0f - w2;
                if (lane == 0) { recE[lr * 2] = e1; recE[lr * 2 + 1] = e2; recW[lr * 2] = w1; recW[lr * 2 + 1] = w2;
                    recR[lr * 2] = __hip_atomic_fetch_add(&lcnt[e1], 1, __ATOMIC_RELAXED, __HIP_MEMORY_SCOPE_WORKGROUP); recR[lr * 2 + 1] = __hip_atomic_fetch_add(&lcnt[8 + e2], 1, __ATOMIC_RELAXED, __HIP_MEMORY_SCOPE_WORKGROUP); }
            }
            __syncthreads();
            if (tid < 16) lbase[tid] = (int)__hip_atomic_fetch_add(ctl + CW_CNT + 64 * tid, (unsigned)lcnt[tid], RLX_AGENT);
            __syncthreads();
            if (tid < 256) { const int lr = tid >> 1, k = tid & 1; const int e = recE[tid]; const int pos = lbase[k * 8 + e] + recR[tid];
                if (pos < LIST_CAP) LTOK[(size_t)(k * 8 + e) * LIST_CAP + pos] = base + lr;
                unsigned* rec = REC + (size_t)(base + lr) * 8 + 3 * k; rec[0] = (unsigned)(k * 8 + e); rec[1] = (unsigned)pos; rec[2] = __builtin_bit_cast(unsigned, recW[tid]); }
            __syncthreads();
        }
    }
    SEAM(13);

    if (IN(14)) {
        pg8::MoeSched S; S.init(ACTA, ws + WT_GU1, LTOK, ctl + CW_CNT, 0, 2 * D_EXP / 256, D, 0, (size_t)2 * D_EXP * D, G, bid);
        if (bid == 0 && tid == 0) { unsigned* tbw = ctl + CW_TB; tbw[0] = 0u; tbw[1] = S.t1; tbw[2] = S.t2; tbw[3] = S.t3; tbw[4] = S.t4; tbw[5] = S.t5; tbw[6] = S.t6; tbw[7] = S.t7; tbw[8] = S.t8;
            tbw[9] = S.t9; tbw[10] = S.t10; tbw[11] = S.t11; tbw[12] = S.t12; tbw[13] = S.t13; tbw[14] = S.t14; tbw[15] = S.t15; }
        pg8::EpiSwiGLU8 E{(unsigned char*)ACTB, D_EXP, 1.0f / 64.0f, 4.0f};
        pg8::gemm_phase<pg8::EpiSwiGLU8, pg8::MoeSched, true, true>(scrb, D, S, E);
    }
    SEAM(14);
    bf16* const YB = (bf16*)(ws + WS_Y);
    if (IN(15)) {
        pg8::MoeSched S; S.init(ACTB, ws + WT_DN1, LTOK, ctl + CW_CNT, 0, D / 256, D_EXP, (size_t)256 * D_EXP, (size_t)D * D_EXP, G, bid);
        pg8::EpiStoreBf16 E{YB, D};
        pg8::gemm_phase<pg8::EpiStoreBf16, pg8::MoeSched, false, true>(scrb, D_EXP, S, E);
    }
    SEAM(15);

    if (IN(16)) {
        for (int m = gw; m < M; m += NGW) {
            const u32x4 r0 = *(const u32x4*)(REC + (size_t)m * 8), r1 = *(const u32x4*)(REC + (size_t)m * 8 + 4);
            const unsigned tb0 = ctl[CW_TB + r0.x], tb1 = ctl[CW_TB + r0.w];
            const unsigned w0b = r0.z, w1b = r1.y;
            const float w0 = __uint_as_float(w0b) * (1.0f / 256.0f), w1 = __uint_as_float(w1b) * (1.0f / 256.0f);
            const u32x2* y0 = (const u32x2*)(YB + ((size_t)tb0 * 256 + r0.y) * D) + lane; const u32x2* y1 = (const u32x2*)(YB + ((size_t)tb1 * 256 + r1.x) * D) + lane;
            f32x4* xr = (f32x4*)(out + (size_t)m * D) + lane; const f32x4* gr = (const f32x4*)args.in[3] + lane;
            f32x4 v[4]; float s = 0.f;
#pragma unroll
            for (int j = 0; j < 4; ++j) { v[j] = xr[64 * j]; const u32x2 a = y0[64 * j], b = y1[64 * j];
                v[j].x += w0 * bf2f(a.x) + w1 * bf2f(b.x); v[j].y += w0 * bf2f(a.x >> 16) + w1 * bf2f(b.x >> 16); v[j].z += w0 * bf2f(a.y) + w1 * bf2f(b.y); v[j].w += w0 * bf2f(a.y >> 16) + w1 * bf2f(b.y >> 16);
                s += (v[j].x * v[j].x + v[j].y * v[j].y) + (v[j].z * v[j].z + v[j].w * v[j].w); }
            const float rstd = rsqrtf(wave_sum(s) * (1.f / D) + EPS);
#pragma unroll
            for (int j = 0; j < 4; ++j) { const f32x4 gv = gr[64 * j]; xr[64 * j] = v[j] * rstd * gv; }
        }
    }
    if (PROBE_A_LO >= 0 && bid == 0 && tid == 0) {
        const unsigned long long t_end = wall_clock64();
        const unsigned long long wait = (unsigned long long)(MISC[9] - MISC[8]) * 4ull + ((PROBE_B_LO >= 0) ? (unsigned long long)(MISC[11] - MISC[10]) * 4ull : 0ull);
        while (wall_clock64() - t_end < wait) __builtin_amdgcn_s_sleep(32);
    }
#undef IN
#undef SEAM
#undef PSTAMP
}

extern "C" void kernel_launch(void* const* d_in, const int* in_sizes, int n_in, void* d_out, int out_size, void* d_ws, size_t ws_size, hipStream_t stream) {
    static int grid = 0;
    if (grid == 0) {
        if (n_in != 25 || in_sizes[0] != M * D || out_size != M * D || ws_size < WS_END) { fprintf(stderr, "kernel_launch: unexpected shapes / workspace (n_in %d, ws %zu, need %zu)\n", n_in, ws_size, (size_t)WS_END); grid = -1; return; }
        int dev = 0, cus = 0, per_cu = 0;
        if (hipGetDevice(&dev) != hipSuccess || hipDeviceGetAttribute(&cus, hipDeviceAttributeMultiprocessorCount, dev) != hipSuccess) { grid = -1; return; }
        if (hipFuncSetAttribute((const void*)fwd_kernel, hipFuncAttributeMaxDynamicSharedMemorySize, LDS_BYTES) != hipSuccess) { fprintf(stderr, "kernel_launch: hipFuncSetAttribute failed\n"); grid = -1; return; }
        if (hipOccupancyMaxActiveBlocksPerMultiprocessor(&per_cu, (const void*)fwd_kernel, 512, LDS_BYTES) != hipSuccess || per_cu < 1) { fprintf(stderr, "kernel_launch: occupancy query says %d\n", per_cu); }
        (void)hipGetLastError();
        grid = cus;
    }
    if (grid < 0) return;
    if (hipMemsetAsync((char*)d_ws + WS_CTL, 0, CTL_ZERO_BYTES, stream) != hipSuccess) return;
    Args a{};
    for (int i = 0; i < 25; ++i) a.in[i] = (const float*)d_in[i];
    a.out = (float*)d_out; a.ws = (unsigned char*)d_ws;
#if MK_N_LAUNCHES == 1
    a.ph_lo = 0; a.ph_hi = NPHASE;
    hipLaunchKernelGGL(fwd_kernel, dim3(grid), dim3(512), LDS_BYTES, stream, a);
#else
    for (int p = 0; p < NPHASE; ++p) { a.ph_lo = p; a.ph_hi = p + 1; hipLaunchKernelGGL(fwd_kernel, dim3(grid), dim3(512), LDS_BYTES, stream, a); }
#endif
}
```

```cpp
#include <hip/hip_runtime.h>
#include <cstdio>
#include <cstdint>

#ifndef OLD_DENSE
#define OLD_DENSE 0
#endif
#ifndef MK_N_LAUNCHES
#define MK_N_LAUNCHES 1
#endif

#ifndef PROBE_A_LO
#define PROBE_A_LO (-1)
#define PROBE_A_HI (-1)
#define PROBE_B_LO (-1)
#define PROBE_B_HI (-1)
#endif
#define GAS __attribute__((address_space(1)))
#define LAS __attribute__((address_space(3)))
typedef unsigned short bf16;
typedef short bf16x8 __attribute__((ext_vector_type(8)));
typedef float f32x4 __attribute__((ext_vector_type(4)));
typedef float f32x2 __attribute__((ext_vector_type(2)));
typedef unsigned u32x4 __attribute__((ext_vector_type(4)));
typedef unsigned u32x2 __attribute__((ext_vector_type(2)));
typedef int v4i_t __attribute__((ext_vector_type(4)));
typedef int v8i_t __attribute__((ext_vector_type(8)));

constexpr int D = 1024, NB = 8, SEQ = 4096, M = NB * SEQ;
constexpr int EVEN_IN = 3584, ODD_IN = 2560, D_FF = 2816, D_EXP = 3584, NEXP = 8;
constexpr int RQ_OFF = 0, RK_OFF = 512, RV_OFF = 1024, RGATE_OFF = 1536, SQ_OFF = 2048, SK_OFF = 2560, SV_OFF = 3072;
constexpr int CB_OFF = 0, CC_OFF = 512, CU_OFF = 1024, XR_OFF = 1536, XG_OFF = 2048;
constexpr float EPS = 1e-6f;
constexpr int LIST_CAP = 32768;
constexpr int MAX_TILES = 135;

constexpr size_t MiB = 1u << 20;
constexpr size_t WS_CTL = 0, CTL_ZERO_BYTES = 1 * MiB;
constexpr size_t WS_ROT = 1 * MiB;
constexpr size_t WS_SCR = 3 * MiB;
constexpr size_t WS_WB = 19 * MiB;
constexpr size_t WT_DN1 = WS_WB;
constexpr size_t WT_IN0 = 47 * MiB;
constexpr size_t WT_OUT0 = WT_IN0 + (size_t)EVEN_IN * D * 2;
constexpr size_t WT_GU0 = WT_OUT0 + (size_t)D * D * 2;
constexpr size_t WT_DN0 = WT_GU0 + (size_t)2 * D_FF * D * 2;
constexpr size_t WT_IN1 = WT_DN0 + (size_t)D * D_FF * 2;
constexpr size_t WT_OUT1 = WT_IN1 + (size_t)ODD_IN * D * 2;
constexpr size_t WT_GU1 = WT_OUT1 + (size_t)D * D * 2;
constexpr size_t WB_END = WT_GU1 + (size_t)NEXP * 2 * D_EXP * D;
constexpr size_t WS_ACTA = 136 * MiB;
constexpr size_t WS_ACTB = 200 * MiB;
constexpr size_t WS_END = WS_ACTB + (size_t)MAX_TILES * 256 * D_EXP * 2;
constexpr size_t WS_Y = WT_IN0;
static_assert(WT_DN1 + (size_t)NEXP * D * D_EXP <= WT_IN0 && WB_END <= WS_ACTA && WS_ACTA + (size_t)M * D * 2 <= WS_ACTB, "weights overlap");
static_assert(WS_Y + (size_t)2 * MAX_TILES * 256 * D * 2 <= WS_ACTB, "y overlay");
static_assert((size_t)M * EVEN_IN * 2 <= (size_t)MAX_TILES * 256 * D_EXP * 2, "ACTB size");
constexpr size_t SCR_LTOK = WS_SCR, SCR_REC = WS_SCR + 4 * MiB;
constexpr int CW_BAR = 4096;
constexpr int CW_TB = 16384;
constexpr int CW_CNT = 8192;

constexpr int LDS_MISC = 0;
constexpr int LDS_SCR = 256;
constexpr int LDS_BYTES = 147456;

#define RLX_AGENT __ATOMIC_RELAXED, __HIP_MEMORY_SCOPE_AGENT
#define LDS_WAIT() asm volatile("s_waitcnt lgkmcnt(0)" ::: "memory")
__device__ __forceinline__ unsigned f2bf(float f) { unsigned u = __builtin_bit_cast(unsigned, f); return (u + 0x7fffu + ((u >> 16) & 1u)) >> 16; }
__device__ __forceinline__ unsigned pk2(float lo, float hi) { return f2bf(lo) | (f2bf(hi) << 16); }
__device__ __forceinline__ float bf2f(unsigned b) { return __builtin_bit_cast(float, (b & 0xffffu) << 16); }
__device__ __forceinline__ float wave_sum(float v) {
#pragma unroll
    for (int o = 1; o < 64; o <<= 1) v += __shfl_xor(v, o);
    return v;
}
__device__ __forceinline__ float sigmoidf_(float x) { return __builtin_amdgcn_rcpf(1.0f + __builtin_amdgcn_exp2f(x * -1.4426950408889634f)); }

#define XB_TMO      128
#define XB_XCNT(j)  (256  + 64 * (j))
#define XB_XSUB(j)  (1280 + 64 * (j))
#define XB_XGEN(j)  (2304 + 64 * (j))
#define XB_TOP      3328
#define XB_TOPGEN   3392
#define XCD_BAR_WORDS 3456
#define XB_SPIN_CAP (1u << 18)

__device__ __forceinline__ unsigned xb_ld(unsigned* p)              { return __hip_atomic_load(p, __ATOMIC_RELAXED, __HIP_MEMORY_SCOPE_AGENT); }
__device__ __forceinline__ unsigned xb_add(unsigned* p, unsigned v) { return __hip_atomic_fetch_add(p, v, __ATOMIC_RELAXED, __HIP_MEMORY_SCOPE_AGENT); }
__device__ __forceinline__ unsigned xb_xcc_id() { return (unsigned)__builtin_amdgcn_s_getreg((3 << 11) | 20) & 0xFu; }
#define XB_SPIN(cond, bar) do { unsigned _sp = 0; while (cond) { __builtin_amdgcn_s_sleep(1); \
    if ((++_sp & 255u) == 0u) { if (xb_ld(&(bar)[XB_TMO])) break; if (_sp > XB_SPIN_CAP) { atomicAdd(&(bar)[XB_TMO], 1u); break; } } } } while (0)

struct XcdBarrier { unsigned* bar; unsigned x; volatile LAS unsigned* st; };

__device__ __forceinline__ XcdBarrier xcd_barrier_post(unsigned* bar, volatile LAS unsigned* st) {
    XcdBarrier b; b.bar = bar; b.x = xb_xcc_id(); b.st = st;
    if (threadIdx.x == 0) (void)xb_add(&bar[XB_XCNT(b.x)], 1u);
    return b;
}
__device__ __forceinline__ void xcd_barrier_complete(unsigned* bar, unsigned x, unsigned& nloc, unsigned& nx) {
    const unsigned G = gridDim.x * gridDim.y * gridDim.z;
    unsigned sum, cnt, mine, sp = 0u;
    for (;;) {
        sum = 0u; cnt = 0u; mine = 0u;
#pragma unroll
        for (unsigned j = 0; j < 16; ++j) { const unsigned c = xb_ld(&bar[XB_XCNT(j)]); sum += c; cnt += (c > 0u) ? 1u : 0u; mine = (j == x) ? c : mine; }
        if (sum == G) break;
        __builtin_amdgcn_s_sleep(1);
        if ((++sp & 255u) == 0u) { if (xb_ld(&bar[XB_TMO])) break; if (sp > XB_SPIN_CAP) { atomicAdd(&bar[XB_TMO], 1u); break; } }
    }
    nloc = mine > 0u ? mine : 1u; nx = cnt > 0u ? cnt : 1u;
}
__device__ __forceinline__ void xcd_barrier(const XcdBarrier& b) {
    asm volatile("s_waitcnt vmcnt(0)" ::: "memory");
    __syncthreads();
    if (threadIdx.x == 0) {
        unsigned* bar = b.bar;
        __builtin_amdgcn_s_waitcnt(0);
        unsigned nloc = b.st[0], nx = b.st[1];
        if (nloc == 0u) { xcd_barrier_complete(bar, b.x, nloc, nx); b.st[0] = nloc; b.st[1] = nx; }
        const unsigned old = xb_add(&bar[XB_XSUB(b.x)], 1u);
        const unsigned gen = old / nloc;
        if (old + 1u == (gen + 1u) * nloc) {
            __builtin_amdgcn_fence(__ATOMIC_RELEASE, "agent");
            asm volatile("s_waitcnt vmcnt(0)" ::: "memory");
            const unsigned og = xb_add(&bar[XB_TOP], 1u);
            const unsigned tg = og / nx;
            if (og + 1u == (tg + 1u) * nx) xb_add(&bar[XB_TOPGEN], 1u);
            else XB_SPIN(xb_ld(&bar[XB_TOPGEN]) == tg, bar);
            __builtin_amdgcn_fence(__ATOMIC_ACQUIRE, "agent");
            xb_add(&bar[XB_XGEN(b.x)], 1u);
            asm volatile("s_waitcnt vmcnt(0)" ::: "memory");
        } else {
            XB_SPIN(xb_ld(&bar[XB_XGEN(b.x)]) == gen, bar);
            __builtin_amdgcn_fence(__ATOMIC_ACQUIRE, "agent");
            asm volatile("s_waitcnt vmcnt(0)" ::: "memory");
        }
    }
    __syncthreads();
}

namespace pg8 {
constexpr int BM = 256, BK = 64, HALF = 128, HTB = HALF * BK * 2, STAGE_BYTES = 8 * HTB, NXCD = 8, WGM = 8;
__device__ __forceinline__ int lds_byte(int r, int c) { const int st = (r >> 4) * 2 + (c >> 5), rr = r & 15, cc = c & 31, ob = rr * 64 + cc * 2; return st * 1024 + (ob ^ (((ob >> 9) & 1) << 5)); }
__device__ __forceinline__ void stage_rc(int b, int& R, int& C) { const int st = b / 1024, sb = b % 1024, swz = sb ^ (((sb >> 9) & 1) << 5); R = (st >> 1) * 16 + swz / 64; C = (st & 1) * 32 + (swz % 64) / 2; }
__device__ __forceinline__ int perm32(int rho) { const int n = rho >> 4, i = rho & 15; return 8 * (i >> 2) + 4 * n + (i & 3); }

struct Unit { int pm, pn, e, lt, cn; };

struct StaticOrder {
    int nM, nN, nwg, G, c;
    __device__ __forceinline__ void init_tiles(int nM_, int nN_, int G_, int c_) { nM = nM_; nN = nN_; nwg = nM * nN; G = G_; c = c_; }
    __device__ __forceinline__ bool next_tile(int i, int& pm, int& pn) const {
        const long L = (long)i * G + c; if (L >= nwg) return false;
        int wgid = (int)L; { const int q = nwg / NXCD, r = nwg % NXCD, xcd = wgid % NXCD, off = wgid / NXCD; wgid = (xcd < r ? xcd * (q + 1) : r * (q + 1) + (xcd - r) * q) + off; }
        const int nig = WGM * nN, gid = wgid / nig, fm = gid * WGM, gsz = (nM - fm) < WGM ? (nM - fm) : WGM;
        pm = fm + ((wgid % nig) % gsz); pn = (wgid % nig) / gsz; return true;
    }
};
struct DenseSched : StaticOrder {
    const char* A; const char* Bt; size_t tstep;
    __device__ __forceinline__ void init(const bf16* A_, const bf16* Bt_, int Mr, int N, int K, int G_, int c_) { A = (const char*)A_; Bt = (const char*)Bt_; tstep = (size_t)BM * K * 2; init_tiles(Mr / BM, N / BM, G_, c_); }
    __device__ __forceinline__ bool next(int i, Unit& u) const { u.e = 0; u.lt = 0; u.cn = 0; return next_tile(i, u.pm, u.pn); }
    __device__ __forceinline__ const char* a_base(const Unit& u) const { return A + (size_t)u.pm * tstep; }
    __device__ __forceinline__ const char* b_base(const Unit& u) const { return Bt + (size_t)u.pn * tstep; }
    __device__ __forceinline__ void a_rows(const Unit&, const int (&)[2], const int (&)[2], unsigned (&)[2][2]) const {}
    __device__ __forceinline__ const int* tok_src(const Unit&) const { return nullptr; }
};
struct MoeSched : StaticOrder {
    const char* A; const char* Bt; size_t a_tstep, b_estep, b_tstep; const int* ltok; int rowb, toff;
    int c0, c1, c2, c3, c4, c5, c6, c7, c8, c9, c10, c11, c12, c13, c14, c15, t1, t2, t3, t4, t5, t6, t7, t8, t9, t10, t11, t12, t13, t14, t15, t16;
    __device__ __forceinline__ static int ldc_(const unsigned* cntw, int e) { int c = (int)__builtin_amdgcn_readfirstlane(__hip_atomic_load(cntw + 64 * e, RLX_AGENT)); return c > LIST_CAP ? LIST_CAP : c; }
    __device__ __forceinline__ void init(const void* A_, const void* Bt_, const int* ltok_, const unsigned* cntw, int which, int nN_, int rowb_, size_t a_tstep_, size_t b_estep_, int G_, int c_) {
        A = (const char*)A_; Bt = (const char*)Bt_; ltok = ltok_; rowb = rowb_; a_tstep = a_tstep_; b_estep = b_estep_; b_tstep = (size_t)BM * rowb_;
        c0 = ldc_(cntw, 0); c1 = ldc_(cntw, 1); c2 = ldc_(cntw, 2); c3 = ldc_(cntw, 3); c4 = ldc_(cntw, 4); c5 = ldc_(cntw, 5); c6 = ldc_(cntw, 6); c7 = ldc_(cntw, 7);
        c8 = ldc_(cntw, 8); c9 = ldc_(cntw, 9); c10 = ldc_(cntw, 10); c11 = ldc_(cntw, 11); c12 = ldc_(cntw, 12); c13 = ldc_(cntw, 13); c14 = ldc_(cntw, 14); c15 = ldc_(cntw, 15);
        t1 = (c0 + 255) >> 8; t2 = t1 + ((c1 + 255) >> 8); t3 = t2 + ((c2 + 255) >> 8); t4 = t3 + ((c3 + 255) >> 8); t5 = t4 + ((c4 + 255) >> 8); t6 = t5 + ((c5 + 255) >> 8); t7 = t6 + ((c6 + 255) >> 8); t8 = t7 + ((c7 + 255) >> 8);
        t9 = t8 + ((c8 + 255) >> 8); t10 = t9 + ((c9 + 255) >> 8); t11 = t10 + ((c10 + 255) >> 8); t12 = t11 + ((c11 + 255) >> 8); t13 = t12 + ((c12 + 255) >> 8); t14 = t13 + ((c13 + 255) >> 8); t15 = t14 + ((c14 + 255) >> 8); t16 = t15 + ((c15 + 255) >> 8);
        toff = which == 2 ? t8 : 0;
        init_tiles(which == 0 ? t16 : (which == 1 ? t8 : t16 - t8), nN_, G_, c_);
    }
    __device__ __forceinline__ bool next(int i, Unit& u) const {
        int pml; if (!next_tile(i, pml, u.pn)) return false;
        const int pm = pml + toff; u.pm = pm;
        const int m1 = pm >= t1, m2 = pm >= t2, m3 = pm >= t3, m4 = pm >= t4, m5 = pm >= t5, m6 = pm >= t6, m7 = pm >= t7, m8 = pm >= t8, m9 = pm >= t9, m10 = pm >= t10, m11 = pm >= t11, m12 = pm >= t12, m13 = pm >= t13, m14 = pm >= t14, m15 = pm >= t15;
        const int e = m1 + m2 + m3 + m4 + m5 + m6 + m7 + m8 + m9 + m10 + m11 + m12 + m13 + m14 + m15;
        const int base = m1 * t1 + m2 * (t2 - t1) + m3 * (t3 - t2) + m4 * (t4 - t3) + m5 * (t5 - t4) + m6 * (t6 - t5) + m7 * (t7 - t6) + m8 * (t8 - t7) + m9 * (t9 - t8) + m10 * (t10 - t9) + m11 * (t11 - t10) + m12 * (t12 - t11) + m13 * (t13 - t12) + m14 * (t14 - t13) + m15 * (t15 - t14);
        const int cn = c0 + m1 * (c1 - c0) + m2 * (c2 - c1) + m3 * (c3 - c2) + m4 * (c4 - c3) + m5 * (c5 - c4) + m6 * (c6 - c5) + m7 * (c7 - c6) + m8 * (c8 - c7) + m9 * (c9 - c8) + m10 * (c10 - c9) + m11 * (c11 - c10) + m12 * (c12 - c11) + m13 * (c13 - c12) + m14 * (c14 - c13) + m15 * (c15 - c14);
        u.e = e; u.lt = pm - base; u.cn = cn; return true;
    }
    __device__ __forceinline__ const char* a_base(const Unit& u) const { return A + (size_t)u.pm * a_tstep; }
    __device__ __forceinline__ const char* b_base(const Unit& u) const { return Bt + (size_t)(u.e & 7) * b_estep + (size_t)u.pn * b_tstep; }
    __device__ __forceinline__ const int* tok_src(const Unit& u) const { return ltok + (size_t)u.e * LIST_CAP + u.lt * 256; }
    __device__ __forceinline__ void a_rows(const Unit& u, const int (&R)[2], const int (&C)[2], unsigned (&off)[2][2]) const {
#pragma unroll
        for (int h = 0; h < 2; ++h)
#pragma unroll
            for (int i = 0; i < 2; ++i) { int rank = u.lt * 256 + h * HALF + R[i]; rank = rank < u.cn ? rank : u.cn - 1;
                const int tok = ltok[(size_t)u.e * LIST_CAP + rank]; off[h][i] = (unsigned)tok * (unsigned)rowb + (unsigned)(C[i] * 2); }
    }
};

__device__ __forceinline__ unsigned cvt_pk_bf16(float lo, float hi) { unsigned r; asm volatile("v_cvt_pk_bf16_f32 %0, %1, %2" : "=v"(r) : "v"(lo), "v"(hi)); return r; }

struct EpiStoreBf16 {
    static constexpr bool PERM = true; static constexpr int NVM = 16;
    bf16* O; int ldc;
    __device__ __forceinline__ void operator()(const f32x4 (&acc)[2][2][4][2], const Unit& u, int wr, int wc, int fr, int fq) const {
        const int row0 = u.pm * BM + wr * 64 + fr, col0 = u.pn * BM + wc * 32 + 8 * fq;
#pragma unroll
        for (int ai = 0; ai < 2; ++ai)
#pragma unroll
            for (int m = 0; m < 4; ++m) { bf16* rowp = O + (size_t)(row0 + ai * HALF + m * 16) * ldc + col0;
#pragma unroll
                for (int bj = 0; bj < 2; ++bj) { const f32x4 v0 = acc[ai][bj][m][0], v1 = acc[ai][bj][m][1];
                    u32x4 w; w.x = cvt_pk_bf16(v0[0], v0[1]); w.y = cvt_pk_bf16(v0[2], v0[3]); w.z = cvt_pk_bf16(v1[0], v1[1]); w.w = cvt_pk_bf16(v1[2], v1[3]);
                    *(u32x4*)(rowp + bj * HALF) = w; } }
    }
};
struct EpiResF32 {
    static constexpr bool PERM = false; static constexpr int NVM = 0;
    const float* base; float* out; int ldc;
    __device__ __forceinline__ void operator()(const f32x4 (&acc)[2][2][4][2], const Unit& u, int wr, int wc, int fr, int fq) const {
        const int row0 = u.pm * BM + wr * 64 + fr, col0 = u.pn * BM + wc * 32 + 4 * fq;
#pragma unroll
        for (int ai = 0; ai < 2; ++ai)
#pragma unroll
            for (int m = 0; m < 4; ++m) { const size_t off = (size_t)(row0 + ai * HALF + m * 16) * ldc + col0;
#pragma unroll
                for (int bj = 0; bj < 2; ++bj)
#pragma unroll
                    for (int n = 0; n < 2; ++n) { const f32x4 bs = *(const f32x4*)(base + off + bj * HALF + n * 16); *(f32x4*)(out + off + bj * HALF + n * 16) = bs + acc[ai][bj][m][n]; } }
    }
};
struct EpiSwiGLU {
    static constexpr bool PERM = true; static constexpr int NVM = 8;
    bf16* H; int ldh;
    __device__ __forceinline__ void operator()(const f32x4 (&acc)[2][2][4][2], const Unit& u, int wr, int wc, int fr, int fq) const {
        const int row0 = u.pm * BM + wr * 64 + fr, col0 = u.pn * HALF + wc * 32 + 8 * fq;
#pragma unroll
        for (int ai = 0; ai < 2; ++ai)
#pragma unroll
            for (int m = 0; m < 4; ++m) { bf16* rowp = H + (size_t)(row0 + ai * HALF + m * 16) * ldh + col0;
                float h[8];
#pragma unroll
                for (int n = 0; n < 2; ++n)
#pragma unroll
                    for (int x = 0; x < 2; ++x) { const f32x2 g = {acc[ai][0][m][n][2 * x], acc[ai][0][m][n][2 * x + 1]}, up = {acc[ai][1][m][n][2 * x], acc[ai][1][m][n][2 * x + 1]};
                        const f32x2 t = g * -1.4426950408889634f; f32x2 e; e.x = __builtin_amdgcn_exp2f(t.x); e.y = __builtin_amdgcn_exp2f(t.y);
                        const f32x2 d = e + 1.0f; f32x2 r; r.x = __builtin_amdgcn_rcpf(d.x); r.y = __builtin_amdgcn_rcpf(d.y);
                        const f32x2 hh = (g * up) * r; h[4 * n + 2 * x] = hh.x; h[4 * n + 2 * x + 1] = hh.y; }
                u32x4 w; w.x = cvt_pk_bf16(h[0], h[1]); w.y = cvt_pk_bf16(h[2], h[3]); w.z = cvt_pk_bf16(h[4], h[5]); w.w = cvt_pk_bf16(h[6], h[7]);
                *(u32x4*)rowp = w; }
    }
};
struct EpiSwiGLU8 {
    static constexpr bool PERM = true; static constexpr int NVM = 8;
    unsigned char* H; int ldh; float iscale, oscale;
    __device__ __forceinline__ void operator()(const f32x4 (&acc)[2][2][4][2], const Unit& u, int wr, int wc, int fr, int fq) const {
        const int row0 = u.pm * BM + wr * 64 + fr, col0 = u.pn * HALF + wc * 32 + 8 * fq;
#pragma unroll
        for (int ai = 0; ai < 2; ++ai)
#pragma unroll
            for (int m = 0; m < 4; ++m) { unsigned char* rowp = H + (size_t)(row0 + ai * HALF + m * 16) * ldh + col0;
                float h[8];
#pragma unroll
                for (int n = 0; n < 2; ++n)
#pragma unroll
                    for (int x = 0; x < 2; ++x) { const f32x2 ga = {acc[ai][0][m][n][2 * x], acc[ai][0][m][n][2 * x + 1]}, ua = {acc[ai][1][m][n][2 * x], acc[ai][1][m][n][2 * x + 1]};
                        const f32x2 t = ga * (-1.4426950408889634f * iscale); f32x2 e; e.x = __builtin_amdgcn_exp2f(t.x); e.y = __builtin_amdgcn_exp2f(t.y);
                        const f32x2 d = e + 1.0f; f32x2 r; r.x = __builtin_amdgcn_rcpf(d.x); r.y = __builtin_amdgcn_rcpf(d.y);
                        const f32x2 hh = ((ga * ua) * (iscale * iscale * oscale)) * r;
                        h[4 * n + 2 * x] = __builtin_amdgcn_fmed3f(hh.x, -448.0f, 448.0f); h[4 * n + 2 * x + 1] = __builtin_amdgcn_fmed3f(hh.y, -448.0f, 448.0f); }
                int w0 = __builtin_amdgcn_cvt_pk_fp8_f32(h[0], h[1], 0, false); w0 = __builtin_amdgcn_cvt_pk_fp8_f32(h[2], h[3], w0, true);
                int w1 = __builtin_amdgcn_cvt_pk_fp8_f32(h[4], h[5], 0, false); w1 = __builtin_amdgcn_cvt_pk_fp8_f32(h[6], h[7], w1, true);
                u32x2 w; w.x = (unsigned)w0; w.y = (unsigned)w1; *(u32x2*)rowp = w; }
    }
};
struct EpiMoeDown {
    static constexpr bool PERM = false; static constexpr int NVM = 0;
    float* out; const int* ltok; const float* lw; float scale;
    __device__ __forceinline__ void operator()(const f32x4 (&acc)[2][2][4][2], const Unit& u, int wr, int wc, int fr, int fq) const {
        const int col0 = u.pn * BM + wc * 32 + 4 * fq;
#pragma unroll
        for (int ai = 0; ai < 2; ++ai)
#pragma unroll
            for (int m = 0; m < 4; ++m) { const int rank = u.lt * 256 + ai * HALF + wr * 64 + m * 16 + fr;
                if (rank < u.cn) { const int tok = ltok[(size_t)u.e * LIST_CAP + rank]; const float w = lw[(size_t)u.e * LIST_CAP + rank] * scale; float* rowp = out + (size_t)tok * D + col0;
#pragma unroll
                    for (int bj = 0; bj < 2; ++bj)
#pragma unroll
                        for (int n = 0; n < 2; ++n) { const f32x4 bs = *(const f32x4*)(rowp + bj * HALF + n * 16); *(f32x4*)(rowp + bj * HALF + n * 16) = bs + acc[ai][bj][m][n] * w; } } }
    }
};

template <class Epi, class Sched, bool GATHER, bool F8 = false>
__device__ __forceinline__ void gemm_phase(LAS unsigned char* lds, const int rowb, const Sched& S, const Epi& E) {
    const int tid = threadIdx.x, wid = __builtin_amdgcn_readfirstlane(tid >> 6), lane = tid & 63, wr = wid >> 2, wc = wid & 3, fr = lane & 15, fq = lane >> 4;
    const int nt = rowb / 128;
    unsigned voffA[2], voffB[2]; int Rr[2], Cc[2];
#pragma unroll
    for (int i = 0; i < 2; ++i) { int R, C; stage_rc(tid * 16 + i * 8192, R, C); const int Rb = Epi::PERM ? ((R & ~31) + perm32(R & 31)) : R;
        voffA[i] = (unsigned)(R * rowb + C * 2); voffB[i] = (unsigned)(Rb * rowb + C * 2); Rr[i] = R; Cc[i] = C; }
    const size_t kstep = (size_t)(BK * 2);
    const size_t hstep = (size_t)HALF * rowb;
    const unsigned ldsw = (unsigned)wid * 1024u;
    const int aoff = lds_byte(wr * 64 + fr, fq * 8), boff = lds_byte(wc * 32 + fr, fq * 8);
#define PG8_SA(b, h) (((b) * 2 + (h)) * HTB)
#define PG8_SB(b, h) ((4 + (b) * 2 + (h)) * HTB)
#define PG8_STAGE(bufoff, gbase, voff) do { _Pragma("unroll") for (int _i = 0; _i < 2; ++_i) \
        __builtin_amdgcn_global_load_lds((const unsigned*)((const char*)(gbase) + (voff)[_i]), (LAS unsigned*)(lds + (bufoff) + ldsw + _i * 8192), 16, 0, 0); } while (0)
#define PG8_STAGE_A(bufoff, kptr, h) do { if constexpr (GATHER) PG8_STAGE(bufoff, kptr, gA[h]); else PG8_STAGE(bufoff, (kptr) + (h) * hstep, voffA); } while (0)
#define PG8_LD8(base) __builtin_shufflevector(*(const LAS v4i_t*)(base), *(const LAS v4i_t*)((base) + 1024), 0, 1, 2, 3, 4, 5, 6, 7)
#define PG8_LDA(dst, b, h) do { _Pragma("unroll") for (int m = 0; m < 4; ++m) { if constexpr (F8) dst##8[m] = PG8_LD8(lds + PG8_SA(b, h) + aoff + m * 2048); else { _Pragma("unroll") for (int k = 0; k < 2; ++k) dst[m][k] = *(const LAS bf16x8*)(lds + PG8_SA(b, h) + aoff + m * 2048 + k * 1024); } } } while (0)
#define PG8_LDB(dst, b, h) do { _Pragma("unroll") for (int n = 0; n < 2; ++n) { if constexpr (F8) dst##8[n] = PG8_LD8(lds + PG8_SB(b, h) + boff + n * 2048); else { _Pragma("unroll") for (int k = 0; k < 2; ++k) dst[n][k] = *(const LAS bf16x8*)(lds + PG8_SB(b, h) + boff + n * 2048 + k * 1024); } } } while (0)
#define PG8_MMA(ai, bj, At, Bt) do { __builtin_amdgcn_s_setprio(1); _Pragma("unroll") for (int m = 0; m < 4; ++m) _Pragma("unroll") for (int n = 0; n < 2; ++n) { \
        if constexpr (F8) asm volatile("v_mfma_f32_16x16x128_f8f6f4 %0, %1, %2, %0" : "+v"(acc[ai][bj][m][n]) : "v"(Bt##8[n]), "v"(At##8[m])); \
        else { _Pragma("unroll") for (int k = 0; k < 2; ++k) acc[ai][bj][m][n] = __builtin_amdgcn_mfma_f32_16x16x32_bf16(Bt[n][k], At[m][k], acc[ai][bj][m][n], 0, 0, 0); } } \
        __builtin_amdgcn_s_setprio(0); } while (0)
#define PG8_WAIT_V(n) asm volatile("s_waitcnt vmcnt(" #n ")" ::: "memory")
#define PG8_WAIT_SEL(flag, n) asm volatile("v_cmp_eq_u32_e32 vcc, 0, %0\n\ts_nop 4\n\ts_cbranch_vccnz .Lw8_%=\n\ts_waitcnt vmcnt(%1)\n\ts_branch .Lwd_%=\n.Lw8_%=:\n\ts_waitcnt vmcnt(8)\n.Lwd_%=:" :: "v"(flag), "n"(n) : "memory", "vcc")
#define PG8_WAIT_L(n) asm volatile("s_waitcnt lgkmcnt(" #n ")" ::: "memory")
#define PG8_BAR __builtin_amdgcn_s_barrier()
#define PG8_SCHED __builtin_amdgcn_sched_barrier(0)
    Unit cur, nxt; int ui = 0;
    if (!S.next(0, cur)) return;
    f32x4 acc[2][2][4][2];
#pragma unroll
    for (int a = 0; a < 2; ++a)
#pragma unroll
        for (int b = 0; b < 2; ++b)
#pragma unroll
            for (int m = 0; m < 4; ++m)
#pragma unroll
                for (int n = 0; n < 2; ++n) acc[a][b][m][n] = (f32x4){0.f, 0.f, 0.f, 0.f};
    bf16x8 At[4][2], B0[2][2], B1[2][2]; v8i_t At8[4], B08[2], B18[2];
    const char* cA = S.a_base(cur); const char* cB = S.b_base(cur);
    unsigned gA[2][2] = {{0u, 0u}, {0u, 0u}};
    if constexpr (GATHER) S.a_rows(cur, Rr, Cc, gA);
    constexpr int TOKTAB = STAGE_BYTES;
    PG8_STAGE(PG8_SB(0, 0), cB, voffB); PG8_STAGE(PG8_SB(0, 1), cB + hstep, voffB); PG8_STAGE_A(PG8_SA(0, 0), cA, 0); PG8_STAGE_A(PG8_SA(0, 1), cA, 1);
    if (wr == 1) PG8_BAR;
    PG8_WAIT_V(2); PG8_BAR;
    PG8_STAGE(PG8_SB(1, 0), cB + kstep, voffB); PG8_STAGE_A(PG8_SA(1, 0), cA + kstep, 0); PG8_STAGE(PG8_SB(1, 1), cB + hstep + kstep, voffB);
    PG8_WAIT_V(6); PG8_BAR;
    for (;;) {
        const bool has_next = S.next(ui + 1, nxt);
        const char* nA = has_next ? S.a_base(nxt) : cA; const char* nB = has_next ? S.b_base(nxt) : cB;
        if constexpr (GATHER) { if (has_next && wid == 0) __builtin_amdgcn_global_load_lds((const unsigned*)(S.tok_src(nxt) + lane * 4), (LAS unsigned*)(lds + TOKTAB), 16, 0, 0); }
        for (int t = 0; t < nt; t += 2) {
            const bool last = (t == nt - 2);
            const char* a1 = cA + (size_t)(t + 1) * kstep;
            const char* a2 = last ? nA : cA + (size_t)(t + 2) * kstep; const char* b2 = last ? nB : cB + (size_t)(t + 2) * kstep;
            const char* a3 = a2 + kstep; const char* b3 = b2 + kstep;
            const int after_epi = ((Epi::NVM > 0) && (t == 0) && (ui > 0)) ? 1 : 0;
            PG8_LDB(B0, 0, 0); PG8_LDB(B1, 0, 1); PG8_SCHED; PG8_LDA(At, 0, 0); PG8_STAGE_A(PG8_SA(1, 1), a1, 1);
            if constexpr (GATHER) { if (last && has_next) { asm volatile("" ::: "memory");
#pragma unroll
                for (int h = 0; h < 2; ++h)
#pragma unroll
                    for (int i = 0; i < 2; ++i) { unsigned tk = *(const LAS unsigned*)(lds + TOKTAB + 4 * (h * HALF + Rr[i])); tk = tk < (unsigned)(M - 1) ? tk : (unsigned)(M - 1); gA[h][i] = tk * (unsigned)rowb + (unsigned)(Cc[i] * 2); } } }
            if constexpr (Epi::NVM > 0) PG8_WAIT_SEL(after_epi, 8 + Epi::NVM); else PG8_WAIT_V(8);
            PG8_WAIT_L(0); PG8_BAR; PG8_MMA(0, 0, At, B0); PG8_MMA(0, 1, At, B1); PG8_BAR; PG8_SCHED;
            PG8_LDA(At, 0, 1); PG8_STAGE(PG8_SB(0, 0), b2, voffB); PG8_STAGE(PG8_SB(0, 1), b2 + hstep, voffB); PG8_STAGE_A(PG8_SA(0, 0), a2, 0);
            if constexpr (Epi::NVM > 0) PG8_WAIT_SEL(after_epi, 8 + Epi::NVM); else PG8_WAIT_V(8);
            PG8_WAIT_L(0); PG8_BAR; PG8_MMA(1, 0, At, B0); PG8_MMA(1, 1, At, B1); PG8_BAR; PG8_SCHED;
            PG8_LDB(B0, 1, 0); PG8_LDB(B1, 1, 1); PG8_SCHED; PG8_LDA(At, 1, 0); PG8_STAGE_A(PG8_SA(0, 1), a2, 1);
            PG8_WAIT_V(8); PG8_WAIT_L(0); PG8_BAR; PG8_MMA(0, 0, At, B0); PG8_MMA(0, 1, At, B1); PG8_BAR; PG8_SCHED;
            PG8_LDA(At, 1, 1); PG8_STAGE(PG8_SB(1, 0), b3, voffB); PG8_STAGE(PG8_SB(1, 1), b3 + hstep, voffB); PG8_STAGE_A(PG8_SA(1, 0), a3, 0);
            PG8_WAIT_V(8); PG8_WAIT_L(0); PG8_BAR; PG8_MMA(1, 0, At, B0); PG8_MMA(1, 1, At, B1); PG8_BAR; PG8_SCHED;
        }
        if (wr == 0) PG8_BAR;
        if constexpr (F8) asm volatile("s_nop 15\n\ts_nop 15" ::: "memory");
        E(acc, cur, wr, wc, fr, fq);
        if (!has_next) break;
#pragma unroll
        for (int a = 0; a < 2; ++a)
#pragma unroll
            for (int b = 0; b < 2; ++b)
#pragma unroll
                for (int m = 0; m < 4; ++m)
#pragma unroll
                    for (int n = 0; n < 2; ++n) acc[a][b][m][n] = (f32x4){0.f, 0.f, 0.f, 0.f};
        cur = nxt; cA = nA; cB = nB; ++ui;
        if (wr == 1) PG8_BAR;
    }
    PG8_WAIT_V(0);
    PG8_BAR;
#undef PG8_SA
#undef PG8_SB
#undef PG8_STAGE
#undef PG8_STAGE_A
#undef PG8_LDA
#undef PG8_LDB
#undef PG8_MMA
#undef PG8_LD8
#undef PG8_WAIT_V
#undef PG8_WAIT_SEL
#undef PG8_WAIT_L
#undef PG8_BAR
#undef PG8_SCHED
}
}

template <int Mr, int Nc, int K, bool ACCUM>
__device__ __forceinline__ void mm_lds(const LAS bf16* A, int lda, const LAS bf16* Bt, int ldb, f32x4 (&acc)[(Mr / 16) * (Nc / 16) / 8], int wave, int lane) {
    constexpr int NT = Nc / 16, TPW = (Mr / 16) * NT / 8;
    const int fr = lane & 15, fq = lane >> 4;
#pragma unroll
    for (int q = 0; q < TPW; ++q) {
        const int t = wave + 8 * q, ti = t / NT, tj = t % NT;
        f32x4 c = ACCUM ? acc[q] : (f32x4){0.f, 0.f, 0.f, 0.f};
#pragma unroll
        for (int k0 = 0; k0 < K; k0 += 32) {
            const bf16x8 a = *(const LAS bf16x8*)(A + (16 * ti + fr) * lda + k0 + 8 * fq);
            const bf16x8 b = *(const LAS bf16x8*)(Bt + (16 * tj + fr) * ldb + k0 + 8 * fq);
            c = __builtin_amdgcn_mfma_f32_16x16x32_bf16(a, b, c, 0, 0, 0);
        }
        acc[q] = c;
        if (TPW > 2) asm volatile("" ::: "memory");
    }
}
#define MM_ROW(NT, q, r) (16 * ((wave + 8 * (q)) / (NT)) + 4 * fq + (r))
#define MM_COL(NT, q)    (16 * ((wave + 8 * (q)) % (NT)) + fr)

struct Args { const float* in[25]; float* out; unsigned char* ws; int ph_lo, ph_hi; };
constexpr int NPHASE = 17;

template <bool F8>
__device__ __forceinline__ void p0_tile(const float* W, int K, int N, void* WTv, int mode, float scale, LAS unsigned* T, int item, int lane) {
    const int nblk = N / 64, kb = item / nblk, nb = item % nblk, k0 = 64 * kb, n0 = 64 * nb;
    const int row0 = mode == 0 ? n0 : ((n0 >> 7) << 8) + (n0 & 127) + (mode == 2 ? 128 : 0);
    const int g = lane >> 4, m = lane & 15;
    constexpr int P = F8 ? 17 : 33;
    f32x4 v[16];
#pragma unroll
    for (int L = 0; L < 16; ++L) { const int kk = F8 ? (16 * (L >> 2) + 4 * g + (L & 3)) : (8 * (L >> 1) + 2 * g + (L & 1)); v[L] = *(const f32x4*)(W + (size_t)(k0 + kk) * N + n0 + 4 * m); }
    if constexpr (F8) {
#pragma unroll
        for (int i = 0; i < 4; ++i)
#pragma unroll
            for (int j = 0; j < 4; ++j) { const float q0 = __builtin_amdgcn_fmed3f(v[4 * i][j] * scale, -448.f, 448.f), q1 = __builtin_amdgcn_fmed3f(v[4 * i + 1][j] * scale, -448.f, 448.f), q2 = __builtin_amdgcn_fmed3f(v[4 * i + 2][j] * scale, -448.f, 448.f), q3 = __builtin_amdgcn_fmed3f(v[4 * i + 3][j] * scale, -448.f, 448.f);
                int w = __builtin_amdgcn_cvt_pk_fp8_f32(q0, q1, 0, false); w = __builtin_amdgcn_cvt_pk_fp8_f32(q2, q3, w, true);
                T[(4 * m + j) * P + 4 * i + g] = (unsigned)w; }
    } else {
#pragma unroll
        for (int i = 0; i < 8; ++i)
#pragma unroll
            for (int j = 0; j < 4; ++j) T[(4 * m + j) * P + 4 * i + g] = pk2(v[2 * i][j], v[2 * i + 1][j]);
    }
    LDS_WAIT(); asm volatile("" ::: "memory");
    if constexpr (F8) {
        unsigned char* WT = (unsigned char*)WTv;
#pragma unroll
        for (int p = 0; p < 4; ++p) { const int n = (lane >> 2) + 16 * p, c = lane & 3; const LAS unsigned* t = T + n * P + 4 * c; u32x4 o; o.x = t[0]; o.y = t[1]; o.z = t[2]; o.w = t[3];
            *(u32x4*)(WT + (size_t)(row0 + n) * K + k0 + 16 * c) = o; }
    } else {
        bf16* WT = (bf16*)WTv;
#pragma unroll
        for (int p = 0; p < 8; ++p) { const int n = (lane >> 3) + 8 * p, c = lane & 7; const LAS unsigned* t = T + n * P + 4 * c; u32x4 o; o.x = t[0]; o.y = t[1]; o.z = t[2]; o.w = t[3];
            *(u32x4*)(WT + (size_t)(row0 + n) * K + k0 + 8 * c) = o; }
    }
    LDS_WAIT(); asm volatile("" ::: "memory");
}
__device__ __forceinline__ void rms_row_bf16(const float* xrow, const float* g, bf16* orow, int lane) {
    const f32x4* xr = (const f32x4*)xrow + lane; const f32x4* gr = (const f32x4*)g + lane;
    f32x4 v[4]; float s = 0.f;
#pragma unroll
    for (int j = 0; j < 4; ++j) { v[j] = xr[64 * j]; s += (v[j].x * v[j].x + v[j].y * v[j].y) + (v[j].z * v[j].z + v[j].w * v[j].w); }
    const float rstd = rsqrtf(wave_sum(s) * (1.f / D) + EPS);
    u32x2* o8 = (u32x2*)orow + lane;
#pragma unroll
    for (int j = 0; j < 4; ++j) { const f32x4 gv = gr[64 * j]; u32x2 w; w.x = pk2(v[j].x * rstd * gv.x, v[j].y * rstd * gv.y); w.y = pk2(v[j].z * rstd * gv.z, v[j].w * rstd * gv.w); o8[64 * j] = w; }
}

__device__ __forceinline__ void rms_res_row_bf16(const float* xin, const bf16* drow, float* xout, const float* g, bf16* orow, int lane) {
    const f32x4* xr = (const f32x4*)xin + lane; const f32x4* gr = (const f32x4*)g + lane; const u32x2* dr = (const u32x2*)drow + lane;
    f32x4 v[4]; u32x2 dv[4]; float s = 0.f;
#pragma unroll
    for (int j = 0; j < 4; ++j) { v[j] = xr[64 * j]; dv[j] = dr[64 * j]; }
#pragma unroll
    for (int j = 0; j < 4; ++j) { v[j].x += bf2f(dv[j].x); v[j].y += bf2f(dv[j].x >> 16); v[j].z += bf2f(dv[j].y); v[j].w += bf2f(dv[j].y >> 16);
        ((f32x4*)xout + lane)[64 * j] = v[j]; s += (v[j].x * v[j].x + v[j].y * v[j].y) + (v[j].z * v[j].z + v[j].w * v[j].w); }
    const float rstd = rsqrtf(wave_sum(s) * (1.f / D) + EPS);
    u32x2* o8 = (u32x2*)orow + lane;
#pragma unroll
    for (int j = 0; j < 4; ++j) { const f32x4 gv = gr[64 * j]; u32x2 w; w.x = pk2(v[j].x * rstd * gv.x, v[j].y * rstd * gv.y); w.y = pk2(v[j].z * rstd * gv.z, v[j].w * rstd * gv.w); o8[64 * j] = w; }
}
__device__ __forceinline__ void rms_res_row2_bf16(const float* xin, const bf16* drow, float* xout, const float* g, bf16* orow, size_t rstride, int lane) {
    const f32x4* gr = (const f32x4*)g + lane;
    f32x4 v[2][4]; u32x2 dv[2][4]; float s[2] = {0.f, 0.f};
#pragma unroll
    for (int r = 0; r < 2; ++r)
#pragma unroll
        for (int j = 0; j < 4; ++j) { v[r][j] = ((const f32x4*)(xin + r * rstride) + lane)[64 * j]; dv[r][j] = ((const u32x2*)(drow + r * rstride) + lane)[64 * j]; }
#pragma unroll
    for (int r = 0; r < 2; ++r)
#pragma unroll
        for (int j = 0; j < 4; ++j) { v[r][j].x += bf2f(dv[r][j].x); v[r][j].y += bf2f(dv[r][j].x >> 16); v[r][j].z += bf2f(dv[r][j].y); v[r][j].w += bf2f(dv[r][j].y >> 16);
            ((f32x4*)(xout + r * rstride) + lane)[64 * j] = v[r][j]; s[r] += (v[r][j].x * v[r][j].x + v[r][j].y * v[r][j].y) + (v[r][j].z * v[r][j].z + v[r][j].w * v[r][j].w); }
#pragma unroll
    for (int r = 0; r < 2; ++r) { const float rstd = rsqrtf(wave_sum(s[r]) * (1.f / D) + EPS);
        u32x2* o8 = (u32x2*)(orow + r * rstride) + lane;
#pragma unroll
        for (int j = 0; j < 4; ++j) { const f32x4 gv = gr[64 * j]; u32x2 w; w.x = pk2(v[r][j].x * rstd * gv.x, v[r][j].y * rstd * gv.y); w.y = pk2(v[r][j].z * rstd * gv.z, v[r][j].w * rstd * gv.w); o8[64 * j] = w; } }
}

struct RetPf { u32x4 q1, q2, k1, k2, v1, v2, g1, g2; f32x4 r0, r1, r2, r3; };
template <bool NEEDQ>
__device__ __forceinline__ void ret_load(RetPf& pf, const bf16* proj, const f32x2* ROT, size_t row0, int tpos0, int h, int tid) {
    const int j = tid >> 3, seg = tid & 7;
    const bf16* prow = proj + (row0 + j) * EVEN_IN + 128 * h;
    pf.k1 = *(const u32x4*)(prow + RK_OFF + 8 * seg); pf.k2 = *(const u32x4*)(prow + RK_OFF + 64 + 8 * seg);
    pf.v1 = *(const u32x4*)(prow + RV_OFF + 16 * seg); pf.v2 = *(const u32x4*)(prow + RV_OFF + 16 * seg + 8);
    if constexpr (NEEDQ) { pf.q1 = *(const u32x4*)(prow + RQ_OFF + 8 * seg); pf.q2 = *(const u32x4*)(prow + RQ_OFF + 64 + 8 * seg);
        pf.g1 = *(const u32x4*)(prow + RGATE_OFF + 16 * seg); pf.g2 = *(const u32x4*)(prow + RGATE_OFF + 16 * seg + 8); }
    const f32x4* rp = (const f32x4*)(ROT + (size_t)(tpos0 + j) * 64 + 8 * seg);
    pf.r0 = rp[0]; pf.r1 = rp[1]; pf.r2 = rp[2]; pf.r3 = rp[3];
}
template <bool NEEDQ>
__device__ __forceinline__ void ret_write(const RetPf& pf, float l2g, LAS bf16* rQ, LAS bf16* rK, LAS bf16* rKdT, LAS bf16* rVT, LAS bf16* rG, int tid) {
    constexpr int LQ = 136, LT = 72;
    const int j = tid >> 3, seg = tid & 7;
    const float cs[16] = {pf.r0.x, pf.r0.y, pf.r0.z, pf.r0.w, pf.r1.x, pf.r1.y, pf.r1.z, pf.r1.w, pf.r2.x, pf.r2.y, pf.r2.z, pf.r2.w, pf.r3.x, pf.r3.y, pf.r3.z, pf.r3.w};
    const unsigned k1w[4] = {pf.k1.x, pf.k1.y, pf.k1.z, pf.k1.w}, k2w[4] = {pf.k2.x, pf.k2.y, pf.k2.z, pf.k2.w}, v1w[4] = {pf.v1.x, pf.v1.y, pf.v1.z, pf.v1.w}, v2w[4] = {pf.v2.x, pf.v2.y, pf.v2.z, pf.v2.w};
    const float dec = exp2f((float)(63 - j) * l2g);
    unsigned qa[4], qb[4], ka[4], kb[4];
#pragma unroll
    for (int w = 0; w < 4; ++w) {
        float kr1[2], kr2[2], qr1[2] = {0.f, 0.f}, qr2[2] = {0.f, 0.f};
#pragma unroll
        for (int x = 0; x < 2; ++x) { const int c = 2 * w + x; const float co = cs[2 * c], si = cs[2 * c + 1];
            const float a = bf2f(k1w[w] >> (16 * x)) * 0.08838834764831845f, b = bf2f(k2w[w] >> (16 * x)) * 0.08838834764831845f;
            kr1[x] = a * co - b * si; kr2[x] = a * si + b * co;
            rKdT[(8 * seg + c) * LT + j] = (bf16)f2bf(kr1[x] * dec); rKdT[(64 + 8 * seg + c) * LT + j] = (bf16)f2bf(kr2[x] * dec);
            if constexpr (NEEDQ) { const unsigned q1w = w == 0 ? pf.q1.x : (w == 1 ? pf.q1.y : (w == 2 ? pf.q1.z : pf.q1.w)), q2w = w == 0 ? pf.q2.x : (w == 1 ? pf.q2.y : (w == 2 ? pf.q2.z : pf.q2.w));
                const float qa_ = bf2f(q1w >> (16 * x)), qb_ = bf2f(q2w >> (16 * x)); qr1[x] = qa_ * co - qb_ * si; qr2[x] = qa_ * si + qb_ * co; }
            rVT[(16 * seg + c) * LT + j] = (bf16)((v1w[w] >> (16 * x)) & 0xffffu); rVT[(16 * seg + 8 + c) * LT + j] = (bf16)((v2w[w] >> (16 * x)) & 0xffffu); }
        if constexpr (NEEDQ) { ka[w] = pk2(kr1[0], kr1[1]); kb[w] = pk2(kr2[0], kr2[1]); qa[w] = pk2(qr1[0], qr1[1]); qb[w] = pk2(qr2[0], qr2[1]); }
    }
    if constexpr (NEEDQ) {
        u32x4 t; t.x = qa[0]; t.y = qa[1]; t.z = qa[2]; t.w = qa[3]; *(LAS u32x4*)(rQ + j * LQ + 8 * seg) = t;
        t.x = qb[0]; t.y = qb[1]; t.z = qb[2]; t.w = qb[3]; *(LAS u32x4*)(rQ + j * LQ + 64 + 8 * seg) = t;
        t.x = ka[0]; t.y = ka[1]; t.z = ka[2]; t.w = ka[3]; *(LAS u32x4*)(rK + j * LQ + 8 * seg) = t;
        t.x = kb[0]; t.y = kb[1]; t.z = kb[2]; t.w = kb[3]; *(LAS u32x4*)(rK + j * LQ + 64 + 8 * seg) = t;
        *(LAS u32x4*)(rG + j * LQ + 16 * seg) = pf.g1; *(LAS u32x4*)(rG + j * LQ + 16 * seg + 8) = pf.g2;
    }
}

__global__ void __launch_bounds__(512, 2) fwd_kernel(Args args) {
    extern __shared__ __attribute__((aligned(16))) unsigned char lds_raw[];
    LAS unsigned char* lds = (LAS unsigned char*)lds_raw;
    volatile LAS unsigned* MISC = (volatile LAS unsigned*)(lds + LDS_MISC);
    LAS unsigned char* scrb = lds + LDS_SCR;
    const int tid = threadIdx.x, lane = tid & 63, wave = __builtin_amdgcn_readfirstlane(tid >> 6);
    const int G = gridDim.x, bid = blockIdx.x;
    const int fr = lane & 15, fq = lane >> 4;
    unsigned char* ws = args.ws;
    unsigned* ctl = (unsigned*)(ws + WS_CTL);
    float* out = args.out;
    const int lo = args.ph_lo, hi = args.ph_hi;

    if (tid < 64) MISC[tid] = 0u;
    __syncthreads();
    XcdBarrier bar; bar.bar = ctl + CW_BAR; bar.x = 0; bar.st = MISC;
    if (hi - lo > 1) bar = xcd_barrier_post(ctl + CW_BAR, MISC);
#ifndef PHASE_MASK
#define PHASE_MASK 0x1ffff
#endif
#define IN(k) ((((PHASE_MASK) >> (k)) & 1) && lo <= (k) && (k) < hi)
#define SEAM(k) do { if (IN(k) && IN((k) + 1)) xcd_barrier(bar); PSTAMP((k) + 1); } while (0)
#define PSTAMP(k) do { if (PROBE_A_LO >= 0 && bid == 0 && tid == 0) { const unsigned _t = (unsigned)wall_clock64(); if ((k) == PROBE_A_LO) MISC[8] = _t; if ((k) == PROBE_A_HI + 1) MISC[9] = _t; if ((k) == PROBE_B_LO) MISC[10] = _t; if ((k) == PROBE_B_HI + 1) MISC[11] = _t; } } while (0)
    PSTAMP(0);

    bf16* const ACTA = (bf16*)(ws + WS_ACTA);
    bf16* const ACTB = (bf16*)(ws + WS_ACTB);
    const f32x2* const ROT = (const f32x2*)(ws + WS_ROT);
    const int gw = bid * 8 + wave, NGW = G * 8;

    if (IN(0)) {
        LAS unsigned* scr = (LAS unsigned*)(scrb + wave * 16384);
        constexpr int I_IN0 = 16 * 56, I_OUT = 16 * 16, I_FF = 16 * 44, I_DN0 = 44 * 16, I_IN1 = 16 * 40, I_EXP = 16 * 56, I_EDN = 56 * 16;
        constexpr int NITEMS = I_IN0 + I_OUT + 2 * I_FF + I_DN0 + I_IN1 + I_OUT + 2 * 8 * I_EXP + 8 * I_EDN;
        for (int it = gw; it < NITEMS; it += NGW) {
            int r = it;
            if (r < 8 * I_EXP) { const int e = r / I_EXP; p0_tile<true>(args.in[22] + (size_t)e * D * D_EXP, D, D_EXP, ws + WT_GU1 + (size_t)e * 2 * D_EXP * D, 1, 64.f, scr, r % I_EXP, lane); continue; } r -= 8 * I_EXP;
            if (r < 8 * I_EXP) { const int e = r / I_EXP; p0_tile<true>(args.in[23] + (size_t)e * D * D_EXP, D, D_EXP, ws + WT_GU1 + (size_t)e * 2 * D_EXP * D, 2, 64.f, scr, r % I_EXP, lane); continue; } r -= 8 * I_EXP;
            if (r < 8 * I_EDN) { const int e = r / I_EDN; p0_tile<true>(args.in[24] + (size_t)e * D_EXP * D, D_EXP, D, ws + WT_DN1 + (size_t)e * D * D_EXP, 0, 64.f, scr, r % I_EDN, lane); continue; } r -= 8 * I_EDN;
            if (r < I_IN0) { p0_tile<false>(args.in[4], D, EVEN_IN, (bf16*)(ws + WT_IN0), 0, 1.f, scr, r, lane); continue; } r -= I_IN0;
            if (r < I_OUT) { p0_tile<false>(args.in[6], D, D, (bf16*)(ws + WT_OUT0), 0, 1.f, scr, r, lane); continue; } r -= I_OUT;
            if (r < I_FF) { p0_tile<false>(args.in[7], D, D_FF, (bf16*)(ws + WT_GU0), 1, 1.f, scr, r, lane); continue; } r -= I_FF;
            if (r < I_FF) { p0_tile<false>(args.in[8], D, D_FF, (bf16*)(ws + WT_GU0), 2, 1.f, scr, r, lane); continue; } r -= I_FF;
            if (r < I_DN0) { p0_tile<false>(args.in[9], D_FF, D, (bf16*)(ws + WT_DN0), 0, 1.f, scr, r, lane); continue; } r -= I_DN0;
            if (r < I_IN1) { p0_tile<false>(args.in[10], D, ODD_IN, (bf16*)(ws + WT_IN1), 0, 1.f, scr, r, lane); continue; } r -= I_IN1;
            p0_tile<false>(args.in[19], D, D, (bf16*)(ws + WT_OUT1), 0, 1.f, scr, r, lane);
        }
        for (int idx = bid * 512 + tid; idx < SEQ * 64; idx += G * 512) {
            const int t = idx >> 6, i = idx & 63;
            const float inv_freq = exp2f(-(float)i * (13.287712379549449f / 64.0f));
            double rev = (double)t * (double)inv_freq * 0.15915494309189535; rev -= floor(rev);
            const float rv = (float)rev;
            f32x2 cs; cs.x = __builtin_amdgcn_cosf(rv); cs.y = __builtin_amdgcn_sinf(rv);
            ((f32x2*)(ws + WS_ROT))[idx] = cs;
        }
        for (int m = gw; m < M; m += NGW) rms_row_bf16(args.in[0] + (size_t)m * D, args.in[1], ACTA + (size_t)m * D, lane);
    }
    SEAM(0);

    if (IN(1)) {
        pg8::DenseSched S; S.init(ACTA, (const bf16*)(ws + WT_IN0), M, EVEN_IN, D, G, bid);
        pg8::EpiStoreBf16 E{ACTB, EVEN_IN};
        pg8::gemm_phase<pg8::EpiStoreBf16, pg8::DenseSched, false>(scrb, 2 * D, S, E);
    }
    SEAM(1);

    constexpr int LQ = 136, LT = 72;
    LAS bf16* const rQ = (LAS bf16*)(scrb);
    LAS bf16* const rK = (LAS bf16*)(scrb + 17408);
    LAS bf16* const rKdT = (LAS bf16*)(scrb + 34816);
    LAS bf16* const rVT = (LAS bf16*)(scrb + 53248);
    LAS bf16* const rS = (LAS bf16*)(scrb + 71680);
    LAS bf16* const rStT = (LAS bf16*)(scrb + 80896);
    LAS float* const rStat = (LAS float*)(scrb + 115712);
    LAS bf16* const rG = (LAS bf16*)(scrb + 120320);
    float* const RGS = (float*)(ws + WS_SCR);

    if (IN(2)) {
        for (int item = bid; item < 256; item += G) {
            const int b = item >> 5, h = (item >> 3) & 3, g = item & 7;
            const float l2g = log2f(1.0f - exp2f(-5.0f - (float)h));
            const float g64 = exp2f(64.0f * l2g);
            f32x4 st[8];
#pragma unroll
            for (int q = 0; q < 8; ++q) st[q] = (f32x4){0.f, 0.f, 0.f, 0.f};
            RetPf pf;
            ret_load<false>(pf, ACTB, ROT, (size_t)b * SEQ + (g * 8) * 64, (g * 8) * 64, h, tid);
            for (int n = 0; n < 8; ++n) {
                ret_write<false>(pf, l2g, rQ, rK, rKdT, rVT, rG, tid);
                if (n < 7) { const int tposn = (g * 8 + n + 1) * 64; ret_load<false>(pf, ACTB, ROT, (size_t)b * SEQ + tposn, tposn, h, tid); }
                __syncthreads();
#pragma unroll
                for (int q = 0; q < 8; ++q) st[q] = st[q] * g64;
                mm_lds<128, 128, 64, true>(rKdT, LT, rVT, LT, st, wave, lane);
                __syncthreads();
            }
            float* gp = RGS + (size_t)item * 16384 + tid;
#pragma unroll
            for (int q = 0; q < 8; ++q)
#pragma unroll
                for (int r = 0; r < 4; ++r) gp[(q * 4 + r) * 512] = st[q][r];
        }
        {
            __syncthreads();
            constexpr int PV = 68;
            LAS bf16* const sV = (LAS bf16*)(scrb + wave * 8704);
            const int vkey = lane >> 3, vpc = lane & 7;
            for (int wi = bid * 8 + wave; wi < NB * 8 * 256; wi += G * 8) {
                const int qt = 255 - (wi & 255), h = (wi >> 8) & 7, b = wi >> 11;
                const size_t brow = (size_t)b * SEQ;
                const int tq = 16 * qt + fr;
                bf16x8 qf[2];
#pragma unroll
                for (int ks = 0; ks < 2; ++ks) qf[ks] = *(const bf16x8*)(ACTB + (brow + tq) * EVEN_IN + SQ_OFF + 64 * h + 32 * ks + 8 * fq);
                f32x4 ot[4];
#pragma unroll
                for (int dt = 0; dt < 4; ++dt) ot[dt] = (f32x4){0.f, 0.f, 0.f, 0.f};
                float C = 1.0f;
                int kt = qt >> 2;
                bf16x8 kf[4][2]; u32x4 vr[8];
#pragma unroll
                for (int tj = 0; tj < 4; ++tj)
#pragma unroll
                    for (int ks = 0; ks < 2; ++ks) kf[tj][ks] = *(const bf16x8*)(ACTB + (brow + 64 * kt + 16 * tj + fr) * EVEN_IN + SK_OFF + 64 * h + 32 * ks + 8 * fq);
#pragma unroll
                for (int i = 0; i < 8; ++i) vr[i] = *(const u32x4*)(ACTB + (brow + 64 * kt + 8 * i + vkey) * EVEN_IN + SV_OFF + 64 * h + 8 * vpc);
                for (;;) {
#pragma unroll
                    for (int i = 0; i < 8; ++i) { LAS u32x2* d = (LAS u32x2*)(sV + (8 * i + vkey) * PV + 8 * vpc); u32x2 lo, hi; lo.x = vr[i].x; lo.y = vr[i].y; hi.x = vr[i].z; hi.y = vr[i].w; d[0] = lo; d[1] = hi; }
                    f32x4 zt[4];
#pragma unroll
                    for (int tj = 0; tj < 4; ++tj) { zt[tj] = __builtin_amdgcn_mfma_f32_16x16x32_bf16(kf[tj][0], qf[0], (f32x4){0.f, 0.f, 0.f, 0.f}, 0, 0, 0); zt[tj] = __builtin_amdgcn_mfma_f32_16x16x32_bf16(kf[tj][1], qf[1], zt[tj], 0, 0, 0); }
                    const int ktn = kt - 1;
                    if (ktn >= 0) {
#pragma unroll
                        for (int tj = 0; tj < 4; ++tj)
#pragma unroll
                            for (int ks = 0; ks < 2; ++ks) kf[tj][ks] = *(const bf16x8*)(ACTB + (brow + 64 * ktn + 16 * tj + fr) * EVEN_IN + SK_OFF + 64 * h + 32 * ks + 8 * fq);
#pragma unroll
                        for (int i = 0; i < 8; ++i) vr[i] = *(const u32x4*)(ACTB + (brow + 64 * ktn + 8 * i + vkey) * EVEN_IN + SV_OFF + 64 * h + 8 * vpc);
                    }
                    float a[4][4], pseg[4];
#pragma unroll
                    for (int tj = 0; tj < 4; ++tj) { float suf = 1.0f;
#pragma unroll
                        for (int r = 3; r >= 0; --r) { const int sk = 64 * kt + 16 * tj + 4 * fq + r; const bool valid = sk < tq;
                            const float pp = __builtin_amdgcn_rcpf(1.0f + __builtin_amdgcn_exp2f(zt[tj][r] * (0.125f * 1.4426950408889634f)));
                            const float p = valid ? pp : 1.0f, be = valid ? 1.0f - pp : 0.0f; a[tj][r] = be * suf; suf *= p; }
                        pseg[tj] = suf; }
                    float run = C;
#pragma unroll
                    for (int tj = 3; tj >= 0; --tj) { const float y = __shfl_xor(pseg[tj], 16); const float pair = pseg[tj] * y; const float zz = __shfl_xor(pair, 32);
                        const float S = ((fq & 1) ? 1.0f : y) * ((fq & 2) ? 1.0f : zz); const float sc = S * run;
#pragma unroll
                        for (int r = 0; r < 4; ++r) a[tj][r] *= sc;
                        run *= pair * zz; }
                    C = run;
                    bf16x8 af[2];
#pragma unroll
                    for (int ks = 0; ks < 2; ++ks) { u32x4 w; w.x = pk2(a[2 * ks][0], a[2 * ks][1]); w.y = pk2(a[2 * ks][2], a[2 * ks][3]); w.z = pk2(a[2 * ks + 1][0], a[2 * ks + 1][1]); w.w = pk2(a[2 * ks + 1][2], a[2 * ks + 1][3]); af[ks] = __builtin_bit_cast(bf16x8, w); }
                    LDS_WAIT(); asm volatile("" ::: "memory");
#pragma unroll
                    for (int dt = 0; dt < 4; ++dt)
#pragma unroll
                        for (int ks = 0; ks < 2; ++ks) { bf16x8 vf;
#pragma unroll
                            for (int j = 0; j < 8; ++j) vf[j] = (short)sV[(32 * ks + 16 * (j >> 2) + 4 * fq + (j & 3)) * PV + 16 * dt + fr];
                            ot[dt] = __builtin_amdgcn_mfma_f32_16x16x32_bf16(vf, af[ks], ot[dt], 0, 0, 0); }
                    LDS_WAIT(); asm volatile("" ::: "memory");
                    if (ktn < 0 || __all(C < 1e-30f)) break;
                    kt = ktn;
                }
#pragma unroll
                for (int dt = 0; dt < 4; ++dt) { u32x2 w; w.x = pk2(ot[dt][0], ot[dt][1]); w.y = pk2(ot[dt][2], ot[dt][3]);
                    *(u32x2*)(ACTA + (brow + tq) * D + 512 + 64 * h + 16 * dt + 4 * fq) = w; }
            }
        }
    }
    SEAM(2);

    if (IN(3)) {
        const int fr0 = fr, fq0 = fq;
        for (int item = bid; item < 256; item += G) {
            const int b = item >> 5, h = (item >> 3) & 3, g = item & 7;
            const float l2g = log2f(1.0f - exp2f(-5.0f - (float)h));
            const float g64 = exp2f(64.0f * l2g), g512 = exp2f(512.0f * l2g);
            f32x4 st[8];
#pragma unroll
            for (int q = 0; q < 8; ++q) st[q] = (f32x4){0.f, 0.f, 0.f, 0.f};
            for (int gp_ = 0; gp_ < g; ++gp_) {
                const float* gp = RGS + (size_t)(item - g + gp_) * 16384 + tid;
#pragma unroll
                for (int q = 0; q < 8; ++q)
#pragma unroll
                    for (int r = 0; r < 4; ++r) st[q][r] = st[q][r] * g512 + gp[(q * 4 + r) * 512];
            }
            RetPf pf;
            ret_load<true>(pf, ACTB, ROT, (size_t)b * SEQ + (g * 8) * 64, (g * 8) * 64, h, tid);
            for (int n = 0; n < 8; ++n) {
                int tid_l = tid, fr_l = fr0, fq_l = fq0;
                asm volatile("" : "+v"(tid_l), "+v"(fr_l), "+v"(fq_l));
                { const int fr = fr_l, fq = fq_l, lane = (fq_l << 4) | fr_l;
                const int tpos0 = (g * 8 + n) * 64; const size_t row0 = (size_t)b * SEQ + tpos0;
                __syncthreads();
                ret_write<true>(pf, l2g, rQ, rK, rKdT, rVT, rG, tid_l);
                if (n < 7) { const int tposn = tpos0 + 64; ret_load<true>(pf, ACTB, ROT, (size_t)b * SEQ + tposn, tposn, h, tid_l); }
#pragma unroll
                for (int q = 0; q < 8; ++q) { u32x2 w; w.x = pk2(st[q][0], st[q][1]); w.y = pk2(st[q][2], st[q][3]);
                    *(LAS u32x2*)(rStT + MM_COL(8, q) * LQ + 16 * q + 4 * fq) = w; }
                __syncthreads();
                { f32x4 sT[2]; mm_lds<64, 64, 128, false>(rK, LQ, rQ, LQ, sT, wave, lane);
                  const int i = MM_COL(4, 0);
#pragma unroll
                  for (int q = 0; q < 2; ++q) { const int j0 = MM_ROW(4, q, 0); float e4[4];
#pragma unroll
                      for (int r = 0; r < 4; ++r) { const int dd = i > j0 + r ? i - j0 - r : j0 + r - i; e4[r] = sT[q][r] * exp2f((float)dd * l2g); }
                      u32x2 w; w.x = pk2(e4[0], e4[1]); w.y = pk2(e4[2], e4[3]); *(LAS u32x2*)(rS + i * LT + j0) = w; } }
                __syncthreads();
                f32x4 oi[4];
                mm_lds<128, 64, 128, false>(rStT, LQ, rQ, LQ, oi, wave, lane);
                const int io = MM_COL(4, 0);
                { const float gi1 = exp2f((float)(io + 1) * l2g);
#pragma unroll
                  for (int q = 0; q < 4; ++q) oi[q] = oi[q] * gi1; }
                mm_lds<128, 64, 64, true>(rVT, LT, rS, LT, oi, wave, lane);
                { float s1 = 0.f, s2 = 0.f;
#pragma unroll
                  for (int q = 0; q < 4; ++q)
#pragma unroll
                      for (int r = 0; r < 4; ++r) { s1 += oi[q][r]; s2 += oi[q][r] * oi[q][r]; }
                  s1 += __shfl_xor(s1, 16); s2 += __shfl_xor(s2, 16); s1 += __shfl_xor(s1, 32); s2 += __shfl_xor(s2, 32);
                  if (fq == 0) { rStat[(io * 2 + (wave >> 2)) * 2] = s1; rStat[(io * 2 + (wave >> 2)) * 2 + 1] = s2; } }
                __syncthreads();
                { const float s1 = rStat[(io * 2) * 2] + rStat[(io * 2 + 1) * 2], s2 = rStat[(io * 2) * 2 + 1] + rStat[(io * 2 + 1) * 2 + 1];
                  const float mu = s1 * (1.0f / 128.0f); float var = s2 * (1.0f / 128.0f) - mu * mu; var = var < 0.f ? 0.f : var; const float rstd = rsqrtf(var + EPS);
#pragma unroll
                  for (int q = 0; q < 4; ++q) { const int e0 = MM_ROW(4, q, 0);
                      const u32x2 gt = *(const LAS u32x2*)(rG + io * LQ + e0); const f32x4 gw4 = *(const f32x4*)(args.in[5] + 128 * h + e0);
                      const float g0 = bf2f(gt.x), g1 = bf2f(gt.x >> 16), g2 = bf2f(gt.y), g3 = bf2f(gt.y >> 16);
                      u32x2 w; w.x = pk2((oi[q][0] - mu) * rstd * gw4.x * g0 * sigmoidf_(g0), (oi[q][1] - mu) * rstd * gw4.y * g1 * sigmoidf_(g1));
                      w.y = pk2((oi[q][2] - mu) * rstd * gw4.z * g2 * sigmoidf_(g2), (oi[q][3] - mu) * rstd * gw4.w * g3 * sigmoidf_(g3));
                      *(LAS u32x2*)(rQ + io * LQ + e0) = w; } }
#pragma unroll
                for (int q = 0; q < 8; ++q) st[q] = st[q] * g64;
                mm_lds<128, 128, 64, true>(rKdT, LT, rVT, LT, st, wave, lane);
                __syncthreads();
                { const int j = tid_l >> 3, seg = tid_l & 7; bf16* yp = ACTA + (row0 + j) * D + 128 * h + 16 * seg;
                  *(u32x4*)yp = *(const LAS u32x4*)(rQ + j * LQ + 16 * seg); *(u32x4*)(yp + 8) = *(const LAS u32x4*)(rQ + j * LQ + 16 * seg + 8); }
                }
            }
        }
    }
    SEAM(3);

    if (IN(4)) {
        pg8::DenseSched S; S.init(ACTA, (const bf16*)(ws + WT_OUT0), M, D, D, G, bid);
#if OLD_DENSE
        pg8::EpiResF32 E{args.in[0], out, D};
        pg8::gemm_phase<pg8::EpiResF32, pg8::DenseSched, false>(scrb, 2 * D, S, E);
#else
        pg8::EpiStoreBf16 E{ACTB, D};
        pg8::gemm_phase<pg8::EpiStoreBf16, pg8::DenseSched, false>(scrb, 2 * D, S, E);
#endif
    }
    SEAM(4);
#if OLD_DENSE
    if (IN(5)) { for (int m = gw; m < M; m += NGW) rms_row_bf16(out + (size_t)m * D, args.in[2], ACTA + (size_t)m * D, lane); }
#else
    if (IN(5)) { for (int m = gw; m < M; m += 2 * NGW) { if (m + NGW < M) rms_res_row2_bf16(args.in[0] + (size_t)m * D, ACTB + (size_t)m * D, out + (size_t)m * D, args.in[2], ACTA + (size_t)m * D, (size_t)NGW * D, lane);
            else rms_res_row_bf16(args.in[0] + (size_t)m * D, ACTB + (size_t)m * D, out + (size_t)m * D, args.in[2], ACTA + (size_t)m * D, lane); } }
#endif
    SEAM(5);
    if (IN(6)) {
        pg8::DenseSched S; S.init(ACTA, (const bf16*)(ws + WT_GU0), M, 2 * D_FF, D, G, bid);
        pg8::EpiSwiGLU E{ACTB, D_FF};
        pg8::gemm_phase<pg8::EpiSwiGLU, pg8::DenseSched, false>(scrb, 2 * D, S, E);
    }
    SEAM(6);
    if (IN(7)) {
        pg8::DenseSched S; S.init(ACTB, (const bf16*)(ws + WT_DN0), M, D, D_FF, G, bid);
#if OLD_DENSE
        pg8::EpiResF32 E{out, out, D};
        pg8::gemm_phase<pg8::EpiResF32, pg8::DenseSched, false>(scrb, 2 * D_FF, S, E);
#else
        pg8::EpiStoreBf16 E{ACTA, D};
        pg8::gemm_phase<pg8::EpiStoreBf16, pg8::DenseSched, false>(scrb, 2 * D_FF, S, E);
#endif
    }
    SEAM(7);
#if OLD_DENSE
    if (IN(8)) { for (int m = gw; m < M; m += NGW) rms_row_bf16(out + (size_t)m * D, args.in[1] + D, ACTA + (size_t)m * D, lane); }
#else
    if (IN(8)) { for (int m = gw; m < M; m += 2 * NGW) { if (m + NGW < M) rms_res_row2_bf16(out + (size_t)m * D, ACTA + (size_t)m * D, out + (size_t)m * D, args.in[1] + D, ACTA + (size_t)m * D, (size_t)NGW * D, lane);
            else rms_res_row_bf16(out + (size_t)m * D, ACTA + (size_t)m * D, out + (size_t)m * D, args.in[1] + D, ACTA + (size_t)m * D, lane); } }
#endif
    SEAM(8);
    if (IN(9)) {
        pg8::DenseSched S; S.init(ACTA, (const bf16*)(ws + WT_IN1), M, ODD_IN, D, G, bid);
        pg8::EpiStoreBf16 E{ACTB, ODD_IN};
        pg8::gemm_phase<pg8::EpiStoreBf16, pg8::DenseSched, false>(scrb, 2 * D, S, E);
    }
    SEAM(9);

    float* const LSUM = (float*)(ws + WS_SCR);
#pragma unroll
    for (int pass = 0; pass < 2; ++pass) {
        if (IN(10 + pass)) {
            LAS bf16* const XR = (LAS bf16*)(scrb + wave * 17408);
            LAS float* const AB = (LAS float*)(scrb + wave * 17408 + 9216);
            const int head = wave, ch = 64 * head + lane;
            bf16x8 Bwa[4][2], Bwx[4][2];
#pragma unroll
            for (int tj = 0; tj < 4; ++tj)
#pragma unroll
                for (int ks = 0; ks < 2; ++ks) { bf16x8 va, vx;
#pragma unroll
                    for (int e = 0; e < 8; ++e) { const int i = 32 * ks + 8 * fq + e, j = 16 * tj + fr; va[e] = (short)f2bf(args.in[14][(size_t)(head * 64 + i) * 64 + j]); vx[e] = (short)f2bf(args.in[16][(size_t)(head * 64 + i) * 64 + j]); }
                    Bwa[tj][ks] = va; Bwx[tj][ks] = vx; }
            float cba[4], cbx[4], csp[4];
#pragma unroll
            for (int tj = 0; tj < 4; ++tj) { const int c = 64 * head + 16 * tj + fr; cba[tj] = args.in[15][c]; cbx[tj] = args.in[17][c]; csp[tj] = log1pf(__expf(-args.in[18][c])); }
            const float cw0 = args.in[12][ch], cw1 = args.in[12][512 + ch], cw2 = args.in[12][1024 + ch], cw3 = args.in[12][1536 + ch], cbias = args.in[13][ch];
            for (int it = bid; it < NB * 64; it += G) {
                const int b = it >> 6, c = it & 63; const size_t row0 = (size_t)b * SEQ + 64 * c;
                { float x0 = 0.f, x1 = 0.f, x2 = 0.f;
                  const bf16* xp = ACTB + row0 * ODD_IN + XR_OFF + ch;
                  if (c > 0) { x0 = bf2f(xp[-3 * ODD_IN]); x1 = bf2f(xp[-2 * ODD_IN]); x2 = bf2f(xp[-1 * ODD_IN]); }
                  for (int tb = 0; tb < 64; tb += 16) {
                      bf16 xv[16];
#pragma unroll
                      for (int u = 0; u < 16; ++u) xv[u] = xp[(size_t)(tb + u) * ODD_IN];
#pragma unroll
                      for (int u = 0; u < 16; ++u) { const float x3 = bf2f(xv[u]);
                          XR[(tb + u) * LT + lane] = (bf16)f2bf(cw0 * x0 + cw1 * x1 + cw2 * x2 + cw3 * x3 + cbias); x0 = x1; x1 = x2; x2 = x3; } } }
                float hst = 0.f, cum = 1.f;
                if (pass == 1) {
                    for (int c0 = 0; c0 < c; c0 += 8) {
                        f32x2 sv[8];
#pragma unroll
                        for (int k = 0; k < 8; ++k) { const int cc = (c0 + k < c) ? c0 + k : c0; sv[k] = ((const f32x2*)LSUM)[(size_t)(b * 64 + cc) * 512 + ch]; }
#pragma unroll
                        for (int k = 0; k < 8; ++k) if (c0 + k < c) hst = sv[k].x * hst + sv[k].y;
                    }
                }
                LDS_WAIT(); asm volatile("" ::: "memory");
                for (int sb = 0; sb < 4; ++sb) {
                    f32x4 aR[4], aX[4];
#pragma unroll
                    for (int tj = 0; tj < 4; ++tj) { aR[tj] = (f32x4){0.f, 0.f, 0.f, 0.f}; aX[tj] = aR[tj]; }
#pragma unroll
                    for (int ks = 0; ks < 2; ++ks) { const bf16x8 af = *(const LAS bf16x8*)(XR + (16 * sb + fr) * LT + 32 * ks + 8 * fq);
#pragma unroll
                        for (int tj = 0; tj < 4; ++tj) { aR[tj] = __builtin_amdgcn_mfma_f32_16x16x32_bf16(af, Bwa[tj][ks], aR[tj], 0, 0, 0); aX[tj] = __builtin_amdgcn_mfma_f32_16x16x32_bf16(af, Bwx[tj][ks], aX[tj], 0, 0, 0); } }
#pragma unroll
                    for (int tj = 0; tj < 4; ++tj)
#pragma unroll
                        for (int r = 0; r < 4; ++r) { const int tl = 4 * fq + r, j = 16 * tj + fr;
                            const float rg = sigmoidf_(aR[tj][r] + cba[tj]), ig = sigmoidf_(aX[tj][r] + cbx[tj]);
                            const float la = -8.0f * rg * csp[tj]; const float a = __expf(la); const float mult = sqrtf(-expm1f(2.0f * la));
                            const float xv = bf2f(XR[(16 * sb + tl) * LT + j]);
                            AB[tl * 64 + j] = a; AB[1024 + tl * 64 + j] = mult * ig * xv; }
                    LDS_WAIT(); asm volatile("" ::: "memory");
                    if (pass == 1) {
                        bf16 gv[16];
#pragma unroll
                        for (int tl = 0; tl < 16; ++tl) gv[tl] = ACTB[(row0 + 16 * sb + tl) * ODD_IN + XG_OFF + ch];
#pragma unroll
                        for (int tl = 0; tl < 16; ++tl) { const float a = AB[tl * 64 + lane], bb = AB[1024 + tl * 64 + lane]; hst = a * hst + bb;
                            const float xg = bf2f(gv[tl]);
                            const float u3 = 0.7978845608028654f * (xg + 0.044715f * xg * xg * xg); const float th = 1.0f - 2.0f * __builtin_amdgcn_rcpf(1.0f + __builtin_amdgcn_exp2f(u3 * 2.8853900817779268f));
                            ACTA[(row0 + 16 * sb + tl) * D + 512 + ch] = (bf16)f2bf(hst * 0.5f * xg * (1.0f + th)); }
                    } else {
#pragma unroll
                        for (int tl = 0; tl < 16; ++tl) { const float a = AB[tl * 64 + lane], bb = AB[1024 + tl * 64 + lane]; hst = a * hst + bb; cum *= a; }
                    }
                    LDS_WAIT(); asm volatile("" ::: "memory");
                }
                if (pass == 0) { f32x2 sv; sv.x = cum; sv.y = hst; ((f32x2*)LSUM)[(size_t)(b * 64 + c) * 512 + ch] = sv; }
            }
            if (pass == 1) {
#pragma unroll 2
                for (int idx = bid * 512 + tid; idx < M * 64; idx += G * 512) {
                    const int row = idx >> 6, c8 = (idx & 63) * 8; const int t = row & (SEQ - 1);
                    const bf16* p = ACTB + (size_t)row * ODD_IN;
                    float acc8[8];
#pragma unroll
                    for (int x = 0; x < 8; ++x) acc8[x] = 0.f;
#pragma unroll
                    for (int k = 0; k < 3; ++k) { const int dt = 2 - k; if (t - dt >= 0) { const bf16* pr = p - (size_t)dt * ODD_IN;
                            const u32x4 gc = *(const u32x4*)(pr + CC_OFF + c8), uu = *(const u32x4*)(pr + CU_OFF + c8); const unsigned gw_[4] = {gc.x, gc.y, gc.z, gc.w}, uw[4] = {uu.x, uu.y, uu.z, uu.w};
#pragma unroll
                            for (int x = 0; x < 4; ++x) { acc8[2 * x] += args.in[11][k * 512 + c8 + 2 * x] * bf2f(gw_[x]) * bf2f(uw[x]); acc8[2 * x + 1] += args.in[11][k * 512 + c8 + 2 * x + 1] * bf2f(gw_[x] >> 16) * bf2f(uw[x] >> 16); } } }
                    const u32x4 gb = *(const u32x4*)(p + CB_OFF + c8); const unsigned gbw[4] = {gb.x, gb.y, gb.z, gb.w};
                    u32x4 w; unsigned ww[4];
#pragma unroll
                    for (int x = 0; x < 4; ++x) ww[x] = pk2(bf2f(gbw[x]) * acc8[2 * x], bf2f(gbw[x] >> 16) * acc8[2 * x + 1]);
                    w.x = ww[0]; w.y = ww[1]; w.z = ww[2]; w.w = ww[3];
                    *(u32x4*)(ACTA + (size_t)row * D + c8) = w;
                }
            }
        }
        SEAM(10 + pass);
    }

    if (IN(12)) {
        pg8::DenseSched S; S.init(ACTA, (const bf16*)(ws + WT_OUT1), M, D, D, G, bid);
#if OLD_DENSE
        pg8::EpiResF32 E{out, out, D};
        pg8::gemm_phase<pg8::EpiResF32, pg8::DenseSched, false>(scrb, 2 * D, S, E);
#else
        pg8::EpiStoreBf16 E{ACTB, D};
        pg8::gemm_phase<pg8::EpiStoreBf16, pg8::DenseSched, false>(scrb, 2 * D, S, E);
#endif
    }
    SEAM(12);

    int* const LTOK = (int*)(ws + SCR_LTOK); unsigned* const REC = (unsigned*)(ws + SCR_REC); unsigned* const REC2 = (unsigned*)(ws + SCR_REC + MiB);
    if (IN(13)) {
        LAS int* const lcnt = (LAS int*)(scrb);
        LAS int* const lbase = (LAS int*)(scrb + 64);
        LAS int* const recE = (LAS int*)(scrb + 128);
        LAS int* const recR = (LAS int*)(scrb + 128 + 1024);
        LAS float* const recW = (LAS float*)(scrb + 128 + 2048);
        float wr_[4][4][8];
#pragma unroll
        for (int j = 0; j < 4; ++j)
#pragma unroll
            for (int x = 0; x < 4; ++x) { const int col = 4 * (lane + 64 * j) + x; const f32x4 w0 = *(const f32x4*)(args.in[20] + (size_t)col * 8), w1 = *(const f32x4*)(args.in[20] + (size_t)col * 8 + 4);
                wr_[j][x][0] = w0.x; wr_[j][x][1] = w0.y; wr_[j][x][2] = w0.z; wr_[j][x][3] = w0.w; wr_[j][x][4] = w1.x; wr_[j][x][5] = w1.y; wr_[j][x][6] = w1.z; wr_[j][x][7] = w1.w; }
        for (int base = bid * 128; base < M; base += G * 128) {
            if (tid < 16) lcnt[tid] = 0;
            __syncthreads();
            f32x4 vn[4]; u32x2 dn[4];
            { const int m = base + wave * 16;
#pragma unroll
              for (int j = 0; j < 4; ++j) { vn[j] = ((const f32x4*)(out + (size_t)m * D) + lane)[64 * j]; dn[j] = ((const u32x2*)(ACTB + (size_t)m * D) + lane)[64 * j]; } }
            for (int rr = 0; rr < 16; ++rr) {
                const int lr = wave * 16 + rr, m = base + lr;
                f32x4* xr = (f32x4*)(out + (size_t)m * D) + lane; const f32x4* gr = (const f32x4*)(args.in[2] + D) + lane;
                f32x4 v[4]; u32x2 dcur[4]; float s = 0.f;
#pragma unroll
                for (int j = 0; j < 4; ++j) { v[j] = vn[j]; dcur[j] = dn[j]; }
                if (rr < 15) {
#pragma unroll
                    for (int j = 0; j < 4; ++j) { vn[j] = ((const f32x4*)(out + (size_t)(m + 1) * D) + lane)[64 * j]; dn[j] = ((const u32x2*)(ACTB + (size_t)(m + 1) * D) + lane)[64 * j]; } }
#pragma unroll
                for (int j = 0; j < 4; ++j) { const u32x2 dv = dcur[j]; v[j].x += bf2f(dv.x); v[j].y += bf2f(dv.x >> 16); v[j].z += bf2f(dv.y); v[j].w += bf2f(dv.y >> 16); xr[64 * j] = v[j];
                    s += (v[j].x * v[j].x + v[j].y * v[j].y) + (v[j].z * v[j].z + v[j].w * v[j].w); }
                const float rstd = rsqrtf(wave_sum(s) * (1.f / D) + EPS);
                float lg[8];
#pragma unroll
                for (int e = 0; e < 8; ++e) lg[e] = 0.f;
                unsigned* o8 = (unsigned*)((unsigned char*)ACTA + (size_t)m * D) + lane;
#pragma unroll
                for (int j = 0; j < 4; ++j) { const f32x4 gv = gr[64 * j]; float y[4] = {v[j].x * rstd * gv.x, v[j].y * rstd * gv.y, v[j].z * rstd * gv.z, v[j].w * rstd * gv.w};
                    { int w = __builtin_amdgcn_cvt_pk_fp8_f32(__builtin_amdgcn_fmed3f(y[0], -448.f, 448.f), __builtin_amdgcn_fmed3f(y[1], -448.f, 448.f), 0, false);
                      w = __builtin_amdgcn_cvt_pk_fp8_f32(__builtin_amdgcn_fmed3f(y[2], -448.f, 448.f), __builtin_amdgcn_fmed3f(y[3], -448.f, 448.f), w, true); o8[64 * j] = (unsigned)w; }
#pragma unroll
                    for (int x = 0; x < 4; ++x)
#pragma unroll
                        for (int e = 0; e < 8; ++e) lg[e] += y[x] * wr_[j][x][e]; }
#pragma unroll
                for (int e = 0; e < 8; ++e) lg[e] = wave_sum(lg[e]) + args.in[21][e];
                int e1 = 0; float l1 = lg[0];
#pragma unroll
                for (int e = 1; e < 8; ++e) if (lg[e] > l1) { l1 = lg[e]; e1 = e; }
                int e2 = -1; float l2 = -3.0e38f;
#pragma unroll
                for (int e = 0; e < 8; ++e) if (e != e1 && lg[e] > l2) { l2 = lg[e]; e2 = e; }
                const float w2 = 1.0f / (1.0f + __expf(l1 - l2)), w1 = 1.0f - w2;
                if (lane == 0) { recE[lr * 2] = e1; recE[lr * 2 + 1] = e2; recW[lr * 2] = w1; recW[lr * 2 + 1] = w2;
                    recR[lr * 2] = __hip_atomic_fetch_add(&lcnt[e1], 1, __ATOMIC_RELAXED, __HIP_MEMORY_SCOPE_WORKGROUP); recR[lr * 2 + 1] = __hip_atomic_fetch_add(&lcnt[8 + e2], 1, __ATOMIC_RELAXED, __HIP_MEMORY_SCOPE_WORKGROUP); }
            }
            __syncthreads();
            if (tid < 16) lbase[tid] = (int)__hip_atomic_fetch_add(ctl + CW_CNT + 64 * tid, (unsigned)lcnt[tid], RLX_AGENT);
            __syncthreads();
            if (tid < 256) { const int lr = tid >> 1, k = tid & 1; const int e = recE[tid]; const int pos = lbase[k * 8 + e] + recR[tid];
                if (pos < LIST_CAP) LTOK[(size_t)(k * 8 + e) * LIST_CAP + pos] = base + lr;
                unsigned* rec = REC + (size_t)(base + lr) * 8 + 3 * k; rec[0] = (unsigned)(k * 8 + e); rec[1] = (unsigned)pos; rec[2] = __builtin_bit_cast(unsigned, recW[tid]); }
            __syncthreads();
        }
    }
    SEAM(13);

    if (IN(14)) {
        pg8::MoeSched S; S.init(ACTA, ws + WT_GU1, LTOK, ctl + CW_CNT, 0, 2 * D_EXP / 256, D, 0, (size_t)2 * D_EXP * D, G, bid);
        if (bid == 0 && tid == 0) { unsigned* tbw = ctl + CW_TB; tbw[0] = 0u; tbw[1] = S.t1; tbw[2] = S.t2; tbw[3] = S.t3; tbw[4] = S.t4; tbw[5] = S.t5; tbw[6] = S.t6; tbw[7] = S.t7; tbw[8] = S.t8;
            tbw[9] = S.t9; tbw[10] = S.t10; tbw[11] = S.t11; tbw[12] = S.t12; tbw[13] = S.t13; tbw[14] = S.t14; tbw[15] = S.t15; }
        pg8::EpiSwiGLU8 E{(unsigned char*)ACTB, D_EXP, 1.0f / 64.0f, 4.0f};
        pg8::gemm_phase<pg8::EpiSwiGLU8, pg8::MoeSched, true, true>(scrb, D, S, E);
    }
    SEAM(14);
    bf16* const YB = (bf16*)(ws + WS_Y);
    if (IN(15)) {
        for (int m = bid * 512 + tid; m < M; m += G * 512) {
            const u32x4 r0 = *(const u32x4*)(REC + (size_t)m * 8), r1 = *(const u32x4*)(REC + (size_t)m * 8 + 4);
            const unsigned ke0 = r0.x, rk0 = r0.y, w0b = r0.z, ke1 = r0.w, rk1 = r1.x, w1b = r1.y;
            u32x4 o; o.x = ctl[CW_TB + ke0] * 256u + rk0; o.y = ctl[CW_TB + ke1] * 256u + rk1; o.z = w0b; o.w = w1b;
            *(u32x4*)(REC2 + (size_t)m * 4) = o; }
        pg8::MoeSched S; S.init(ACTB, ws + WT_DN1, LTOK, ctl + CW_CNT, 0, D / 256, D_EXP, (size_t)256 * D_EXP, (size_t)D * D_EXP, G, bid);
        pg8::EpiStoreBf16 E{YB, D};
        pg8::gemm_phase<pg8::EpiStoreBf16, pg8::MoeSched, false, true>(scrb, D_EXP, S, E);
    }
    SEAM(15);

    if (IN(16)) {
        const f32x4* gr = (const f32x4*)args.in[3] + lane;
        for (int m0 = gw; m0 < M; m0 += 2 * NGW) {
            const int NR = (m0 + NGW < M) ? NGW : 0;
            u32x4 rc[2];
#pragma unroll
            for (int r = 0; r < 2; ++r) rc[r] = *(const u32x4*)(REC2 + (size_t)(m0 + r * NR) * 4);
            f32x4 v[2][4]; u32x2 ya[2][4], yb[2][4];
#pragma unroll
            for (int r = 0; r < 2; ++r) { const unsigned row0 = rc[r].x, row1 = rc[r].y;
                const u32x2* y0 = (const u32x2*)(YB + (size_t)row0 * D) + lane; const u32x2* y1 = (const u32x2*)(YB + (size_t)row1 * D) + lane; const f32x4* xr = (const f32x4*)(out + (size_t)(m0 + r * NR) * D) + lane;
#pragma unroll
                for (int j = 0; j < 4; ++j) { v[r][j] = xr[64 * j]; ya[r][j] = y0[64 * j]; yb[r][j] = y1[64 * j]; } }
#pragma unroll
            for (int r = 0; r < 2; ++r) { const unsigned w0u = rc[r].z, w1u = rc[r].w; const float w0 = __uint_as_float(w0u) * (1.0f / 256.0f), w1 = __uint_as_float(w1u) * (1.0f / 256.0f);
                float s = 0.f;
#pragma unroll
                for (int j = 0; j < 4; ++j) { const u32x2 a = ya[r][j], b = yb[r][j];
                    v[r][j].x += w0 * bf2f(a.x) + w1 * bf2f(b.x); v[r][j].y += w0 * bf2f(a.x >> 16) + w1 * bf2f(b.x >> 16); v[r][j].z += w0 * bf2f(a.y) + w1 * bf2f(b.y); v[r][j].w += w0 * bf2f(a.y >> 16) + w1 * bf2f(b.y >> 16);
                    s += (v[r][j].x * v[r][j].x + v[r][j].y * v[r][j].y) + (v[r][j].z * v[r][j].z + v[r][j].w * v[r][j].w); }
                const float rstd = rsqrtf(wave_sum(s) * (1.f / D) + EPS);
                f32x4* xw = (f32x4*)(out + (size_t)(m0 + r * NR) * D) + lane;
#pragma unroll
                for (int j = 0; j < 4; ++j) { const f32x4 gv = gr[64 * j]; xw[64 * j] = v[r][j] * rstd * gv; } }
        }
    }
    if (PROBE_A_LO >= 0 && bid == 0 && tid == 0) {
        const unsigned long long t_end = wall_clock64();
        const unsigned long long wait = (unsigned long long)(MISC[9] - MISC[8]) * 4ull + ((PROBE_B_LO >= 0) ? (unsigned long long)(MISC[11] - MISC[10]) * 4ull : 0ull);
        while (wall_clock64() - t_end < wait) __builtin_amdgcn_s_sleep(32);
    }
#undef IN
#undef SEAM
#undef PSTAMP
}

extern "C" void kernel_launch(void* const* d_in, const int* in_sizes, int n_in, void* d_out, int out_size, void* d_ws, size_t ws_size, hipStream_t stream) {
    static int grid = 0;
    if (grid == 0) {
        if (n_in != 25 || in_sizes[0] != M * D || out_size != M * D || ws_size < WS_END) { fprintf(stderr, "kernel_launch: unexpected shapes / workspace (n_in %d, ws %zu, need %zu)\n", n_in, ws_size, (size_t)WS_END); grid = -1; return; }
        int dev = 0, cus = 0, per_cu = 0;
        if (hipGetDevice(&dev) != hipSuccess || hipDeviceGetAttribute(&cus, hipDeviceAttributeMultiprocessorCount, dev) != hipSuccess) { grid = -1; return; }
        if (hipFuncSetAttribute((const void*)fwd_kernel, hipFuncAttributeMaxDynamicSharedMemorySize, LDS_BYTES) != hipSuccess) { fprintf(stderr, "kernel_launch: hipFuncSetAttribute failed\n"); grid = -1; return; }
        if (hipOccupancyMaxActiveBlocksPerMultiprocessor(&per_cu, (const void*)fwd_kernel, 512, LDS_BYTES) != hipSuccess || per_cu < 1) { fprintf(stderr, "kernel_launch: occupancy query says %d\n", per_cu); }
        (void)hipGetLastError();
        grid = cus;
    }
    if (grid < 0) return;
    if (hipMemsetAsync((char*)d_ws + WS_CTL, 0, CTL_ZERO_BYTES, stream) != hipSuccess) return;
    Args a{};
    for (int i = 0; i < 25; ++i) a.in[i] = (const float*)d_in[i];
    a.out = (float*)d_out; a.ws = (unsigned char*)d_ws;
#if MK_N_LAUNCHES == 1
    a.ph_lo = 0; a.ph_hi = NPHASE;
    hipLaunchKernelGGL(fwd_kernel, dim3(grid), dim3(512), LDS_BYTES, stream, a);
#else
    for (int p = 0; p < NPHASE; ++p) { a.ph_lo = p; a.ph_hi = p + 1; hipLaunchKernelGGL(fwd_kernel, dim3(grid), dim3(512), LDS_BYTES, stream, a); }
#endif
}
```

```cpp
#include <hip/hip_runtime.h>
#include <cstdio>
#include <cstdint>

#ifndef OLD_DENSE
#define OLD_DENSE 0
#endif
#ifndef MK_N_LAUNCHES
#define MK_N_LAUNCHES 1
#endif

#ifndef PROBE_A_LO
#define PROBE_A_LO (-1)
#define PROBE_A_HI (-1)
#define PROBE_B_LO (-1)
#define PROBE_B_HI (-1)
#endif
#define GAS __attribute__((address_space(1)))
#define LAS __attribute__((address_space(3)))
typedef unsigned short bf16;
typedef short bf16x8 __attribute__((ext_vector_type(8)));
typedef float f32x4 __attribute__((ext_vector_type(4)));
typedef float f32x2 __attribute__((ext_vector_type(2)));
typedef unsigned u32x4 __attribute__((ext_vector_type(4)));
typedef unsigned u32x2 __attribute__((ext_vector_type(2)));
typedef int v4i_t __attribute__((ext_vector_type(4)));
typedef short v4s_t __attribute__((ext_vector_type(4)));
typedef int v8i_t __attribute__((ext_vector_type(8)));

constexpr int D = 1024, NB = 8, SEQ = 4096, M = NB * SEQ;
constexpr int EVEN_IN = 3584, ODD_IN = 2560, D_FF = 2816, D_EXP = 3584, NEXP = 8;
constexpr int RQ_OFF = 0, RK_OFF = 512, RV_OFF = 1024, RGATE_OFF = 1536, SQ_OFF = 2048, SK_OFF = 2560, SV_OFF = 3072;
constexpr int CB_OFF = 0, CC_OFF = 512, CU_OFF = 1024, XR_OFF = 1536, XG_OFF = 2048;
constexpr float EPS = 1e-6f;
constexpr int LIST_CAP = 32768;
constexpr int MAX_TILES = 135;

constexpr size_t MiB = 1u << 20;
constexpr size_t WS_CTL = 0, CTL_ZERO_BYTES = 1 * MiB;
constexpr size_t WS_ROT = 1 * MiB;
constexpr size_t WS_SCR = 3 * MiB;
constexpr size_t WS_WB = 19 * MiB;
constexpr size_t WT_DN1 = WS_WB;
constexpr size_t WT_IN0 = 47 * MiB;
constexpr size_t WT_OUT0 = WT_IN0 + (size_t)EVEN_IN * D * 2;
constexpr size_t WT_GU0 = WT_OUT0 + (size_t)D * D * 2;
constexpr size_t WT_DN0 = WT_GU0 + (size_t)2 * D_FF * D * 2;
constexpr size_t WT_IN1 = WT_DN0 + (size_t)D * D_FF * 2;
constexpr size_t WT_OUT1 = WT_IN1 + (size_t)ODD_IN * D * 2;
constexpr size_t WT_GU1 = WT_OUT1 + (size_t)D * D * 2;
constexpr size_t WB_END = WT_GU1 + (size_t)NEXP * 2 * D_EXP * D;
constexpr size_t WS_ACTA = 136 * MiB;
constexpr size_t WS_ACTB = 200 * MiB;
constexpr size_t WS_END = WS_ACTB + (size_t)MAX_TILES * 256 * D_EXP * 2;
constexpr size_t WS_Y = WT_IN0;
static_assert(WT_DN1 + (size_t)NEXP * D * D_EXP <= WT_IN0 && WB_END <= WS_ACTA && WS_ACTA + (size_t)M * D * 2 <= WS_ACTB, "weights overlap");
static_assert(WS_Y + (size_t)2 * MAX_TILES * 256 * D * 2 <= WS_ACTB, "y overlay");
static_assert((size_t)M * EVEN_IN * 2 <= (size_t)MAX_TILES * 256 * D_EXP * 2, "ACTB size");
constexpr size_t SCR_LTOK = WS_SCR, SCR_REC = WS_SCR + 4 * MiB;
constexpr int CW_BAR = 4096;
constexpr int CW_TB = 16384;
constexpr int CW_CNT = 8192;

constexpr int LDS_MISC = 0;
constexpr int LDS_SCR = 256;
constexpr int LDS_BYTES = 147456;

#define RLX_AGENT __ATOMIC_RELAXED, __HIP_MEMORY_SCOPE_AGENT
#define LDS_WAIT() asm volatile("s_waitcnt lgkmcnt(0)" ::: "memory")
__device__ __forceinline__ unsigned pk2(float lo, float hi) { unsigned r; asm("v_cvt_pk_bf16_f32 %0, %1, %2" : "=v"(r) : "v"(lo), "v"(hi)); return r; }
__device__ __forceinline__ unsigned f2bf(float f) { return pk2(f, 0.0f) & 0xffffu; }
__device__ __forceinline__ float bf2f(unsigned b) { return __builtin_bit_cast(float, (b & 0xffffu) << 16); }
__device__ __forceinline__ float wave_sum(float v) {
#pragma unroll
    for (int o = 1; o < 64; o <<= 1) v += __shfl_xor(v, o);
    return v;
}
__device__ __forceinline__ float sigmoidf_(float x) { return __builtin_amdgcn_rcpf(1.0f + __builtin_amdgcn_exp2f(x * -1.4426950408889634f)); }

#define XB_TMO      128
#define XB_XCNT(j)  (256  + 64 * (j))
#define XB_XSUB(j)  (1280 + 64 * (j))
#define XB_XGEN(j)  (2304 + 64 * (j))
#define XB_TOP      3328
#define XB_TOPGEN   3392
#define XCD_BAR_WORDS 3456
#define XB_SPIN_CAP (1u << 18)

__device__ __forceinline__ unsigned xb_ld(unsigned* p)              { return __hip_atomic_load(p, __ATOMIC_RELAXED, __HIP_MEMORY_SCOPE_AGENT); }
__device__ __forceinline__ unsigned xb_add(unsigned* p, unsigned v) { return __hip_atomic_fetch_add(p, v, __ATOMIC_RELAXED, __HIP_MEMORY_SCOPE_AGENT); }
__device__ __forceinline__ unsigned xb_xcc_id() { return (unsigned)__builtin_amdgcn_s_getreg((3 << 11) | 20) & 0xFu; }
#define XB_SPIN(cond, bar) do { unsigned _sp = 0; while (cond) { __builtin_amdgcn_s_sleep(1); \
    if ((++_sp & 255u) == 0u) { if (xb_ld(&(bar)[XB_TMO])) break; if (_sp > XB_SPIN_CAP) { atomicAdd(&(bar)[XB_TMO], 1u); break; } } } } while (0)

struct XcdBarrier { unsigned* bar; unsigned x; volatile LAS unsigned* st; };

__device__ __forceinline__ XcdBarrier xcd_barrier_post(unsigned* bar, volatile LAS unsigned* st) {
    XcdBarrier b; b.bar = bar; b.x = xb_xcc_id(); b.st = st;
    if (threadIdx.x == 0) (void)xb_add(&bar[XB_XCNT(b.x)], 1u);
    return b;
}
__device__ __forceinline__ void xcd_barrier_complete(unsigned* bar, unsigned x, unsigned& nloc, unsigned& nx) {
    const unsigned G = gridDim.x * gridDim.y * gridDim.z;
    unsigned sum, cnt, mine, sp = 0u;
    for (;;) {
        sum = 0u; cnt = 0u; mine = 0u;
#pragma unroll
        for (unsigned j = 0; j < 16; ++j) { const unsigned c = xb_ld(&bar[XB_XCNT(j)]); sum += c; cnt += (c > 0u) ? 1u : 0u; mine = (j == x) ? c : mine; }
        if (sum == G) break;
        __builtin_amdgcn_s_sleep(1);
        if ((++sp & 255u) == 0u) { if (xb_ld(&bar[XB_TMO])) break; if (sp > XB_SPIN_CAP) { atomicAdd(&bar[XB_TMO], 1u); break; } }
    }
    nloc = mine > 0u ? mine : 1u; nx = cnt > 0u ? cnt : 1u;
}
__device__ __forceinline__ void xcd_barrier(const XcdBarrier& b) {
    asm volatile("s_waitcnt vmcnt(0)" ::: "memory");
    __syncthreads();
    if (threadIdx.x == 0) {
        unsigned* bar = b.bar;
        __builtin_amdgcn_s_waitcnt(0);
        unsigned nloc = b.st[0], nx = b.st[1];
        if (nloc == 0u) { xcd_barrier_complete(bar, b.x, nloc, nx); b.st[0] = nloc; b.st[1] = nx; }
        const unsigned old = xb_add(&bar[XB_XSUB(b.x)], 1u);
        const unsigned gen = old / nloc;
        if (old + 1u == (gen + 1u) * nloc) {
            __builtin_amdgcn_fence(__ATOMIC_RELEASE, "agent");
            asm volatile("s_waitcnt vmcnt(0)" ::: "memory");
            const unsigned og = xb_add(&bar[XB_TOP], 1u);
            const unsigned tg = og / nx;
            if (og + 1u == (tg + 1u) * nx) xb_add(&bar[XB_TOPGEN], 1u);
            else XB_SPIN(xb_ld(&bar[XB_TOPGEN]) == tg, bar);
            __builtin_amdgcn_fence(__ATOMIC_ACQUIRE, "agent");
            xb_add(&bar[XB_XGEN(b.x)], 1u);
            asm volatile("s_waitcnt vmcnt(0)" ::: "memory");
        } else {
            XB_SPIN(xb_ld(&bar[XB_XGEN(b.x)]) == gen, bar);
            __builtin_amdgcn_fence(__ATOMIC_ACQUIRE, "agent");
            asm volatile("s_waitcnt vmcnt(0)" ::: "memory");
        }
    }
    __syncthreads();
}

namespace pg8 {
constexpr int BM = 256, BK = 64, HALF = 128, HTB = HALF * BK * 2, STAGE_BYTES = 8 * HTB, NXCD = 8, WGM = 8;
__device__ __forceinline__ int lds_byte(int r, int c) { const int st = (r >> 4) * 2 + (c >> 5), rr = r & 15, cc = c & 31, ob = rr * 64 + cc * 2; return st * 1024 + (ob ^ (((ob >> 9) & 1) << 5)); }
__device__ __forceinline__ void stage_rc(int b, int& R, int& C) { const int st = b / 1024, sb = b % 1024, swz = sb ^ (((sb >> 9) & 1) << 5); R = (st >> 1) * 16 + swz / 64; C = (st & 1) * 32 + (swz % 64) / 2; }
__device__ __forceinline__ int perm32(int rho) { const int n = rho >> 4, i = rho & 15; return 8 * (i >> 2) + 4 * n + (i & 3); }

struct Unit { int pm, pn, e, lt, cn; };

struct StaticOrder {
    int nM, nN, nwg, G, c;
    __device__ __forceinline__ void init_tiles(int nM_, int nN_, int G_, int c_) { nM = nM_; nN = nN_; nwg = nM * nN; G = G_; c = c_; }
    __device__ __forceinline__ bool next_tile(int i, int& pm, int& pn) const {
        const long L = (long)i * G + c; if (L >= nwg) return false;
        int wgid = (int)L; { const int q = nwg / NXCD, r = nwg % NXCD, xcd = wgid % NXCD, off = wgid / NXCD; wgid = (xcd < r ? xcd * (q + 1) : r * (q + 1) + (xcd - r) * q) + off; }
        const int nig = WGM * nN, gid = wgid / nig, fm = gid * WGM, gsz = (nM - fm) < WGM ? (nM - fm) : WGM;
        pm = fm + ((wgid % nig) % gsz); pn = (wgid % nig) / gsz; return true;
    }
};
struct DenseSched : StaticOrder {
    const char* A; const char* Bt; size_t tstep;
    __device__ __forceinline__ void init(const bf16* A_, const bf16* Bt_, int Mr, int N, int K, int G_, int c_) { A = (const char*)A_; Bt = (const char*)Bt_; tstep = (size_t)BM * K * 2; init_tiles(Mr / BM, N / BM, G_, c_); }
    __device__ __forceinline__ bool next(int i, Unit& u) const { u.e = 0; u.lt = 0; u.cn = 0; return next_tile(i, u.pm, u.pn); }
    __device__ __forceinline__ const char* a_base(const Unit& u) const { return A + (size_t)u.pm * tstep; }
    __device__ __forceinline__ const char* b_base(const Unit& u) const { return Bt + (size_t)u.pn * tstep; }
    __device__ __forceinline__ void a_rows(const Unit&, const int (&)[2], const int (&)[2], unsigned (&)[2][2]) const {}
    __device__ __forceinline__ const int* tok_src(const Unit&) const { return nullptr; }
};
struct MoeSched : StaticOrder {
    const char* A; const char* Bt; size_t a_tstep, b_estep, b_tstep; const int* ltok; int rowb, toff;
    int c0, c1, c2, c3, c4, c5, c6, c7, c8, c9, c10, c11, c12, c13, c14, c15, t1, t2, t3, t4, t5, t6, t7, t8, t9, t10, t11, t12, t13, t14, t15, t16;
    __device__ __forceinline__ static int ldc_(const unsigned* cntw, int e) { int c = (int)__builtin_amdgcn_readfirstlane(__hip_atomic_load(cntw + 64 * e, RLX_AGENT)); return c > LIST_CAP ? LIST_CAP : c; }
    __device__ __forceinline__ void init(const void* A_, const void* Bt_, const int* ltok_, const unsigned* cntw, int which, int nN_, int rowb_, size_t a_tstep_, size_t b_estep_, int G_, int c_) {
        A = (const char*)A_; Bt = (const char*)Bt_; ltok = ltok_; rowb = rowb_; a_tstep = a_tstep_; b_estep = b_estep_; b_tstep = (size_t)BM * rowb_;
        c0 = ldc_(cntw, 0); c1 = ldc_(cntw, 1); c2 = ldc_(cntw, 2); c3 = ldc_(cntw, 3); c4 = ldc_(cntw, 4); c5 = ldc_(cntw, 5); c6 = ldc_(cntw, 6); c7 = ldc_(cntw, 7);
        c8 = ldc_(cntw, 8); c9 = ldc_(cntw, 9); c10 = ldc_(cntw, 10); c11 = ldc_(cntw, 11); c12 = ldc_(cntw, 12); c13 = ldc_(cntw, 13); c14 = ldc_(cntw, 14); c15 = ldc_(cntw, 15);
        t1 = (c0 + 255) >> 8; t2 = t1 + ((c1 + 255) >> 8); t3 = t2 + ((c2 + 255) >> 8); t4 = t3 + ((c3 + 255) >> 8); t5 = t4 + ((c4 + 255) >> 8); t6 = t5 + ((c5 + 255) >> 8); t7 = t6 + ((c6 + 255) >> 8); t8 = t7 + ((c7 + 255) >> 8);
        t9 = t8 + ((c8 + 255) >> 8); t10 = t9 + ((c9 + 255) >> 8); t11 = t10 + ((c10 + 255) >> 8); t12 = t11 + ((c11 + 255) >> 8); t13 = t12 + ((c12 + 255) >> 8); t14 = t13 + ((c13 + 255) >> 8); t15 = t14 + ((c14 + 255) >> 8); t16 = t15 + ((c15 + 255) >> 8);
        toff = which == 2 ? t8 : 0;
        init_tiles(which == 0 ? t16 : (which == 1 ? t8 : t16 - t8), nN_, G_, c_);
    }
    __device__ __forceinline__ bool next(int i, Unit& u) const {
        int pml; if (!next_tile(i, pml, u.pn)) return false;
        const int pm = pml + toff; u.pm = pm;
        const int m1 = pm >= t1, m2 = pm >= t2, m3 = pm >= t3, m4 = pm >= t4, m5 = pm >= t5, m6 = pm >= t6, m7 = pm >= t7, m8 = pm >= t8, m9 = pm >= t9, m10 = pm >= t10, m11 = pm >= t11, m12 = pm >= t12, m13 = pm >= t13, m14 = pm >= t14, m15 = pm >= t15;
        const int e = m1 + m2 + m3 + m4 + m5 + m6 + m7 + m8 + m9 + m10 + m11 + m12 + m13 + m14 + m15;
        const int base = m1 * t1 + m2 * (t2 - t1) + m3 * (t3 - t2) + m4 * (t4 - t3) + m5 * (t5 - t4) + m6 * (t6 - t5) + m7 * (t7 - t6) + m8 * (t8 - t7) + m9 * (t9 - t8) + m10 * (t10 - t9) + m11 * (t11 - t10) + m12 * (t12 - t11) + m13 * (t13 - t12) + m14 * (t14 - t13) + m15 * (t15 - t14);
        const int cn = c0 + m1 * (c1 - c0) + m2 * (c2 - c1) + m3 * (c3 - c2) + m4 * (c4 - c3) + m5 * (c5 - c4) + m6 * (c6 - c5) + m7 * (c7 - c6) + m8 * (c8 - c7) + m9 * (c9 - c8) + m10 * (c10 - c9) + m11 * (c11 - c10) + m12 * (c12 - c11) + m13 * (c13 - c12) + m14 * (c14 - c13) + m15 * (c15 - c14);
        u.e = e; u.lt = pm - base; u.cn = cn; return true;
    }
    __device__ __forceinline__ const char* a_base(const Unit& u) const { return A + (size_t)u.pm * a_tstep; }
    __device__ __forceinline__ const char* b_base(const Unit& u) const { return Bt + (size_t)(u.e & 7) * b_estep + (size_t)u.pn * b_tstep; }
    __device__ __forceinline__ const int* tok_src(const Unit& u) const { return ltok + (size_t)u.e * LIST_CAP + u.lt * 256; }
    __device__ __forceinline__ void a_rows(const Unit& u, const int (&R)[2], const int (&C)[2], unsigned (&off)[2][2]) const {
#pragma unroll
        for (int h = 0; h < 2; ++h)
#pragma unroll
            for (int i = 0; i < 2; ++i) { int rank = u.lt * 256 + h * HALF + R[i]; rank = rank < u.cn ? rank : u.cn - 1;
                const int tok = ltok[(size_t)u.e * LIST_CAP + rank]; off[h][i] = (unsigned)tok * (unsigned)rowb + (unsigned)(C[i] * 2); }
    }
};

__device__ __forceinline__ unsigned cvt_pk_bf16(float lo, float hi) { unsigned r; asm volatile("v_cvt_pk_bf16_f32 %0, %1, %2" : "=v"(r) : "v"(lo), "v"(hi)); return r; }

struct EpiStoreBf16 {
    static constexpr bool PERM = true; static constexpr int NVM = 16;
    bf16* O; int ldc;
    __device__ __forceinline__ void operator()(const f32x4 (&acc)[2][2][4][2], const Unit& u, int wr, int wc, int fr, int fq) const {
        const int row0 = u.pm * BM + wr * 64 + fr, col0 = u.pn * BM + wc * 32 + 8 * fq;
#pragma unroll
        for (int ai = 0; ai < 2; ++ai)
#pragma unroll
            for (int m = 0; m < 4; ++m) { bf16* rowp = O + (size_t)(row0 + ai * HALF + m * 16) * ldc + col0;
#pragma unroll
                for (int bj = 0; bj < 2; ++bj) { const f32x4 v0 = acc[ai][bj][m][0], v1 = acc[ai][bj][m][1];
                    u32x4 w; w.x = cvt_pk_bf16(v0[0], v0[1]); w.y = cvt_pk_bf16(v0[2], v0[3]); w.z = cvt_pk_bf16(v1[0], v1[1]); w.w = cvt_pk_bf16(v1[2], v1[3]);
                    *(u32x4*)(rowp + bj * HALF) = w; } }
    }
};
struct EpiResF32 {
    static constexpr bool PERM = false; static constexpr int NVM = 0;
    const float* base; float* out; int ldc;
    __device__ __forceinline__ void operator()(const f32x4 (&acc)[2][2][4][2], const Unit& u, int wr, int wc, int fr, int fq) const {
        const int row0 = u.pm * BM + wr * 64 + fr, col0 = u.pn * BM + wc * 32 + 4 * fq;
#pragma unroll
        for (int ai = 0; ai < 2; ++ai)
#pragma unroll
            for (int m = 0; m < 4; ++m) { const size_t off = (size_t)(row0 + ai * HALF + m * 16) * ldc + col0;
#pragma unroll
                for (int bj = 0; bj < 2; ++bj)
#pragma unroll
                    for (int n = 0; n < 2; ++n) { const f32x4 bs = *(const f32x4*)(base + off + bj * HALF + n * 16); *(f32x4*)(out + off + bj * HALF + n * 16) = bs + acc[ai][bj][m][n]; } }
    }
};
struct EpiSwiGLU {
    static constexpr bool PERM = true; static constexpr int NVM = 8;
    bf16* H; int ldh;
    __device__ __forceinline__ void operator()(const f32x4 (&acc)[2][2][4][2], const Unit& u, int wr, int wc, int fr, int fq) const {
        const int row0 = u.pm * BM + wr * 64 + fr, col0 = u.pn * HALF + wc * 32 + 8 * fq;
#pragma unroll
        for (int ai = 0; ai < 2; ++ai)
#pragma unroll
            for (int m = 0; m < 4; ++m) { bf16* rowp = H + (size_t)(row0 + ai * HALF + m * 16) * ldh + col0;
                float h[8];
#pragma unroll
                for (int n = 0; n < 2; ++n)
#pragma unroll
                    for (int x = 0; x < 2; ++x) { const f32x2 g = {acc[ai][0][m][n][2 * x], acc[ai][0][m][n][2 * x + 1]}, up = {acc[ai][1][m][n][2 * x], acc[ai][1][m][n][2 * x + 1]};
                        const f32x2 t = g * -1.4426950408889634f; f32x2 e; e.x = __builtin_amdgcn_exp2f(t.x); e.y = __builtin_amdgcn_exp2f(t.y);
                        const f32x2 d = e + 1.0f; f32x2 r; r.x = __builtin_amdgcn_rcpf(d.x); r.y = __builtin_amdgcn_rcpf(d.y);
                        const f32x2 hh = (g * up) * r; h[4 * n + 2 * x] = hh.x; h[4 * n + 2 * x + 1] = hh.y; }
                u32x4 w; w.x = cvt_pk_bf16(h[0], h[1]); w.y = cvt_pk_bf16(h[2], h[3]); w.z = cvt_pk_bf16(h[4], h[5]); w.w = cvt_pk_bf16(h[6], h[7]);
                *(u32x4*)rowp = w; }
    }
};
struct EpiSwiGLU8 {
    static constexpr bool PERM = true; static constexpr int NVM = 8;
    unsigned char* H; int ldh; float iscale, oscale;
    __device__ __forceinline__ void operator()(const f32x4 (&acc)[2][2][4][2], const Unit& u, int wr, int wc, int fr, int fq) const {
        const int row0 = u.pm * BM + wr * 64 + fr, col0 = u.pn * HALF + wc * 32 + 8 * fq;
#pragma unroll
        for (int ai = 0; ai < 2; ++ai)
#pragma unroll
            for (int m = 0; m < 4; ++m) { unsigned char* rowp = H + (size_t)(row0 + ai * HALF + m * 16) * ldh + col0;
                float h[8];
#pragma unroll
                for (int n = 0; n < 2; ++n)
#pragma unroll
                    for (int x = 0; x < 2; ++x) { const f32x2 ga = {acc[ai][0][m][n][2 * x], acc[ai][0][m][n][2 * x + 1]}, ua = {acc[ai][1][m][n][2 * x], acc[ai][1][m][n][2 * x + 1]};
                        const f32x2 t = ga * (-1.4426950408889634f * iscale); f32x2 e; e.x = __builtin_amdgcn_exp2f(t.x); e.y = __builtin_amdgcn_exp2f(t.y);
                        const f32x2 d = e + 1.0f; f32x2 r; r.x = __builtin_amdgcn_rcpf(d.x); r.y = __builtin_amdgcn_rcpf(d.y);
                        const f32x2 hh = ((ga * ua) * (iscale * iscale * oscale)) * r;
                        h[4 * n + 2 * x] = __builtin_amdgcn_fmed3f(hh.x, -448.0f, 448.0f); h[4 * n + 2 * x + 1] = __builtin_amdgcn_fmed3f(hh.y, -448.0f, 448.0f); }
                int w0 = __builtin_amdgcn_cvt_pk_fp8_f32(h[0], h[1], 0, false); w0 = __builtin_amdgcn_cvt_pk_fp8_f32(h[2], h[3], w0, true);
                int w1 = __builtin_amdgcn_cvt_pk_fp8_f32(h[4], h[5], 0, false); w1 = __builtin_amdgcn_cvt_pk_fp8_f32(h[6], h[7], w1, true);
                u32x2 w; w.x = (unsigned)w0; w.y = (unsigned)w1; *(u32x2*)rowp = w; }
    }
};
struct EpiMoeDown {
    static constexpr bool PERM = false; static constexpr int NVM = 0;
    float* out; const int* ltok; const float* lw; float scale;
    __device__ __forceinline__ void operator()(const f32x4 (&acc)[2][2][4][2], const Unit& u, int wr, int wc, int fr, int fq) const {
        const int col0 = u.pn * BM + wc * 32 + 4 * fq;
#pragma unroll
        for (int ai = 0; ai < 2; ++ai)
#pragma unroll
            for (int m = 0; m < 4; ++m) { const int rank = u.lt * 256 + ai * HALF + wr * 64 + m * 16 + fr;
                if (rank < u.cn) { const int tok = ltok[(size_t)u.e * LIST_CAP + rank]; const float w = lw[(size_t)u.e * LIST_CAP + rank] * scale; float* rowp = out + (size_t)tok * D + col0;
#pragma unroll
                    for (int bj = 0; bj < 2; ++bj)
#pragma unroll
                        for (int n = 0; n < 2; ++n) { const f32x4 bs = *(const f32x4*)(rowp + bj * HALF + n * 16); *(f32x4*)(rowp + bj * HALF + n * 16) = bs + acc[ai][bj][m][n] * w; } } }
    }
};

template <class Epi, class Sched, bool GATHER, bool F8 = false>
__device__ __forceinline__ void gemm_phase(LAS unsigned char* lds, const int rowb, const Sched& S, const Epi& E) {
    const int tid = threadIdx.x, wid = __builtin_amdgcn_readfirstlane(tid >> 6), lane = tid & 63, wr = wid >> 2, wc = wid & 3, fr = lane & 15, fq = lane >> 4;
    const int nt = rowb / 128;
    unsigned voffA[2], voffB[2]; int Rr[2], Cc[2];
#pragma unroll
    for (int i = 0; i < 2; ++i) { int R, C; stage_rc(tid * 16 + i * 8192, R, C); const int Rb = Epi::PERM ? ((R & ~31) + perm32(R & 31)) : R;
        voffA[i] = (unsigned)(R * rowb + C * 2); voffB[i] = (unsigned)(Rb * rowb + C * 2); Rr[i] = R; Cc[i] = C; }
    const size_t kstep = (size_t)(BK * 2);
    const size_t hstep = (size_t)HALF * rowb;
    const unsigned ldsw = (unsigned)wid * 1024u;
    const int aoff = lds_byte(wr * 64 + fr, fq * 8), boff = lds_byte(wc * 32 + fr, fq * 8);
#define PG8_SA(b, h) (((b) * 2 + (h)) * HTB)
#define PG8_SB(b, h) ((4 + (b) * 2 + (h)) * HTB)
#define PG8_STAGE(bufoff, gbase, voff) do { _Pragma("unroll") for (int _i = 0; _i < 2; ++_i) \
        __builtin_amdgcn_global_load_lds((const unsigned*)((const char*)(gbase) + (voff)[_i]), (LAS unsigned*)(lds + (bufoff) + ldsw + _i * 8192), 16, 0, 0); } while (0)
#define PG8_STAGE_A(bufoff, kptr, h) do { if constexpr (GATHER) PG8_STAGE(bufoff, kptr, gA[h]); else PG8_STAGE(bufoff, (kptr) + (h) * hstep, voffA); } while (0)
#define PG8_LD8(base) __builtin_shufflevector(*(const LAS v4i_t*)(base), *(const LAS v4i_t*)((base) + 1024), 0, 1, 2, 3, 4, 5, 6, 7)
#define PG8_LDA(dst, b, h) do { _Pragma("unroll") for (int m = 0; m < 4; ++m) { if constexpr (F8) dst##8[m] = PG8_LD8(lds + PG8_SA(b, h) + aoff + m * 2048); else { _Pragma("unroll") for (int k = 0; k < 2; ++k) dst[m][k] = *(const LAS bf16x8*)(lds + PG8_SA(b, h) + aoff + m * 2048 + k * 1024); } } } while (0)
#define PG8_LDB(dst, b, h) do { _Pragma("unroll") for (int n = 0; n < 2; ++n) { if constexpr (F8) dst##8[n] = PG8_LD8(lds + PG8_SB(b, h) + boff + n * 2048); else { _Pragma("unroll") for (int k = 0; k < 2; ++k) dst[n][k] = *(const LAS bf16x8*)(lds + PG8_SB(b, h) + boff + n * 2048 + k * 1024); } } } while (0)
#define PG8_MMA(ai, bj, At, Bt) do { __builtin_amdgcn_s_setprio(1); _Pragma("unroll") for (int m = 0; m < 4; ++m) _Pragma("unroll") for (int n = 0; n < 2; ++n) { \
        if constexpr (F8) asm volatile("v_mfma_f32_16x16x128_f8f6f4 %0, %1, %2, %0" : "+v"(acc[ai][bj][m][n]) : "v"(Bt##8[n]), "v"(At##8[m])); \
        else { _Pragma("unroll") for (int k = 0; k < 2; ++k) acc[ai][bj][m][n] = __builtin_amdgcn_mfma_f32_16x16x32_bf16(Bt[n][k], At[m][k], acc[ai][bj][m][n], 0, 0, 0); } } \
        __builtin_amdgcn_s_setprio(0); } while (0)
#define PG8_WAIT_V(n) asm volatile("s_waitcnt vmcnt(" #n ")" ::: "memory")
#define PG8_WAIT_SEL(flag, n) asm volatile("v_cmp_eq_u32_e32 vcc, 0, %0\n\ts_nop 4\n\ts_cbranch_vccnz .Lw8_%=\n\ts_waitcnt vmcnt(%1)\n\ts_branch .Lwd_%=\n.Lw8_%=:\n\ts_waitcnt vmcnt(8)\n.Lwd_%=:" :: "v"(flag), "n"(n) : "memory", "vcc")
#define PG8_WAIT_L(n) asm volatile("s_waitcnt lgkmcnt(" #n ")" ::: "memory")
#define PG8_BAR __builtin_amdgcn_s_barrier()
#define PG8_SCHED __builtin_amdgcn_sched_barrier(0)
    Unit cur, nxt; int ui = 0;
    if (!S.next(0, cur)) return;
    f32x4 acc[2][2][4][2];
#pragma unroll
    for (int a = 0; a < 2; ++a)
#pragma unroll
        for (int b = 0; b < 2; ++b)
#pragma unroll
            for (int m = 0; m < 4; ++m)
#pragma unroll
                for (int n = 0; n < 2; ++n) acc[a][b][m][n] = (f32x4){0.f, 0.f, 0.f, 0.f};
    bf16x8 At[4][2], B0[2][2], B1[2][2]; v8i_t At8[4], B08[2], B18[2];
    const char* cA = S.a_base(cur); const char* cB = S.b_base(cur);
    unsigned gA[2][2] = {{0u, 0u}, {0u, 0u}};
    if constexpr (GATHER) S.a_rows(cur, Rr, Cc, gA);
    constexpr int TOKTAB = STAGE_BYTES;
    PG8_STAGE(PG8_SB(0, 0), cB, voffB); PG8_STAGE(PG8_SB(0, 1), cB + hstep, voffB); PG8_STAGE_A(PG8_SA(0, 0), cA, 0); PG8_STAGE_A(PG8_SA(0, 1), cA, 1);
    if (wr == 1) PG8_BAR;
    PG8_WAIT_V(2); PG8_BAR;
    PG8_STAGE(PG8_SB(1, 0), cB + kstep, voffB); PG8_STAGE_A(PG8_SA(1, 0), cA + kstep, 0); PG8_STAGE(PG8_SB(1, 1), cB + hstep + kstep, voffB);
    PG8_WAIT_V(6); PG8_BAR;
    for (;;) {
        const bool has_next = S.next(ui + 1, nxt);
        const char* nA = has_next ? S.a_base(nxt) : cA; const char* nB = has_next ? S.b_base(nxt) : cB;
        if constexpr (GATHER) { if (has_next && wid == 0) __builtin_amdgcn_global_load_lds((const unsigned*)(S.tok_src(nxt) + lane * 4), (LAS unsigned*)(lds + TOKTAB), 16, 0, 0); }
        for (int t = 0; t < nt; t += 2) {
            const bool last = (t == nt - 2);
            const char* a1 = cA + (size_t)(t + 1) * kstep;
            const char* a2 = last ? nA : cA + (size_t)(t + 2) * kstep; const char* b2 = last ? nB : cB + (size_t)(t + 2) * kstep;
            const char* a3 = a2 + kstep; const char* b3 = b2 + kstep;
            const int after_epi = ((Epi::NVM > 0) && (t == 0) && (ui > 0)) ? 1 : 0;
            PG8_LDB(B0, 0, 0); PG8_LDB(B1, 0, 1); PG8_SCHED; PG8_LDA(At, 0, 0); PG8_STAGE_A(PG8_SA(1, 1), a1, 1);
            if constexpr (GATHER) { if (last && has_next) { asm volatile("" ::: "memory");
#pragma unroll
                for (int h = 0; h < 2; ++h)
#pragma unroll
                    for (int i = 0; i < 2; ++i) { unsigned tk = *(const LAS unsigned*)(lds + TOKTAB + 4 * (h * HALF + Rr[i])); tk = tk < (unsigned)(M - 1) ? tk : (unsigned)(M - 1); gA[h][i] = tk * (unsigned)rowb + (unsigned)(Cc[i] * 2); } } }
            if constexpr (Epi::NVM > 0) PG8_WAIT_SEL(after_epi, 8 + Epi::NVM); else PG8_WAIT_V(8);
            PG8_WAIT_L(0); PG8_BAR; PG8_MMA(0, 0, At, B0); PG8_MMA(0, 1, At, B1); PG8_BAR; PG8_SCHED;
            PG8_LDA(At, 0, 1); PG8_STAGE(PG8_SB(0, 0), b2, voffB); PG8_STAGE(PG8_SB(0, 1), b2 + hstep, voffB); PG8_STAGE_A(PG8_SA(0, 0), a2, 0);
            if constexpr (Epi::NVM > 0) PG8_WAIT_SEL(after_epi, 8 + Epi::NVM); else PG8_WAIT_V(8);
            PG8_WAIT_L(0); PG8_BAR; PG8_MMA(1, 0, At, B0); PG8_MMA(1, 1, At, B1); PG8_BAR; PG8_SCHED;
            PG8_LDB(B0, 1, 0); PG8_LDB(B1, 1, 1); PG8_SCHED; PG8_LDA(At, 1, 0); PG8_STAGE_A(PG8_SA(0, 1), a2, 1);
            PG8_WAIT_V(8); PG8_WAIT_L(0); PG8_BAR; PG8_MMA(0, 0, At, B0); PG8_MMA(0, 1, At, B1); PG8_BAR; PG8_SCHED;
            PG8_LDA(At, 1, 1); PG8_STAGE(PG8_SB(1, 0), b3, voffB); PG8_STAGE(PG8_SB(1, 1), b3 + hstep, voffB); PG8_STAGE_A(PG8_SA(1, 0), a3, 0);
            PG8_WAIT_V(8); PG8_WAIT_L(0); PG8_BAR; PG8_MMA(1, 0, At, B0); PG8_MMA(1, 1, At, B1); PG8_BAR; PG8_SCHED;
        }
        if (wr == 0) PG8_BAR;
        if constexpr (F8) asm volatile("s_nop 15\n\ts_nop 15" ::: "memory");
        E(acc, cur, wr, wc, fr, fq);
        if (!has_next) break;
#pragma unroll
        for (int a = 0; a < 2; ++a)
#pragma unroll
            for (int b = 0; b < 2; ++b)
#pragma unroll
                for (int m = 0; m < 4; ++m)
#pragma unroll
                    for (int n = 0; n < 2; ++n) acc[a][b][m][n] = (f32x4){0.f, 0.f, 0.f, 0.f};
        cur = nxt; cA = nA; cB = nB; ++ui;
        if (wr == 1) PG8_BAR;
    }
    PG8_WAIT_V(0);
    PG8_BAR;
#undef PG8_SA
#undef PG8_SB
#undef PG8_STAGE
#undef PG8_STAGE_A
#undef PG8_LDA
#undef PG8_LDB
#undef PG8_MMA
#undef PG8_LD8
#undef PG8_WAIT_V
#undef PG8_WAIT_SEL
#undef PG8_WAIT_L
#undef PG8_BAR
#undef PG8_SCHED
}
}

template <int Mr, int Nc, int K, bool ACCUM>
__device__ __forceinline__ void mm_lds(const LAS bf16* A, int lda, const LAS bf16* Bt, int ldb, f32x4 (&acc)[(Mr / 16) * (Nc / 16) / 8], int wave, int lane) {
    constexpr int NT = Nc / 16, TPW = (Mr / 16) * NT / 8;
    const int fr = lane & 15, fq = lane >> 4;
#pragma unroll
    for (int q = 0; q < TPW; ++q) {
        const int t = wave + 8 * q, ti = t / NT, tj = t % NT;
        f32x4 c = ACCUM ? acc[q] : (f32x4){0.f, 0.f, 0.f, 0.f};
#pragma unroll
        for (int k0 = 0; k0 < K; k0 += 32) {
            const bf16x8 a = *(const LAS bf16x8*)(A + (16 * ti + fr) * lda + k0 + 8 * fq);
            const bf16x8 b = *(const LAS bf16x8*)(Bt + (16 * tj + fr) * ldb + k0 + 8 * fq);
            c = __builtin_amdgcn_mfma_f32_16x16x32_bf16(a, b, c, 0, 0, 0);
        }
        acc[q] = c;
        if (TPW > 2) asm volatile("" ::: "memory");
    }
}
#define MM_ROW(NT, q, r) (16 * ((wave + 8 * (q)) / (NT)) + 4 * fq + (r))
#define MM_COL(NT, q)    (16 * ((wave + 8 * (q)) % (NT)) + fr)

struct Args { const float* in[25]; float* out; unsigned char* ws; int ph_lo, ph_hi; };
constexpr int NPHASE = 17;

template <bool F8>
__device__ __forceinline__ void p0_tile(const float* W, int K, int N, void* WTv, int mode, float scale, LAS unsigned* T, int item, int lane) {
    const int nblk = N / 64, kb = item / nblk, nb = item % nblk, k0 = 64 * kb, n0 = 64 * nb;
    const int row0 = mode == 0 ? n0 : ((n0 >> 7) << 8) + (n0 & 127) + (mode == 2 ? 128 : 0);
    const int g = lane >> 4, m = lane & 15;
    constexpr int P = F8 ? 17 : 33;
    f32x4 v[16];
#pragma unroll
    for (int L = 0; L < 16; ++L) { const int kk = F8 ? (16 * (L >> 2) + 4 * g + (L & 3)) : (8 * (L >> 1) + 2 * g + (L & 1)); v[L] = *(const f32x4*)(W + (size_t)(k0 + kk) * N + n0 + 4 * m); }
    if constexpr (F8) {
#pragma unroll
        for (int i = 0; i < 4; ++i)
#pragma unroll
            for (int j = 0; j < 4; ++j) { const float q0 = __builtin_amdgcn_fmed3f(v[4 * i][j] * scale, -448.f, 448.f), q1 = __builtin_amdgcn_fmed3f(v[4 * i + 1][j] * scale, -448.f, 448.f), q2 = __builtin_amdgcn_fmed3f(v[4 * i + 2][j] * scale, -448.f, 448.f), q3 = __builtin_amdgcn_fmed3f(v[4 * i + 3][j] * scale, -448.f, 448.f);
                int w = __builtin_amdgcn_cvt_pk_fp8_f32(q0, q1, 0, false); w = __builtin_amdgcn_cvt_pk_fp8_f32(q2, q3, w, true);
                T[(4 * m + j) * P + 4 * i + g] = (unsigned)w; }
    } else {
#pragma unroll
        for (int i = 0; i < 8; ++i)
#pragma unroll
            for (int j = 0; j < 4; ++j) T[(4 * m + j) * P + 4 * i + g] = pk2(v[2 * i][j], v[2 * i + 1][j]);
    }
    LDS_WAIT(); asm volatile("" ::: "memory");
    if constexpr (F8) {
        unsigned char* WT = (unsigned char*)WTv;
#pragma unroll
        for (int p = 0; p < 4; ++p) { const int n = (lane >> 2) + 16 * p, c = lane & 3; const LAS unsigned* t = T + n * P + 4 * c; u32x4 o; o.x = t[0]; o.y = t[1]; o.z = t[2]; o.w = t[3];
            *(u32x4*)(WT + (size_t)(row0 + n) * K + k0 + 16 * c) = o; }
    } else {
        bf16* WT = (bf16*)WTv;
#pragma unroll
        for (int p = 0; p < 8; ++p) { const int n = (lane >> 3) + 8 * p, c = lane & 7; const LAS unsigned* t = T + n * P + 4 * c; u32x4 o; o.x = t[0]; o.y = t[1]; o.z = t[2]; o.w = t[3];
            *(u32x4*)(WT + (size_t)(row0 + n) * K + k0 + 8 * c) = o; }
    }
    LDS_WAIT(); asm volatile("" ::: "memory");
}
__device__ __forceinline__ void rms_row_bf16(const float* xrow, const float* g, bf16* orow, int lane) {
    const f32x4* xr = (const f32x4*)xrow + lane; const f32x4* gr = (const f32x4*)g + lane;
    f32x4 v[4]; float s = 0.f;
#pragma unroll
    for (int j = 0; j < 4; ++j) { v[j] = xr[64 * j]; s += (v[j].x * v[j].x + v[j].y * v[j].y) + (v[j].z * v[j].z + v[j].w * v[j].w); }
    const float rstd = rsqrtf(wave_sum(s) * (1.f / D) + EPS);
    u32x2* o8 = (u32x2*)orow + lane;
#pragma unroll
    for (int j = 0; j < 4; ++j) { const f32x4 gv = gr[64 * j]; u32x2 w; w.x = pk2(v[j].x * rstd * gv.x, v[j].y * rstd * gv.y); w.y = pk2(v[j].z * rstd * gv.z, v[j].w * rstd * gv.w); o8[64 * j] = w; }
}

__device__ __forceinline__ void rms_res_row_bf16(const float* xin, const bf16* drow, float* xout, const float* g, bf16* orow, int lane) {
    const f32x4* xr = (const f32x4*)xin + lane; const f32x4* gr = (const f32x4*)g + lane; const u32x2* dr = (const u32x2*)drow + lane;
    f32x4 v[4]; u32x2 dv[4]; float s = 0.f;
#pragma unroll
    for (int j = 0; j < 4; ++j) { v[j] = xr[64 * j]; dv[j] = dr[64 * j]; }
#pragma unroll
    for (int j = 0; j < 4; ++j) { v[j].x += bf2f(dv[j].x); v[j].y += bf2f(dv[j].x >> 16); v[j].z += bf2f(dv[j].y); v[j].w += bf2f(dv[j].y >> 16);
        ((f32x4*)xout + lane)[64 * j] = v[j]; s += (v[j].x * v[j].x + v[j].y * v[j].y) + (v[j].z * v[j].z + v[j].w * v[j].w); }
    const float rstd = rsqrtf(wave_sum(s) * (1.f / D) + EPS);
    u32x2* o8 = (u32x2*)orow + lane;
#pragma unroll
    for (int j = 0; j < 4; ++j) { const f32x4 gv = gr[64 * j]; u32x2 w; w.x = pk2(v[j].x * rstd * gv.x, v[j].y * rstd * gv.y); w.y = pk2(v[j].z * rstd * gv.z, v[j].w * rstd * gv.w); o8[64 * j] = w; }
}
__device__ __forceinline__ void rms_res_row2_bf16(const float* xin, const bf16* drow, float* xout, const float* g, bf16* orow, size_t rstride, int lane) {
    const f32x4* gr = (const f32x4*)g + lane;
    f32x4 v[2][4]; u32x2 dv[2][4]; float s[2] = {0.f, 0.f};
#pragma unroll
    for (int r = 0; r < 2; ++r)
#pragma unroll
        for (int j = 0; j < 4; ++j) { v[r][j] = ((const f32x4*)(xin + r * rstride) + lane)[64 * j]; dv[r][j] = ((const u32x2*)(drow + r * rstride) + lane)[64 * j]; }
#pragma unroll
    for (int r = 0; r < 2; ++r)
#pragma unroll
        for (int j = 0; j < 4; ++j) { v[r][j].x += bf2f(dv[r][j].x); v[r][j].y += bf2f(dv[r][j].x >> 16); v[r][j].z += bf2f(dv[r][j].y); v[r][j].w += bf2f(dv[r][j].y >> 16);
            ((f32x4*)(xout + r * rstride) + lane)[64 * j] = v[r][j]; s[r] += (v[r][j].x * v[r][j].x + v[r][j].y * v[r][j].y) + (v[r][j].z * v[r][j].z + v[r][j].w * v[r][j].w); }
#pragma unroll
    for (int r = 0; r < 2; ++r) { const float rstd = rsqrtf(wave_sum(s[r]) * (1.f / D) + EPS);
        u32x2* o8 = (u32x2*)(orow + r * rstride) + lane;
#pragma unroll
        for (int j = 0; j < 4; ++j) { const f32x4 gv = gr[64 * j]; u32x2 w; w.x = pk2(v[r][j].x * rstd * gv.x, v[r][j].y * rstd * gv.y); w.y = pk2(v[r][j].z * rstd * gv.z, v[r][j].w * rstd * gv.w); o8[64 * j] = w; } }
}

struct RetPf { u32x4 q1, q2, k1, k2, v1, v2, g1, g2; f32x4 r0, r1, r2, r3; };
template <bool NEEDQ>
__device__ __forceinline__ void ret_load(RetPf& pf, const bf16* proj, const f32x2* ROT, size_t row0, int tpos0, int h, int tid) {
    const int j = tid >> 3, seg = tid & 7;
    const bf16* prow = proj + (row0 + j) * EVEN_IN + 128 * h;
    pf.k1 = *(const u32x4*)(prow + RK_OFF + 8 * seg); pf.k2 = *(const u32x4*)(prow + RK_OFF + 64 + 8 * seg);
    pf.v1 = *(const u32x4*)(prow + RV_OFF + 16 * seg); pf.v2 = *(const u32x4*)(prow + RV_OFF + 16 * seg + 8);
    if constexpr (NEEDQ) { pf.q1 = *(const u32x4*)(prow + RQ_OFF + 8 * seg); pf.q2 = *(const u32x4*)(prow + RQ_OFF + 64 + 8 * seg);
        pf.g1 = *(const u32x4*)(prow + RGATE_OFF + 16 * seg); pf.g2 = *(const u32x4*)(prow + RGATE_OFF + 16 * seg + 8); }
    const f32x4* rp = (const f32x4*)(ROT + (size_t)(tpos0 + j) * 64 + 8 * seg);
    pf.r0 = rp[0]; pf.r1 = rp[1]; pf.r2 = rp[2]; pf.r3 = rp[3];
}
template <bool NEEDQ>
__device__ __forceinline__ void ret_write(const RetPf& pf, float l2g, LAS bf16* rQ, LAS bf16* rK, LAS bf16* rKdT, LAS bf16* rVT, LAS bf16* rG, int tid) {
    constexpr int LQ = 136, LT = 72;
    const int j = tid >> 3, seg = tid & 7;
    const float cs[16] = {pf.r0.x, pf.r0.y, pf.r0.z, pf.r0.w, pf.r1.x, pf.r1.y, pf.r1.z, pf.r1.w, pf.r2.x, pf.r2.y, pf.r2.z, pf.r2.w, pf.r3.x, pf.r3.y, pf.r3.z, pf.r3.w};
    const unsigned k1w[4] = {pf.k1.x, pf.k1.y, pf.k1.z, pf.k1.w}, k2w[4] = {pf.k2.x, pf.k2.y, pf.k2.z, pf.k2.w}, v1w[4] = {pf.v1.x, pf.v1.y, pf.v1.z, pf.v1.w}, v2w[4] = {pf.v2.x, pf.v2.y, pf.v2.z, pf.v2.w};
    const float dec = exp2f((float)(63 - j) * l2g);
    unsigned qa[4], qb[4], ka[4], kb[4];
#pragma unroll
    for (int w = 0; w < 4; ++w) {
        float kr1[2], kr2[2], qr1[2] = {0.f, 0.f}, qr2[2] = {0.f, 0.f};
#pragma unroll
        for (int x = 0; x < 2; ++x) { const int c = 2 * w + x; const float co = cs[2 * c], si = cs[2 * c + 1];
            const float a = bf2f(k1w[w] >> (16 * x)) * 0.08838834764831845f, b = bf2f(k2w[w] >> (16 * x)) * 0.08838834764831845f;
            kr1[x] = a * co - b * si; kr2[x] = a * si + b * co;
            rKdT[(8 * seg + c) * LT + j] = (bf16)f2bf(kr1[x] * dec); rKdT[(64 + 8 * seg + c) * LT + j] = (bf16)f2bf(kr2[x] * dec);
            if constexpr (NEEDQ) { const unsigned q1w = w == 0 ? pf.q1.x : (w == 1 ? pf.q1.y : (w == 2 ? pf.q1.z : pf.q1.w)), q2w = w == 0 ? pf.q2.x : (w == 1 ? pf.q2.y : (w == 2 ? pf.q2.z : pf.q2.w));
                const float qa_ = bf2f(q1w >> (16 * x)), qb_ = bf2f(q2w >> (16 * x)); qr1[x] = qa_ * co - qb_ * si; qr2[x] = qa_ * si + qb_ * co; }
            rVT[(16 * seg + c) * LT + j] = (bf16)((v1w[w] >> (16 * x)) & 0xffffu); rVT[(16 * seg + 8 + c) * LT + j] = (bf16)((v2w[w] >> (16 * x)) & 0xffffu); }
        if constexpr (NEEDQ) { ka[w] = pk2(kr1[0], kr1[1]); kb[w] = pk2(kr2[0], kr2[1]); qa[w] = pk2(qr1[0], qr1[1]); qb[w] = pk2(qr2[0], qr2[1]); }
    }
    if constexpr (NEEDQ) {
        u32x4 t; t.x = qa[0]; t.y = qa[1]; t.z = qa[2]; t.w = qa[3]; *(LAS u32x4*)(rQ + j * LQ + 8 * seg) = t;
        t.x = qb[0]; t.y = qb[1]; t.z = qb[2]; t.w = qb[3]; *(LAS u32x4*)(rQ + j * LQ + 64 + 8 * seg) = t;
        t.x = ka[0]; t.y = ka[1]; t.z = ka[2]; t.w = ka[3]; *(LAS u32x4*)(rK + j * LQ + 8 * seg) = t;
        t.x = kb[0]; t.y = kb[1]; t.z = kb[2]; t.w = kb[3]; *(LAS u32x4*)(rK + j * LQ + 64 + 8 * seg) = t;
        *(LAS u32x4*)(rG + j * LQ + 16 * seg) = pf.g1; *(LAS u32x4*)(rG + j * LQ + 16 * seg + 8) = pf.g2;
    }
}

__global__ void __launch_bounds__(512, 2) fwd_kernel(Args args) {
    extern __shared__ __attribute__((aligned(16))) unsigned char lds_raw[];
    LAS unsigned char* lds = (LAS unsigned char*)lds_raw;
    volatile LAS unsigned* MISC = (volatile LAS unsigned*)(lds + LDS_MISC);
    LAS unsigned char* scrb = lds + LDS_SCR;
    const int tid = threadIdx.x, lane = tid & 63, wave = __builtin_amdgcn_readfirstlane(tid >> 6);
    const int G = gridDim.x, bid = blockIdx.x;
    const int fr = lane & 15, fq = lane >> 4;
    unsigned char* ws = args.ws;
    unsigned* ctl = (unsigned*)(ws + WS_CTL);
    float* out = args.out;
    const int lo = args.ph_lo, hi = args.ph_hi;

    if (tid < 64) MISC[tid] = 0u;
    __syncthreads();
    XcdBarrier bar; bar.bar = ctl + CW_BAR; bar.x = 0; bar.st = MISC;
    if (hi - lo > 1) bar = xcd_barrier_post(ctl + CW_BAR, MISC);
#ifndef PHASE_MASK
#define PHASE_MASK 0x1ffff
#endif
#define IN(k) ((((PHASE_MASK) >> (k)) & 1) && lo <= (k) && (k) < hi)
#define SEAM(k) do { if (IN(k) && IN((k) + 1)) xcd_barrier(bar); PSTAMP((k) + 1); } while (0)
#define PSTAMP(k) do { if (PROBE_A_LO >= 0 && bid == 0 && tid == 0) { const unsigned _t = (unsigned)wall_clock64(); if ((k) == PROBE_A_LO) MISC[8] = _t; if ((k) == PROBE_A_HI + 1) MISC[9] = _t; if ((k) == PROBE_B_LO) MISC[10] = _t; if ((k) == PROBE_B_HI + 1) MISC[11] = _t; } } while (0)
    PSTAMP(0);

    bf16* const ACTA = (bf16*)(ws + WS_ACTA);
    bf16* const ACTB = (bf16*)(ws + WS_ACTB);
    const f32x2* const ROT = (const f32x2*)(ws + WS_ROT);
    const int gw = bid * 8 + wave, NGW = G * 8;

    if (IN(0)) {
        LAS unsigned* scr = (LAS unsigned*)(scrb + wave * 16384);
        constexpr int I_IN0 = 16 * 56, I_OUT = 16 * 16, I_FF = 16 * 44, I_DN0 = 44 * 16, I_IN1 = 16 * 40, I_EXP = 16 * 56, I_EDN = 56 * 16;
        constexpr int NITEMS = I_IN0 + I_OUT + 2 * I_FF + I_DN0 + I_IN1 + I_OUT + 2 * 8 * I_EXP + 8 * I_EDN;
        for (int it = gw; it < NITEMS; it += NGW) {
            int r = it;
            if (r < 8 * I_EXP) { const int e = r / I_EXP; p0_tile<true>(args.in[22] + (size_t)e * D * D_EXP, D, D_EXP, ws + WT_GU1 + (size_t)e * 2 * D_EXP * D, 1, 64.f, scr, r % I_EXP, lane); continue; } r -= 8 * I_EXP;
            if (r < 8 * I_EXP) { const int e = r / I_EXP; p0_tile<true>(args.in[23] + (size_t)e * D * D_EXP, D, D_EXP, ws + WT_GU1 + (size_t)e * 2 * D_EXP * D, 2, 64.f, scr, r % I_EXP, lane); continue; } r -= 8 * I_EXP;
            if (r < 8 * I_EDN) { const int e = r / I_EDN; p0_tile<true>(args.in[24] + (size_t)e * D_EXP * D, D_EXP, D, ws + WT_DN1 + (size_t)e * D * D_EXP, 0, 64.f, scr, r % I_EDN, lane); continue; } r -= 8 * I_EDN;
            if (r < I_IN0) { p0_tile<false>(args.in[4], D, EVEN_IN, (bf16*)(ws + WT_IN0), 0, 1.f, scr, r, lane); continue; } r -= I_IN0;
            if (r < I_OUT) { p0_tile<false>(args.in[6], D, D, (bf16*)(ws + WT_OUT0), 0, 1.f, scr, r, lane); continue; } r -= I_OUT;
            if (r < I_FF) { p0_tile<false>(args.in[7], D, D_FF, (bf16*)(ws + WT_GU0), 1, 1.f, scr, r, lane); continue; } r -= I_FF;
            if (r < I_FF) { p0_tile<false>(args.in[8], D, D_FF, (bf16*)(ws + WT_GU0), 2, 1.f, scr, r, lane); continue; } r -= I_FF;
            if (r < I_DN0) { p0_tile<false>(args.in[9], D_FF, D, (bf16*)(ws + WT_DN0), 0, 1.f, scr, r, lane); continue; } r -= I_DN0;
            if (r < I_IN1) { p0_tile<false>(args.in[10], D, ODD_IN, (bf16*)(ws + WT_IN1), 0, 1.f, scr, r, lane); continue; } r -= I_IN1;
            p0_tile<false>(args.in[19], D, D, (bf16*)(ws + WT_OUT1), 0, 1.f, scr, r, lane);
        }
        for (int idx = bid * 512 + tid; idx < SEQ * 64; idx += G * 512) {
            const int t = idx >> 6, i = idx & 63;
            const float inv_freq = exp2f(-(float)i * (13.287712379549449f / 64.0f));
            double rev = (double)t * (double)inv_freq * 0.15915494309189535; rev -= floor(rev);
            const float rv = (float)rev;
            f32x2 cs; cs.x = __builtin_amdgcn_cosf(rv); cs.y = __builtin_amdgcn_sinf(rv);
            ((f32x2*)(ws + WS_ROT))[idx] = cs;
        }
        for (int m = gw; m < M; m += NGW) rms_row_bf16(args.in[0] + (size_t)m * D, args.in[1], ACTA + (size_t)m * D, lane);
    }
    SEAM(0);

    if (IN(1)) {
        pg8::DenseSched S; S.init(ACTA, (const bf16*)(ws + WT_IN0), M, EVEN_IN, D, G, bid);
        pg8::EpiStoreBf16 E{ACTB, EVEN_IN};
        pg8::gemm_phase<pg8::EpiStoreBf16, pg8::DenseSched, false>(scrb, 2 * D, S, E);
    }
    SEAM(1);

    constexpr int LQ = 136, LT = 72;
    LAS bf16* const rQ = (LAS bf16*)(scrb);
    LAS bf16* const rK = (LAS bf16*)(scrb + 17408);
    LAS bf16* const rKdT = (LAS bf16*)(scrb + 34816);
    LAS bf16* const rVT = (LAS bf16*)(scrb + 53248);
    LAS bf16* const rS = (LAS bf16*)(scrb + 71680);
    LAS bf16* const rStT = (LAS bf16*)(scrb + 80896);
    LAS float* const rStat = (LAS float*)(scrb + 115712);
    LAS bf16* const rG = (LAS bf16*)(scrb + 120320);
    float* const RGS = (float*)(ws + WS_SCR);

    if (IN(2)) {
        for (int item = bid; item < 256; item += G) {
            const int b = item >> 5, h = (item >> 3) & 3, g = item & 7;
            const float l2g = log2f(1.0f - exp2f(-5.0f - (float)h));
            const float g64 = exp2f(64.0f * l2g);
            f32x4 st[8];
#pragma unroll
            for (int q = 0; q < 8; ++q) st[q] = (f32x4){0.f, 0.f, 0.f, 0.f};
            RetPf pf;
            ret_load<false>(pf, ACTB, ROT, (size_t)b * SEQ + (g * 8) * 64, (g * 8) * 64, h, tid);
            for (int n = 0; n < 8; ++n) {
                ret_write<false>(pf, l2g, rQ, rK, rKdT, rVT, rG, tid);
                if (n < 7) { const int tposn = (g * 8 + n + 1) * 64; ret_load<false>(pf, ACTB, ROT, (size_t)b * SEQ + tposn, tposn, h, tid); }
                __syncthreads();
#pragma unroll
                for (int q = 0; q < 8; ++q) st[q] = st[q] * g64;
                mm_lds<128, 128, 64, true>(rKdT, LT, rVT, LT, st, wave, lane);
                __syncthreads();
            }
            float* gp = RGS + (size_t)item * 16384 + tid;
#pragma unroll
            for (int q = 0; q < 8; ++q)
#pragma unroll
                for (int r = 0; r < 4; ++r) gp[(q * 4 + r) * 512] = st[q][r];
        }
        {
            __syncthreads();
            constexpr int PV = 80;
            LAS bf16* const sV = (LAS bf16*)(scrb + wave * 10240);
            const int vkey = lane >> 3, vpc = lane & 7;
            for (int wi = bid * 8 + wave; wi < NB * 8 * 256; wi += G * 8) {
                const int qt = 255 - (wi & 255), h = (wi >> 8) & 7, b = wi >> 11;
                const size_t brow = (size_t)b * SEQ;
                const int tq = 16 * qt + fr;
                bf16x8 qf[2];
#pragma unroll
                for (int ks = 0; ks < 2; ++ks) qf[ks] = *(const bf16x8*)(ACTB + (brow + tq) * EVEN_IN + SQ_OFF + 64 * h + 32 * ks + 8 * fq);
                f32x4 ot[4];
#pragma unroll
                for (int dt = 0; dt < 4; ++dt) ot[dt] = (f32x4){0.f, 0.f, 0.f, 0.f};
                float C = 1.0f;
                int kt = qt >> 2;
                bf16x8 kf[4][2]; u32x4 vr[8];
#pragma unroll
                for (int tj = 0; tj < 4; ++tj)
#pragma unroll
                    for (int ks = 0; ks < 2; ++ks) kf[tj][ks] = *(const bf16x8*)(ACTB + (brow + 64 * kt + 16 * tj + fr) * EVEN_IN + SK_OFF + 64 * h + 32 * ks + 8 * fq);
#pragma unroll
                for (int i = 0; i < 8; ++i) vr[i] = *(const u32x4*)(ACTB + (brow + 64 * kt + 8 * i + vkey) * EVEN_IN + SV_OFF + 64 * h + 8 * vpc);
                for (;;) {
#pragma unroll
                    for (int i = 0; i < 8; ++i) { LAS u32x2* d = (LAS u32x2*)(sV + (8 * i + vkey) * PV + 8 * vpc); u32x2 lo, hi; lo.x = vr[i].x; lo.y = vr[i].y; hi.x = vr[i].z; hi.y = vr[i].w; d[0] = lo; d[1] = hi; }
                    f32x4 zt[4];
#pragma unroll
                    for (int tj = 0; tj < 4; ++tj) { zt[tj] = __builtin_amdgcn_mfma_f32_16x16x32_bf16(kf[tj][0], qf[0], (f32x4){0.f, 0.f, 0.f, 0.f}, 0, 0, 0); zt[tj] = __builtin_amdgcn_mfma_f32_16x16x32_bf16(kf[tj][1], qf[1], zt[tj], 0, 0, 0); }
                    const int ktn = kt - 1;
                    if (ktn >= 0) {
#pragma unroll
                        for (int tj = 0; tj < 4; ++tj)
#pragma unroll
                            for (int ks = 0; ks < 2; ++ks) kf[tj][ks] = *(const bf16x8*)(ACTB + (brow + 64 * ktn + 16 * tj + fr) * EVEN_IN + SK_OFF + 64 * h + 32 * ks + 8 * fq);
#pragma unroll
                        for (int i = 0; i < 8; ++i) vr[i] = *(const u32x4*)(ACTB + (brow + 64 * ktn + 8 * i + vkey) * EVEN_IN + SV_OFF + 64 * h + 8 * vpc);
                    }
                    float a[4][4], pseg[4];
#pragma unroll
                    for (int tj = 0; tj < 4; ++tj) { float suf = 1.0f;
#pragma unroll
                        for (int r = 3; r >= 0; --r) { const int sk = 64 * kt + 16 * tj + 4 * fq + r; const bool valid = sk < tq;
                            const float pp = __builtin_amdgcn_rcpf(1.0f + __builtin_amdgcn_exp2f(zt[tj][r] * (0.125f * 1.4426950408889634f)));
                            const float p = valid ? pp : 1.0f, be = valid ? 1.0f - pp : 0.0f; a[tj][r] = be * suf; suf *= p; }
                        pseg[tj] = suf; }
                    float run = C;
#pragma unroll
                    for (int tj = 3; tj >= 0; --tj) { const float y = __shfl_xor(pseg[tj], 16); const float pair = pseg[tj] * y; const float zz = __shfl_xor(pair, 32);
                        const float S = ((fq & 1) ? 1.0f : y) * ((fq & 2) ? 1.0f : zz); const float sc = S * run;
#pragma unroll
                        for (int r = 0; r < 4; ++r) a[tj][r] *= sc;
                        run *= pair * zz; }
                    C = run;
                    bf16x8 af[2];
#pragma unroll
                    for (int ks = 0; ks < 2; ++ks) { u32x4 w; w.x = pk2(a[2 * ks][0], a[2 * ks][1]); w.y = pk2(a[2 * ks][2], a[2 * ks][3]); w.z = pk2(a[2 * ks + 1][0], a[2 * ks + 1][1]); w.w = pk2(a[2 * ks + 1][2], a[2 * ks + 1][3]); af[ks] = __builtin_bit_cast(bf16x8, w); }
                    LDS_WAIT(); asm volatile("" ::: "memory");
#pragma unroll
                    for (int dt = 0; dt < 4; ++dt)
#pragma unroll
                        for (int ks = 0; ks < 2; ++ks) {
                            const LAS v4s_t* tp = (const LAS v4s_t*)(sV + (32 * ks + 4 * fq + (fr >> 2)) * PV + 16 * dt + 4 * (fr & 3));
                            const v4s_t lo = __builtin_amdgcn_ds_read_tr16_b64_v4i16((LAS v4s_t*)tp), hi = __builtin_amdgcn_ds_read_tr16_b64_v4i16((LAS v4s_t*)(tp + 4 * PV));
                            const bf16x8 vf = __builtin_shufflevector(lo, hi, 0, 1, 2, 3, 4, 5, 6, 7);
                            ot[dt] = __builtin_amdgcn_mfma_f32_16x16x32_bf16(vf, af[ks], ot[dt], 0, 0, 0); }
                    LDS_WAIT(); asm volatile("" ::: "memory");
                    if (ktn < 0 || __all(C < 1e-30f)) break;
                    kt = ktn;
                }
#pragma unroll
                for (int dt = 0; dt < 4; ++dt) { u32x2 w; w.x = pk2(ot[dt][0], ot[dt][1]); w.y = pk2(ot[dt][2], ot[dt][3]);
                    *(u32x2*)(ACTA + (brow + tq) * D + 512 + 64 * h + 16 * dt + 4 * fq) = w; }
            }
        }
    }
    SEAM(2);

    if (IN(3)) {
        const int fr0 = fr, fq0 = fq;
        for (int item = bid; item < 256; item += G) {
            const int b = item >> 5, h = (item >> 3) & 3, g = item & 7;
            const float l2g = log2f(1.0f - exp2f(-5.0f - (float)h));
            const float g64 = exp2f(64.0f * l2g), g512 = exp2f(512.0f * l2g);
            f32x4 st[8];
#pragma unroll
            for (int q = 0; q < 8; ++q) st[q] = (f32x4){0.f, 0.f, 0.f, 0.f};
            for (int gp_ = 0; gp_ < g; ++gp_) {
                const float* gp = RGS + (size_t)(item - g + gp_) * 16384 + tid;
#pragma unroll
                for (int q = 0; q < 8; ++q)
#pragma unroll
                    for (int r = 0; r < 4; ++r) st[q][r] = st[q][r] * g512 + gp[(q * 4 + r) * 512];
            }
            RetPf pf;
            ret_load<true>(pf, ACTB, ROT, (size_t)b * SEQ + (g * 8) * 64, (g * 8) * 64, h, tid);
            for (int n = 0; n < 8; ++n) {
                int tid_l = tid, fr_l = fr0, fq_l = fq0;
                asm volatile("" : "+v"(tid_l), "+v"(fr_l), "+v"(fq_l));
                { const int fr = fr_l, fq = fq_l, lane = (fq_l << 4) | fr_l;
                const int tpos0 = (g * 8 + n) * 64; const size_t row0 = (size_t)b * SEQ + tpos0;
                __syncthreads();
                ret_write<true>(pf, l2g, rQ, rK, rKdT, rVT, rG, tid_l);
                if (n < 7) { const int tposn = tpos0 + 64; ret_load<true>(pf, ACTB, ROT, (size_t)b * SEQ + tposn, tposn, h, tid_l); }
#pragma unroll
                for (int q = 0; q < 8; ++q) { u32x2 w; w.x = pk2(st[q][0], st[q][1]); w.y = pk2(st[q][2], st[q][3]);
                    *(LAS u32x2*)(rStT + MM_COL(8, q) * LQ + 16 * q + 4 * fq) = w; }
                __syncthreads();
                { f32x4 sT[2]; mm_lds<64, 64, 128, false>(rK, LQ, rQ, LQ, sT, wave, lane);
                  const int i = MM_COL(4, 0);
#pragma unroll
                  for (int q = 0; q < 2; ++q) { const int j0 = MM_ROW(4, q, 0); float e4[4];
#pragma unroll
                      for (int r = 0; r < 4; ++r) { const int dd = i > j0 + r ? i - j0 - r : j0 + r - i; e4[r] = sT[q][r] * exp2f((float)dd * l2g); }
                      u32x2 w; w.x = pk2(e4[0], e4[1]); w.y = pk2(e4[2], e4[3]); *(LAS u32x2*)(rS + i * LT + j0) = w; } }
                __syncthreads();
                f32x4 oi[4];
                mm_lds<128, 64, 128, false>(rStT, LQ, rQ, LQ, oi, wave, lane);
                const int io = MM_COL(4, 0);
                { const float gi1 = exp2f((float)(io + 1) * l2g);
#pragma unroll
                  for (int q = 0; q < 4; ++q) oi[q] = oi[q] * gi1; }
                mm_lds<128, 64, 64, true>(rVT, LT, rS, LT, oi, wave, lane);
                { float s1 = 0.f, s2 = 0.f;
#pragma unroll
                  for (int q = 0; q < 4; ++q)
#pragma unroll
                      for (int r = 0; r < 4; ++r) { s1 += oi[q][r]; s2 += oi[q][r] * oi[q][r]; }
                  s1 += __shfl_xor(s1, 16); s2 += __shfl_xor(s2, 16); s1 += __shfl_xor(s1, 32); s2 += __shfl_xor(s2, 32);
                  if (fq == 0) { rStat[(io * 2 + (wave >> 2)) * 2] = s1; rStat[(io * 2 + (wave >> 2)) * 2 + 1] = s2; } }
                __syncthreads();
                { const float s1 = rStat[(io * 2) * 2] + rStat[(io * 2 + 1) * 2], s2 = rStat[(io * 2) * 2 + 1] + rStat[(io * 2 + 1) * 2 + 1];
                  const float mu = s1 * (1.0f / 128.0f); float var = s2 * (1.0f / 128.0f) - mu * mu; var = var < 0.f ? 0.f : var; const float rstd = rsqrtf(var + EPS);
#pragma unroll
                  for (int q = 0; q < 4; ++q) { const int e0 = MM_ROW(4, q, 0);
                      const u32x2 gt = *(const LAS u32x2*)(rG + io * LQ + e0); const f32x4 gw4 = *(const f32x4*)(args.in[5] + 128 * h + e0);
                      const float g0 = bf2f(gt.x), g1 = bf2f(gt.x >> 16), g2 = bf2f(gt.y), g3 = bf2f(gt.y >> 16);
                      u32x2 w; w.x = pk2((oi[q][0] - mu) * rstd * gw4.x * g0 * sigmoidf_(g0), (oi[q][1] - mu) * rstd * gw4.y * g1 * sigmoidf_(g1));
                      w.y = pk2((oi[q][2] - mu) * rstd * gw4.z * g2 * sigmoidf_(g2), (oi[q][3] - mu) * rstd * gw4.w * g3 * sigmoidf_(g3));
                      *(LAS u32x2*)(rQ + io * LQ + e0) = w; } }
#pragma unroll
                for (int q = 0; q < 8; ++q) st[q] = st[q] * g64;
                mm_lds<128, 128, 64, true>(rKdT, LT, rVT, LT, st, wave, lane);
                __syncthreads();
                { const int j = tid_l >> 3, seg = tid_l & 7; bf16* yp = ACTA + (row0 + j) * D + 128 * h + 16 * seg;
                  *(u32x4*)yp = *(const LAS u32x4*)(rQ + j * LQ + 16 * seg); *(u32x4*)(yp + 8) = *(const LAS u32x4*)(rQ + j * LQ + 16 * seg + 8); }
                }
            }
        }
    }
    SEAM(3);

    if (IN(4)) {
        pg8::DenseSched S; S.init(ACTA, (const bf16*)(ws + WT_OUT0), M, D, D, G, bid);
#if OLD_DENSE
        pg8::EpiResF32 E{args.in[0], out, D};
        pg8::gemm_phase<pg8::EpiResF32, pg8::DenseSched, false>(scrb, 2 * D, S, E);
#else
        pg8::EpiStoreBf16 E{ACTB, D};
        pg8::gemm_phase<pg8::EpiStoreBf16, pg8::DenseSched, false>(scrb, 2 * D, S, E);
#endif
    }
    SEAM(4);
#if OLD_DENSE
    if (IN(5)) { for (int m = gw; m < M; m += NGW) rms_row_bf16(out + (size_t)m * D, args.in[2], ACTA + (size_t)m * D, lane); }
#else
    if (IN(5)) { for (int m = gw; m < M; m += 2 * NGW) { if (m + NGW < M) rms_res_row2_bf16(args.in[0] + (size_t)m * D, ACTB + (size_t)m * D, out + (size_t)m * D, args.in[2], ACTA + (size_t)m * D, (size_t)NGW * D, lane);
            else rms_res_row_bf16(args.in[0] + (size_t)m * D, ACTB + (size_t)m * D, out + (size_t)m * D, args.in[2], ACTA + (size_t)m * D, lane); } }
#endif
    SEAM(5);
    if (IN(6)) {
        pg8::DenseSched S; S.init(ACTA, (const bf16*)(ws + WT_GU0), M, 2 * D_FF, D, G, bid);
        pg8::EpiSwiGLU E{ACTB, D_FF};
        pg8::gemm_phase<pg8::EpiSwiGLU, pg8::DenseSched, false>(scrb, 2 * D, S, E);
    }
    SEAM(6);
    if (IN(7)) {
        pg8::DenseSched S; S.init(ACTB, (const bf16*)(ws + WT_DN0), M, D, D_FF, G, bid);
#if OLD_DENSE
        pg8::EpiResF32 E{out, out, D};
        pg8::gemm_phase<pg8::EpiResF32, pg8::DenseSched, false>(scrb, 2 * D_FF, S, E);
#else
        pg8::EpiStoreBf16 E{ACTA, D};
        pg8::gemm_phase<pg8::EpiStoreBf16, pg8::DenseSched, false>(scrb, 2 * D_FF, S, E);
#endif
    }
    SEAM(7);
#if OLD_DENSE
    if (IN(8)) { for (int m = gw; m < M; m += NGW) rms_row_bf16(out + (size_t)m * D, args.in[1] + D, ACTA + (size_t)m * D, lane); }
#else
    if (IN(8)) { for (int m = gw; m < M; m += 2 * NGW) { if (m + NGW < M) rms_res_row2_bf16(out + (size_t)m * D, ACTA + (size_t)m * D, out + (size_t)m * D, args.in[1] + D, ACTA + (size_t)m * D, (size_t)NGW * D, lane);
            else rms_res_row_bf16(out + (size_t)m * D, ACTA + (size_t)m * D, out + (size_t)m * D, args.in[1] + D, ACTA + (size_t)m * D, lane); } }
#endif
    SEAM(8);
    if (IN(9)) {
        pg8::DenseSched S; S.init(ACTA, (const bf16*)(ws + WT_IN1), M, ODD_IN, D, G, bid);
        pg8::EpiStoreBf16 E{ACTB, ODD_IN};
        pg8::gemm_phase<pg8::EpiStoreBf16, pg8::DenseSched, false>(scrb, 2 * D, S, E);
    }
    SEAM(9);

    float* const LSUM = (float*)(ws + WS_SCR);
#pragma unroll
    for (int pass = 0; pass < 2; ++pass) {
        if (IN(10 + pass)) {
            LAS bf16* const XR = (LAS bf16*)(scrb + wave * 17408);
            LAS float* const AB = (LAS float*)(scrb + wave * 17408 + 9216);
            const int head = wave, ch = 64 * head + lane;
            bf16x8 Bwa[4][2], Bwx[4][2];
#pragma unroll
            for (int tj = 0; tj < 4; ++tj)
#pragma unroll
                for (int ks = 0; ks < 2; ++ks) { bf16x8 va, vx;
#pragma unroll
                    for (int e = 0; e < 8; ++e) { const int i = 32 * ks + 8 * fq + e, j = 16 * tj + fr; va[e] = (short)f2bf(args.in[14][(size_t)(head * 64 + i) * 64 + j]); vx[e] = (short)f2bf(args.in[16][(size_t)(head * 64 + i) * 64 + j]); }
                    Bwa[tj][ks] = va; Bwx[tj][ks] = vx; }
            float cba[4], cbx[4], csp[4];
#pragma unroll
            for (int tj = 0; tj < 4; ++tj) { const int c = 64 * head + 16 * tj + fr; cba[tj] = args.in[15][c]; cbx[tj] = args.in[17][c]; csp[tj] = log1pf(__expf(-args.in[18][c])); }
            const float cw0 = args.in[12][ch], cw1 = args.in[12][512 + ch], cw2 = args.in[12][1024 + ch], cw3 = args.in[12][1536 + ch], cbias = args.in[13][ch];
            for (int it = bid; it < NB * 64; it += G) {
                const int b = it >> 6, c = it & 63; const size_t row0 = (size_t)b * SEQ + 64 * c;
                { float x0 = 0.f, x1 = 0.f, x2 = 0.f;
                  const bf16* xp = ACTB + row0 * ODD_IN + XR_OFF + ch;
                  if (c > 0) { x0 = bf2f(xp[-3 * ODD_IN]); x1 = bf2f(xp[-2 * ODD_IN]); x2 = bf2f(xp[-1 * ODD_IN]); }
                  for (int tb = 0; tb < 64; tb += 16) {
                      bf16 xv[16];
#pragma unroll
                      for (int u = 0; u < 16; ++u) xv[u] = xp[(size_t)(tb + u) * ODD_IN];
#pragma unroll
                      for (int u = 0; u < 16; ++u) { const float x3 = bf2f(xv[u]);
                          XR[(tb + u) * LT + lane] = (bf16)f2bf(cw0 * x0 + cw1 * x1 + cw2 * x2 + cw3 * x3 + cbias); x0 = x1; x1 = x2; x2 = x3; } } }
                float hst = 0.f, cum = 1.f;
                if (pass == 1) {
                    for (int c0 = 0; c0 < c; c0 += 8) {
                        f32x2 sv[8];
#pragma unroll
                        for (int k = 0; k < 8; ++k) { const int cc = (c0 + k < c) ? c0 + k : c0; sv[k] = ((const f32x2*)LSUM)[(size_t)(b * 64 + cc) * 512 + ch]; }
#pragma unroll
                        for (int k = 0; k < 8; ++k) if (c0 + k < c) hst = sv[k].x * hst + sv[k].y;
                    }
                }
                LDS_WAIT(); asm volatile("" ::: "memory");
                for (int sb = 0; sb < 4; ++sb) {
                    f32x4 aR[4], aX[4];
#pragma unroll
                    for (int tj = 0; tj < 4; ++tj) { aR[tj] = (f32x4){0.f, 0.f, 0.f, 0.f}; aX[tj] = aR[tj]; }
#pragma unroll
                    for (int ks = 0; ks < 2; ++ks) { const bf16x8 af = *(const LAS bf16x8*)(XR + (16 * sb + fr) * LT + 32 * ks + 8 * fq);
#pragma unroll
                        for (int tj = 0; tj < 4; ++tj) { aR[tj] = __builtin_amdgcn_mfma_f32_16x16x32_bf16(af, Bwa[tj][ks], aR[tj], 0, 0, 0); aX[tj] = __builtin_amdgcn_mfma_f32_16x16x32_bf16(af, Bwx[tj][ks], aX[tj], 0, 0, 0); } }
#pragma unroll
                    for (int tj = 0; tj < 4; ++tj)
#pragma unroll
                        for (int r = 0; r < 4; ++r) { const int tl = 4 * fq + r, j = 16 * tj + fr;
                            const float rg = sigmoidf_(aR[tj][r] + cba[tj]), ig = sigmoidf_(aX[tj][r] + cbx[tj]);
                            const float la = -8.0f * rg * csp[tj]; const float a = __expf(la); const float mult = sqrtf(-expm1f(2.0f * la));
                            const float xv = bf2f(XR[(16 * sb + tl) * LT + j]);
                            AB[tl * 64 + j] = a; AB[1024 + tl * 64 + j] = mult * ig * xv; }
                    LDS_WAIT(); asm volatile("" ::: "memory");
                    if (pass == 1) {
                        bf16 gv[16];
#pragma unroll
                        for (int tl = 0; tl < 16; ++tl) gv[tl] = ACTB[(row0 + 16 * sb + tl) * ODD_IN + XG_OFF + ch];
#pragma unroll
                        for (int tl = 0; tl < 16; ++tl) { const float a = AB[tl * 64 + lane], bb = AB[1024 + tl * 64 + lane]; hst = a * hst + bb;
                            const float xg = bf2f(gv[tl]);
                            const float u3 = 0.7978845608028654f * (xg + 0.044715f * xg * xg * xg); const float th = 1.0f - 2.0f * __builtin_amdgcn_rcpf(1.0f + __builtin_amdgcn_exp2f(u3 * 2.8853900817779268f));
                            ACTA[(row0 + 16 * sb + tl) * D + 512 + ch] = (bf16)f2bf(hst * 0.5f * xg * (1.0f + th)); }
                    } else {
#pragma unroll
                        for (int tl = 0; tl < 16; ++tl) { const float a = AB[tl * 64 + lane], bb = AB[1024 + tl * 64 + lane]; hst = a * hst + bb; cum *= a; }
                    }
                    LDS_WAIT(); asm volatile("" ::: "memory");
                }
                if (pass == 0) { f32x2 sv; sv.x = cum; sv.y = hst; ((f32x2*)LSUM)[(size_t)(b * 64 + c) * 512 + ch] = sv; }
            }
            if (pass == 1) {
#pragma unroll 2
                for (int idx = bid * 512 + tid; idx < M * 64; idx += G * 512) {
                    const int row = idx >> 6, c8 = (idx & 63) * 8; const int t = row & (SEQ - 1);
                    const bf16* p = ACTB + (size_t)row * ODD_IN;
                    float acc8[8];
#pragma unroll
                    for (int x = 0; x < 8; ++x) acc8[x] = 0.f;
#pragma unroll
                    for (int k = 0; k < 3; ++k) { const int dt = 2 - k; if (t - dt >= 0) { const bf16* pr = p - (size_t)dt * ODD_IN;
                            const u32x4 gc = *(const u32x4*)(pr + CC_OFF + c8), uu = *(const u32x4*)(pr + CU_OFF + c8); const unsigned gw_[4] = {gc.x, gc.y, gc.z, gc.w}, uw[4] = {uu.x, uu.y, uu.z, uu.w};
#pragma unroll
                            for (int x = 0; x < 4; ++x) { acc8[2 * x] += args.in[11][k * 512 + c8 + 2 * x] * bf2f(gw_[x]) * bf2f(uw[x]); acc8[2 * x + 1] += args.in[11][k * 512 + c8 + 2 * x + 1] * bf2f(gw_[x] >> 16) * bf2f(uw[x] >> 16); } } }
                    const u32x4 gb = *(const u32x4*)(p + CB_OFF + c8); const unsigned gbw[4] = {gb.x, gb.y, gb.z, gb.w};
                    u32x4 w; unsigned ww[4];
#pragma unroll
                    for (int x = 0; x < 4; ++x) ww[x] = pk2(bf2f(gbw[x]) * acc8[2 * x], bf2f(gbw[x] >> 16) * acc8[2 * x + 1]);
                    w.x = ww[0]; w.y = ww[1]; w.z = ww[2]; w.w = ww[3];
                    *(u32x4*)(ACTA + (size_t)row * D + c8) = w;
                }
            }
        }
        SEAM(10 + pass);
    }

    if (IN(12)) {
        pg8::DenseSched S; S.init(ACTA, (const bf16*)(ws + WT_OUT1), M, D, D, G, bid);
#if OLD_DENSE
        pg8::EpiResF32 E{out, out, D};
        pg8::gemm_phase<pg8::EpiResF32, pg8::DenseSched, false>(scrb, 2 * D, S, E);
#else
        pg8::EpiStoreBf16 E{ACTB, D};
        pg8::gemm_phase<pg8::EpiStoreBf16, pg8::DenseSched, false>(scrb, 2 * D, S, E);
#endif
    }
    SEAM(12);

    int* const LTOK = (int*)(ws + SCR_LTOK); unsigned* const REC = (unsigned*)(ws + SCR_REC); unsigned* const REC2 = (unsigned*)(ws + SCR_REC + MiB);
    if (IN(13)) {
        LAS int* const lcnt = (LAS int*)(scrb);
        LAS int* const lbase = (LAS int*)(scrb + 64);
        LAS int* const recE = (LAS int*)(scrb + 128);
        LAS int* const recR = (LAS int*)(scrb + 128 + 1024);
        LAS float* const recW = (LAS float*)(scrb + 128 + 2048);
        float wr_[4][4][8];
#pragma unroll
        for (int j = 0; j < 4; ++j)
#pragma unroll
            for (int x = 0; x < 4; ++x) { const int col = 4 * (lane + 64 * j) + x; const f32x4 w0 = *(const f32x4*)(args.in[20] + (size_t)col * 8), w1 = *(const f32x4*)(args.in[20] + (size_t)col * 8 + 4);
                wr_[j][x][0] = w0.x; wr_[j][x][1] = w0.y; wr_[j][x][2] = w0.z; wr_[j][x][3] = w0.w; wr_[j][x][4] = w1.x; wr_[j][x][5] = w1.y; wr_[j][x][6] = w1.z; wr_[j][x][7] = w1.w; }
        for (int base = bid * 128; base < M; base += G * 128) {
            if (tid < 16) lcnt[tid] = 0;
            __syncthreads();
            f32x4 vn[4]; u32x2 dn[4];
            { const int m = base + wave * 16;
#pragma unroll
              for (int j = 0; j < 4; ++j) { vn[j] = ((const f32x4*)(out + (size_t)m * D) + lane)[64 * j]; dn[j] = ((const u32x2*)(ACTB + (size_t)m * D) + lane)[64 * j]; } }
            for (int rr = 0; rr < 16; ++rr) {
                const int lr = wave * 16 + rr, m = base + lr;
                f32x4* xr = (f32x4*)(out + (size_t)m * D) + lane; const f32x4* gr = (const f32x4*)(args.in[2] + D) + lane;
                f32x4 v[4]; u32x2 dcur[4]; float s = 0.f;
#pragma unroll
                for (int j = 0; j < 4; ++j) { v[j] = vn[j]; dcur[j] = dn[j]; }
                if (rr < 15) {
#pragma unroll
                    for (int j = 0; j < 4; ++j) { vn[j] = ((const f32x4*)(out + (size_t)(m + 1) * D) + lane)[64 * j]; dn[j] = ((const u32x2*)(ACTB + (size_t)(m + 1) * D) + lane)[64 * j]; } }
#pragma unroll
                for (int j = 0; j < 4; ++j) { const u32x2 dv = dcur[j]; v[j].x += bf2f(dv.x); v[j].y += bf2f(dv.x >> 16); v[j].z += bf2f(dv.y); v[j].w += bf2f(dv.y >> 16); xr[64 * j] = v[j];
                    s += (v[j].x * v[j].x + v[j].y * v[j].y) + (v[j].z * v[j].z + v[j].w * v[j].w); }
                const float rstd = rsqrtf(wave_sum(s) * (1.f / D) + EPS);
                float lg[8];
#pragma unroll
                for (int e = 0; e < 8; ++e) lg[e] = 0.f;
                unsigned* o8 = (unsigned*)((unsigned char*)ACTA + (size_t)m * D) + lane;
#pragma unroll
                for (int j = 0; j < 4; ++j) { const f32x4 gv = gr[64 * j]; float y[4] = {v[j].x * rstd * gv.x, v[j].y * rstd * gv.y, v[j].z * rstd * gv.z, v[j].w * rstd * gv.w};
                    { int w = __builtin_amdgcn_cvt_pk_fp8_f32(__builtin_amdgcn_fmed3f(y[0], -448.f, 448.f), __builtin_amdgcn_fmed3f(y[1], -448.f, 448.f), 0, false);
                      w = __builtin_amdgcn_cvt_pk_fp8_f32(__builtin_amdgcn_fmed3f(y[2], -448.f, 448.f), __builtin_amdgcn_fmed3f(y[3], -448.f, 448.f), w, true); o8[64 * j] = (unsigned)w; }
#pragma unroll
                    for (int x = 0; x < 4; ++x)
#pragma unroll
                        for (int e = 0; e < 8; ++e) lg[e] += y[x] * wr_[j][x][e]; }
#pragma unroll
                for (int e = 0; e < 8; ++e) lg[e] = wave_sum(lg[e]) + args.in[21][e];
                int e1 = 0; float l1 = lg[0];
#pragma unroll
                for (int e = 1; e < 8; ++e) if (lg[e] > l1) { l1 = lg[e]; e1 = e; }
                int e2 = -1; float l2 = -3.0e38f;
#pragma unroll
                for (int e = 0; e < 8; ++e) if (e != e1 && lg[e] > l2) { l2 = lg[e]; e2 = e; }
                const float w2 = 1.0f / (1.0f + __expf(l1 - l2)), w1 = 1.0f - w2;
                if (lane == 0) { recE[lr * 2] = e1; recE[lr * 2 + 1] = e2; recW[lr * 2] = w1; recW[lr * 2 + 1] = w2;
                    recR[lr * 2] = __hip_atomic_fetch_add(&lcnt[e1], 1, __ATOMIC_RELAXED, __HIP_MEMORY_SCOPE_WORKGROUP); recR[lr * 2 + 1] = __hip_atomic_fetch_add(&lcnt[8 + e2], 1, __ATOMIC_RELAXED, __HIP_MEMORY_SCOPE_WORKGROUP); }
            }
            __syncthreads();
            if (tid < 16) lbase[tid] = (int)__hip_atomic_fetch_add(ctl + CW_CNT + 64 * tid, (unsigned)lcnt[tid], RLX_AGENT);
            __syncthreads();
            if (tid < 256) { const int lr = tid >> 1, k = tid & 1; const int e = recE[tid]; const int pos = lbase[k * 8 + e] + recR[tid];
                if (pos < LIST_CAP) LTOK[(size_t)(k * 8 + e) * LIST_CAP + pos] = base + lr;
                unsigned* rec = REC + (size_t)(base + lr) * 8 + 3 * k; rec[0] = (unsigned)(k * 8 + e); rec[1] = (unsigned)pos; rec[2] = __builtin_bit_cast(unsigned, recW[tid]); }
            __syncthreads();
        }
    }
    SEAM(13);

    if (IN(14)) {
        pg8::MoeSched S; S.init(ACTA, ws + WT_GU1, LTOK, ctl + CW_CNT, 0, 2 * D_EXP / 256, D, 0, (size_t)2 * D_EXP * D, G, bid);
        if (bid == 0 && tid == 0) { unsigned* tbw = ctl + CW_TB; tbw[0] = 0u; tbw[1] = S.t1; tbw[2] = S.t2; tbw[3] = S.t3; tbw[4] = S.t4; tbw[5] = S.t5; tbw[6] = S.t6; tbw[7] = S.t7; tbw[8] = S.t8;
            tbw[9] = S.t9; tbw[10] = S.t10; tbw[11] = S.t11; tbw[12] = S.t12; tbw[13] = S.t13; tbw[14] = S.t14; tbw[15] = S.t15; }
        pg8::EpiSwiGLU8 E{(unsigned char*)ACTB, D_EXP, 1.0f / 64.0f, 4.0f};
        pg8::gemm_phase<pg8::EpiSwiGLU8, pg8::MoeSched, true, true>(scrb, D, S, E);
    }
    SEAM(14);
    bf16* const YB = (bf16*)(ws + WS_Y);
    if (IN(15)) {
        for (int m = bid * 512 + tid; m < M; m += G * 512) {
            const u32x4 r0 = *(const u32x4*)(REC + (size_t)m * 8), r1 = *(const u32x4*)(REC + (size_t)m * 8 + 4);
            const unsigned ke0 = r0.x, rk0 = r0.y, w0b = r0.z, ke1 = r0.w, rk1 = r1.x, w1b = r1.y;
            u32x4 o; o.x = ctl[CW_TB + ke0] * 256u + rk0; o.y = ctl[CW_TB + ke1] * 256u + rk1; o.z = w0b; o.w = w1b;
            *(u32x4*)(REC2 + (size_t)m * 4) = o; }
        pg8::MoeSched S; S.init(ACTB, ws + WT_DN1, LTOK, ctl + CW_CNT, 0, D / 256, D_EXP, (size_t)256 * D_EXP, (size_t)D * D_EXP, G, bid);
        pg8::EpiStoreBf16 E{YB, D};
        pg8::gemm_phase<pg8::EpiStoreBf16, pg8::MoeSched, false, true>(scrb, D_EXP, S, E);
    }
    SEAM(15);

    if (IN(16)) {
        const f32x4* gr = (const f32x4*)args.in[3] + lane;
        for (int m0 = gw; m0 < M; m0 += 2 * NGW) {
            const int NR = (m0 + NGW < M) ? NGW : 0;
            u32x4 rc[2];
#pragma unroll
            for (int r = 0; r < 2; ++r) rc[r] = *(const u32x4*)(REC2 + (size_t)(m0 + r * NR) * 4);
            f32x4 v[2][4]; u32x2 ya[2][4], yb[2][4];
#pragma unroll
            for (int r = 0; r < 2; ++r) { const unsigned row0 = rc[r].x, row1 = rc[r].y;
                const u32x2* y0 = (const u32x2*)(YB + (size_t)row0 * D) + lane; const u32x2* y1 = (const u32x2*)(YB + (size_t)row1 * D) + lane; const f32x4* xr = (const f32x4*)(out + (size_t)(m0 + r * NR) * D) + lane;
#pragma unroll
                for (int j = 0; j < 4; ++j) { v[r][j] = xr[64 * j]; ya[r][j] = y0[64 * j]; yb[r][j] = y1[64 * j]; } }
#pragma unroll
            for (int r = 0; r < 2; ++r) { const unsigned w0u = rc[r].z, w1u = rc[r].w; const float w0 = __uint_as_float(w0u) * (1.0f / 256.0f), w1 = __uint_as_float(w1u) * (1.0f / 256.0f);
                float s = 0.f;
#pragma unroll
                for (int j = 0; j < 4; ++j) { const u32x2 a = ya[r][j], b = yb[r][j];
                    v[r][j].x += w0 * bf2f(a.x) + w1 * bf2f(b.x); v[r][j].y += w0 * bf2f(a.x >> 16) + w1 * bf2f(b.x >> 16); v[r][j].z += w0 * bf2f(a.y) + w1 * bf2f(b.y); v[r][j].w += w0 * bf2f(a.y >> 16) + w1 * bf2f(b.y >> 16);
                    s += (v[r][j].x * v[r][j].x + v[r][j].y * v[r][j].y) + (v[r][j].z * v[r][j].z + v[r][j].w * v[r][j].w); }
                const float rstd = rsqrtf(wave_sum(s) * (1.f / D) + EPS);
                f32x4* xw = (f32x4*)(out + (size_t)(m0 + r * NR) * D) + lane;
#pragma unroll
                for (int j = 0; j < 4; ++j) { const f32x4 gv = gr[64 * j]; xw[64 * j] = v[r][j] * rstd * gv; } }
        }
    }
    if (PROBE_A_LO >= 0 && bid == 0 && tid == 0) {
        const unsigned long long t_end = wall_clock64();
        const unsigned long long wait = (unsigned long long)(MISC[9] - MISC[8]) * 4ull + ((PROBE_B_LO >= 0) ? (unsigned long long)(MISC[11] - MISC[10]) * 4ull : 0ull);
        while (wall_clock64() - t_end < wait) __builtin_amdgcn_s_sleep(32);
    }
#undef IN
#undef SEAM
#undef PSTAMP
}

extern "C" void kernel_launch(void* const* d_in, const int* in_sizes, int n_in, void* d_out, int out_size, void* d_ws, size_t ws_size, hipStream_t stream) {
    static int grid = 0;
    if (grid == 0) {
        if (n_in != 25 || in_sizes[0] != M * D || out_size != M * D || ws_size < WS_END) { fprintf(stderr, "kernel_launch: unexpected shapes / workspace (n_in %d, ws %zu, need %zu)\n", n_in, ws_size, (size_t)WS_END); grid = -1; return; }
        int dev = 0, cus = 0, per_cu = 0;
        if (hipGetDevice(&dev) != hipSuccess || hipDeviceGetAttribute(&cus, hipDeviceAttributeMultiprocessorCount, dev) != hipSuccess) { grid = -1; return; }
        if (hipFuncSetAttribute((const void*)fwd_kernel, hipFuncAttributeMaxDynamicSharedMemorySize, LDS_BYTES) != hipSuccess) { fprintf(stderr, "kernel_launch: hipFuncSetAttribute failed\n"); grid = -1; return; }
        if (hipOccupancyMaxActiveBlocksPerMultiprocessor(&per_cu, (const void*)fwd_kernel, 512, LDS_BYTES) != hipSuccess || per_cu < 1) { fprintf(stderr, "kernel_launch: occupancy query says %d\n", per_cu); }
        (void)hipGetLastError();
        grid = cus;
    }
    if (grid < 0) return;
    if (hipMemsetAsync((char*)d_ws + WS_CTL, 0, CTL_ZERO_BYTES, stream) != hipSuccess) return;
    Args a{};
    for (int i = 0; i < 25; ++i) a.in[i] = (const float*)d_in[i];
    a.out = (float*)d_out; a.ws = (unsigned char*)d_ws;
#if MK_N_LAUNCHES == 1
    a.ph_lo = 0; a.ph_hi = NPHASE;
    hipLaunchKernelGGL(fwd_kernel, dim3(grid), dim3(512), LDS_BYTES, stream, a);
#else
    for (int p = 0; p < NPHASE; ++p) { a.ph_lo = p; a.ph_hi = p + 1; hipLaunchKernelGGL(fwd_kernel, dim3(grid), dim3(512), LDS_BYTES, stream, a); }
#endif
}
```

```cpp
#include <hip/hip_runtime.h>
#include <cstdio>
#include <cstdint>

#ifndef MK_N_LAUNCHES
#define MK_N_LAUNCHES 1
#endif

#ifndef PROBE_A_LO
#define PROBE_A_LO (-1)
#define PROBE_A_HI (-1)
#define PROBE_B_LO (-1)
#define PROBE_B_HI (-1)
#endif
#define GAS __attribute__((address_space(1)))
#define LAS __attribute__((address_space(3)))
typedef unsigned short bf16;
typedef short bf16x8 __attribute__((ext_vector_type(8)));
typedef float f32x4 __attribute__((ext_vector_type(4)));
typedef float f32x2 __attribute__((ext_vector_type(2)));
typedef unsigned u32x4 __attribute__((ext_vector_type(4)));
typedef unsigned u32x2 __attribute__((ext_vector_type(2)));
typedef int v4i_t __attribute__((ext_vector_type(4)));
typedef short v4s_t __attribute__((ext_vector_type(4)));
typedef int v8i_t __attribute__((ext_vector_type(8)));

constexpr int D = 1024, NB = 8, SEQ = 4096, M = NB * SEQ;
constexpr int EVEN_IN = 3584, ODD_IN = 2560, D_FF = 2816, D_EXP = 3584, NEXP = 8;
constexpr int RQ_OFF = 0, RK_OFF = 512, RV_OFF = 1024, RGATE_OFF = 1536, SQ_OFF = 2048, SK_OFF = 2560, SV_OFF = 3072;
constexpr int CB_OFF = 0, CC_OFF = 512, CU_OFF = 1024, XR_OFF = 1536, XG_OFF = 2048;
constexpr float EPS = 1e-6f;
constexpr int LIST_CAP = 32768;
constexpr int MAX_TILES = 135;

constexpr size_t MiB = 1u << 20;
constexpr size_t WS_CTL = 0, CTL_ZERO_BYTES = 1 * MiB;
constexpr size_t WS_ROT = 1 * MiB;
constexpr size_t WS_SCR = 3 * MiB;
constexpr size_t WS_WB = 19 * MiB;
constexpr size_t WT_DN1 = WS_WB;
constexpr size_t WT_IN0 = 47 * MiB;
constexpr size_t WT_OUT0 = WT_IN0 + (size_t)EVEN_IN * D * 2;
constexpr size_t WT_GU0 = WT_OUT0 + (size_t)D * D * 2;
constexpr size_t WT_DN0 = WT_GU0 + (size_t)2 * D_FF * D * 2;
constexpr size_t WT_IN1 = WT_DN0 + (size_t)D * D_FF * 2;
constexpr size_t WT_OUT1 = WT_IN1 + (size_t)ODD_IN * D * 2;
constexpr size_t WT_GU1 = WT_OUT1 + (size_t)D * D * 2;
constexpr size_t WB_END = WT_GU1 + (size_t)NEXP * 2 * D_EXP * D;
constexpr size_t WS_ACTA = 136 * MiB;
constexpr size_t WS_ACTB = 200 * MiB;
constexpr size_t WS_END = WS_ACTB + (size_t)MAX_TILES * 256 * D_EXP * 2;
constexpr size_t WS_Y = WT_IN0;
static_assert(WT_DN1 + (size_t)NEXP * D * D_EXP <= WT_IN0 && WB_END <= WS_ACTA && WS_ACTA + (size_t)M * D * 2 <= WS_ACTB, "weights overlap");
static_assert(WS_Y + (size_t)2 * MAX_TILES * 256 * D * 2 <= WS_ACTB, "y overlay");
static_assert((size_t)M * EVEN_IN * 2 <= (size_t)MAX_TILES * 256 * D_EXP * 2, "ACTB size");
constexpr size_t SCR_LTOK = WS_SCR, SCR_REC = WS_SCR + 4 * MiB;
constexpr int CW_BAR = 4096;
constexpr int CW_TB = 16384;
constexpr int CW_CNT = 8192;

constexpr int LDS_MISC = 0;
constexpr int LDS_SCR = 256;
constexpr int LDS_BYTES = 147456;

#define RLX_AGENT __ATOMIC_RELAXED, __HIP_MEMORY_SCOPE_AGENT
#define LDS_WAIT() asm volatile("s_waitcnt lgkmcnt(0)" ::: "memory")
__device__ __forceinline__ unsigned pk2(float lo, float hi) { unsigned r; asm("v_cvt_pk_bf16_f32 %0, %1, %2" : "=v"(r) : "v"(lo), "v"(hi)); return r; }
__device__ __forceinline__ unsigned f2bf(float f) { return pk2(f, 0.0f) & 0xffffu; }
__device__ __forceinline__ float bf2f(unsigned b) { return __builtin_bit_cast(float, (b & 0xffffu) << 16); }
__device__ __forceinline__ float wave_sum(float v) {
#pragma unroll
    for (int o = 1; o < 64; o <<= 1) v += __shfl_xor(v, o);
    return v;
}
__device__ __forceinline__ float sigmoidf_(float x) { return __builtin_amdgcn_rcpf(1.0f + __builtin_amdgcn_exp2f(x * -1.4426950408889634f)); }

#define XB_TMO      128
#define XB_XCNT(j)  (256  + 64 * (j))
#define XB_XSUB(j)  (1280 + 64 * (j))
#define XB_XGEN(j)  (2304 + 64 * (j))
#define XB_TOP      3328
#define XB_TOPGEN   3392
#define XCD_BAR_WORDS 3456
#define XB_SPIN_CAP (1u << 18)

__device__ __forceinline__ unsigned xb_ld(unsigned* p)              { return __hip_atomic_load(p, __ATOMIC_RELAXED, __HIP_MEMORY_SCOPE_AGENT); }
__device__ __forceinline__ unsigned xb_add(unsigned* p, unsigned v) { return __hip_atomic_fetch_add(p, v, __ATOMIC_RELAXED, __HIP_MEMORY_SCOPE_AGENT); }
__device__ __forceinline__ unsigned xb_xcc_id() { return (unsigned)__builtin_amdgcn_s_getreg((3 << 11) | 20) & 0xFu; }
#define XB_SPIN(cond, bar) do { unsigned _sp = 0; while (cond) { __builtin_amdgcn_s_sleep(1); \
    if ((++_sp & 255u) == 0u) { if (xb_ld(&(bar)[XB_TMO])) break; if (_sp > XB_SPIN_CAP) { atomicAdd(&(bar)[XB_TMO], 1u); break; } } } } while (0)

struct XcdBarrier { unsigned* bar; unsigned x; volatile LAS unsigned* st; };

__device__ __forceinline__ XcdBarrier xcd_barrier_post(unsigned* bar, volatile LAS unsigned* st) {
    XcdBarrier b; b.bar = bar; b.x = xb_xcc_id(); b.st = st;
    if (threadIdx.x == 0) (void)xb_add(&bar[XB_XCNT(b.x)], 1u);
    return b;
}
__device__ __forceinline__ void xcd_barrier_complete(unsigned* bar, unsigned x, unsigned& nloc, unsigned& nx) {
    const unsigned G = gridDim.x * gridDim.y * gridDim.z;
    unsigned sum, cnt, mine, sp = 0u;
    for (;;) {
        sum = 0u; cnt = 0u; mine = 0u;
#pragma unroll
        for (unsigned j = 0; j < 16; ++j) { const unsigned c = xb_ld(&bar[XB_XCNT(j)]); sum += c; cnt += (c > 0u) ? 1u : 0u; mine = (j == x) ? c : mine; }
        if (sum == G) break;
        __builtin_amdgcn_s_sleep(1);
        if ((++sp & 255u) == 0u) { if (xb_ld(&bar[XB_TMO])) break; if (sp > XB_SPIN_CAP) { atomicAdd(&bar[XB_TMO], 1u); break; } }
    }
    nloc = mine > 0u ? mine : 1u; nx = cnt > 0u ? cnt : 1u;
}
__device__ __forceinline__ void xcd_barrier(const XcdBarrier& b) {
    asm volatile("s_waitcnt vmcnt(0)" ::: "memory");
    __syncthreads();
    if (threadIdx.x == 0) {
        unsigned* bar = b.bar;
        __builtin_amdgcn_s_waitcnt(0);
        unsigned nloc = b.st[0], nx = b.st[1];
        if (nloc == 0u) { xcd_barrier_complete(bar, b.x, nloc, nx); b.st[0] = nloc; b.st[1] = nx; }
        const unsigned old = xb_add(&bar[XB_XSUB(b.x)], 1u);
        const unsigned gen = old / nloc;
        if (old + 1u == (gen + 1u) * nloc) {
            __builtin_amdgcn_fence(__ATOMIC_RELEASE, "agent");
            asm volatile("s_waitcnt vmcnt(0)" ::: "memory");
            const unsigned og = xb_add(&bar[XB_TOP], 1u);
            const unsigned tg = og / nx;
            if (og + 1u == (tg + 1u) * nx) xb_add(&bar[XB_TOPGEN], 1u);
            else XB_SPIN(xb_ld(&bar[XB_TOPGEN]) == tg, bar);
            __builtin_amdgcn_fence(__ATOMIC_ACQUIRE, "agent");
            xb_add(&bar[XB_XGEN(b.x)], 1u);
            asm volatile("s_waitcnt vmcnt(0)" ::: "memory");
        } else {
            XB_SPIN(xb_ld(&bar[XB_XGEN(b.x)]) == gen, bar);
            __builtin_amdgcn_fence(__ATOMIC_ACQUIRE, "agent");
            asm volatile("s_waitcnt vmcnt(0)" ::: "memory");
        }
    }
    __syncthreads();
}

namespace pg8 {
constexpr int BM = 256, BK = 64, HALF = 128, HTB = HALF * BK * 2, STAGE_BYTES = 8 * HTB, NXCD = 8, WGM = 8;
__device__ __forceinline__ int lds_byte(int r, int c) { const int st = (r >> 4) * 2 + (c >> 5), rr = r & 15, cc = c & 31, ob = rr * 64 + cc * 2; return st * 1024 + (ob ^ (((ob >> 9) & 1) << 5)); }
__device__ __forceinline__ void stage_rc(int b, int& R, int& C) { const int st = b / 1024, sb = b % 1024, swz = sb ^ (((sb >> 9) & 1) << 5); R = (st >> 1) * 16 + swz / 64; C = (st & 1) * 32 + (swz % 64) / 2; }
__device__ __forceinline__ int perm32(int rho) { const int n = rho >> 4, i = rho & 15; return 8 * (i >> 2) + 4 * n + (i & 3); }

struct Unit { int pm, pn, e, lt, cn; };

struct StaticOrder {
    int nM, nN, nwg, G, c;
    __device__ __forceinline__ void init_tiles(int nM_, int nN_, int G_, int c_) { nM = nM_; nN = nN_; nwg = nM * nN; G = G_; c = c_; }
    __device__ __forceinline__ bool next_tile(int i, int& pm, int& pn) const {
        const long L = (long)i * G + c; if (L >= nwg) return false;
        int wgid = (int)L; { const int q = nwg / NXCD, r = nwg % NXCD, xcd = wgid % NXCD, off = wgid / NXCD; wgid = (xcd < r ? xcd * (q + 1) : r * (q + 1) + (xcd - r) * q) + off; }
        const int nig = WGM * nN, gid = wgid / nig, fm = gid * WGM, gsz = (nM - fm) < WGM ? (nM - fm) : WGM;
        pm = fm + ((wgid % nig) % gsz); pn = (wgid % nig) / gsz; return true;
    }
};
struct DenseSched : StaticOrder {
    const char* A; const char* Bt; size_t tstep;
    __device__ __forceinline__ void init(const bf16* A_, const bf16* Bt_, int Mr, int N, int K, int G_, int c_) { A = (const char*)A_; Bt = (const char*)Bt_; tstep = (size_t)BM * K * 2; init_tiles(Mr / BM, N / BM, G_, c_); }
    __device__ __forceinline__ bool next(int i, Unit& u) const { u.e = 0; u.lt = 0; u.cn = 0; return next_tile(i, u.pm, u.pn); }
    __device__ __forceinline__ const char* a_base(const Unit& u) const { return A + (size_t)u.pm * tstep; }
    __device__ __forceinline__ const char* b_base(const Unit& u) const { return Bt + (size_t)u.pn * tstep; }
    __device__ __forceinline__ void a_rows(const Unit&, const int (&)[2], const int (&)[2], unsigned (&)[2][2]) const {}
    __device__ __forceinline__ const int* tok_src(const Unit&) const { return nullptr; }
};
struct MoeSched : StaticOrder {
    const char* A; const char* Bt; size_t a_tstep, b_estep, b_tstep; const int* ltok; int rowb, toff;
    int c0, c1, c2, c3, c4, c5, c6, c7, c8, c9, c10, c11, c12, c13, c14, c15, t1, t2, t3, t4, t5, t6, t7, t8, t9, t10, t11, t12, t13, t14, t15, t16;
    __device__ __forceinline__ static int ldc_(const unsigned* cntw, int e) { int c = (int)__builtin_amdgcn_readfirstlane(__hip_atomic_load(cntw + 64 * e, RLX_AGENT)); return c > LIST_CAP ? LIST_CAP : c; }
    __device__ __forceinline__ void init(const void* A_, const void* Bt_, const int* ltok_, const unsigned* cntw, int which, int nN_, int rowb_, size_t a_tstep_, size_t b_estep_, int G_, int c_) {
        A = (const char*)A_; Bt = (const char*)Bt_; ltok = ltok_; rowb = rowb_; a_tstep = a_tstep_; b_estep = b_estep_; b_tstep = (size_t)BM * rowb_;
        c0 = ldc_(cntw, 0); c1 = ldc_(cntw, 1); c2 = ldc_(cntw, 2); c3 = ldc_(cntw, 3); c4 = ldc_(cntw, 4); c5 = ldc_(cntw, 5); c6 = ldc_(cntw, 6); c7 = ldc_(cntw, 7);
        c8 = ldc_(cntw, 8); c9 = ldc_(cntw, 9); c10 = ldc_(cntw, 10); c11 = ldc_(cntw, 11); c12 = ldc_(cntw, 12); c13 = ldc_(cntw, 13); c14 = ldc_(cntw, 14); c15 = ldc_(cntw, 15);
        t1 = (c0 + 255) >> 8; t2 = t1 + ((c1 + 255) >> 8); t3 = t2 + ((c2 + 255) >> 8); t4 = t3 + ((c3 + 255) >> 8); t5 = t4 + ((c4 + 255) >> 8); t6 = t5 + ((c5 + 255) >> 8); t7 = t6 + ((c6 + 255) >> 8); t8 = t7 + ((c7 + 255) >> 8);
        t9 = t8 + ((c8 + 255) >> 8); t10 = t9 + ((c9 + 255) >> 8); t11 = t10 + ((c10 + 255) >> 8); t12 = t11 + ((c11 + 255) >> 8); t13 = t12 + ((c12 + 255) >> 8); t14 = t13 + ((c13 + 255) >> 8); t15 = t14 + ((c14 + 255) >> 8); t16 = t15 + ((c15 + 255) >> 8);
        toff = which == 2 ? t8 : 0;
        init_tiles(which == 0 ? t16 : (which == 1 ? t8 : t16 - t8), nN_, G_, c_);
    }
    __device__ __forceinline__ bool next(int i, Unit& u) const {
        int pml; if (!next_tile(i, pml, u.pn)) return false;
        const int pm = pml + toff; u.pm = pm;
        const int m1 = pm >= t1, m2 = pm >= t2, m3 = pm >= t3, m4 = pm >= t4, m5 = pm >= t5, m6 = pm >= t6, m7 = pm >= t7, m8 = pm >= t8, m9 = pm >= t9, m10 = pm >= t10, m11 = pm >= t11, m12 = pm >= t12, m13 = pm >= t13, m14 = pm >= t14, m15 = pm >= t15;
        const int e = m1 + m2 + m3 + m4 + m5 + m6 + m7 + m8 + m9 + m10 + m11 + m12 + m13 + m14 + m15;
        const int base = m1 * t1 + m2 * (t2 - t1) + m3 * (t3 - t2) + m4 * (t4 - t3) + m5 * (t5 - t4) + m6 * (t6 - t5) + m7 * (t7 - t6) + m8 * (t8 - t7) + m9 * (t9 - t8) + m10 * (t10 - t9) + m11 * (t11 - t10) + m12 * (t12 - t11) + m13 * (t13 - t12) + m14 * (t14 - t13) + m15 * (t15 - t14);
        const int cn = c0 + m1 * (c1 - c0) + m2 * (c2 - c1) + m3 * (c3 - c2) + m4 * (c4 - c3) + m5 * (c5 - c4) + m6 * (c6 - c5) + m7 * (c7 - c6) + m8 * (c8 - c7) + m9 * (c9 - c8) + m10 * (c10 - c9) + m11 * (c11 - c10) + m12 * (c12 - c11) + m13 * (c13 - c12) + m14 * (c14 - c13) + m15 * (c15 - c14);
        u.e = e; u.lt = pm - base; u.cn = cn; return true;
    }
    __device__ __forceinline__ const char* a_base(const Unit& u) const { return A + (size_t)u.pm * a_tstep; }
    __device__ __forceinline__ const char* b_base(const Unit& u) const { return Bt + (size_t)(u.e & 7) * b_estep + (size_t)u.pn * b_tstep; }
    __device__ __forceinline__ const int* tok_src(const Unit& u) const { return ltok + (size_t)u.e * LIST_CAP + u.lt * 256; }
    __device__ __forceinline__ void a_rows(const Unit& u, const int (&R)[2], const int (&C)[2], unsigned (&off)[2][2]) const {
#pragma unroll
        for (int h = 0; h < 2; ++h)
#pragma unroll
            for (int i = 0; i < 2; ++i) { int rank = u.lt * 256 + h * HALF + R[i]; rank = rank < u.cn ? rank : u.cn - 1;
                const int tok = ltok[(size_t)u.e * LIST_CAP + rank]; off[h][i] = (unsigned)tok * (unsigned)rowb + (unsigned)(C[i] * 2); }
    }
};

__device__ __forceinline__ unsigned cvt_pk_bf16(float lo, float hi) { unsigned r; asm volatile("v_cvt_pk_bf16_f32 %0, %1, %2" : "=v"(r) : "v"(lo), "v"(hi)); return r; }

struct EpiStoreBf16 {
    static constexpr bool PERM = true; static constexpr int NVM = 16;
    bf16* O; int ldc;
    __device__ __forceinline__ void operator()(const f32x4 (&acc)[2][2][4][2], const Unit& u, int wr, int wc, int fr, int fq) const {
        const int row0 = u.pm * BM + wr * 64 + fr, col0 = u.pn * BM + wc * 32 + 8 * fq;
#pragma unroll
        for (int ai = 0; ai < 2; ++ai)
#pragma unroll
            for (int m = 0; m < 4; ++m) { bf16* rowp = O + (size_t)(row0 + ai * HALF + m * 16) * ldc + col0;
#pragma unroll
                for (int bj = 0; bj < 2; ++bj) { const f32x4 v0 = acc[ai][bj][m][0], v1 = acc[ai][bj][m][1];
                    u32x4 w; w.x = cvt_pk_bf16(v0[0], v0[1]); w.y = cvt_pk_bf16(v0[2], v0[3]); w.z = cvt_pk_bf16(v1[0], v1[1]); w.w = cvt_pk_bf16(v1[2], v1[3]);
                    *(u32x4*)(rowp + bj * HALF) = w; } }
    }
};
struct EpiResF32 {
    static constexpr bool PERM = false; static constexpr int NVM = 0;
    const float* base; float* out; int ldc;
    __device__ __forceinline__ void operator()(const f32x4 (&acc)[2][2][4][2], const Unit& u, int wr, int wc, int fr, int fq) const {
        const int row0 = u.pm * BM + wr * 64 + fr, col0 = u.pn * BM + wc * 32 + 4 * fq;
#pragma unroll
        for (int ai = 0; ai < 2; ++ai)
#pragma unroll
            for (int m = 0; m < 4; ++m) { const size_t off = (size_t)(row0 + ai * HALF + m * 16) * ldc + col0;
#pragma unroll
                for (int bj = 0; bj < 2; ++bj)
#pragma unroll
                    for (int n = 0; n < 2; ++n) { const f32x4 bs = *(const f32x4*)(base + off + bj * HALF + n * 16); *(f32x4*)(out + off + bj * HALF + n * 16) = bs + acc[ai][bj][m][n]; } }
    }
};
struct EpiSwiGLU {
    static constexpr bool PERM = true; static constexpr int NVM = 8;
    bf16* H; int ldh;
    __device__ __forceinline__ void operator()(const f32x4 (&acc)[2][2][4][2], const Unit& u, int wr, int wc, int fr, int fq) const {
        const int row0 = u.pm * BM + wr * 64 + fr, col0 = u.pn * HALF + wc * 32 + 8 * fq;
#pragma unroll
        for (int ai = 0; ai < 2; ++ai)
#pragma unroll
            for (int m = 0; m < 4; ++m) { bf16* rowp = H + (size_t)(row0 + ai * HALF + m * 16) * ldh + col0;
                float h[8];
#pragma unroll
                for (int n = 0; n < 2; ++n)
#pragma unroll
                    for (int x = 0; x < 2; ++x) { const f32x2 g = {acc[ai][0][m][n][2 * x], acc[ai][0][m][n][2 * x + 1]}, up = {acc[ai][1][m][n][2 * x], acc[ai][1][m][n][2 * x + 1]};
                        const f32x2 t = g * -1.4426950408889634f; f32x2 e; e.x = __builtin_amdgcn_exp2f(t.x); e.y = __builtin_amdgcn_exp2f(t.y);
                        const f32x2 d = e + 1.0f; f32x2 r; r.x = __builtin_amdgcn_rcpf(d.x); r.y = __builtin_amdgcn_rcpf(d.y);
                        const f32x2 hh = (g * up) * r; h[4 * n + 2 * x] = hh.x; h[4 * n + 2 * x + 1] = hh.y; }
                u32x4 w; w.x = cvt_pk_bf16(h[0], h[1]); w.y = cvt_pk_bf16(h[2], h[3]); w.z = cvt_pk_bf16(h[4], h[5]); w.w = cvt_pk_bf16(h[6], h[7]);
                *(u32x4*)rowp = w; }
    }
};
struct EpiSwiGLU8 {
    static constexpr bool PERM = true; static constexpr int NVM = 8;
    unsigned char* H; int ldh; float iscale, oscale;
    __device__ __forceinline__ void operator()(const f32x4 (&acc)[2][2][4][2], const Unit& u, int wr, int wc, int fr, int fq) const {
        const int row0 = u.pm * BM + wr * 64 + fr, col0 = u.pn * HALF + wc * 32 + 8 * fq;
#pragma unroll
        for (int ai = 0; ai < 2; ++ai)
#pragma unroll
            for (int m = 0; m < 4; ++m) { unsigned char* rowp = H + (size_t)(row0 + ai * HALF + m * 16) * ldh + col0;
                float h[8];
#pragma unroll
                for (int n = 0; n < 2; ++n)
#pragma unroll
                    for (int x = 0; x < 2; ++x) { const f32x2 ga = {acc[ai][0][m][n][2 * x], acc[ai][0][m][n][2 * x + 1]}, ua = {acc[ai][1][m][n][2 * x], acc[ai][1][m][n][2 * x + 1]};
                        const f32x2 t = ga * (-1.4426950408889634f * iscale); f32x2 e; e.x = __builtin_amdgcn_exp2f(t.x); e.y = __builtin_amdgcn_exp2f(t.y);
                        const f32x2 d = e + 1.0f; f32x2 r; r.x = __builtin_amdgcn_rcpf(d.x); r.y = __builtin_amdgcn_rcpf(d.y);
                        const f32x2 hh = ((ga * ua) * (iscale * iscale * oscale)) * r;
                        h[4 * n + 2 * x] = __builtin_amdgcn_fmed3f(hh.x, -448.0f, 448.0f); h[4 * n + 2 * x + 1] = __builtin_amdgcn_fmed3f(hh.y, -448.0f, 448.0f); }
                int w0 = __builtin_amdgcn_cvt_pk_fp8_f32(h[0], h[1], 0, false); w0 = __builtin_amdgcn_cvt_pk_fp8_f32(h[2], h[3], w0, true);
                int w1 = __builtin_amdgcn_cvt_pk_fp8_f32(h[4], h[5], 0, false); w1 = __builtin_amdgcn_cvt_pk_fp8_f32(h[6], h[7], w1, true);
                u32x2 w; w.x = (unsigned)w0; w.y = (unsigned)w1; *(u32x2*)rowp = w; }
    }
};
struct EpiMoeDown {
    static constexpr bool PERM = false; static constexpr int NVM = 0;
    float* out; const int* ltok; const float* lw; float scale;
    __device__ __forceinline__ void operator()(const f32x4 (&acc)[2][2][4][2], const Unit& u, int wr, int wc, int fr, int fq) const {
        const int col0 = u.pn * BM + wc * 32 + 4 * fq;
#pragma unroll
        for (int ai = 0; ai < 2; ++ai)
#pragma unroll
            for (int m = 0; m < 4; ++m) { const int rank = u.lt * 256 + ai * HALF + wr * 64 + m * 16 + fr;
                if (rank < u.cn) { const int tok = ltok[(size_t)u.e * LIST_CAP + rank]; const float w = lw[(size_t)u.e * LIST_CAP + rank] * scale; float* rowp = out + (size_t)tok * D + col0;
#pragma unroll
                    for (int bj = 0; bj < 2; ++bj)
#pragma unroll
                        for (int n = 0; n < 2; ++n) { const f32x4 bs = *(const f32x4*)(rowp + bj * HALF + n * 16); *(f32x4*)(rowp + bj * HALF + n * 16) = bs + acc[ai][bj][m][n] * w; } } }
    }
};

template <class Epi, class Sched, bool GATHER, bool F8 = false>
__device__ __forceinline__ void gemm_phase(LAS unsigned char* lds, const int rowb, const Sched& S, const Epi& E) {
    const int tid = threadIdx.x, wid = __builtin_amdgcn_readfirstlane(tid >> 6), lane = tid & 63, wr = wid >> 2, wc = wid & 3, fr = lane & 15, fq = lane >> 4;
    const int nt = rowb / 128;
    unsigned voffA[2], voffB[2]; int Rr[2], Cc[2];
#pragma unroll
    for (int i = 0; i < 2; ++i) { int R, C; stage_rc(tid * 16 + i * 8192, R, C); const int Rb = Epi::PERM ? ((R & ~31) + perm32(R & 31)) : R;
        voffA[i] = (unsigned)(R * rowb + C * 2); voffB[i] = (unsigned)(Rb * rowb + C * 2); Rr[i] = R; Cc[i] = C; }
    const size_t kstep = (size_t)(BK * 2);
    const size_t hstep = (size_t)HALF * rowb;
    const unsigned ldsw = (unsigned)wid * 1024u;
    const int aoff = lds_byte(wr * 64 + fr, fq * 8), boff = lds_byte(wc * 32 + fr, fq * 8);
#define PG8_SA(b, h) (((b) * 2 + (h)) * HTB)
#define PG8_SB(b, h) ((4 + (b) * 2 + (h)) * HTB)
#define PG8_STAGE(bufoff, gbase, voff) do { _Pragma("unroll") for (int _i = 0; _i < 2; ++_i) \
        __builtin_amdgcn_global_load_lds((const unsigned*)((const char*)(gbase) + (voff)[_i]), (LAS unsigned*)(lds + (bufoff) + ldsw + _i * 8192), 16, 0, 0); } while (0)
#define PG8_STAGE_A(bufoff, kptr, h) do { if constexpr (GATHER) PG8_STAGE(bufoff, kptr, gA[h]); else PG8_STAGE(bufoff, (kptr) + (h) * hstep, voffA); } while (0)
#define PG8_LD8(base) __builtin_shufflevector(*(const LAS v4i_t*)(base), *(const LAS v4i_t*)((base) + 1024), 0, 1, 2, 3, 4, 5, 6, 7)
#define PG8_LDA(dst, b, h) do { _Pragma("unroll") for (int m = 0; m < 4; ++m) { if constexpr (F8) dst##8[m] = PG8_LD8(lds + PG8_SA(b, h) + aoff + m * 2048); else { _Pragma("unroll") for (int k = 0; k < 2; ++k) dst[m][k] = *(const LAS bf16x8*)(lds + PG8_SA(b, h) + aoff + m * 2048 + k * 1024); } } } while (0)
#define PG8_LDB(dst, b, h) do { _Pragma("unroll") for (int n = 0; n < 2; ++n) { if constexpr (F8) dst##8[n] = PG8_LD8(lds + PG8_SB(b, h) + boff + n * 2048); else { _Pragma("unroll") for (int k = 0; k < 2; ++k) dst[n][k] = *(const LAS bf16x8*)(lds + PG8_SB(b, h) + boff + n * 2048 + k * 1024); } } } while (0)
#define PG8_MMA(ai, bj, At, Bt) do { __builtin_amdgcn_s_setprio(1); _Pragma("unroll") for (int m = 0; m < 4; ++m) _Pragma("unroll") for (int n = 0; n < 2; ++n) { \
        if constexpr (F8) asm volatile("v_mfma_f32_16x16x128_f8f6f4 %0, %1, %2, %0" : "+v"(acc[ai][bj][m][n]) : "v"(Bt##8[n]), "v"(At##8[m])); \
        else { _Pragma("unroll") for (int k = 0; k < 2; ++k) acc[ai][bj][m][n] = __builtin_amdgcn_mfma_f32_16x16x32_bf16(Bt[n][k], At[m][k], acc[ai][bj][m][n], 0, 0, 0); } } \
        __builtin_amdgcn_s_setprio(0); } while (0)
#define PG8_WAIT_V(n) asm volatile("s_waitcnt vmcnt(" #n ")" ::: "memory")
#define PG8_WAIT_SEL(flag, n) asm volatile("v_cmp_eq_u32_e32 vcc, 0, %0\n\ts_nop 4\n\ts_cbranch_vccnz .Lw8_%=\n\ts_waitcnt vmcnt(%1)\n\ts_branch .Lwd_%=\n.Lw8_%=:\n\ts_waitcnt vmcnt(8)\n.Lwd_%=:" :: "v"(flag), "n"(n) : "memory", "vcc")
#define PG8_WAIT_L(n) asm volatile("s_waitcnt lgkmcnt(" #n ")" ::: "memory")
#define PG8_BAR __builtin_amdgcn_s_barrier()
#define PG8_SCHED __builtin_amdgcn_sched_barrier(0)
    Unit cur, nxt; int ui = 0;
    if (!S.next(0, cur)) return;
    f32x4 acc[2][2][4][2];
#pragma unroll
    for (int a = 0; a < 2; ++a)
#pragma unroll
        for (int b = 0; b < 2; ++b)
#pragma unroll
            for (int m = 0; m < 4; ++m)
#pragma unroll
                for (int n = 0; n < 2; ++n) acc[a][b][m][n] = (f32x4){0.f, 0.f, 0.f, 0.f};
    bf16x8 At[4][2], B0[2][2], B1[2][2]; v8i_t At8[4], B08[2], B18[2];
    const char* cA = S.a_base(cur); const char* cB = S.b_base(cur);
    unsigned gA[2][2] = {{0u, 0u}, {0u, 0u}};
    if constexpr (GATHER) S.a_rows(cur, Rr, Cc, gA);
    constexpr int TOKTAB = STAGE_BYTES;
    PG8_STAGE(PG8_SB(0, 0), cB, voffB); PG8_STAGE(PG8_SB(0, 1), cB + hstep, voffB); PG8_STAGE_A(PG8_SA(0, 0), cA, 0); PG8_STAGE_A(PG8_SA(0, 1), cA, 1);
    if (wr == 1) PG8_BAR;
    PG8_WAIT_V(2); PG8_BAR;
    PG8_STAGE(PG8_SB(1, 0), cB + kstep, voffB); PG8_STAGE_A(PG8_SA(1, 0), cA + kstep, 0); PG8_STAGE(PG8_SB(1, 1), cB + hstep + kstep, voffB);
    PG8_WAIT_V(6); PG8_BAR;
    for (;;) {
        const bool has_next = S.next(ui + 1, nxt);
        const char* nA = has_next ? S.a_base(nxt) : cA; const char* nB = has_next ? S.b_base(nxt) : cB;
        if constexpr (GATHER) { if (has_next && wid == 0) __builtin_amdgcn_global_load_lds((const unsigned*)(S.tok_src(nxt) + lane * 4), (LAS unsigned*)(lds + TOKTAB), 16, 0, 0); }
        for (int t = 0; t < nt; t += 2) {
            const bool last = (t == nt - 2);
            const char* a1 = cA + (size_t)(t + 1) * kstep;
            const char* a2 = last ? nA : cA + (size_t)(t + 2) * kstep; const char* b2 = last ? nB : cB + (size_t)(t + 2) * kstep;
            const char* a3 = a2 + kstep; const char* b3 = b2 + kstep;
            const int after_epi = ((Epi::NVM > 0) && (t == 0) && (ui > 0)) ? 1 : 0;
            PG8_LDB(B0, 0, 0); PG8_LDB(B1, 0, 1); PG8_SCHED; PG8_LDA(At, 0, 0); PG8_STAGE_A(PG8_SA(1, 1), a1, 1);
            if constexpr (GATHER) { if (last && has_next) { asm volatile("" ::: "memory");
#pragma unroll
                for (int h = 0; h < 2; ++h)
#pragma unroll
                    for (int i = 0; i < 2; ++i) { unsigned tk = *(const LAS unsigned*)(lds + TOKTAB + 4 * (h * HALF + Rr[i])); tk = tk < (unsigned)(M - 1) ? tk : (unsigned)(M - 1); gA[h][i] = tk * (unsigned)rowb + (unsigned)(Cc[i] * 2); } } }
            if constexpr (Epi::NVM > 0) PG8_WAIT_SEL(after_epi, 8 + Epi::NVM); else PG8_WAIT_V(8);
            PG8_WAIT_L(0); PG8_BAR; PG8_MMA(0, 0, At, B0); PG8_MMA(0, 1, At, B1); PG8_BAR; PG8_SCHED;
            PG8_LDA(At, 0, 1); PG8_STAGE(PG8_SB(0, 0), b2, voffB); PG8_STAGE(PG8_SB(0, 1), b2 + hstep, voffB); PG8_STAGE_A(PG8_SA(0, 0), a2, 0);
            if constexpr (Epi::NVM > 0) PG8_WAIT_SEL(after_epi, 8 + Epi::NVM); else PG8_WAIT_V(8);
            PG8_WAIT_L(0); PG8_BAR; PG8_MMA(1, 0, At, B0); PG8_MMA(1, 1, At, B1); PG8_BAR; PG8_SCHED;
            PG8_LDB(B0, 1, 0); PG8_LDB(B1, 1, 1); PG8_SCHED; PG8_LDA(At, 1, 0); PG8_STAGE_A(PG8_SA(0, 1), a2, 1);
            PG8_WAIT_V(8); PG8_WAIT_L(0); PG8_BAR; PG8_MMA(0, 0, At, B0); PG8_MMA(0, 1, At, B1); PG8_BAR; PG8_SCHED;
            PG8_LDA(At, 1, 1); PG8_STAGE(PG8_SB(1, 0), b3, voffB); PG8_STAGE(PG8_SB(1, 1), b3 + hstep, voffB); PG8_STAGE_A(PG8_SA(1, 0), a3, 0);
            PG8_WAIT_V(8); PG8_WAIT_L(0); PG8_BAR; PG8_MMA(1, 0, At, B0); PG8_MMA(1, 1, At, B1); PG8_BAR; PG8_SCHED;
        }
        if (wr == 0) PG8_BAR;
        if constexpr (F8) asm volatile("s_nop 15\n\ts_nop 15" ::: "memory");
        E(acc, cur, wr, wc, fr, fq);
        if (!has_next) break;
#pragma unroll
        for (int a = 0; a < 2; ++a)
#pragma unroll
            for (int b = 0; b < 2; ++b)
#pragma unroll
                for (int m = 0; m < 4; ++m)
#pragma unroll
                    for (int n = 0; n < 2; ++n) acc[a][b][m][n] = (f32x4){0.f, 0.f, 0.f, 0.f};
        cur = nxt; cA = nA; cB = nB; ++ui;
        if (wr == 1) PG8_BAR;
    }
    PG8_WAIT_V(0);
    PG8_BAR;
#undef PG8_SA
#undef PG8_SB
#undef PG8_STAGE
#undef PG8_STAGE_A
#undef PG8_LDA
#undef PG8_LDB
#undef PG8_MMA
#undef PG8_LD8
#undef PG8_WAIT_V
#undef PG8_WAIT_SEL
#undef PG8_WAIT_L
#undef PG8_BAR
#undef PG8_SCHED
}
}

template <int Mr, int Nc, int K, bool ACCUM>
__device__ __forceinline__ void mm_lds(const LAS bf16* A, int lda, const LAS bf16* Bt, int ldb, f32x4 (&acc)[(Mr / 16) * (Nc / 16) / 8], int wave, int lane) {
    constexpr int NT = Nc / 16, TPW = (Mr / 16) * NT / 8;
    const int fr = lane & 15, fq = lane >> 4;
#pragma unroll
    for (int q = 0; q < TPW; ++q) {
        const int t = wave + 8 * q, ti = t / NT, tj = t % NT;
        f32x4 c = ACCUM ? acc[q] : (f32x4){0.f, 0.f, 0.f, 0.f};
#pragma unroll
        for (int k0 = 0; k0 < K; k0 += 32) {
            const bf16x8 a = *(const LAS bf16x8*)(A + (16 * ti + fr) * lda + k0 + 8 * fq);
            const bf16x8 b = *(const LAS bf16x8*)(Bt + (16 * tj + fr) * ldb + k0 + 8 * fq);
            c = __builtin_amdgcn_mfma_f32_16x16x32_bf16(a, b, c, 0, 0, 0);
        }
        acc[q] = c;
        if (TPW > 2) asm volatile("" ::: "memory");
    }
}
#define MM_ROW(NT, q, r) (16 * ((wave + 8 * (q)) / (NT)) + 4 * fq + (r))
#define MM_COL(NT, q)    (16 * ((wave + 8 * (q)) % (NT)) + fr)

struct Args { const float* in[25]; float* out; unsigned char* ws; int ph_lo, ph_hi; };
constexpr int NPHASE = 17;

template <bool F8>
__device__ __forceinline__ void p0_tile(const float* W, int K, int N, void* WTv, int mode, float scale, LAS unsigned* T, int item, int lane) {
    const int nblk = N / 64, kb = item / nblk, nb = item % nblk, k0 = 64 * kb, n0 = 64 * nb;
    const int row0 = mode == 0 ? n0 : ((n0 >> 7) << 8) + (n0 & 127) + (mode == 2 ? 128 : 0);
    const int g = lane >> 4, m = lane & 15;
    constexpr int P = F8 ? 17 : 33;
    f32x4 v[16];
#pragma unroll
    for (int L = 0; L < 16; ++L) { const int kk = F8 ? (16 * (L >> 2) + 4 * g + (L & 3)) : (8 * (L >> 1) + 2 * g + (L & 1)); v[L] = *(const f32x4*)(W + (size_t)(k0 + kk) * N + n0 + 4 * m); }
    if constexpr (F8) {
#pragma unroll
        for (int i = 0; i < 4; ++i)
#pragma unroll
            for (int j = 0; j < 4; ++j) { const float q0 = __builtin_amdgcn_fmed3f(v[4 * i][j] * scale, -448.f, 448.f), q1 = __builtin_amdgcn_fmed3f(v[4 * i + 1][j] * scale, -448.f, 448.f), q2 = __builtin_amdgcn_fmed3f(v[4 * i + 2][j] * scale, -448.f, 448.f), q3 = __builtin_amdgcn_fmed3f(v[4 * i + 3][j] * scale, -448.f, 448.f);
                int w = __builtin_amdgcn_cvt_pk_fp8_f32(q0, q1, 0, false); w = __builtin_amdgcn_cvt_pk_fp8_f32(q2, q3, w, true);
                T[(4 * m + j) * P + 4 * i + g] = (unsigned)w; }
    } else {
#pragma unroll
        for (int i = 0; i < 8; ++i)
#pragma unroll
            for (int j = 0; j < 4; ++j) T[(4 * m + j) * P + 4 * i + g] = pk2(v[2 * i][j], v[2 * i + 1][j]);
    }
    LDS_WAIT(); asm volatile("" ::: "memory");
    if constexpr (F8) {
        unsigned char* WT = (unsigned char*)WTv;
#pragma unroll
        for (int p = 0; p < 4; ++p) { const int n = (lane >> 2) + 16 * p, c = lane & 3; const LAS unsigned* t = T + n * P + 4 * c; u32x4 o; o.x = t[0]; o.y = t[1]; o.z = t[2]; o.w = t[3];
            *(u32x4*)(WT + (size_t)(row0 + n) * K + k0 + 16 * c) = o; }
    } else {
        bf16* WT = (bf16*)WTv;
#pragma unroll
        for (int p = 0; p < 8; ++p) { const int n = (lane >> 3) + 8 * p, c = lane & 7; const LAS unsigned* t = T + n * P + 4 * c; u32x4 o; o.x = t[0]; o.y = t[1]; o.z = t[2]; o.w = t[3];
            *(u32x4*)(WT + (size_t)(row0 + n) * K + k0 + 8 * c) = o; }
    }
    LDS_WAIT(); asm volatile("" ::: "memory");
}
__device__ __forceinline__ void rms_row_bf16(const float* xrow, const float* g, bf16* orow, int lane) {
    const f32x4* xr = (const f32x4*)xrow + lane; const f32x4* gr = (const f32x4*)g + lane;
    f32x4 v[4]; float s = 0.f;
#pragma unroll
    for (int j = 0; j < 4; ++j) { v[j] = xr[64 * j]; s += (v[j].x * v[j].x + v[j].y * v[j].y) + (v[j].z * v[j].z + v[j].w * v[j].w); }
    const float rstd = rsqrtf(wave_sum(s) * (1.f / D) + EPS);
    u32x2* o8 = (u32x2*)orow + lane;
#pragma unroll
    for (int j = 0; j < 4; ++j) { const f32x4 gv = gr[64 * j]; u32x2 w; w.x = pk2(v[j].x * rstd * gv.x, v[j].y * rstd * gv.y); w.y = pk2(v[j].z * rstd * gv.z, v[j].w * rstd * gv.w); o8[64 * j] = w; }
}

__device__ __forceinline__ void rms_res_row_bf16(const float* xin, const bf16* drow, float* xout, const float* g, bf16* orow, int lane) {
    const f32x4* xr = (const f32x4*)xin + lane; const f32x4* gr = (const f32x4*)g + lane; const u32x2* dr = (const u32x2*)drow + lane;
    f32x4 v[4]; u32x2 dv[4]; float s = 0.f;
#pragma unroll
    for (int j = 0; j < 4; ++j) { v[j] = xr[64 * j]; dv[j] = dr[64 * j]; }
#pragma unroll
    for (int j = 0; j < 4; ++j) { v[j].x += bf2f(dv[j].x); v[j].y += bf2f(dv[j].x >> 16); v[j].z += bf2f(dv[j].y); v[j].w += bf2f(dv[j].y >> 16);
        ((f32x4*)xout + lane)[64 * j] = v[j]; s += (v[j].x * v[j].x + v[j].y * v[j].y) + (v[j].z * v[j].z + v[j].w * v[j].w); }
    const float rstd = rsqrtf(wave_sum(s) * (1.f / D) + EPS);
    u32x2* o8 = (u32x2*)orow + lane;
#pragma unroll
    for (int j = 0; j < 4; ++j) { const f32x4 gv = gr[64 * j]; u32x2 w; w.x = pk2(v[j].x * rstd * gv.x, v[j].y * rstd * gv.y); w.y = pk2(v[j].z * rstd * gv.z, v[j].w * rstd * gv.w); o8[64 * j] = w; }
}
__device__ __forceinline__ void rms_res_row2_bf16(const float* xin, const bf16* drow, float* xout, const float* g, bf16* orow, size_t rstride, int lane) {
    const f32x4* gr = (const f32x4*)g + lane;
    f32x4 v[2][4]; u32x2 dv[2][4]; float s[2] = {0.f, 0.f};
#pragma unroll
    for (int r = 0; r < 2; ++r)
#pragma unroll
        for (int j = 0; j < 4; ++j) { v[r][j] = ((const f32x4*)(xin + r * rstride) + lane)[64 * j]; dv[r][j] = ((const u32x2*)(drow + r * rstride) + lane)[64 * j]; }
#pragma unroll
    for (int r = 0; r < 2; ++r)
#pragma unroll
        for (int j = 0; j < 4; ++j) { v[r][j].x += bf2f(dv[r][j].x); v[r][j].y += bf2f(dv[r][j].x >> 16); v[r][j].z += bf2f(dv[r][j].y); v[r][j].w += bf2f(dv[r][j].y >> 16);
            ((f32x4*)(xout + r * rstride) + lane)[64 * j] = v[r][j]; s[r] += (v[r][j].x * v[r][j].x + v[r][j].y * v[r][j].y) + (v[r][j].z * v[r][j].z + v[r][j].w * v[r][j].w); }
#pragma unroll
    for (int r = 0; r < 2; ++r) { const float rstd = rsqrtf(wave_sum(s[r]) * (1.f / D) + EPS);
        u32x2* o8 = (u32x2*)(orow + r * rstride) + lane;
#pragma unroll
        for (int j = 0; j < 4; ++j) { const f32x4 gv = gr[64 * j]; u32x2 w; w.x = pk2(v[r][j].x * rstd * gv.x, v[r][j].y * rstd * gv.y); w.y = pk2(v[r][j].z * rstd * gv.z, v[r][j].w * rstd * gv.w); o8[64 * j] = w; } }
}

struct RetPf { u32x4 q1, q2, k1, k2, v1, v2, g1, g2; f32x4 r0, r1, r2, r3; };
template <bool NEEDQ>
__device__ __forceinline__ void ret_load(RetPf& pf, const bf16* proj, const f32x2* ROT, size_t row0, int tpos0, int h, int tid) {
    const int j = tid >> 3, seg = tid & 7;
    const bf16* prow = proj + (row0 + j) * EVEN_IN + 128 * h;
    pf.k1 = *(const u32x4*)(prow + RK_OFF + 8 * seg); pf.k2 = *(const u32x4*)(prow + RK_OFF + 64 + 8 * seg);
    pf.v1 = *(const u32x4*)(prow + RV_OFF + 16 * seg); pf.v2 = *(const u32x4*)(prow + RV_OFF + 16 * seg + 8);
    if constexpr (NEEDQ) { pf.q1 = *(const u32x4*)(prow + RQ_OFF + 8 * seg); pf.q2 = *(const u32x4*)(prow + RQ_OFF + 64 + 8 * seg);
        pf.g1 = *(const u32x4*)(prow + RGATE_OFF + 16 * seg); pf.g2 = *(const u32x4*)(prow + RGATE_OFF + 16 * seg + 8); }
    const f32x4* rp = (const f32x4*)(ROT + (size_t)(tpos0 + j) * 64 + 8 * seg);
    pf.r0 = rp[0]; pf.r1 = rp[1]; pf.r2 = rp[2]; pf.r3 = rp[3];
}
template <bool NEEDQ>
__device__ __forceinline__ void ret_write(const RetPf& pf, float l2g, LAS bf16* rQ, LAS bf16* rK, LAS bf16* rKdT, LAS bf16* rVT, LAS bf16* rG, int tid) {
    constexpr int LQ = 136, LT = 72;
    const int j = tid >> 3, seg = tid & 7;
    const float cs[16] = {pf.r0.x, pf.r0.y, pf.r0.z, pf.r0.w, pf.r1.x, pf.r1.y, pf.r1.z, pf.r1.w, pf.r2.x, pf.r2.y, pf.r2.z, pf.r2.w, pf.r3.x, pf.r3.y, pf.r3.z, pf.r3.w};
    const unsigned k1w[4] = {pf.k1.x, pf.k1.y, pf.k1.z, pf.k1.w}, k2w[4] = {pf.k2.x, pf.k2.y, pf.k2.z, pf.k2.w}, v1w[4] = {pf.v1.x, pf.v1.y, pf.v1.z, pf.v1.w}, v2w[4] = {pf.v2.x, pf.v2.y, pf.v2.z, pf.v2.w};
    const float dec = exp2f((float)(63 - j) * l2g);
    unsigned qa[4], qb[4], ka[4], kb[4];
#pragma unroll
    for (int w = 0; w < 4; ++w) {
        float kr1[2], kr2[2], qr1[2] = {0.f, 0.f}, qr2[2] = {0.f, 0.f};
#pragma unroll
        for (int x = 0; x < 2; ++x) { const int c = 2 * w + x; const float co = cs[2 * c], si = cs[2 * c + 1];
            const float a = bf2f(k1w[w] >> (16 * x)) * 0.08838834764831845f, b = bf2f(k2w[w] >> (16 * x)) * 0.08838834764831845f;
            kr1[x] = a * co - b * si; kr2[x] = a * si + b * co;
            rKdT[(8 * seg + c) * LT + j] = (bf16)f2bf(kr1[x] * dec); rKdT[(64 + 8 * seg + c) * LT + j] = (bf16)f2bf(kr2[x] * dec);
            if constexpr (NEEDQ) { const unsigned q1w = w == 0 ? pf.q1.x : (w == 1 ? pf.q1.y : (w == 2 ? pf.q1.z : pf.q1.w)), q2w = w == 0 ? pf.q2.x : (w == 1 ? pf.q2.y : (w == 2 ? pf.q2.z : pf.q2.w));
                const float qa_ = bf2f(q1w >> (16 * x)), qb_ = bf2f(q2w >> (16 * x)); qr1[x] = qa_ * co - qb_ * si; qr2[x] = qa_ * si + qb_ * co; }
            rVT[(16 * seg + c) * LT + j] = (bf16)((v1w[w] >> (16 * x)) & 0xffffu); rVT[(16 * seg + 8 + c) * LT + j] = (bf16)((v2w[w] >> (16 * x)) & 0xffffu); }
        if constexpr (NEEDQ) { ka[w] = pk2(kr1[0], kr1[1]); kb[w] = pk2(kr2[0], kr2[1]); qa[w] = pk2(qr1[0], qr1[1]); qb[w] = pk2(qr2[0], qr2[1]); }
    }
    if constexpr (NEEDQ) {
        u32x4 t; t.x = qa[0]; t.y = qa[1]; t.z = qa[2]; t.w = qa[3]; *(LAS u32x4*)(rQ + j * LQ + 8 * seg) = t;
        t.x = qb[0]; t.y = qb[1]; t.z = qb[2]; t.w = qb[3]; *(LAS u32x4*)(rQ + j * LQ + 64 + 8 * seg) = t;
        t.x = ka[0]; t.y = ka[1]; t.z = ka[2]; t.w = ka[3]; *(LAS u32x4*)(rK + j * LQ + 8 * seg) = t;
        t.x = kb[0]; t.y = kb[1]; t.z = kb[2]; t.w = kb[3]; *(LAS u32x4*)(rK + j * LQ + 64 + 8 * seg) = t;
        *(LAS u32x4*)(rG + j * LQ + 16 * seg) = pf.g1; *(LAS u32x4*)(rG + j * LQ + 16 * seg + 8) = pf.g2;
    }
}

__global__ void __launch_bounds__(512, 2) fwd_kernel(Args args) {
    extern __shared__ __attribute__((aligned(16))) unsigned char lds_raw[];
    LAS unsigned char* lds = (LAS unsigned char*)lds_raw;
    volatile LAS unsigned* MISC = (volatile LAS unsigned*)(lds + LDS_MISC);
    LAS unsigned char* scrb = lds + LDS_SCR;
    const int tid = threadIdx.x, lane = tid & 63, wave = __builtin_amdgcn_readfirstlane(tid >> 6);
    const int G = gridDim.x, bid = blockIdx.x;
    const int fr = lane & 15, fq = lane >> 4;
    unsigned char* ws = args.ws;
    unsigned* ctl = (unsigned*)(ws + WS_CTL);
    float* out = args.out;
    const int lo = args.ph_lo, hi = args.ph_hi;

    if (tid < 64) MISC[tid] = 0u;
    __syncthreads();
    XcdBarrier bar; bar.bar = ctl + CW_BAR; bar.x = 0; bar.st = MISC;
    if (hi - lo > 1) bar = xcd_barrier_post(ctl + CW_BAR, MISC);
#ifndef PHASE_MASK
#define PHASE_MASK 0x1ffff
#endif
#define IN(k) ((((PHASE_MASK) >> (k)) & 1) && lo <= (k) && (k) < hi)
#define SEAM(k) do { if (IN(k) && IN((k) + 1)) xcd_barrier(bar); PSTAMP((k) + 1); } while (0)
#define PSTAMP(k) do { if (PROBE_A_LO >= 0 && bid == 0 && tid == 0) { const unsigned _t = (unsigned)wall_clock64(); if ((k) == PROBE_A_LO) MISC[8] = _t; if ((k) == PROBE_A_HI + 1) MISC[9] = _t; if ((k) == PROBE_B_LO) MISC[10] = _t; if ((k) == PROBE_B_HI + 1) MISC[11] = _t; } } while (0)
    PSTAMP(0);

    bf16* const ACTA = (bf16*)(ws + WS_ACTA);
    bf16* const ACTB = (bf16*)(ws + WS_ACTB);
    const f32x2* const ROT = (const f32x2*)(ws + WS_ROT);
    const int gw = bid * 8 + wave, NGW = G * 8;

    if (IN(0)) {
        LAS unsigned* scr = (LAS unsigned*)(scrb + wave * 16384);
        constexpr int I_IN0 = 16 * 56, I_OUT = 16 * 16, I_FF = 16 * 44, I_DN0 = 44 * 16, I_IN1 = 16 * 40, I_EXP = 16 * 56, I_EDN = 56 * 16;
        constexpr int NITEMS = I_IN0 + I_OUT + 2 * I_FF + I_DN0 + I_IN1 + I_OUT + 2 * 8 * I_EXP + 8 * I_EDN;
        for (int it = gw; it < NITEMS; it += NGW) {
            int r = it;
            if (r < 8 * I_EXP) { const int e = r / I_EXP; p0_tile<true>(args.in[22] + (size_t)e * D * D_EXP, D, D_EXP, ws + WT_GU1 + (size_t)e * 2 * D_EXP * D, 1, 64.f, scr, r % I_EXP, lane); continue; } r -= 8 * I_EXP;
            if (r < 8 * I_EXP) { const int e = r / I_EXP; p0_tile<true>(args.in[23] + (size_t)e * D * D_EXP, D, D_EXP, ws + WT_GU1 + (size_t)e * 2 * D_EXP * D, 2, 64.f, scr, r % I_EXP, lane); continue; } r -= 8 * I_EXP;
            if (r < 8 * I_EDN) { const int e = r / I_EDN; p0_tile<true>(args.in[24] + (size_t)e * D_EXP * D, D_EXP, D, ws + WT_DN1 + (size_t)e * D * D_EXP, 0, 64.f, scr, r % I_EDN, lane); continue; } r -= 8 * I_EDN;
            if (r < I_IN0) { p0_tile<false>(args.in[4], D, EVEN_IN, (bf16*)(ws + WT_IN0), 0, 1.f, scr, r, lane); continue; } r -= I_IN0;
            if (r < I_OUT) { p0_tile<false>(args.in[6], D, D, (bf16*)(ws + WT_OUT0), 0, 1.f, scr, r, lane); continue; } r -= I_OUT;
            if (r < I_FF) { p0_tile<false>(args.in[7], D, D_FF, (bf16*)(ws + WT_GU0), 1, 1.f, scr, r, lane); continue; } r -= I_FF;
            if (r < I_FF) { p0_tile<false>(args.in[8], D, D_FF, (bf16*)(ws + WT_GU0), 2, 1.f, scr, r, lane); continue; } r -= I_FF;
            if (r < I_DN0) { p0_tile<false>(args.in[9], D_FF, D, (bf16*)(ws + WT_DN0), 0, 1.f, scr, r, lane); continue; } r -= I_DN0;
            if (r < I_IN1) { p0_tile<false>(args.in[10], D, ODD_IN, (bf16*)(ws + WT_IN1), 0, 1.f, scr, r, lane); continue; } r -= I_IN1;
            p0_tile<false>(args.in[19], D, D, (bf16*)(ws + WT_OUT1), 0, 1.f, scr, r, lane);
        }
        for (int idx = bid * 512 + tid; idx < SEQ * 64; idx += G * 512) {
            const int t = idx >> 6, i = idx & 63;
            const float inv_freq = exp2f(-(float)i * (13.287712379549449f / 64.0f));
            double rev = (double)t * (double)inv_freq * 0.15915494309189535; rev -= floor(rev);
            const float rv = (float)rev;
            f32x2 cs; cs.x = __builtin_amdgcn_cosf(rv); cs.y = __builtin_amdgcn_sinf(rv);
            ((f32x2*)(ws + WS_ROT))[idx] = cs;
        }
        for (int m = gw; m < M; m += NGW) rms_row_bf16(args.in[0] + (size_t)m * D, args.in[1], ACTA + (size_t)m * D, lane);
    }
    SEAM(0);

    if (IN(1)) {
        pg8::DenseSched S; S.init(ACTA, (const bf16*)(ws + WT_IN0), M, EVEN_IN, D, G, bid);
        pg8::EpiStoreBf16 E{ACTB, EVEN_IN};
        pg8::gemm_phase<pg8::EpiStoreBf16, pg8::DenseSched, false>(scrb, 2 * D, S, E);
    }
    SEAM(1);

    constexpr int LQ = 136, LT = 72;
    LAS bf16* const rQ = (LAS bf16*)(scrb);
    LAS bf16* const rK = (LAS bf16*)(scrb + 17408);
    LAS bf16* const rKdT = (LAS bf16*)(scrb + 34816);
    LAS bf16* const rVT = (LAS bf16*)(scrb + 53248);
    LAS bf16* const rS = (LAS bf16*)(scrb + 71680);
    LAS bf16* const rStT = (LAS bf16*)(scrb + 80896);
    LAS float* const rStat = (LAS float*)(scrb + 115712);
    LAS bf16* const rG = (LAS bf16*)(scrb + 120320);
    float* const RGS = (float*)(ws + WS_SCR);

    if (IN(2)) {
        for (int item = bid; item < 256; item += G) {
            const int b = item >> 5, h = (item >> 3) & 3, g = item & 7;
            const float l2g = log2f(1.0f - exp2f(-5.0f - (float)h));
            const float g64 = exp2f(64.0f * l2g);
            f32x4 st[8];
#pragma unroll
            for (int q = 0; q < 8; ++q) st[q] = (f32x4){0.f, 0.f, 0.f, 0.f};
            RetPf pf;
            ret_load<false>(pf, ACTB, ROT, (size_t)b * SEQ + (g * 8) * 64, (g * 8) * 64, h, tid);
            for (int n = 0; n < 8; ++n) {
                ret_write<false>(pf, l2g, rQ, rK, rKdT, rVT, rG, tid);
                if (n < 7) { const int tposn = (g * 8 + n + 1) * 64; ret_load<false>(pf, ACTB, ROT, (size_t)b * SEQ + tposn, tposn, h, tid); }
                __syncthreads();
#pragma unroll
                for (int q = 0; q < 8; ++q) st[q] = st[q] * g64;
                mm_lds<128, 128, 64, true>(rKdT, LT, rVT, LT, st, wave, lane);
                __syncthreads();
            }
            float* gp = RGS + (size_t)item * 16384 + tid;
#pragma unroll
            for (int q = 0; q < 8; ++q)
#pragma unroll
                for (int r = 0; r < 4; ++r) gp[(q * 4 + r) * 512] = st[q][r];
        }
        {
            __syncthreads();
            constexpr int PV = 80;
            LAS bf16* const sV = (LAS bf16*)(scrb + wave * 10240);
            const int vkey = lane >> 3, vpc = lane & 7;
            for (int wi = bid * 8 + wave; wi < NB * 8 * 256; wi += G * 8) {
                const int qt = 255 - (wi & 255), h = (wi >> 8) & 7, b = wi >> 11;
                const size_t brow = (size_t)b * SEQ;
                const int tq = 16 * qt + fr;
                bf16x8 qf[2];
#pragma unroll
                for (int ks = 0; ks < 2; ++ks) qf[ks] = *(const bf16x8*)(ACTB + (brow + tq) * EVEN_IN + SQ_OFF + 64 * h + 32 * ks + 8 * fq);
                f32x4 ot[4];
#pragma unroll
                for (int dt = 0; dt < 4; ++dt) ot[dt] = (f32x4){0.f, 0.f, 0.f, 0.f};
                float C = 1.0f;
                int kt = qt >> 2;
                bf16x8 kf[4][2]; u32x4 vr[8];
#pragma unroll
                for (int tj = 0; tj < 4; ++tj)
#pragma unroll
                    for (int ks = 0; ks < 2; ++ks) kf[tj][ks] = *(const bf16x8*)(ACTB + (brow + 64 * kt + 16 * tj + fr) * EVEN_IN + SK_OFF + 64 * h + 32 * ks + 8 * fq);
#pragma unroll
                for (int i = 0; i < 8; ++i) vr[i] = *(const u32x4*)(ACTB + (brow + 64 * kt + 8 * i + vkey) * EVEN_IN + SV_OFF + 64 * h + 8 * vpc);
                for (;;) {
#pragma unroll
                    for (int i = 0; i < 8; ++i) { LAS u32x2* d = (LAS u32x2*)(sV + (8 * i + vkey) * PV + 8 * vpc); u32x2 lo, hi; lo.x = vr[i].x; lo.y = vr[i].y; hi.x = vr[i].z; hi.y = vr[i].w; d[0] = lo; d[1] = hi; }
                    f32x4 zt[4];
#pragma unroll
                    for (int tj = 0; tj < 4; ++tj) { zt[tj] = __builtin_amdgcn_mfma_f32_16x16x32_bf16(kf[tj][0], qf[0], (f32x4){0.f, 0.f, 0.f, 0.f}, 0, 0, 0); zt[tj] = __builtin_amdgcn_mfma_f32_16x16x32_bf16(kf[tj][1], qf[1], zt[tj], 0, 0, 0); }
                    const int ktn = kt - 1;
                    if (ktn >= 0) {
#pragma unroll
                        for (int tj = 0; tj < 4; ++tj)
#pragma unroll
                            for (int ks = 0; ks < 2; ++ks) kf[tj][ks] = *(const bf16x8*)(ACTB + (brow + 64 * ktn + 16 * tj + fr) * EVEN_IN + SK_OFF + 64 * h + 32 * ks + 8 * fq);
#pragma unroll
                        for (int i = 0; i < 8; ++i) vr[i] = *(const u32x4*)(ACTB + (brow + 64 * ktn + 8 * i + vkey) * EVEN_IN + SV_OFF + 64 * h + 8 * vpc);
                    }
                    float a[4][4], pseg[4];
#pragma unroll
                    for (int tj = 0; tj < 4; ++tj) { float suf = 1.0f;
#pragma unroll
                        for (int r = 3; r >= 0; --r) { const int sk = 64 * kt + 16 * tj + 4 * fq + r; const bool valid = sk < tq;
                            const float pp = __builtin_amdgcn_rcpf(1.0f + __builtin_amdgcn_exp2f(zt[tj][r] * (0.125f * 1.4426950408889634f)));
                            const float p = valid ? pp : 1.0f, be = valid ? 1.0f - pp : 0.0f; a[tj][r] = be * suf; suf *= p; }
                        pseg[tj] = suf; }
                    float run = C;
#pragma unroll
                    for (int tj = 3; tj >= 0; --tj) { const float y = __shfl_xor(pseg[tj], 16); const float pair = pseg[tj] * y; const float zz = __shfl_xor(pair, 32);
                        const float S = ((fq & 1) ? 1.0f : y) * ((fq & 2) ? 1.0f : zz); const float sc = S * run;
#pragma unroll
                        for (int r = 0; r < 4; ++r) a[tj][r] *= sc;
                        run *= pair * zz; }
                    C = run;
                    bf16x8 af[2];
#pragma unroll
                    for (int ks = 0; ks < 2; ++ks) { u32x4 w; w.x = pk2(a[2 * ks][0], a[2 * ks][1]); w.y = pk2(a[2 * ks][2], a[2 * ks][3]); w.z = pk2(a[2 * ks + 1][0], a[2 * ks + 1][1]); w.w = pk2(a[2 * ks + 1][2], a[2 * ks + 1][3]); af[ks] = __builtin_bit_cast(bf16x8, w); }
                    LDS_WAIT(); asm volatile("" ::: "memory");
#pragma unroll
                    for (int dt = 0; dt < 4; ++dt)
#pragma unroll
                        for (int ks = 0; ks < 2; ++ks) {
                            const LAS v4s_t* tp = (const LAS v4s_t*)(sV + (32 * ks + 4 * fq + (fr >> 2)) * PV + 16 * dt + 4 * (fr & 3));
                            const v4s_t lo = __builtin_amdgcn_ds_read_tr16_b64_v4i16((LAS v4s_t*)tp), hi = __builtin_amdgcn_ds_read_tr16_b64_v4i16((LAS v4s_t*)(tp + 4 * PV));
                            const bf16x8 vf = __builtin_shufflevector(lo, hi, 0, 1, 2, 3, 4, 5, 6, 7);
                            ot[dt] = __builtin_amdgcn_mfma_f32_16x16x32_bf16(vf, af[ks], ot[dt], 0, 0, 0); }
                    LDS_WAIT(); asm volatile("" ::: "memory");
                    if (ktn < 0 || __all(C < 1e-30f)) break;
                    kt = ktn;
                }
#pragma unroll
                for (int dt = 0; dt < 4; ++dt) { u32x2 w; w.x = pk2(ot[dt][0], ot[dt][1]); w.y = pk2(ot[dt][2], ot[dt][3]);
                    *(u32x2*)(ACTA + (brow + tq) * D + 512 + 64 * h + 16 * dt + 4 * fq) = w; }
            }
        }
    }
    SEAM(2);

    if (IN(3)) {
        const int fr0 = fr, fq0 = fq;
        for (int item = bid; item < 256; item += G) {
            const int b = item >> 5, h = (item >> 3) & 3, g = item & 7;
            const float l2g = log2f(1.0f - exp2f(-5.0f - (float)h));
            const float g64 = exp2f(64.0f * l2g), g512 = exp2f(512.0f * l2g);
            f32x4 st[8];
#pragma unroll
            for (int q = 0; q < 8; ++q) st[q] = (f32x4){0.f, 0.f, 0.f, 0.f};
            for (int gp_ = 0; gp_ < g; ++gp_) {
                const float* gp = RGS + (size_t)(item - g + gp_) * 16384 + tid;
#pragma unroll
                for (int q = 0; q < 8; ++q)
#pragma unroll
                    for (int r = 0; r < 4; ++r) st[q][r] = st[q][r] * g512 + gp[(q * 4 + r) * 512];
            }
            RetPf pf;
            ret_load<true>(pf, ACTB, ROT, (size_t)b * SEQ + (g * 8) * 64, (g * 8) * 64, h, tid);
            for (int n = 0; n < 8; ++n) {
                int tid_l = tid, fr_l = fr0, fq_l = fq0;
                asm volatile("" : "+v"(tid_l), "+v"(fr_l), "+v"(fq_l));
                { const int fr = fr_l, fq = fq_l, lane = (fq_l << 4) | fr_l;
                const int tpos0 = (g * 8 + n) * 64; const size_t row0 = (size_t)b * SEQ + tpos0;
                __syncthreads();
                ret_write<true>(pf, l2g, rQ, rK, rKdT, rVT, rG, tid_l);
                if (n < 7) { const int tposn = tpos0 + 64; ret_load<true>(pf, ACTB, ROT, (size_t)b * SEQ + tposn, tposn, h, tid_l); }
#pragma unroll
                for (int q = 0; q < 8; ++q) { u32x2 w; w.x = pk2(st[q][0], st[q][1]); w.y = pk2(st[q][2], st[q][3]);
                    *(LAS u32x2*)(rStT + MM_COL(8, q) * LQ + 16 * q + 4 * fq) = w; }
                __syncthreads();
                { f32x4 sT[2]; mm_lds<64, 64, 128, false>(rK, LQ, rQ, LQ, sT, wave, lane);
                  const int i = MM_COL(4, 0);
#pragma unroll
                  for (int q = 0; q < 2; ++q) { const int j0 = MM_ROW(4, q, 0); float e4[4];
#pragma unroll
                      for (int r = 0; r < 4; ++r) { const int dd = i > j0 + r ? i - j0 - r : j0 + r - i; e4[r] = sT[q][r] * exp2f((float)dd * l2g); }
                      u32x2 w; w.x = pk2(e4[0], e4[1]); w.y = pk2(e4[2], e4[3]); *(LAS u32x2*)(rS + i * LT + j0) = w; } }
                __syncthreads();
                f32x4 oi[4];
                mm_lds<128, 64, 128, false>(rStT, LQ, rQ, LQ, oi, wave, lane);
                const int io = MM_COL(4, 0);
                { const float gi1 = exp2f((float)(io + 1) * l2g);
#pragma unroll
                  for (int q = 0; q < 4; ++q) oi[q] = oi[q] * gi1; }
                mm_lds<128, 64, 64, true>(rVT, LT, rS, LT, oi, wave, lane);
                { float s1 = 0.f, s2 = 0.f;
#pragma unroll
                  for (int q = 0; q < 4; ++q)
#pragma unroll
                      for (int r = 0; r < 4; ++r) { s1 += oi[q][r]; s2 += oi[q][r] * oi[q][r]; }
                  s1 += __shfl_xor(s1, 16); s2 += __shfl_xor(s2, 16); s1 += __shfl_xor(s1, 32); s2 += __shfl_xor(s2, 32);
                  if (fq == 0) { rStat[(io * 2 + (wave >> 2)) * 2] = s1; rStat[(io * 2 + (wave >> 2)) * 2 + 1] = s2; } }
                __syncthreads();
                { const float s1 = rStat[(io * 2) * 2] + rStat[(io * 2 + 1) * 2], s2 = rStat[(io * 2) * 2 + 1] + rStat[(io * 2 + 1) * 2 + 1];
                  const float mu = s1 * (1.0f / 128.0f); float var = s2 * (1.0f / 128.0f) - mu * mu; var = var < 0.f ? 0.f : var; const float rstd = rsqrtf(var + EPS);
#pragma unroll
                  for (int q = 0; q < 4; ++q) { const int e0 = MM_ROW(4, q, 0);
                      const u32x2 gt = *(const LAS u32x2*)(rG + io * LQ + e0); const f32x4 gw4 = *(const f32x4*)(args.in[5] + 128 * h + e0);
                      const float g0 = bf2f(gt.x), g1 = bf2f(gt.x >> 16), g2 = bf2f(gt.y), g3 = bf2f(gt.y >> 16);
                      u32x2 w; w.x = pk2((oi[q][0] - mu) * rstd * gw4.x * g0 * sigmoidf_(g0), (oi[q][1] - mu) * rstd * gw4.y * g1 * sigmoidf_(g1));
                      w.y = pk2((oi[q][2] - mu) * rstd * gw4.z * g2 * sigmoidf_(g2), (oi[q][3] - mu) * rstd * gw4.w * g3 * sigmoidf_(g3));
                      *(LAS u32x2*)(rQ + io * LQ + e0) = w; } }
#pragma unroll
                for (int q = 0; q < 8; ++q) st[q] = st[q] * g64;
                mm_lds<128, 128, 64, true>(rKdT, LT, rVT, LT, st, wave, lane);
                __syncthreads();
                { const int j = tid_l >> 3, seg = tid_l & 7; bf16* yp = ACTA + (row0 + j) * D + 128 * h + 16 * seg;
                  *(u32x4*)yp = *(const LAS u32x4*)(rQ + j * LQ + 16 * seg); *(u32x4*)(yp + 8) = *(const LAS u32x4*)(rQ + j * LQ + 16 * seg + 8); }
                }
            }
        }
    }
    SEAM(3);

    if (IN(4)) {
        pg8::DenseSched S; S.init(ACTA, (const bf16*)(ws + WT_OUT0), M, D, D, G, bid);
        pg8::EpiStoreBf16 E{ACTB, D};
        pg8::gemm_phase<pg8::EpiStoreBf16, pg8::DenseSched, false>(scrb, 2 * D, S, E);
    }
    SEAM(4);
    if (IN(5)) { for (int m = gw; m < M; m += 2 * NGW) { if (m + NGW < M) rms_res_row2_bf16(args.in[0] + (size_t)m * D, ACTB + (size_t)m * D, out + (size_t)m * D, args.in[2], ACTA + (size_t)m * D, (size_t)NGW * D, lane);
            else rms_res_row_bf16(args.in[0] + (size_t)m * D, ACTB + (size_t)m * D, out + (size_t)m * D, args.in[2], ACTA + (size_t)m * D, lane); } }
    SEAM(5);
    if (IN(6)) {
        pg8::DenseSched S; S.init(ACTA, (const bf16*)(ws + WT_GU0), M, 2 * D_FF, D, G, bid);
        pg8::EpiSwiGLU E{ACTB, D_FF};
        pg8::gemm_phase<pg8::EpiSwiGLU, pg8::DenseSched, false>(scrb, 2 * D, S, E);
    }
    SEAM(6);
    if (IN(7)) {
        pg8::DenseSched S; S.init(ACTB, (const bf16*)(ws + WT_DN0), M, D, D_FF, G, bid);
        pg8::EpiStoreBf16 E{ACTA, D};
        pg8::gemm_phase<pg8::EpiStoreBf16, pg8::DenseSched, false>(scrb, 2 * D_FF, S, E);
    }
    SEAM(7);
    if (IN(8)) { for (int m = gw; m < M; m += 2 * NGW) { if (m + NGW < M) rms_res_row2_bf16(out + (size_t)m * D, ACTA + (size_t)m * D, out + (size_t)m * D, args.in[1] + D, ACTA + (size_t)m * D, (size_t)NGW * D, lane);
            else rms_res_row_bf16(out + (size_t)m * D, ACTA + (size_t)m * D, out + (size_t)m * D, args.in[1] + D, ACTA + (size_t)m * D, lane); } }
    SEAM(8);
    if (IN(9)) {
        pg8::DenseSched S; S.init(ACTA, (const bf16*)(ws + WT_IN1), M, ODD_IN, D, G, bid);
        pg8::EpiStoreBf16 E{ACTB, ODD_IN};
        pg8::gemm_phase<pg8::EpiStoreBf16, pg8::DenseSched, false>(scrb, 2 * D, S, E);
    }
    SEAM(9);

    float* const LSUM = (float*)(ws + WS_SCR);
#pragma unroll
    for (int pass = 0; pass < 2; ++pass) {
        if (IN(10 + pass)) {
            LAS bf16* const XT = (LAS bf16*)(scrb + wave * 17984);
            LAS bf16* const XR = XT + 3 * LT;
            LAS float* const AB = (LAS float*)(scrb + wave * 17984 + 9792);
            const int head = wave, ch = 64 * head + lane;
            bf16x8 Bwa[4][2], Bwx[4][2];
#pragma unroll
            for (int tj = 0; tj < 4; ++tj)
#pragma unroll
                for (int ks = 0; ks < 2; ++ks) { bf16x8 va, vx;
#pragma unroll
                    for (int e = 0; e < 8; ++e) { const int i = 32 * ks + 8 * fq + e, j = 16 * tj + fr; va[e] = (short)f2bf(args.in[14][(size_t)(head * 64 + i) * 64 + j]); vx[e] = (short)f2bf(args.in[16][(size_t)(head * 64 + i) * 64 + j]); }
                    Bwa[tj][ks] = va; Bwx[tj][ks] = vx; }
            float cba[4], cbx[4], csp[4];
#pragma unroll
            for (int tj = 0; tj < 4; ++tj) { const int c = 64 * head + 16 * tj + fr; cba[tj] = args.in[15][c]; cbx[tj] = args.in[17][c]; csp[tj] = -8.0f * 1.4426950408889634f * log1pf(__expf(-args.in[18][c])); }
            const float cw0 = args.in[12][ch], cw1 = args.in[12][512 + ch], cw2 = args.in[12][1024 + ch], cw3 = args.in[12][1536 + ch], cbias = args.in[13][ch];
            for (int it = bid; it < NB * 64; it += G) {
                const int b = it >> 6, c = it & 63; const size_t row0 = (size_t)b * SEQ + 64 * c;
                { const int r8 = lane >> 3, pc = lane & 7;
                  u32x4 raw[9];
#pragma unroll
                  for (int i = 0; i < 9; ++i) raw[i] = *(const u32x4*)(ACTB + (row0 + 8 * i + r8 - 3) * ODD_IN + XR_OFF + 64 * head + 8 * pc);
#pragma unroll
                  for (int i = 0; i < 9; ++i) if (8 * i + r8 < 68) *(LAS u32x4*)(XT + (8 * i + r8) * LT + 8 * pc) = raw[i];
                  LDS_WAIT(); asm volatile("" ::: "memory");
                  float x0 = 0.f, x1 = 0.f, x2 = 0.f;
                  if (c > 0) { x0 = bf2f(XT[0 * LT + lane]); x1 = bf2f(XT[1 * LT + lane]); x2 = bf2f(XT[2 * LT + lane]); }
#pragma unroll 16
                  for (int t = 0; t < 64; ++t) { const float x3 = bf2f(XT[(t + 3) * LT + lane]);
                      XT[(t + 3) * LT + lane] = (bf16)f2bf(cw0 * x0 + cw1 * x1 + cw2 * x2 + cw3 * x3 + cbias); x0 = x1; x1 = x2; x2 = x3; } }
                float hst = 0.f, cum = 1.f;
                if (pass == 1) {
                    for (int c0 = 0; c0 < c; c0 += 8) {
                        f32x2 sv[8];
#pragma unroll
                        for (int k = 0; k < 8; ++k) { const int cc = (c0 + k < c) ? c0 + k : c0; sv[k] = ((const f32x2*)LSUM)[(size_t)(b * 64 + cc) * 512 + ch]; }
#pragma unroll
                        for (int k = 0; k < 8; ++k) if (c0 + k < c) hst = sv[k].x * hst + sv[k].y;
                    }
                }
                LDS_WAIT(); asm volatile("" ::: "memory");
                for (int sb = 0; sb < 4; ++sb) {
                    bf16 gv[16];
                    if (pass == 1) {
#pragma unroll
                        for (int tl = 0; tl < 16; ++tl) gv[tl] = ACTB[(row0 + 16 * sb + tl) * ODD_IN + XG_OFF + ch]; }
                    f32x4 aR[4], aX[4];
#pragma unroll
                    for (int tj = 0; tj < 4; ++tj) { aR[tj] = (f32x4){0.f, 0.f, 0.f, 0.f}; aX[tj] = aR[tj]; }
#pragma unroll
                    for (int ks = 0; ks < 2; ++ks) { const bf16x8 af = *(const LAS bf16x8*)(XR + (16 * sb + fr) * LT + 32 * ks + 8 * fq);
#pragma unroll
                        for (int tj = 0; tj < 4; ++tj) { aR[tj] = __builtin_amdgcn_mfma_f32_16x16x32_bf16(af, Bwa[tj][ks], aR[tj], 0, 0, 0); aX[tj] = __builtin_amdgcn_mfma_f32_16x16x32_bf16(af, Bwx[tj][ks], aX[tj], 0, 0, 0); } }
#pragma unroll
                    for (int tj = 0; tj < 4; ++tj)
#pragma unroll
                        for (int r = 0; r < 4; ++r) { const int tl = 4 * fq + r, j = 16 * tj + fr;
                            const float rg = sigmoidf_(aR[tj][r] + cba[tj]), ig = sigmoidf_(aX[tj][r] + cbx[tj]);
                            const float a = __builtin_amdgcn_exp2f(rg * csp[tj]);
                            const float mult = __builtin_amdgcn_sqrtf(fmaxf(1.0f - a * a, 0.0f));
                            const float xv = bf2f(XR[(16 * sb + tl) * LT + j]);
                            AB[tl * 64 + j] = a; AB[1024 + tl * 64 + j] = mult * ig * xv; }
                    LDS_WAIT(); asm volatile("" ::: "memory");
                    if (pass == 1) {
#pragma unroll
                        for (int tl = 0; tl < 16; ++tl) { const float a = AB[tl * 64 + lane], bb = AB[1024 + tl * 64 + lane]; hst = a * hst + bb;
                            const float xg = bf2f(gv[tl]);
                            const float u3 = 0.7978845608028654f * (xg + 0.044715f * xg * xg * xg); const float th = 1.0f - 2.0f * __builtin_amdgcn_rcpf(1.0f + __builtin_amdgcn_exp2f(u3 * 2.8853900817779268f));
                            ACTA[(row0 + 16 * sb + tl) * D + 512 + ch] = (bf16)f2bf(hst * 0.5f * xg * (1.0f + th)); }
                    } else {
#pragma unroll
                        for (int tl = 0; tl < 16; ++tl) { const float a = AB[tl * 64 + lane], bb = AB[1024 + tl * 64 + lane]; hst = a * hst + bb; cum *= a; }
                    }
                    LDS_WAIT(); asm volatile("" ::: "memory");
                }
                if (pass == 0) { f32x2 sv; sv.x = cum; sv.y = hst; ((f32x2*)LSUM)[(size_t)(b * 64 + c) * 512 + ch] = sv; }
            }
            if (pass == 1) {
#pragma unroll 2
                for (int idx = bid * 512 + tid; idx < M * 64; idx += G * 512) {
                    const int row = idx >> 6, c8 = (idx & 63) * 8; const int t = row & (SEQ - 1);
                    const bf16* p = ACTB + (size_t)row * ODD_IN;
                    float acc8[8];
#pragma unroll
                    for (int x = 0; x < 8; ++x) acc8[x] = 0.f;
#pragma unroll
                    for (int k = 0; k < 3; ++k) { const int dt = 2 - k; if (t - dt >= 0) { const bf16* pr = p - (size_t)dt * ODD_IN;
                            const u32x4 gc = *(const u32x4*)(pr + CC_OFF + c8), uu = *(const u32x4*)(pr + CU_OFF + c8); const unsigned gw_[4] = {gc.x, gc.y, gc.z, gc.w}, uw[4] = {uu.x, uu.y, uu.z, uu.w};
#pragma unroll
                            for (int x = 0; x < 4; ++x) { acc8[2 * x] += args.in[11][k * 512 + c8 + 2 * x] * bf2f(gw_[x]) * bf2f(uw[x]); acc8[2 * x + 1] += args.in[11][k * 512 + c8 + 2 * x + 1] * bf2f(gw_[x] >> 16) * bf2f(uw[x] >> 16); } } }
                    const u32x4 gb = *(const u32x4*)(p + CB_OFF + c8); const unsigned gbw[4] = {gb.x, gb.y, gb.z, gb.w};
                    u32x4 w; unsigned ww[4];
#pragma unroll
                    for (int x = 0; x < 4; ++x) ww[x] = pk2(bf2f(gbw[x]) * acc8[2 * x], bf2f(gbw[x] >> 16) * acc8[2 * x + 1]);
                    w.x = ww[0]; w.y = ww[1]; w.z = ww[2]; w.w = ww[3];
                    *(u32x4*)(ACTA + (size_t)row * D + c8) = w;
                }
            }
        }
        SEAM(10 + pass);
    }

    if (IN(12)) {
        pg8::DenseSched S; S.init(ACTA, (const bf16*)(ws + WT_OUT1), M, D, D, G, bid);
        pg8::EpiStoreBf16 E{ACTB, D};
        pg8::gemm_phase<pg8::EpiStoreBf16, pg8::DenseSched, false>(scrb, 2 * D, S, E);
    }
    SEAM(12);

    int* const LTOK = (int*)(ws + SCR_LTOK); unsigned* const REC = (unsigned*)(ws + SCR_REC); unsigned* const REC2 = (unsigned*)(ws + SCR_REC + MiB);
    if (IN(13)) {
        LAS int* const lcnt = (LAS int*)(scrb);
        LAS int* const lbase = (LAS int*)(scrb + 64);
        LAS int* const recE = (LAS int*)(scrb + 128);
        LAS int* const recR = (LAS int*)(scrb + 128 + 1024);
        LAS float* const recW = (LAS float*)(scrb + 128 + 2048);
        float wr_[4][4][8];
#pragma unroll
        for (int j = 0; j < 4; ++j)
#pragma unroll
            for (int x = 0; x < 4; ++x) { const int col = 4 * (lane + 64 * j) + x; const f32x4 w0 = *(const f32x4*)(args.in[20] + (size_t)col * 8), w1 = *(const f32x4*)(args.in[20] + (size_t)col * 8 + 4);
                wr_[j][x][0] = w0.x; wr_[j][x][1] = w0.y; wr_[j][x][2] = w0.z; wr_[j][x][3] = w0.w; wr_[j][x][4] = w1.x; wr_[j][x][5] = w1.y; wr_[j][x][6] = w1.z; wr_[j][x][7] = w1.w; }
        for (int base = bid * 128; base < M; base += G * 128) {
            if (tid < 16) lcnt[tid] = 0;
            __syncthreads();
            f32x4 vn[4]; u32x2 dn[4];
            { const int m = base + wave * 16;
#pragma unroll
              for (int j = 0; j < 4; ++j) { vn[j] = ((const f32x4*)(out + (size_t)m * D) + lane)[64 * j]; dn[j] = ((const u32x2*)(ACTB + (size_t)m * D) + lane)[64 * j]; } }
            for (int rr = 0; rr < 16; ++rr) {
                const int lr = wave * 16 + rr, m = base + lr;
                f32x4* xr = (f32x4*)(out + (size_t)m * D) + lane; const f32x4* gr = (const f32x4*)(args.in[2] + D) + lane;
                f32x4 v[4]; u32x2 dcur[4]; float s = 0.f;
#pragma unroll
                for (int j = 0; j < 4; ++j) { v[j] = vn[j]; dcur[j] = dn[j]; }
                if (rr < 15) {
#pragma unroll
                    for (int j = 0; j < 4; ++j) { vn[j] = ((const f32x4*)(out + (size_t)(m + 1) * D) + lane)[64 * j]; dn[j] = ((const u32x2*)(ACTB + (size_t)(m + 1) * D) + lane)[64 * j]; } }
#pragma unroll
                for (int j = 0; j < 4; ++j) { const u32x2 dv = dcur[j]; v[j].x += bf2f(dv.x); v[j].y += bf2f(dv.x >> 16); v[j].z += bf2f(dv.y); v[j].w += bf2f(dv.y >> 16); xr[64 * j] = v[j];
                    s += (v[j].x * v[j].x + v[j].y * v[j].y) + (v[j].z * v[j].z + v[j].w * v[j].w); }
                const float rstd = rsqrtf(wave_sum(s) * (1.f / D) + EPS);
                float lg[8];
#pragma unroll
                for (int e = 0; e < 8; ++e) lg[e] = 0.f;
                unsigned* o8 = (unsigned*)((unsigned char*)ACTA + (size_t)m * D) + lane;
#pragma unroll
                for (int j = 0; j < 4; ++j) { const f32x4 gv = gr[64 * j]; float y[4] = {v[j].x * rstd * gv.x, v[j].y * rstd * gv.y, v[j].z * rstd * gv.z, v[j].w * rstd * gv.w};
                    { int w = __builtin_amdgcn_cvt_pk_fp8_f32(__builtin_amdgcn_fmed3f(y[0], -448.f, 448.f), __builtin_amdgcn_fmed3f(y[1], -448.f, 448.f), 0, false);
                      w = __builtin_amdgcn_cvt_pk_fp8_f32(__builtin_amdgcn_fmed3f(y[2], -448.f, 448.f), __builtin_amdgcn_fmed3f(y[3], -448.f, 448.f), w, true); o8[64 * j] = (unsigned)w; }
#pragma unroll
                    for (int x = 0; x < 4; ++x)
#pragma unroll
                        for (int e = 0; e < 8; ++e) lg[e] += y[x] * wr_[j][x][e]; }
#pragma unroll
                for (int e = 0; e < 8; ++e) lg[e] = wave_sum(lg[e]) + args.in[21][e];
                int e1 = 0; float l1 = lg[0];
#pragma unroll
                for (int e = 1; e < 8; ++e) if (lg[e] > l1) { l1 = lg[e]; e1 = e; }
                int e2 = -1; float l2 = -3.0e38f;
#pragma unroll
                for (int e = 0; e < 8; ++e) if (e != e1 && lg[e] > l2) { l2 = lg[e]; e2 = e; }
                const float w2 = 1.0f / (1.0f + __expf(l1 - l2)), w1 = 1.0f - w2;
                if (lane == 0) { recE[lr * 2] = e1; recE[lr * 2 + 1] = e2; recW[lr * 2] = w1; recW[lr * 2 + 1] = w2;
                    recR[lr * 2] = __hip_atomic_fetch_add(&lcnt[e1], 1, __ATOMIC_RELAXED, __HIP_MEMORY_SCOPE_WORKGROUP); recR[lr * 2 + 1] = __hip_atomic_fetch_add(&lcnt[8 + e2], 1, __ATOMIC_RELAXED, __HIP_MEMORY_SCOPE_WORKGROUP); }
            }
            __syncthreads();
            if (tid < 16) lbase[tid] = (int)__hip_atomic_fetch_add(ctl + CW_CNT + 64 * tid, (unsigned)lcnt[tid], RLX_AGENT);
            __syncthreads();
            if (tid < 256) { const int lr = tid >> 1, k = tid & 1; const int e = recE[tid]; const int pos = lbase[k * 8 + e] + recR[tid];
                if (pos < LIST_CAP) LTOK[(size_t)(k * 8 + e) * LIST_CAP + pos] = base + lr;
                unsigned* rec = REC + (size_t)(base + lr) * 8 + 3 * k; rec[0] = (unsigned)(k * 8 + e); rec[1] = (unsigned)pos; rec[2] = __builtin_bit_cast(unsigned, recW[tid]); }
            __syncthreads();
        }
    }
    SEAM(13);

    if (IN(14)) {
        pg8::MoeSched S; S.init(ACTA, ws + WT_GU1, LTOK, ctl + CW_CNT, 0, 2 * D_EXP / 256, D, 0, (size_t)2 * D_EXP * D, G, bid);
        if (bid == 0 && tid == 0) { unsigned* tbw = ctl + CW_TB; tbw[0] = 0u; tbw[1] = S.t1; tbw[2] = S.t2; tbw[3] = S.t3; tbw[4] = S.t4; tbw[5] = S.t5; tbw[6] = S.t6; tbw[7] = S.t7; tbw[8] = S.t8;
            tbw[9] = S.t9; tbw[10] = S.t10; tbw[11] = S.t11; tbw[12] = S.t12; tbw[13] = S.t13; tbw[14] = S.t14; tbw[15] = S.t15; }
        pg8::EpiSwiGLU8 E{(unsigned char*)ACTB, D_EXP, 1.0f / 64.0f, 4.0f};
        pg8::gemm_phase<pg8::EpiSwiGLU8, pg8::MoeSched, true, true>(scrb, D, S, E);
    }
    SEAM(14);
    bf16* const YB = (bf16*)(ws + WS_Y);
    if (IN(15)) {
        for (int m = bid * 512 + tid; m < M; m += G * 512) {
            const u32x4 r0 = *(const u32x4*)(REC + (size_t)m * 8), r1 = *(const u32x4*)(REC + (size_t)m * 8 + 4);
            const unsigned ke0 = r0.x, rk0 = r0.y, w0b = r0.z, ke1 = r0.w, rk1 = r1.x, w1b = r1.y;
            u32x4 o; o.x = ctl[CW_TB + ke0] * 256u + rk0; o.y = ctl[CW_TB + ke1] * 256u + rk1; o.z = w0b; o.w = w1b;
            *(u32x4*)(REC2 + (size_t)m * 4) = o; }
        pg8::MoeSched S; S.init(ACTB, ws + WT_DN1, LTOK, ctl + CW_CNT, 0, D / 256, D_EXP, (size_t)256 * D_EXP, (size_t)D * D_EXP, G, bid);
        pg8::EpiStoreBf16 E{YB, D};
        pg8::gemm_phase<pg8::EpiStoreBf16, pg8::MoeSched, false, true>(scrb, D_EXP, S, E);
    }
    SEAM(15);

    if (IN(16)) {
        const f32x4* gr = (const f32x4*)args.in[3] + lane;
        for (int m0 = gw; m0 < M; m0 += 2 * NGW) {
            const int NR = (m0 + NGW < M) ? NGW : 0;
            u32x4 rc[2];
#pragma unroll
            for (int r = 0; r < 2; ++r) rc[r] = *(const u32x4*)(REC2 + (size_t)(m0 + r * NR) * 4);
            f32x4 v[2][4]; u32x2 ya[2][4], yb[2][4];
#pragma unroll
            for (int r = 0; r < 2; ++r) { const unsigned row0 = rc[r].x, row1 = rc[r].y;
                const u32x2* y0 = (const u32x2*)(YB + (size_t)row0 * D) + lane; const u32x2* y1 = (const u32x2*)(YB + (size_t)row1 * D) + lane; const f32x4* xr = (const f32x4*)(out + (size_t)(m0 + r * NR) * D) + lane;
#pragma unroll
                for (int j = 0; j < 4; ++j) { v[r][j] = xr[64 * j]; ya[r][j] = y0[64 * j]; yb[r][j] = y1[64 * j]; } }
#pragma unroll
            for (int r = 0; r < 2; ++r) { const unsigned w0u = rc[r].z, w1u = rc[r].w; const float w0 = __uint_as_float(w0u) * (1.0f / 256.0f), w1 = __uint_as_float(w1u) * (1.0f / 256.0f);
                float s = 0.f;
#pragma unroll
                for (int j = 0; j < 4; ++j) { const u32x2 a = ya[r][j], b = yb[r][j];
                    v[r][j].x += w0 * bf2f(a.x) + w1 * bf2f(b.x); v[r][j].y += w0 * bf2f(a.x >> 16) + w1 * bf2f(b.x >> 16); v[r][j].z += w0 * bf2f(a.y) + w1 * bf2f(b.y); v[r][j].w += w0 * bf2f(a.y >> 16) + w1 * bf2f(b.y >> 16);
                    s += (v[r][j].x * v[r][j].x + v[r][j].y * v[r][j].y) + (v[r][j].z * v[r][j].z + v[r][j].w * v[r][j].w); }
                const float rstd = rsqrtf(wave_sum(s) * (1.f / D) + EPS);
                f32x4* xw = (f32x4*)(out + (size_t)(m0 + r * NR) * D) + lane;
#pragma unroll
                for (int j = 0; j < 4; ++j) { const f32x4 gv = gr[64 * j]; xw[64 * j] = v[r][j] * rstd * gv; } }
        }
    }
    if (PROBE_A_LO >= 0 && bid == 0 && tid == 0) {
        const unsigned long long t_end = wall_clock64();
        const unsigned long long wait = (unsigned long long)(MISC[9] - MISC[8]) * 4ull + ((PROBE_B_LO >= 0) ? (unsigned long long)(MISC[11] - MISC[10]) * 4ull : 0ull);
        while (wall_clock64() - t_end < wait) __builtin_amdgcn_s_sleep(32);
    }
#undef IN
#undef SEAM
#undef PSTAMP
}

extern "C" void kernel_launch(void* const* d_in, const int* in_sizes, int n_in, void* d_out, int out_size, void* d_ws, size_t ws_size, hipStream_t stream) {
    static int grid = 0;
    if (grid == 0) {
        if (n_in != 25 || in_sizes[0] != M * D || out_size != M * D || ws_size < WS_END) { fprintf(stderr, "kernel_launch: unexpected shapes / workspace (n_in %d, ws %zu, need %zu)\n", n_in, ws_size, (size_t)WS_END); grid = -1; return; }
        int dev = 0, cus = 0, per_cu = 0;
        if (hipGetDevice(&dev) != hipSuccess || hipDeviceGetAttribute(&cus, hipDeviceAttributeMultiprocessorCount, dev) != hipSuccess) { grid = -1; return; }
        if (hipFuncSetAttribute((const void*)fwd_kernel, hipFuncAttributeMaxDynamicSharedMemorySize, LDS_BYTES) != hipSuccess) { fprintf(stderr, "kernel_launch: hipFuncSetAttribute failed\n"); grid = -1; return; }
        if (hipOccupancyMaxActiveBlocksPerMultiprocessor(&per_cu, (const void*)fwd_kernel, 512, LDS_BYTES) != hipSuccess || per_cu < 1) { fprintf(stderr, "kernel_launch: occupancy query says %d\n", per_cu); }
        (void)hipGetLastError();
        grid = cus;
    }
    if (grid < 0) return;
    if (hipMemsetAsync((char*)d_ws + WS_CTL, 0, CTL_ZERO_BYTES, stream) != hipSuccess) return;
    Args a{};
    for (int i = 0; i < 25; ++i) a.in[i] = (const float*)d_in[i];
    a.out = (float*)d_out; a.ws = (unsigned char*)d_ws;
#if MK_N_LAUNCHES == 1
    a.ph_lo = 0; a.ph_hi = NPHASE;
    hipLaunchKernelGGL(fwd_kernel, dim3(grid), dim3(512), LDS_BYTES, stream, a);
#else
    for (int p = 0; p < NPHASE; ++p) { a.ph_lo = p; a.ph_hi = p + 1; hipLaunchKernelGGL(fwd_kernel, dim3(grid), dim3(512), LDS_BYTES, stream, a); }
#endif
}
```

```cpp
#include <hip/hip_runtime.h>
#include <cstdio>
#include <cstdint>

#ifndef MK_N_LAUNCHES
#define MK_N_LAUNCHES 1
#endif

#ifndef PROBE_A_LO
#define PROBE_A_LO (-1)
#define PROBE_A_HI (-1)
#define PROBE_B_LO (-1)
#define PROBE_B_HI (-1)
#endif
#define GAS __attribute__((address_space(1)))
#define LAS __attribute__((address_space(3)))
typedef unsigned short bf16;
typedef short bf16x8 __attribute__((ext_vector_type(8)));
typedef float f32x4 __attribute__((ext_vector_type(4)));
typedef float f32x2 __attribute__((ext_vector_type(2)));
typedef unsigned u32x4 __attribute__((ext_vector_type(4)));
typedef unsigned u32x2 __attribute__((ext_vector_type(2)));
typedef int v4i_t __attribute__((ext_vector_type(4)));
typedef short v4s_t __attribute__((ext_vector_type(4)));
typedef int v8i_t __attribute__((ext_vector_type(8)));

constexpr int D = 1024, NB = 8, SEQ = 4096, M = NB * SEQ;
constexpr int EVEN_IN = 3584, ODD_IN = 2560, D_FF = 2816, D_EXP = 3584, NEXP = 8;
constexpr int RQ_OFF = 0, RK_OFF = 512, RV_OFF = 1024, RGATE_OFF = 1536, SQ_OFF = 2048, SK_OFF = 2560, SV_OFF = 3072;
constexpr int CB_OFF = 0, CC_OFF = 512, CU_OFF = 1024, XR_OFF = 1536, XG_OFF = 2048;
constexpr float EPS = 1e-6f;
constexpr int LIST_CAP = 32768;
constexpr int MAX_TILES = 135;

constexpr size_t MiB = 1u << 20;
constexpr size_t WS_CTL = 0, CTL_ZERO_BYTES = 1 * MiB;
constexpr size_t WS_ROT = 1 * MiB;
constexpr size_t WS_SCR = 3 * MiB;
constexpr size_t WS_WB = 19 * MiB;
constexpr size_t WT_DN1 = WS_WB;
constexpr size_t WT_IN0 = 47 * MiB;
constexpr size_t WT_OUT0 = WT_IN0 + (size_t)EVEN_IN * D * 2;
constexpr size_t WT_GU0 = WT_OUT0 + (size_t)D * D * 2;
constexpr size_t WT_DN0 = WT_GU0 + (size_t)2 * D_FF * D * 2;
constexpr size_t WT_IN1 = WT_DN0 + (size_t)D * D_FF * 2;
constexpr size_t WT_OUT1 = WT_IN1 + (size_t)ODD_IN * D * 2;
constexpr size_t WT_GU1 = WT_OUT1 + (size_t)D * D * 2;
constexpr size_t WB_END = WT_GU1 + (size_t)NEXP * 2 * D_EXP * D;
constexpr size_t WS_ACTA = 136 * MiB;
constexpr size_t WS_ACTB = 200 * MiB;
constexpr size_t WS_END = WS_ACTB + (size_t)MAX_TILES * 256 * D_EXP * 2;
constexpr size_t WS_Y = WT_IN0;
static_assert(WT_DN1 + (size_t)NEXP * D * D_EXP <= WT_IN0 && WB_END <= WS_ACTA && WS_ACTA + (size_t)M * D * 2 <= WS_ACTB, "weights overlap");
static_assert(WS_Y + (size_t)2 * MAX_TILES * 256 * D * 2 <= WS_ACTB, "y overlay");
static_assert((size_t)M * EVEN_IN * 2 <= (size_t)MAX_TILES * 256 * D_EXP * 2, "ACTB size");
constexpr size_t SCR_LTOK = WS_SCR, SCR_REC = WS_SCR + 4 * MiB;
constexpr int CW_BAR = 4096;
constexpr int CW_TB = 16384;
constexpr int CW_CNT = 8192;

constexpr int LDS_MISC = 0;
constexpr int LDS_SCR = 256;
constexpr int LDS_BYTES = 147456;

#define RLX_AGENT __ATOMIC_RELAXED, __HIP_MEMORY_SCOPE_AGENT
#define LDS_WAIT() asm volatile("s_waitcnt lgkmcnt(0)" ::: "memory")
__device__ __forceinline__ unsigned pk2(float lo, float hi) { unsigned r; asm("v_cvt_pk_bf16_f32 %0, %1, %2" : "=v"(r) : "v"(lo), "v"(hi)); return r; }
__device__ __forceinline__ unsigned f2bf(float f) { return pk2(f, 0.0f) & 0xffffu; }
__device__ __forceinline__ float bf2f(unsigned b) { return __builtin_bit_cast(float, (b & 0xffffu) << 16); }
__device__ __forceinline__ float wave_sum(float v) {
#pragma unroll
    for (int o = 1; o < 64; o <<= 1) v += __shfl_xor(v, o);
    return v;
}
__device__ __forceinline__ float sigmoidf_(float x) { return __builtin_amdgcn_rcpf(1.0f + __builtin_amdgcn_exp2f(x * -1.4426950408889634f)); }

#define XB_TMO      128
#define XB_XCNT(j)  (256  + 64 * (j))
#define XB_XSUB(j)  (1280 + 64 * (j))
#define XB_XGEN(j)  (2304 + 64 * (j))
#define XB_TOP      3328
#define XB_TOPGEN   3392
#define XCD_BAR_WORDS 3456
#define XB_SPIN_CAP (1u << 18)

__device__ __forceinline__ unsigned xb_ld(unsigned* p)              { return __hip_atomic_load(p, __ATOMIC_RELAXED, __HIP_MEMORY_SCOPE_AGENT); }
__device__ __forceinline__ unsigned xb_add(unsigned* p, unsigned v) { return __hip_atomic_fetch_add(p, v, __ATOMIC_RELAXED, __HIP_MEMORY_SCOPE_AGENT); }
__device__ __forceinline__ unsigned xb_xcc_id() { return (unsigned)__builtin_amdgcn_s_getreg((3 << 11) | 20) & 0xFu; }
#define XB_SPIN(cond, bar) do { unsigned _sp = 0; while (cond) { __builtin_amdgcn_s_sleep(1); \
    if ((++_sp & 255u) == 0u) { if (xb_ld(&(bar)[XB_TMO])) break; if (_sp > XB_SPIN_CAP) { atomicAdd(&(bar)[XB_TMO], 1u); break; } } } } while (0)

struct XcdBarrier { unsigned* bar; unsigned x; volatile LAS unsigned* st; };

__device__ __forceinline__ XcdBarrier xcd_barrier_post(unsigned* bar, volatile LAS unsigned* st) {
    XcdBarrier b; b.bar = bar; b.x = xb_xcc_id(); b.st = st;
    if (threadIdx.x == 0) (void)xb_add(&bar[XB_XCNT(b.x)], 1u);
    return b;
}
__device__ __forceinline__ void xcd_barrier_complete(unsigned* bar, unsigned x, unsigned& nloc, unsigned& nx) {
    const unsigned G = gridDim.x * gridDim.y * gridDim.z;
    unsigned sum, cnt, mine, sp = 0u;
    for (;;) {
        sum = 0u; cnt = 0u; mine = 0u;
#pragma unroll
        for (unsigned j = 0; j < 16; ++j) { const unsigned c = xb_ld(&bar[XB_XCNT(j)]); sum += c; cnt += (c > 0u) ? 1u : 0u; mine = (j == x) ? c : mine; }
        if (sum == G) break;
        __builtin_amdgcn_s_sleep(1);
        if ((++sp & 255u) == 0u) { if (xb_ld(&bar[XB_TMO])) break; if (sp > XB_SPIN_CAP) { atomicAdd(&bar[XB_TMO], 1u); break; } }
    }
    nloc = mine > 0u ? mine : 1u; nx = cnt > 0u ? cnt : 1u;
}
__device__ __forceinline__ void xcd_barrier(const XcdBarrier& b) {
    asm volatile("s_waitcnt vmcnt(0)" ::: "memory");
    __syncthreads();
    if (threadIdx.x == 0) {
        unsigned* bar = b.bar;
        __builtin_amdgcn_s_waitcnt(0);
        unsigned nloc = b.st[0], nx = b.st[1];
        if (nloc == 0u) { xcd_barrier_complete(bar, b.x, nloc, nx); b.st[0] = nloc; b.st[1] = nx; }
        const unsigned old = xb_add(&bar[XB_XSUB(b.x)], 1u);
        const unsigned gen = old / nloc;
        if (old + 1u == (gen + 1u) * nloc) {
            __builtin_amdgcn_fence(__ATOMIC_RELEASE, "agent");
            asm volatile("s_waitcnt vmcnt(0)" ::: "memory");
            const unsigned og = xb_add(&bar[XB_TOP], 1u);
            const unsigned tg = og / nx;
            if (og + 1u == (tg + 1u) * nx) xb_add(&bar[XB_TOPGEN], 1u);
            else XB_SPIN(xb_ld(&bar[XB_TOPGEN]) == tg, bar);
            __builtin_amdgcn_fence(__ATOMIC_ACQUIRE, "agent");
            xb_add(&bar[XB_XGEN(b.x)], 1u);
            asm volatile("s_waitcnt vmcnt(0)" ::: "memory");
        } else {
            XB_SPIN(xb_ld(&bar[XB_XGEN(b.x)]) == gen, bar);
            __builtin_amdgcn_fence(__ATOMIC_ACQUIRE, "agent");
            asm volatile("s_waitcnt vmcnt(0)" ::: "memory");
        }
    }
    __syncthreads();
}

namespace pg8 {
constexpr int BM = 256, BK = 64, HALF = 128, HTB = HALF * BK * 2, STAGE_BYTES = 8 * HTB, NXCD = 8, WGM = 8;
__device__ __forceinline__ int lds_byte(int r, int c) { const int st = (r >> 4) * 2 + (c >> 5), rr = r & 15, cc = c & 31, ob = rr * 64 + cc * 2; return st * 1024 + (ob ^ (((ob >> 9) & 1) << 5)); }
__device__ __forceinline__ void stage_rc(int b, int& R, int& C) { const int st = b / 1024, sb = b % 1024, swz = sb ^ (((sb >> 9) & 1) << 5); R = (st >> 1) * 16 + swz / 64; C = (st & 1) * 32 + (swz % 64) / 2; }
__device__ __forceinline__ int perm32(int rho) { const int n = rho >> 4, i = rho & 15; return 8 * (i >> 2) + 4 * n + (i & 3); }

struct Unit { int pm, pn, e, lt, cn; };

struct StaticOrder {
    int nM, nN, nwg, G, c;
    __device__ __forceinline__ void init_tiles(int nM_, int nN_, int G_, int c_) { nM = nM_; nN = nN_; nwg = nM * nN; G = G_; c = c_; }
    __device__ __forceinline__ bool next_tile(int i, int& pm, int& pn) const {
        const long L = (long)i * G + c; if (L >= nwg) return false;
        int wgid = (int)L; { const int q = nwg / NXCD, r = nwg % NXCD, xcd = wgid % NXCD, off = wgid / NXCD; wgid = (xcd < r ? xcd * (q + 1) : r * (q + 1) + (xcd - r) * q) + off; }
        const int nig = WGM * nN, gid = wgid / nig, fm = gid * WGM, gsz = (nM - fm) < WGM ? (nM - fm) : WGM;
        pm = fm + ((wgid % nig) % gsz); pn = (wgid % nig) / gsz; return true;
    }
};
struct DenseSched : StaticOrder {
    const char* A; const char* Bt; size_t tstep;
    __device__ __forceinline__ void init(const bf16* A_, const bf16* Bt_, int Mr, int N, int K, int G_, int c_) { A = (const char*)A_; Bt = (const char*)Bt_; tstep = (size_t)BM * K * 2; init_tiles(Mr / BM, N / BM, G_, c_); }
    __device__ __forceinline__ bool next(int i, Unit& u) const { u.e = 0; u.lt = 0; u.cn = 0; return next_tile(i, u.pm, u.pn); }
    __device__ __forceinline__ const char* a_base(const Unit& u) const { return A + (size_t)u.pm * tstep; }
    __device__ __forceinline__ const char* b_base(const Unit& u) const { return Bt + (size_t)u.pn * tstep; }
    __device__ __forceinline__ void a_rows(const Unit&, const int (&)[2], const int (&)[2], unsigned (&)[2][2]) const {}
    __device__ __forceinline__ const int* tok_src(const Unit&) const { return nullptr; }
};
struct MoeSched : StaticOrder {
    const char* A; const char* Bt; size_t a_tstep, b_estep, b_tstep; const int* ltok; int rowb, toff;
    int c0, c1, c2, c3, c4, c5, c6, c7, c8, c9, c10, c11, c12, c13, c14, c15, t1, t2, t3, t4, t5, t6, t7, t8, t9, t10, t11, t12, t13, t14, t15, t16;
    __device__ __forceinline__ static int ldc_(const unsigned* cntw, int e) { int c = (int)__builtin_amdgcn_readfirstlane(__hip_atomic_load(cntw + 64 * e, RLX_AGENT)); return c > LIST_CAP ? LIST_CAP : c; }
    __device__ __forceinline__ void init(const void* A_, const void* Bt_, const int* ltok_, const unsigned* cntw, int which, int nN_, int rowb_, size_t a_tstep_, size_t b_estep_, int G_, int c_) {
        A = (const char*)A_; Bt = (const char*)Bt_; ltok = ltok_; rowb = rowb_; a_tstep = a_tstep_; b_estep = b_estep_; b_tstep = (size_t)BM * rowb_;
        c0 = ldc_(cntw, 0); c1 = ldc_(cntw, 1); c2 = ldc_(cntw, 2); c3 = ldc_(cntw, 3); c4 = ldc_(cntw, 4); c5 = ldc_(cntw, 5); c6 = ldc_(cntw, 6); c7 = ldc_(cntw, 7);
        c8 = ldc_(cntw, 8); c9 = ldc_(cntw, 9); c10 = ldc_(cntw, 10); c11 = ldc_(cntw, 11); c12 = ldc_(cntw, 12); c13 = ldc_(cntw, 13); c14 = ldc_(cntw, 14); c15 = ldc_(cntw, 15);
        t1 = (c0 + 255) >> 8; t2 = t1 + ((c1 + 255) >> 8); t3 = t2 + ((c2 + 255) >> 8); t4 = t3 + ((c3 + 255) >> 8); t5 = t4 + ((c4 + 255) >> 8); t6 = t5 + ((c5 + 255) >> 8); t7 = t6 + ((c6 + 255) >> 8); t8 = t7 + ((c7 + 255) >> 8);
        t9 = t8 + ((c8 + 255) >> 8); t10 = t9 + ((c9 + 255) >> 8); t11 = t10 + ((c10 + 255) >> 8); t12 = t11 + ((c11 + 255) >> 8); t13 = t12 + ((c12 + 255) >> 8); t14 = t13 + ((c13 + 255) >> 8); t15 = t14 + ((c14 + 255) >> 8); t16 = t15 + ((c15 + 255) >> 8);
        toff = which == 2 ? t8 : 0;
        init_tiles(which == 0 ? t16 : (which == 1 ? t8 : t16 - t8), nN_, G_, c_);
    }
    __device__ __forceinline__ bool next(int i, Unit& u) const {
        int pml; if (!next_tile(i, pml, u.pn)) return false;
        const int pm = pml + toff; u.pm = pm;
        const int m1 = pm >= t1, m2 = pm >= t2, m3 = pm >= t3, m4 = pm >= t4, m5 = pm >= t5, m6 = pm >= t6, m7 = pm >= t7, m8 = pm >= t8, m9 = pm >= t9, m10 = pm >= t10, m11 = pm >= t11, m12 = pm >= t12, m13 = pm >= t13, m14 = pm >= t14, m15 = pm >= t15;
        const int e = m1 + m2 + m3 + m4 + m5 + m6 + m7 + m8 + m9 + m10 + m11 + m12 + m13 + m14 + m15;
        const int base = m1 * t1 + m2 * (t2 - t1) + m3 * (t3 - t2) + m4 * (t4 - t3) + m5 * (t5 - t4) + m6 * (t6 - t5) + m7 * (t7 - t6) + m8 * (t8 - t7) + m9 * (t9 - t8) + m10 * (t10 - t9) + m11 * (t11 - t10) + m12 * (t12 - t11) + m13 * (t13 - t12) + m14 * (t14 - t13) + m15 * (t15 - t14);
        const int cn = c0 + m1 * (c1 - c0) + m2 * (c2 - c1) + m3 * (c3 - c2) + m4 * (c4 - c3) + m5 * (c5 - c4) + m6 * (c6 - c5) + m7 * (c7 - c6) + m8 * (c8 - c7) + m9 * (c9 - c8) + m10 * (c10 - c9) + m11 * (c11 - c10) + m12 * (c12 - c11) + m13 * (c13 - c12) + m14 * (c14 - c13) + m15 * (c15 - c14);
        u.e = e; u.lt = pm - base; u.cn = cn; return true;
    }
    __device__ __forceinline__ const char* a_base(const Unit& u) const { return A + (size_t)u.pm * a_tstep; }
    __device__ __forceinline__ const char* b_base(const Unit& u) const { return Bt + (size_t)(u.e & 7) * b_estep + (size_t)u.pn * b_tstep; }
    __device__ __forceinline__ const int* tok_src(const Unit& u) const { return ltok + (size_t)u.e * LIST_CAP + u.lt * 256; }
    __device__ __forceinline__ void a_rows(const Unit& u, const int (&R)[2], const int (&C)[2], unsigned (&off)[2][2]) const {
#pragma unroll
        for (int h = 0; h < 2; ++h)
#pragma unroll
            for (int i = 0; i < 2; ++i) { int rank = u.lt * 256 + h * HALF + R[i]; rank = rank < u.cn ? rank : u.cn - 1;
                const int tok = ltok[(size_t)u.e * LIST_CAP + rank]; off[h][i] = (unsigned)tok * (unsigned)rowb + (unsigned)(C[i] * 2); }
    }
};

__device__ __forceinline__ unsigned cvt_pk_bf16(float lo, float hi) { unsigned r; asm volatile("v_cvt_pk_bf16_f32 %0, %1, %2" : "=v"(r) : "v"(lo), "v"(hi)); return r; }

struct EpiStoreBf16 {
    static constexpr bool PERM = true; static constexpr int NVM = 16;
    bf16* O; int ldc;
    __device__ __forceinline__ void operator()(const f32x4 (&acc)[2][2][4][2], const Unit& u, int wr, int wc, int fr, int fq) const {
        const int row0 = u.pm * BM + wr * 64 + fr, col0 = u.pn * BM + wc * 32 + 8 * fq;
#pragma unroll
        for (int ai = 0; ai < 2; ++ai)
#pragma unroll
            for (int m = 0; m < 4; ++m) { bf16* rowp = O + (size_t)(row0 + ai * HALF + m * 16) * ldc + col0;
#pragma unroll
                for (int bj = 0; bj < 2; ++bj) { const f32x4 v0 = acc[ai][bj][m][0], v1 = acc[ai][bj][m][1];
                    u32x4 w; w.x = cvt_pk_bf16(v0[0], v0[1]); w.y = cvt_pk_bf16(v0[2], v0[3]); w.z = cvt_pk_bf16(v1[0], v1[1]); w.w = cvt_pk_bf16(v1[2], v1[3]);
                    *(u32x4*)(rowp + bj * HALF) = w; } }
    }
};
struct EpiResF32 {
    static constexpr bool PERM = false; static constexpr int NVM = 0;
    const float* base; float* out; int ldc;
    __device__ __forceinline__ void operator()(const f32x4 (&acc)[2][2][4][2], const Unit& u, int wr, int wc, int fr, int fq) const {
        const int row0 = u.pm * BM + wr * 64 + fr, col0 = u.pn * BM + wc * 32 + 4 * fq;
#pragma unroll
        for (int ai = 0; ai < 2; ++ai)
#pragma unroll
            for (int m = 0; m < 4; ++m) { const size_t off = (size_t)(row0 + ai * HALF + m * 16) * ldc + col0;
#pragma unroll
                for (int bj = 0; bj < 2; ++bj)
#pragma unroll
                    for (int n = 0; n < 2; ++n) { const f32x4 bs = *(const f32x4*)(base + off + bj * HALF + n * 16); *(f32x4*)(out + off + bj * HALF + n * 16) = bs + acc[ai][bj][m][n]; } }
    }
};
struct EpiSwiGLU {
    static constexpr bool PERM = true; static constexpr int NVM = 8;
    bf16* H; int ldh;
    __device__ __forceinline__ void operator()(const f32x4 (&acc)[2][2][4][2], const Unit& u, int wr, int wc, int fr, int fq) const {
        const int row0 = u.pm * BM + wr * 64 + fr, col0 = u.pn * HALF + wc * 32 + 8 * fq;
#pragma unroll
        for (int ai = 0; ai < 2; ++ai)
#pragma unroll
            for (int m = 0; m < 4; ++m) { bf16* rowp = H + (size_t)(row0 + ai * HALF + m * 16) * ldh + col0;
                float h[8];
#pragma unroll
                for (int n = 0; n < 2; ++n)
#pragma unroll
                    for (int x = 0; x < 2; ++x) { const f32x2 g = {acc[ai][0][m][n][2 * x], acc[ai][0][m][n][2 * x + 1]}, up = {acc[ai][1][m][n][2 * x], acc[ai][1][m][n][2 * x + 1]};
                        const f32x2 t = g * -1.4426950408889634f; f32x2 e; e.x = __builtin_amdgcn_exp2f(t.x); e.y = __builtin_amdgcn_exp2f(t.y);
                        const f32x2 d = e + 1.0f; f32x2 r; r.x = __builtin_amdgcn_rcpf(d.x); r.y = __builtin_amdgcn_rcpf(d.y);
                        const f32x2 hh = (g * up) * r; h[4 * n + 2 * x] = hh.x; h[4 * n + 2 * x + 1] = hh.y; }
                u32x4 w; w.x = cvt_pk_bf16(h[0], h[1]); w.y = cvt_pk_bf16(h[2], h[3]); w.z = cvt_pk_bf16(h[4], h[5]); w.w = cvt_pk_bf16(h[6], h[7]);
                *(u32x4*)rowp = w; }
    }
};
struct EpiSwiGLU8 {
    static constexpr bool PERM = true; static constexpr int NVM = 8;
    unsigned char* H; int ldh; float iscale, oscale;
    __device__ __forceinline__ void operator()(const f32x4 (&acc)[2][2][4][2], const Unit& u, int wr, int wc, int fr, int fq) const {
        const int row0 = u.pm * BM + wr * 64 + fr, col0 = u.pn * HALF + wc * 32 + 8 * fq;
#pragma unroll
        for (int ai = 0; ai < 2; ++ai)
#pragma unroll
            for (int m = 0; m < 4; ++m) { unsigned char* rowp = H + (size_t)(row0 + ai * HALF + m * 16) * ldh + col0;
                float h[8];
#pragma unroll
                for (int n = 0; n < 2; ++n)
#pragma unroll
                    for (int x = 0; x < 2; ++x) { const f32x2 ga = {acc[ai][0][m][n][2 * x], acc[ai][0][m][n][2 * x + 1]}, ua = {acc[ai][1][m][n][2 * x], acc[ai][1][m][n][2 * x + 1]};
                        const f32x2 t = ga * (-1.4426950408889634f * iscale); f32x2 e; e.x = __builtin_amdgcn_exp2f(t.x); e.y = __builtin_amdgcn_exp2f(t.y);
                        const f32x2 d = e + 1.0f; f32x2 r; r.x = __builtin_amdgcn_rcpf(d.x); r.y = __builtin_amdgcn_rcpf(d.y);
                        const f32x2 hh = ((ga * ua) * (iscale * iscale * oscale)) * r;
                        h[4 * n + 2 * x] = __builtin_amdgcn_fmed3f(hh.x, -448.0f, 448.0f); h[4 * n + 2 * x + 1] = __builtin_amdgcn_fmed3f(hh.y, -448.0f, 448.0f); }
                int w0 = __builtin_amdgcn_cvt_pk_fp8_f32(h[0], h[1], 0, false); w0 = __builtin_amdgcn_cvt_pk_fp8_f32(h[2], h[3], w0, true);
                int w1 = __builtin_amdgcn_cvt_pk_fp8_f32(h[4], h[5], 0, false); w1 = __builtin_amdgcn_cvt_pk_fp8_f32(h[6], h[7], w1, true);
                u32x2 w; w.x = (unsigned)w0; w.y = (unsigned)w1; *(u32x2*)rowp = w; }
    }
};
struct EpiMoeDown {
    static constexpr bool PERM = false; static constexpr int NVM = 0;
    float* out; const int* ltok; const float* lw; float scale;
    __device__ __forceinline__ void operator()(const f32x4 (&acc)[2][2][4][2], const Unit& u, int wr, int wc, int fr, int fq) const {
        const int col0 = u.pn * BM + wc * 32 + 4 * fq;
#pragma unroll
        for (int ai = 0; ai < 2; ++ai)
#pragma unroll
            for (int m = 0; m < 4; ++m) { const int rank = u.lt * 256 + ai * HALF + wr * 64 + m * 16 + fr;
                if (rank < u.cn) { const int tok = ltok[(size_t)u.e * LIST_CAP + rank]; const float w = lw[(size_t)u.e * LIST_CAP + rank] * scale; float* rowp = out + (size_t)tok * D + col0;
#pragma unroll
                    for (int bj = 0; bj < 2; ++bj)
#pragma unroll
                        for (int n = 0; n < 2; ++n) { const f32x4 bs = *(const f32x4*)(rowp + bj * HALF + n * 16); *(f32x4*)(rowp + bj * HALF + n * 16) = bs + acc[ai][bj][m][n] * w; } } }
    }
};

template <class Epi, class Sched, bool GATHER, bool F8 = false>
__device__ __forceinline__ void gemm_phase(LAS unsigned char* lds, const int rowb, const Sched& S, const Epi& E) {
    const int tid = threadIdx.x, wid = __builtin_amdgcn_readfirstlane(tid >> 6), lane = tid & 63, wr = wid >> 2, wc = wid & 3, fr = lane & 15, fq = lane >> 4;
    const int nt = rowb / 128;
    unsigned voffA[2], voffB[2]; int Rr[2], Cc[2];
#pragma unroll
    for (int i = 0; i < 2; ++i) { int R, C; stage_rc(tid * 16 + i * 8192, R, C); const int Rb = Epi::PERM ? ((R & ~31) + perm32(R & 31)) : R;
        voffA[i] = (unsigned)(R * rowb + C * 2); voffB[i] = (unsigned)(Rb * rowb + C * 2); Rr[i] = R; Cc[i] = C; }
    const size_t kstep = (size_t)(BK * 2);
    const size_t hstep = (size_t)HALF * rowb;
    const unsigned ldsw = (unsigned)wid * 1024u;
    const int aoff = lds_byte(wr * 64 + fr, fq * 8), boff = lds_byte(wc * 32 + fr, fq * 8);
#define PG8_SA(b, h) (((b) * 2 + (h)) * HTB)
#define PG8_SB(b, h) ((4 + (b) * 2 + (h)) * HTB)
#define PG8_STAGE(bufoff, gbase, voff) do { _Pragma("unroll") for (int _i = 0; _i < 2; ++_i) \
        __builtin_amdgcn_global_load_lds((const unsigned*)((const char*)(gbase) + (voff)[_i]), (LAS unsigned*)(lds + (bufoff) + ldsw + _i * 8192), 16, 0, 0); } while (0)
#define PG8_STAGE_A(bufoff, kptr, h) do { if constexpr (GATHER) PG8_STAGE(bufoff, kptr, gA[h]); else PG8_STAGE(bufoff, (kptr) + (h) * hstep, voffA); } while (0)
#define PG8_LD8(base) __builtin_shufflevector(*(const LAS v4i_t*)(base), *(const LAS v4i_t*)((base) + 1024), 0, 1, 2, 3, 4, 5, 6, 7)
#define PG8_LDA(dst, b, h) do { _Pragma("unroll") for (int m = 0; m < 4; ++m) { if constexpr (F8) dst##8[m] = PG8_LD8(lds + PG8_SA(b, h) + aoff + m * 2048); else { _Pragma("unroll") for (int k = 0; k < 2; ++k) dst[m][k] = *(const LAS bf16x8*)(lds + PG8_SA(b, h) + aoff + m * 2048 + k * 1024); } } } while (0)
#define PG8_LDB(dst, b, h) do { _Pragma("unroll") for (int n = 0; n < 2; ++n) { if constexpr (F8) dst##8[n] = PG8_LD8(lds + PG8_SB(b, h) + boff + n * 2048); else { _Pragma("unroll") for (int k = 0; k < 2; ++k) dst[n][k] = *(const LAS bf16x8*)(lds + PG8_SB(b, h) + boff + n * 2048 + k * 1024); } } } while (0)
#define PG8_MMA(ai, bj, At, Bt) do { __builtin_amdgcn_s_setprio(1); _Pragma("unroll") for (int m = 0; m < 4; ++m) _Pragma("unroll") for (int n = 0; n < 2; ++n) { \
        if constexpr (F8) asm volatile("v_mfma_f32_16x16x128_f8f6f4 %0, %1, %2, %0" : "+v"(acc[ai][bj][m][n]) : "v"(Bt##8[n]), "v"(At##8[m])); \
        else { _Pragma("unroll") for (int k = 0; k < 2; ++k) acc[ai][bj][m][n] = __builtin_amdgcn_mfma_f32_16x16x32_bf16(Bt[n][k], At[m][k], acc[ai][bj][m][n], 0, 0, 0); } } \
        __builtin_amdgcn_s_setprio(0); } while (0)
#define PG8_WAIT_V(n) asm volatile("s_waitcnt vmcnt(" #n ")" ::: "memory")
#define PG8_WAIT_SEL(flag, n) asm volatile("v_cmp_eq_u32_e32 vcc, 0, %0\n\ts_nop 4\n\ts_cbranch_vccnz .Lw8_%=\n\ts_waitcnt vmcnt(%1)\n\ts_branch .Lwd_%=\n.Lw8_%=:\n\ts_waitcnt vmcnt(8)\n.Lwd_%=:" :: "v"(flag), "n"(n) : "memory", "vcc")
#define PG8_WAIT_L(n) asm volatile("s_waitcnt lgkmcnt(" #n ")" ::: "memory")
#define PG8_BAR __builtin_amdgcn_s_barrier()
#define PG8_SCHED __builtin_amdgcn_sched_barrier(0)
    Unit cur, nxt; int ui = 0;
    if (!S.next(0, cur)) return;
    f32x4 acc[2][2][4][2];
#pragma unroll
    for (int a = 0; a < 2; ++a)
#pragma unroll
        for (int b = 0; b < 2; ++b)
#pragma unroll
            for (int m = 0; m < 4; ++m)
#pragma unroll
                for (int n = 0; n < 2; ++n) acc[a][b][m][n] = (f32x4){0.f, 0.f, 0.f, 0.f};
    bf16x8 At[4][2], B0[2][2], B1[2][2]; v8i_t At8[4], B08[2], B18[2];
    const char* cA = S.a_base(cur); const char* cB = S.b_base(cur);
    unsigned gA[2][2] = {{0u, 0u}, {0u, 0u}};
    if constexpr (GATHER) S.a_rows(cur, Rr, Cc, gA);
    constexpr int TOKTAB = STAGE_BYTES;
    PG8_STAGE(PG8_SB(0, 0), cB, voffB); PG8_STAGE(PG8_SB(0, 1), cB + hstep, voffB); PG8_STAGE_A(PG8_SA(0, 0), cA, 0); PG8_STAGE_A(PG8_SA(0, 1), cA, 1);
    if (wr == 1) PG8_BAR;
    PG8_WAIT_V(2); PG8_BAR;
    PG8_STAGE(PG8_SB(1, 0), cB + kstep, voffB); PG8_STAGE_A(PG8_SA(1, 0), cA + kstep, 0); PG8_STAGE(PG8_SB(1, 1), cB + hstep + kstep, voffB);
    PG8_WAIT_V(6); PG8_BAR;
    for (;;) {
        const bool has_next = S.next(ui + 1, nxt);
        const char* nA = has_next ? S.a_base(nxt) : cA; const char* nB = has_next ? S.b_base(nxt) : cB;
        if constexpr (GATHER) { if (has_next && wid == 0) __builtin_amdgcn_global_load_lds((const unsigned*)(S.tok_src(nxt) + lane * 4), (LAS unsigned*)(lds + TOKTAB), 16, 0, 0); }
        for (int t = 0; t < nt; t += 2) {
            const bool last = (t == nt - 2);
            const char* a1 = cA + (size_t)(t + 1) * kstep;
            const char* a2 = last ? nA : cA + (size_t)(t + 2) * kstep; const char* b2 = last ? nB : cB + (size_t)(t + 2) * kstep;
            const char* a3 = a2 + kstep; const char* b3 = b2 + kstep;
            const int after_epi = ((Epi::NVM > 0) && (t == 0) && (ui > 0)) ? 1 : 0;
            PG8_LDB(B0, 0, 0); PG8_LDB(B1, 0, 1); PG8_SCHED; PG8_LDA(At, 0, 0); PG8_STAGE_A(PG8_SA(1, 1), a1, 1);
            if constexpr (GATHER) { if (last && has_next) { asm volatile("" ::: "memory");
#pragma unroll
                for (int h = 0; h < 2; ++h)
#pragma unroll
                    for (int i = 0; i < 2; ++i) { unsigned tk = *(const LAS unsigned*)(lds + TOKTAB + 4 * (h * HALF + Rr[i])); tk = tk < (unsigned)(M - 1) ? tk : (unsigned)(M - 1); gA[h][i] = tk * (unsigned)rowb + (unsigned)(Cc[i] * 2); } } }
            if constexpr (Epi::NVM > 0) PG8_WAIT_SEL(after_epi, 8 + Epi::NVM); else PG8_WAIT_V(8);
            PG8_WAIT_L(0); PG8_BAR; PG8_MMA(0, 0, At, B0); PG8_MMA(0, 1, At, B1); PG8_BAR; PG8_SCHED;
            PG8_LDA(At, 0, 1); PG8_STAGE(PG8_SB(0, 0), b2, voffB); PG8_STAGE(PG8_SB(0, 1), b2 + hstep, voffB); PG8_STAGE_A(PG8_SA(0, 0), a2, 0);
            if constexpr (Epi::NVM > 0) PG8_WAIT_SEL(after_epi, 8 + Epi::NVM); else PG8_WAIT_V(8);
            PG8_WAIT_L(0); PG8_BAR; PG8_MMA(1, 0, At, B0); PG8_MMA(1, 1, At, B1); PG8_BAR; PG8_SCHED;
            PG8_LDB(B0, 1, 0); PG8_LDB(B1, 1, 1); PG8_SCHED; PG8_LDA(At, 1, 0); PG8_STAGE_A(PG8_SA(0, 1), a2, 1);
            PG8_WAIT_V(8); PG8_WAIT_L(0); PG8_BAR; PG8_MMA(0, 0, At, B0); PG8_MMA(0, 1, At, B1); PG8_BAR; PG8_SCHED;
            PG8_LDA(At, 1, 1); PG8_STAGE(PG8_SB(1, 0), b3, voffB); PG8_STAGE(PG8_SB(1, 1), b3 + hstep, voffB); PG8_STAGE_A(PG8_SA(1, 0), a3, 0);
            PG8_WAIT_V(8); PG8_WAIT_L(0); PG8_BAR; PG8_MMA(1, 0, At, B0); PG8_MMA(1, 1, At, B1); PG8_BAR; PG8_SCHED;
        }
        if (wr == 0) PG8_BAR;
        if constexpr (F8) asm volatile("s_nop 15\n\ts_nop 15" ::: "memory");
        E(acc, cur, wr, wc, fr, fq);
        if (!has_next) break;
#pragma unroll
        for (int a = 0; a < 2; ++a)
#pragma unroll
            for (int b = 0; b < 2; ++b)
#pragma unroll
                for (int m = 0; m < 4; ++m)
#pragma unroll
                    for (int n = 0; n < 2; ++n) acc[a][b][m][n] = (f32x4){0.f, 0.f, 0.f, 0.f};
        cur = nxt; cA = nA; cB = nB; ++ui;
        if (wr == 1) PG8_BAR;
    }
    PG8_WAIT_V(0);
    PG8_BAR;
#undef PG8_SA
#undef PG8_SB
#undef PG8_STAGE
#undef PG8_STAGE_A
#undef PG8_LDA
#undef PG8_LDB
#undef PG8_MMA
#undef PG8_LD8
#undef PG8_WAIT_V
#undef PG8_WAIT_SEL
#undef PG8_WAIT_L
#undef PG8_BAR
#undef PG8_SCHED
}
}

template <int Mr, int Nc, int K, bool ACCUM>
__device__ __forceinline__ void mm_lds(const LAS bf16* A, int lda, const LAS bf16* Bt, int ldb, f32x4 (&acc)[(Mr / 16) * (Nc / 16) / 8], int wave, int lane) {
    constexpr int NT = Nc / 16, TPW = (Mr / 16) * NT / 8;
    const int fr = lane & 15, fq = lane >> 4;
#pragma unroll
    for (int q = 0; q < TPW; ++q) {
        const int t = wave + 8 * q, ti = t / NT, tj = t % NT;
        f32x4 c = ACCUM ? acc[q] : (f32x4){0.f, 0.f, 0.f, 0.f};
#pragma unroll
        for (int k0 = 0; k0 < K; k0 += 32) {
            const bf16x8 a = *(const LAS bf16x8*)(A + (16 * ti + fr) * lda + k0 + 8 * fq);
            const bf16x8 b = *(const LAS bf16x8*)(Bt + (16 * tj + fr) * ldb + k0 + 8 * fq);
            c = __builtin_amdgcn_mfma_f32_16x16x32_bf16(a, b, c, 0, 0, 0);
        }
        acc[q] = c;
        if (TPW > 2) asm volatile("" ::: "memory");
    }
}
#define MM_ROW(NT, q, r) (16 * ((wave + 8 * (q)) / (NT)) + 4 * fq + (r))
#define MM_COL(NT, q)    (16 * ((wave + 8 * (q)) % (NT)) + fr)

struct Args { const float* in[25]; float* out; unsigned char* ws; int ph_lo, ph_hi; };
constexpr int NPHASE = 17;

template <bool F8>
__device__ __forceinline__ void p0_tile(const float* W, int K, int N, void* WTv, int mode, float scale, LAS unsigned* T, int item, int lane) {
    const int nblk = N / 64, kb = item / nblk, nb = item % nblk, k0 = 64 * kb, n0 = 64 * nb;
    const int row0 = mode == 0 ? n0 : ((n0 >> 7) << 8) + (n0 & 127) + (mode == 2 ? 128 : 0);
    const int g = lane >> 4, m = lane & 15;
    constexpr int P = F8 ? 17 : 33;
    f32x4 v[16];
#pragma unroll
    for (int L = 0; L < 16; ++L) { const int kk = F8 ? (16 * (L >> 2) + 4 * g + (L & 3)) : (8 * (L >> 1) + 2 * g + (L & 1)); v[L] = *(const f32x4*)(W + (size_t)(k0 + kk) * N + n0 + 4 * m); }
    if constexpr (F8) {
#pragma unroll
        for (int i = 0; i < 4; ++i)
#pragma unroll
            for (int j = 0; j < 4; ++j) { const float q0 = __builtin_amdgcn_fmed3f(v[4 * i][j] * scale, -448.f, 448.f), q1 = __builtin_amdgcn_fmed3f(v[4 * i + 1][j] * scale, -448.f, 448.f), q2 = __builtin_amdgcn_fmed3f(v[4 * i + 2][j] * scale, -448.f, 448.f), q3 = __builtin_amdgcn_fmed3f(v[4 * i + 3][j] * scale, -448.f, 448.f);
                int w = __builtin_amdgcn_cvt_pk_fp8_f32(q0, q1, 0, false); w = __builtin_amdgcn_cvt_pk_fp8_f32(q2, q3, w, true);
                T[(4 * m + j) * P + 4 * i + g] = (unsigned)w; }
    } else {
#pragma unroll
        for (int i = 0; i < 8; ++i)
#pragma unroll
            for (int j = 0; j < 4; ++j) T[(4 * m + j) * P + 4 * i + g] = pk2(v[2 * i][j], v[2 * i + 1][j]);
    }
    LDS_WAIT(); asm volatile("" ::: "memory");
    if constexpr (F8) {
        unsigned char* WT = (unsigned char*)WTv;
#pragma unroll
        for (int p = 0; p < 4; ++p) { const int n = (lane >> 2) + 16 * p, c = lane & 3; const LAS unsigned* t = T + n * P + 4 * c; u32x4 o; o.x = t[0]; o.y = t[1]; o.z = t[2]; o.w = t[3];
            *(u32x4*)(WT + (size_t)(row0 + n) * K + k0 + 16 * c) = o; }
    } else {
        bf16* WT = (bf16*)WTv;
#pragma unroll
        for (int p = 0; p < 8; ++p) { const int n = (lane >> 3) + 8 * p, c = lane & 7; const LAS unsigned* t = T + n * P + 4 * c; u32x4 o; o.x = t[0]; o.y = t[1]; o.z = t[2]; o.w = t[3];
            *(u32x4*)(WT + (size_t)(row0 + n) * K + k0 + 8 * c) = o; }
    }
    LDS_WAIT(); asm volatile("" ::: "memory");
}
struct TileDesc { const float* W; unsigned char* WT; int K, N, mode, f8, item; float scale; };
__device__ __forceinline__ TileDesc p0_desc(const Args& a, unsigned char* ws, int r) {
    constexpr int I_OUT = 16 * 16, I_FF = 16 * 44, I_DN0 = 44 * 16, I_IN1 = 16 * 40, I_EXP = 16 * 56, I_EDN = 56 * 16;
    TileDesc d; d.scale = 64.f; d.f8 = 1;
    if (r < 8 * I_EXP) { const int e = r / I_EXP; d.W = a.in[22] + (size_t)e * D * D_EXP; d.WT = ws + WT_GU1 + (size_t)e * 2 * D_EXP * D; d.K = D; d.N = D_EXP; d.mode = 1; d.item = r % I_EXP; return d; } r -= 8 * I_EXP;
    if (r < 8 * I_EXP) { const int e = r / I_EXP; d.W = a.in[23] + (size_t)e * D * D_EXP; d.WT = ws + WT_GU1 + (size_t)e * 2 * D_EXP * D; d.K = D; d.N = D_EXP; d.mode = 2; d.item = r % I_EXP; return d; } r -= 8 * I_EXP;
    if (r < 8 * I_EDN) { const int e = r / I_EDN; d.W = a.in[24] + (size_t)e * D_EXP * D; d.WT = ws + WT_DN1 + (size_t)e * D * D_EXP; d.K = D_EXP; d.N = D; d.mode = 0; d.item = r % I_EDN; return d; } r -= 8 * I_EDN;
    d.scale = 1.f; d.f8 = 0; d.mode = 0; d.item = r;
    if (r < I_OUT) { d.W = a.in[6]; d.WT = ws + WT_OUT0; d.K = D; d.N = D; return d; } r -= I_OUT;
    if (r < I_FF) { d.W = a.in[7]; d.WT = ws + WT_GU0; d.K = D; d.N = D_FF; d.mode = 1; d.item = r; return d; } r -= I_FF;
    if (r < I_FF) { d.W = a.in[8]; d.WT = ws + WT_GU0; d.K = D; d.N = D_FF; d.mode = 2; d.item = r; return d; } r -= I_FF;
    if (r < I_DN0) { d.W = a.in[9]; d.WT = ws + WT_DN0; d.K = D_FF; d.N = D; d.item = r; return d; } r -= I_DN0;
    if (r < I_IN1) { d.W = a.in[10]; d.WT = ws + WT_IN1; d.K = D; d.N = ODD_IN; d.item = r; return d; } r -= I_IN1;
    d.W = a.in[19]; d.WT = ws + WT_OUT1; d.K = D; d.N = D; d.item = r; return d;
}
constexpr int P0_NREST = 2 * 8 * 16 * 56 + 8 * 56 * 16 + 16 * 16 + 2 * 16 * 44 + 44 * 16 + 16 * 40 + 16 * 16;
__device__ __forceinline__ void p0_load(f32x4 (&v)[16], const TileDesc& d, int lane) {
    const int nblk = d.N / 64, kb = d.item / nblk, nb = d.item % nblk, k0 = 64 * kb, n0 = 64 * nb, g = lane >> 4, m = lane & 15;
#pragma unroll
    for (int L = 0; L < 16; ++L) { const int kk = d.f8 ? (16 * (L >> 2) + 4 * g + (L & 3)) : (8 * (L >> 1) + 2 * g + (L & 1)); v[L] = *(const f32x4*)(d.W + (size_t)(k0 + kk) * d.N + n0 + 4 * m); }
}
__device__ __forceinline__ void p0_finish(const f32x4 (&v)[16], const TileDesc& d, LAS unsigned* T, int lane) {
    const int nblk = d.N / 64, kb = d.item / nblk, nb = d.item % nblk, k0 = 64 * kb, n0 = 64 * nb, g = lane >> 4, m = lane & 15;
    const int row0 = d.mode == 0 ? n0 : ((n0 >> 7) << 8) + (n0 & 127) + (d.mode == 2 ? 128 : 0);
    if (d.f8) {
        constexpr int P = 17;
#pragma unroll
        for (int i = 0; i < 4; ++i)
#pragma unroll
            for (int j = 0; j < 4; ++j) { const float q0 = __builtin_amdgcn_fmed3f(v[4 * i][j] * d.scale, -448.f, 448.f), q1 = __builtin_amdgcn_fmed3f(v[4 * i + 1][j] * d.scale, -448.f, 448.f), q2 = __builtin_amdgcn_fmed3f(v[4 * i + 2][j] * d.scale, -448.f, 448.f), q3 = __builtin_amdgcn_fmed3f(v[4 * i + 3][j] * d.scale, -448.f, 448.f);
                int w = __builtin_amdgcn_cvt_pk_fp8_f32(q0, q1, 0, false); w = __builtin_amdgcn_cvt_pk_fp8_f32(q2, q3, w, true);
                T[(4 * m + j) * P + 4 * i + g] = (unsigned)w; }
        LDS_WAIT(); asm volatile("" ::: "memory");
#pragma unroll
        for (int p = 0; p < 4; ++p) { const int n = (lane >> 2) + 16 * p, c = lane & 3; const LAS unsigned* t = T + n * P + 4 * c; u32x4 o; o.x = t[0]; o.y = t[1]; o.z = t[2]; o.w = t[3];
            *(u32x4*)(d.WT + (size_t)(row0 + n) * d.K + k0 + 16 * c) = o; }
    } else {
        constexpr int P = 33;
#pragma unroll
        for (int i = 0; i < 8; ++i)
#pragma unroll
            for (int j = 0; j < 4; ++j) T[(4 * m + j) * P + 4 * i + g] = pk2(v[2 * i][j], v[2 * i + 1][j]);
        LDS_WAIT(); asm volatile("" ::: "memory");
#pragma unroll
        for (int p = 0; p < 8; ++p) { const int n = (lane >> 3) + 8 * p, c = lane & 7; const LAS unsigned* t = T + n * P + 4 * c; u32x4 o; o.x = t[0]; o.y = t[1]; o.z = t[2]; o.w = t[3];
            *(u32x4*)((bf16*)d.WT + (size_t)(row0 + n) * d.K + k0 + 8 * c) = o; }
    }
    LDS_WAIT(); asm volatile("" ::: "memory");
}
__device__ __forceinline__ void rms_row_bf16(const float* xrow, const float* g, bf16* orow, int lane) {
    const f32x4* xr = (const f32x4*)xrow + lane; const f32x4* gr = (const f32x4*)g + lane;
    f32x4 v[4]; float s = 0.f;
#pragma unroll
    for (int j = 0; j < 4; ++j) { v[j] = xr[64 * j]; s += (v[j].x * v[j].x + v[j].y * v[j].y) + (v[j].z * v[j].z + v[j].w * v[j].w); }
    const float rstd = rsqrtf(wave_sum(s) * (1.f / D) + EPS);
    u32x2* o8 = (u32x2*)orow + lane;
#pragma unroll
    for (int j = 0; j < 4; ++j) { const f32x4 gv = gr[64 * j]; u32x2 w; w.x = pk2(v[j].x * rstd * gv.x, v[j].y * rstd * gv.y); w.y = pk2(v[j].z * rstd * gv.z, v[j].w * rstd * gv.w); o8[64 * j] = w; }
}

__device__ __forceinline__ void rms_res_row_bf16(const float* xin, const bf16* drow, float* xout, const float* g, bf16* orow, int lane) {
    const f32x4* xr = (const f32x4*)xin + lane; const f32x4* gr = (const f32x4*)g + lane; const u32x2* dr = (const u32x2*)drow + lane;
    f32x4 v[4]; u32x2 dv[4]; float s = 0.f;
#pragma unroll
    for (int j = 0; j < 4; ++j) { v[j] = xr[64 * j]; dv[j] = dr[64 * j]; }
#pragma unroll
    for (int j = 0; j < 4; ++j) { v[j].x += bf2f(dv[j].x); v[j].y += bf2f(dv[j].x >> 16); v[j].z += bf2f(dv[j].y); v[j].w += bf2f(dv[j].y >> 16);
        ((f32x4*)xout + lane)[64 * j] = v[j]; s += (v[j].x * v[j].x + v[j].y * v[j].y) + (v[j].z * v[j].z + v[j].w * v[j].w); }
    const float rstd = rsqrtf(wave_sum(s) * (1.f / D) + EPS);
    u32x2* o8 = (u32x2*)orow + lane;
#pragma unroll
    for (int j = 0; j < 4; ++j) { const f32x4 gv = gr[64 * j]; u32x2 w; w.x = pk2(v[j].x * rstd * gv.x, v[j].y * rstd * gv.y); w.y = pk2(v[j].z * rstd * gv.z, v[j].w * rstd * gv.w); o8[64 * j] = w; }
}
__device__ __forceinline__ void rms_res_row2_bf16(const float* xin, const bf16* drow, float* xout, const float* g, bf16* orow, size_t rstride, int lane) {
    const f32x4* gr = (const f32x4*)g + lane;
    f32x4 v[2][4]; u32x2 dv[2][4]; float s[2] = {0.f, 0.f};
#pragma unroll
    for (int r = 0; r < 2; ++r)
#pragma unroll
        for (int j = 0; j < 4; ++j) { v[r][j] = ((const f32x4*)(xin + r * rstride) + lane)[64 * j]; dv[r][j] = ((const u32x2*)(drow + r * rstride) + lane)[64 * j]; }
#pragma unroll
    for (int r = 0; r < 2; ++r)
#pragma unroll
        for (int j = 0; j < 4; ++j) { v[r][j].x += bf2f(dv[r][j].x); v[r][j].y += bf2f(dv[r][j].x >> 16); v[r][j].z += bf2f(dv[r][j].y); v[r][j].w += bf2f(dv[r][j].y >> 16);
            ((f32x4*)(xout + r * rstride) + lane)[64 * j] = v[r][j]; s[r] += (v[r][j].x * v[r][j].x + v[r][j].y * v[r][j].y) + (v[r][j].z * v[r][j].z + v[r][j].w * v[r][j].w); }
#pragma unroll
    for (int r = 0; r < 2; ++r) { const float rstd = rsqrtf(wave_sum(s[r]) * (1.f / D) + EPS);
        u32x2* o8 = (u32x2*)(orow + r * rstride) + lane;
#pragma unroll
        for (int j = 0; j < 4; ++j) { const f32x4 gv = gr[64 * j]; u32x2 w; w.x = pk2(v[r][j].x * rstd * gv.x, v[r][j].y * rstd * gv.y); w.y = pk2(v[r][j].z * rstd * gv.z, v[r][j].w * rstd * gv.w); o8[64 * j] = w; } }
}

struct RetPf { u32x4 q1, q2, k1, k2, v1, v2, g1, g2; f32x4 r0, r1, r2, r3; };
template <bool NEEDQ>
__device__ __forceinline__ void ret_load(RetPf& pf, const bf16* proj, const f32x2* ROT, size_t row0, int tpos0, int h, int tid) {
    const int j = tid >> 3, seg = tid & 7;
    const bf16* prow = proj + (row0 + j) * EVEN_IN + 128 * h;
    pf.k1 = *(const u32x4*)(prow + RK_OFF + 8 * seg); pf.k2 = *(const u32x4*)(prow + RK_OFF + 64 + 8 * seg);
    pf.v1 = *(const u32x4*)(prow + RV_OFF + 16 * seg); pf.v2 = *(const u32x4*)(prow + RV_OFF + 16 * seg + 8);
    if constexpr (NEEDQ) { pf.q1 = *(const u32x4*)(prow + RQ_OFF + 8 * seg); pf.q2 = *(const u32x4*)(prow + RQ_OFF + 64 + 8 * seg);
        pf.g1 = *(const u32x4*)(prow + RGATE_OFF + 16 * seg); pf.g2 = *(const u32x4*)(prow + RGATE_OFF + 16 * seg + 8); }
    const f32x4* rp = (const f32x4*)(ROT + (size_t)(tpos0 + j) * 64 + 8 * seg);
    pf.r0 = rp[0]; pf.r1 = rp[1]; pf.r2 = rp[2]; pf.r3 = rp[3];
}
template <bool NEEDQ>
__device__ __forceinline__ void ret_write(const RetPf& pf, float l2g, LAS bf16* rQ, LAS bf16* rK, LAS bf16* rKdT, LAS bf16* rVT, LAS bf16* rG, int tid) {
    constexpr int LQ = 136, LT = 72;
    const int j = tid >> 3, seg = tid & 7;
    const float cs[16] = {pf.r0.x, pf.r0.y, pf.r0.z, pf.r0.w, pf.r1.x, pf.r1.y, pf.r1.z, pf.r1.w, pf.r2.x, pf.r2.y, pf.r2.z, pf.r2.w, pf.r3.x, pf.r3.y, pf.r3.z, pf.r3.w};
    const unsigned k1w[4] = {pf.k1.x, pf.k1.y, pf.k1.z, pf.k1.w}, k2w[4] = {pf.k2.x, pf.k2.y, pf.k2.z, pf.k2.w}, v1w[4] = {pf.v1.x, pf.v1.y, pf.v1.z, pf.v1.w}, v2w[4] = {pf.v2.x, pf.v2.y, pf.v2.z, pf.v2.w};
    const float dec = exp2f((float)(63 - j) * l2g);
    unsigned qa[4], qb[4], ka[4], kb[4];
#pragma unroll
    for (int w = 0; w < 4; ++w) {
        float kr1[2], kr2[2], qr1[2] = {0.f, 0.f}, qr2[2] = {0.f, 0.f};
#pragma unroll
        for (int x = 0; x < 2; ++x) { const int c = 2 * w + x; const float co = cs[2 * c], si = cs[2 * c + 1];
            const float a = bf2f(k1w[w] >> (16 * x)) * 0.08838834764831845f, b = bf2f(k2w[w] >> (16 * x)) * 0.08838834764831845f;
            kr1[x] = a * co - b * si; kr2[x] = a * si + b * co;
            rKdT[(8 * seg + c) * LT + j] = (bf16)f2bf(kr1[x] * dec); rKdT[(64 + 8 * seg + c) * LT + j] = (bf16)f2bf(kr2[x] * dec);
            if constexpr (NEEDQ) { const unsigned q1w = w == 0 ? pf.q1.x : (w == 1 ? pf.q1.y : (w == 2 ? pf.q1.z : pf.q1.w)), q2w = w == 0 ? pf.q2.x : (w == 1 ? pf.q2.y : (w == 2 ? pf.q2.z : pf.q2.w));
                const float qa_ = bf2f(q1w >> (16 * x)), qb_ = bf2f(q2w >> (16 * x)); qr1[x] = qa_ * co - qb_ * si; qr2[x] = qa_ * si + qb_ * co; }
            rVT[(16 * seg + c) * LT + j] = (bf16)((v1w[w] >> (16 * x)) & 0xffffu); rVT[(16 * seg + 8 + c) * LT + j] = (bf16)((v2w[w] >> (16 * x)) & 0xffffu); }
        if constexpr (NEEDQ) { ka[w] = pk2(kr1[0], kr1[1]); kb[w] = pk2(kr2[0], kr2[1]); qa[w] = pk2(qr1[0], qr1[1]); qb[w] = pk2(qr2[0], qr2[1]); }
    }
    if constexpr (NEEDQ) {
        u32x4 t; t.x = qa[0]; t.y = qa[1]; t.z = qa[2]; t.w = qa[3]; *(LAS u32x4*)(rQ + j * LQ + 8 * seg) = t;
        t.x = qb[0]; t.y = qb[1]; t.z = qb[2]; t.w = qb[3]; *(LAS u32x4*)(rQ + j * LQ + 64 + 8 * seg) = t;
        t.x = ka[0]; t.y = ka[1]; t.z = ka[2]; t.w = ka[3]; *(LAS u32x4*)(rK + j * LQ + 8 * seg) = t;
        t.x = kb[0]; t.y = kb[1]; t.z = kb[2]; t.w = kb[3]; *(LAS u32x4*)(rK + j * LQ + 64 + 8 * seg) = t;
        *(LAS u32x4*)(rG + j * LQ + 16 * seg) = pf.g1; *(LAS u32x4*)(rG + j * LQ + 16 * seg + 8) = pf.g2;
    }
}

__global__ void __launch_bounds__(512, 2) fwd_kernel(Args args) {
    extern __shared__ __attribute__((aligned(16))) unsigned char lds_raw[];
    LAS unsigned char* lds = (LAS unsigned char*)lds_raw;
    volatile LAS unsigned* MISC = (volatile LAS unsigned*)(lds + LDS_MISC);
    LAS unsigned char* scrb = lds + LDS_SCR;
    const int tid = threadIdx.x, lane = tid & 63, wave = __builtin_amdgcn_readfirstlane(tid >> 6);
    const int G = gridDim.x, bid = blockIdx.x;
    const int fr = lane & 15, fq = lane >> 4;
    unsigned char* ws = args.ws;
    unsigned* ctl = (unsigned*)(ws + WS_CTL);
    float* out = args.out;
    const int lo = args.ph_lo, hi = args.ph_hi;

    if (tid < 64) MISC[tid] = 0u;
    __syncthreads();
    XcdBarrier bar; bar.bar = ctl + CW_BAR; bar.x = 0; bar.st = MISC;
    if (hi - lo > 1) bar = xcd_barrier_post(ctl + CW_BAR, MISC);
#ifndef PHASE_MASK
#define PHASE_MASK 0x1ffff
#endif
#define IN(k) ((((PHASE_MASK) >> (k)) & 1) && lo <= (k) && (k) < hi)
#define SEAM(k) do { if (IN(k) && IN((k) + 1)) xcd_barrier(bar); PSTAMP((k) + 1); } while (0)
#define PSTAMP(k) do { if (PROBE_A_LO >= 0 && bid == 0 && tid == 0) { const unsigned _t = (unsigned)wall_clock64(); if ((k) == PROBE_A_LO) MISC[8] = _t; if ((k) == PROBE_A_HI + 1) MISC[9] = _t; if ((k) == PROBE_B_LO) MISC[10] = _t; if ((k) == PROBE_B_HI + 1) MISC[11] = _t; } } while (0)
    PSTAMP(0);

    bf16* const ACTA = (bf16*)(ws + WS_ACTA);
    bf16* const ACTB = (bf16*)(ws + WS_ACTB);
    const f32x2* const ROT = (const f32x2*)(ws + WS_ROT);
    const int gw = bid * 8 + wave, NGW = G * 8;

    if (IN(0)) {
        LAS unsigned* scr = (LAS unsigned*)(scrb + wave * 16384);
        constexpr int I_IN0 = 16 * 56;
        for (int it = gw; it < I_IN0; it += NGW) p0_tile<false>(args.in[4], D, EVEN_IN, (bf16*)(ws + WT_IN0), 0, 1.f, scr, it, lane);
        for (int idx = bid * 512 + tid; idx < SEQ * 64; idx += G * 512) {
            const int t = idx >> 6, i = idx & 63;
            const float inv_freq = exp2f(-(float)i * (13.287712379549449f / 64.0f));
            double rev = (double)t * (double)inv_freq * 0.15915494309189535; rev -= floor(rev);
            const float rv = (float)rev;
            f32x2 cs; cs.x = __builtin_amdgcn_cosf(rv); cs.y = __builtin_amdgcn_sinf(rv);
            ((f32x2*)(ws + WS_ROT))[idx] = cs;
        }
        for (int m = gw; m < M; m += NGW) rms_row_bf16(args.in[0] + (size_t)m * D, args.in[1], ACTA + (size_t)m * D, lane);
    }
    SEAM(0);

    if (IN(1)) {
        pg8::DenseSched S; S.init(ACTA, (const bf16*)(ws + WT_IN0), M, EVEN_IN, D, G, bid);
        pg8::EpiStoreBf16 E{ACTB, EVEN_IN};
        pg8::gemm_phase<pg8::EpiStoreBf16, pg8::DenseSched, false>(scrb, 2 * D, S, E);
    }
    SEAM(1);

    constexpr int LQ = 136, LT = 72;
    LAS bf16* const rQ = (LAS bf16*)(scrb);
    LAS bf16* const rK = (LAS bf16*)(scrb + 17408);
    LAS bf16* const rKdT = (LAS bf16*)(scrb + 34816);
    LAS bf16* const rVT = (LAS bf16*)(scrb + 53248);
    LAS bf16* const rS = (LAS bf16*)(scrb + 71680);
    LAS bf16* const rStT = (LAS bf16*)(scrb + 80896);
    LAS float* const rStat = (LAS float*)(scrb + 115712);
    LAS bf16* const rG = (LAS bf16*)(scrb + 120320);
    float* const RGS = (float*)(ws + WS_SCR);

    if (IN(2)) {
        for (int item = bid; item < 256; item += G) {
            const int b = item >> 5, h = (item >> 3) & 3, g = item & 7;
            const float l2g = log2f(1.0f - exp2f(-5.0f - (float)h));
            const float g64 = exp2f(64.0f * l2g);
            f32x4 st[8];
#pragma unroll
            for (int q = 0; q < 8; ++q) st[q] = (f32x4){0.f, 0.f, 0.f, 0.f};
            RetPf pf;
            ret_load<false>(pf, ACTB, ROT, (size_t)b * SEQ + (g * 8) * 64, (g * 8) * 64, h, tid);
            f32x4 cva[16]; TileDesc cda = p0_desc(args, ws, 0);
            LAS unsigned* const Ta = (LAS unsigned*)(scrb + wave * 4352);
            for (int n = 0; n < 8; ++n) {
                ret_write<false>(pf, l2g, rQ, rK, rKdT, rVT, rG, tid);
                if (n < 7) { const int tposn = (g * 8 + n + 1) * 64; ret_load<false>(pf, ACTB, ROT, (size_t)b * SEQ + tposn, tposn, h, tid); }
                if (item < G) { if (n > 0) p0_finish(cva, cda, Ta, lane); cda = p0_desc(args, ws, (item * 8 + wave) + n * (G * 8)); p0_load(cva, cda, lane); }
                __syncthreads();
#pragma unroll
                for (int q = 0; q < 8; ++q) st[q] = st[q] * g64;
                mm_lds<128, 128, 64, true>(rKdT, LT, rVT, LT, st, wave, lane);
                __syncthreads();
            }
            if (item < G) p0_finish(cva, cda, Ta, lane);
            float* gp = RGS + (size_t)item * 16384 + tid;
#pragma unroll
            for (int q = 0; q < 8; ++q)
#pragma unroll
                for (int r = 0; r < 4; ++r) gp[(q * 4 + r) * 512] = st[q][r];
        }
        {
            __syncthreads();
            constexpr int PV = 80;
            LAS bf16* const sV = (LAS bf16*)(scrb + wave * 10240);
            const int vkey = lane >> 3, vpc = lane & 7;
            int cv_next = (G < 256 ? G : 256) * 64 + bid * 8 + wave; bool cv_have = false; f32x4 cv[16]; TileDesc cd = p0_desc(args, ws, 0);
            for (int wi = bid * 8 + wave; wi < NB * 8 * 256; wi += G * 8) {
                const int qt = 255 - (wi & 255), h = (wi >> 8) & 7, b = wi >> 11;
                const size_t brow = (size_t)b * SEQ;
                const int tq = 16 * qt + fr;
                bf16x8 qf[2];
#pragma unroll
                for (int ks = 0; ks < 2; ++ks) qf[ks] = *(const bf16x8*)(ACTB + (brow + tq) * EVEN_IN + SQ_OFF + 64 * h + 32 * ks + 8 * fq);
                f32x4 ot[4];
#pragma unroll
                for (int dt = 0; dt < 4; ++dt) ot[dt] = (f32x4){0.f, 0.f, 0.f, 0.f};
                float C = 1.0f;
                int kt = qt >> 2;
                bf16x8 kf[4][2]; u32x4 vr[8];
#pragma unroll
                for (int tj = 0; tj < 4; ++tj)
#pragma unroll
                    for (int ks = 0; ks < 2; ++ks) kf[tj][ks] = *(const bf16x8*)(ACTB + (brow + 64 * kt + 16 * tj + fr) * EVEN_IN + SK_OFF + 64 * h + 32 * ks + 8 * fq);
#pragma unroll
                for (int i = 0; i < 8; ++i) vr[i] = *(const u32x4*)(ACTB + (brow + 64 * kt + 8 * i + vkey) * EVEN_IN + SV_OFF + 64 * h + 8 * vpc);
                for (;;) {
                    if (cv_have) { p0_finish(cv, cd, (LAS unsigned*)sV, lane); cv_have = false; }
                    if (cv_next < P0_NREST) { cd = p0_desc(args, ws, cv_next); p0_load(cv, cd, lane); cv_have = true; cv_next += NGW; }
#pragma unroll
                    for (int i = 0; i < 8; ++i) { LAS u32x2* d = (LAS u32x2*)(sV + (8 * i + vkey) * PV + 8 * vpc); u32x2 lo, hi; lo.x = vr[i].x; lo.y = vr[i].y; hi.x = vr[i].z; hi.y = vr[i].w; d[0] = lo; d[1] = hi; }
                    f32x4 zt[4];
#pragma unroll
                    for (int tj = 0; tj < 4; ++tj) { zt[tj] = __builtin_amdgcn_mfma_f32_16x16x32_bf16(kf[tj][0], qf[0], (f32x4){0.f, 0.f, 0.f, 0.f}, 0, 0, 0); zt[tj] = __builtin_amdgcn_mfma_f32_16x16x32_bf16(kf[tj][1], qf[1], zt[tj], 0, 0, 0); }
                    const int ktn = kt - 1;
                    if (ktn >= 0) {
#pragma unroll
                        for (int tj = 0; tj < 4; ++tj)
#pragma unroll
                            for (int ks = 0; ks < 2; ++ks) kf[tj][ks] = *(const bf16x8*)(ACTB + (brow + 64 * ktn + 16 * tj + fr) * EVEN_IN + SK_OFF + 64 * h + 32 * ks + 8 * fq);
#pragma unroll
                        for (int i = 0; i < 8; ++i) vr[i] = *(const u32x4*)(ACTB + (brow + 64 * ktn + 8 * i + vkey) * EVEN_IN + SV_OFF + 64 * h + 8 * vpc);
                    }
                    float a[4][4], pseg[4];
#pragma unroll
                    for (int tj = 0; tj < 4; ++tj) { float suf = 1.0f;
#pragma unroll
                        for (int r = 3; r >= 0; --r) { const int sk = 64 * kt + 16 * tj + 4 * fq + r; const bool valid = sk < tq;
                            const float pp = __builtin_amdgcn_rcpf(1.0f + __builtin_amdgcn_exp2f(zt[tj][r] * (0.125f * 1.4426950408889634f)));
                            const float p = valid ? pp : 1.0f, be = valid ? 1.0f - pp : 0.0f; a[tj][r] = be * suf; suf *= p; }
                        pseg[tj] = suf; }
                    float run = C;
#pragma unroll
                    for (int tj = 3; tj >= 0; --tj) { const float y = __shfl_xor(pseg[tj], 16); const float pair = pseg[tj] * y; const float zz = __shfl_xor(pair, 32);
                        const float S = ((fq & 1) ? 1.0f : y) * ((fq & 2) ? 1.0f : zz); const float sc = S * run;
#pragma unroll
                        for (int r = 0; r < 4; ++r) a[tj][r] *= sc;
                        run *= pair * zz; }
                    C = run;
                    bf16x8 af[2];
#pragma unroll
                    for (int ks = 0; ks < 2; ++ks) { u32x4 w; w.x = pk2(a[2 * ks][0], a[2 * ks][1]); w.y = pk2(a[2 * ks][2], a[2 * ks][3]); w.z = pk2(a[2 * ks + 1][0], a[2 * ks + 1][1]); w.w = pk2(a[2 * ks + 1][2], a[2 * ks + 1][3]); af[ks] = __builtin_bit_cast(bf16x8, w); }
                    LDS_WAIT(); asm volatile("" ::: "memory");
#pragma unroll
                    for (int dt = 0; dt < 4; ++dt)
#pragma unroll
                        for (int ks = 0; ks < 2; ++ks) {
                            const LAS v4s_t* tp = (const LAS v4s_t*)(sV + (32 * ks + 4 * fq + (fr >> 2)) * PV + 16 * dt + 4 * (fr & 3));
                            const v4s_t lo = __builtin_amdgcn_ds_read_tr16_b64_v4i16((LAS v4s_t*)tp), hi = __builtin_amdgcn_ds_read_tr16_b64_v4i16((LAS v4s_t*)(tp + 4 * PV));
                            const bf16x8 vf = __builtin_shufflevector(lo, hi, 0, 1, 2, 3, 4, 5, 6, 7);
                            ot[dt] = __builtin_amdgcn_mfma_f32_16x16x32_bf16(vf, af[ks], ot[dt], 0, 0, 0); }
                    LDS_WAIT(); asm volatile("" ::: "memory");
                    if (ktn < 0 || __all(C < 1e-30f)) break;
                    kt = ktn;
                }
#pragma unroll
                for (int dt = 0; dt < 4; ++dt) { u32x2 w; w.x = pk2(ot[dt][0], ot[dt][1]); w.y = pk2(ot[dt][2], ot[dt][3]);
                    *(u32x2*)(ACTA + (brow + tq) * D + 512 + 64 * h + 16 * dt + 4 * fq) = w; }
            }
            if (cv_have) p0_finish(cv, cd, (LAS unsigned*)sV, lane);
            for (; cv_next < P0_NREST; cv_next += NGW) { cd = p0_desc(args, ws, cv_next); p0_load(cv, cd, lane); p0_finish(cv, cd, (LAS unsigned*)sV, lane); }
        }
    }
    SEAM(2);

    if (IN(3)) {
        const int fr0 = fr, fq0 = fq;
        for (int item = bid; item < 256; item += G) {
            const int b = item >> 5, h = (item >> 3) & 3, g = item & 7;
            const float l2g = log2f(1.0f - exp2f(-5.0f - (float)h));
            const float g64 = exp2f(64.0f * l2g), g512 = exp2f(512.0f * l2g);
            f32x4 st[8];
#pragma unroll
            for (int q = 0; q < 8; ++q) st[q] = (f32x4){0.f, 0.f, 0.f, 0.f};
            for (int gp_ = 0; gp_ < g; ++gp_) {
                const float* gp = RGS + (size_t)(item - g + gp_) * 16384 + tid;
#pragma unroll
                for (int q = 0; q < 8; ++q)
#pragma unroll
                    for (int r = 0; r < 4; ++r) st[q][r] = st[q][r] * g512 + gp[(q * 4 + r) * 512];
            }
            RetPf pf;
            ret_load<true>(pf, ACTB, ROT, (size_t)b * SEQ + (g * 8) * 64, (g * 8) * 64, h, tid);
            for (int n = 0; n < 8; ++n) {
                int tid_l = tid, fr_l = fr0, fq_l = fq0;
                asm volatile("" : "+v"(tid_l), "+v"(fr_l), "+v"(fq_l));
                { const int fr = fr_l, fq = fq_l, lane = (fq_l << 4) | fr_l;
                const int tpos0 = (g * 8 + n) * 64; const size_t row0 = (size_t)b * SEQ + tpos0;
                __syncthreads();
                ret_write<true>(pf, l2g, rQ, rK, rKdT, rVT, rG, tid_l);
                if (n < 7) { const int tposn = tpos0 + 64; ret_load<true>(pf, ACTB, ROT, (size_t)b * SEQ + tposn, tposn, h, tid_l); }
#pragma unroll
                for (int q = 0; q < 8; ++q) { u32x2 w; w.x = pk2(st[q][0], st[q][1]); w.y = pk2(st[q][2], st[q][3]);
                    *(LAS u32x2*)(rStT + MM_COL(8, q) * LQ + 16 * q + 4 * fq) = w; }
                __syncthreads();
                { f32x4 sT[2]; mm_lds<64, 64, 128, false>(rK, LQ, rQ, LQ, sT, wave, lane);
                  const int i = MM_COL(4, 0);
#pragma unroll
                  for (int q = 0; q < 2; ++q) { const int j0 = MM_ROW(4, q, 0); float e4[4];
#pragma unroll
                      for (int r = 0; r < 4; ++r) { const int dd = i > j0 + r ? i - j0 - r : j0 + r - i; e4[r] = sT[q][r] * exp2f((float)dd * l2g); }
                      u32x2 w; w.x = pk2(e4[0], e4[1]); w.y = pk2(e4[2], e4[3]); *(LAS u32x2*)(rS + i * LT + j0) = w; } }
                __syncthreads();
                f32x4 oi[4];
                mm_lds<128, 64, 128, false>(rStT, LQ, rQ, LQ, oi, wave, lane);
                const int io = MM_COL(4, 0);
                { const float gi1 = exp2f((float)(io + 1) * l2g);
#pragma unroll
                  for (int q = 0; q < 4; ++q) oi[q] = oi[q] * gi1; }
                mm_lds<128, 64, 64, true>(rVT, LT, rS, LT, oi, wave, lane);
                { float s1 = 0.f, s2 = 0.f;
#pragma unroll
                  for (int q = 0; q < 4; ++q)
#pragma unroll
                      for (int r = 0; r < 4; ++r) { s1 += oi[q][r]; s2 += oi[q][r] * oi[q][r]; }
                  s1 += __shfl_xor(s1, 16); s2 += __shfl_xor(s2, 16); s1 += __shfl_xor(s1, 32); s2 += __shfl_xor(s2, 32);
                  if (fq == 0) { rStat[(io * 2 + (wave >> 2)) * 2] = s1; rStat[(io * 2 + (wave >> 2)) * 2 + 1] = s2; } }
                __syncthreads();
                { const float s1 = rStat[(io * 2) * 2] + rStat[(io * 2 + 1) * 2], s2 = rStat[(io * 2) * 2 + 1] + rStat[(io * 2 + 1) * 2 + 1];
                  const float mu = s1 * (1.0f / 128.0f); float var = s2 * (1.0f / 128.0f) - mu * mu; var = var < 0.f ? 0.f : var; const float rstd = rsqrtf(var + EPS);
#pragma unroll
                  for (int q = 0; q < 4; ++q) { const int e0 = MM_ROW(4, q, 0);
                      const u32x2 gt = *(const LAS u32x2*)(rG + io * LQ + e0); const f32x4 gw4 = *(const f32x4*)(args.in[5] + 128 * h + e0);
                      const float g0 = bf2f(gt.x), g1 = bf2f(gt.x >> 16), g2 = bf2f(gt.y), g3 = bf2f(gt.y >> 16);
                      u32x2 w; w.x = pk2((oi[q][0] - mu) * rstd * gw4.x * g0 * sigmoidf_(g0), (oi[q][1] - mu) * rstd * gw4.y * g1 * sigmoidf_(g1));
                      w.y = pk2((oi[q][2] - mu) * rstd * gw4.z * g2 * sigmoidf_(g2), (oi[q][3] - mu) * rstd * gw4.w * g3 * sigmoidf_(g3));
                      *(LAS u32x2*)(rQ + io * LQ + e0) = w; } }
#pragma unroll
                for (int q = 0; q < 8; ++q) st[q] = st[q] * g64;
                mm_lds<128, 128, 64, true>(rKdT, LT, rVT, LT, st, wave, lane);
                __syncthreads();
                { const int j = tid_l >> 3, seg = tid_l & 7; bf16* yp = ACTA + (row0 + j) * D + 128 * h + 16 * seg;
                  *(u32x4*)yp = *(const LAS u32x4*)(rQ + j * LQ + 16 * seg); *(u32x4*)(yp + 8) = *(const LAS u32x4*)(rQ + j * LQ + 16 * seg + 8); }
                }
            }
        }
    }
    SEAM(3);

    if (IN(4)) {
        pg8::DenseSched S; S.init(ACTA, (const bf16*)(ws + WT_OUT0), M, D, D, G, bid);
        pg8::EpiStoreBf16 E{ACTB, D};
        pg8::gemm_phase<pg8::EpiStoreBf16, pg8::DenseSched, false>(scrb, 2 * D, S, E);
    }
    SEAM(4);
    if (IN(5)) { for (int m = gw; m < M; m += 2 * NGW) { if (m + NGW < M) rms_res_row2_bf16(args.in[0] + (size_t)m * D, ACTB + (size_t)m * D, out + (size_t)m * D, args.in[2], ACTA + (size_t)m * D, (size_t)NGW * D, lane);
            else rms_res_row_bf16(args.in[0] + (size_t)m * D, ACTB + (size_t)m * D, out + (size_t)m * D, args.in[2], ACTA + (size_t)m * D, lane); } }
    SEAM(5);
    if (IN(6)) {
        pg8::DenseSched S; S.init(ACTA, (const bf16*)(ws + WT_GU0), M, 2 * D_FF, D, G, bid);
        pg8::EpiSwiGLU E{ACTB, D_FF};
        pg8::gemm_phase<pg8::EpiSwiGLU, pg8::DenseSched, false>(scrb, 2 * D, S, E);
    }
    SEAM(6);
    if (IN(7)) {
        pg8::DenseSched S; S.init(ACTB, (const bf16*)(ws + WT_DN0), M, D, D_FF, G, bid);
        pg8::EpiStoreBf16 E{ACTA, D};
        pg8::gemm_phase<pg8::EpiStoreBf16, pg8::DenseSched, false>(scrb, 2 * D_FF, S, E);
    }
    SEAM(7);
    if (IN(8)) { for (int m = gw; m < M; m += 2 * NGW) { if (m + NGW < M) rms_res_row2_bf16(out + (size_t)m * D, ACTA + (size_t)m * D, out + (size_t)m * D, args.in[1] + D, ACTA + (size_t)m * D, (size_t)NGW * D, lane);
            else rms_res_row_bf16(out + (size_t)m * D, ACTA + (size_t)m * D, out + (size_t)m * D, args.in[1] + D, ACTA + (size_t)m * D, lane); } }
    SEAM(8);
    if (IN(9)) {
        pg8::DenseSched S; S.init(ACTA, (const bf16*)(ws + WT_IN1), M, ODD_IN, D, G, bid);
        pg8::EpiStoreBf16 E{ACTB, ODD_IN};
        pg8::gemm_phase<pg8::EpiStoreBf16, pg8::DenseSched, false>(scrb, 2 * D, S, E);
    }
    SEAM(9);

    float* const LSUM = (float*)(ws + WS_SCR);
#pragma unroll
    for (int pass = 0; pass < 2; ++pass) {
        if (IN(10 + pass)) {
            LAS bf16* const XT = (LAS bf16*)(scrb + wave * 17984);
            LAS bf16* const XR = XT + 3 * LT;
            LAS float* const AB = (LAS float*)(scrb + wave * 17984 + 9792);
            const int head = wave, ch = 64 * head + lane;
            bf16x8 Bwa[4][2], Bwx[4][2];
#pragma unroll
            for (int tj = 0; tj < 4; ++tj)
#pragma unroll
                for (int ks = 0; ks < 2; ++ks) { bf16x8 va, vx;
#pragma unroll
                    for (int e = 0; e < 8; ++e) { const int i = 32 * ks + 8 * fq + e, j = 16 * tj + fr; va[e] = (short)f2bf(args.in[14][(size_t)(head * 64 + i) * 64 + j]); vx[e] = (short)f2bf(args.in[16][(size_t)(head * 64 + i) * 64 + j]); }
                    Bwa[tj][ks] = va; Bwx[tj][ks] = vx; }
            float cba[4], cbx[4], csp[4];
#pragma unroll
            for (int tj = 0; tj < 4; ++tj) { const int c = 64 * head + 16 * tj + fr; cba[tj] = args.in[15][c]; cbx[tj] = args.in[17][c]; csp[tj] = -8.0f * 1.4426950408889634f * log1pf(__expf(-args.in[18][c])); }
            const float cw0 = args.in[12][ch], cw1 = args.in[12][512 + ch], cw2 = args.in[12][1024 + ch], cw3 = args.in[12][1536 + ch], cbias = args.in[13][ch];
            for (int it = bid; it < NB * 64; it += G) {
                const int b = it >> 6, c = it & 63; const size_t row0 = (size_t)b * SEQ + 64 * c;
                { const int r8 = lane >> 3, pc = lane & 7;
                  u32x4 raw[9];
#pragma unroll
                  for (int i = 0; i < 9; ++i) raw[i] = *(const u32x4*)(ACTB + (row0 + 8 * i + r8 - 3) * ODD_IN + XR_OFF + 64 * head + 8 * pc);
#pragma unroll
                  for (int i = 0; i < 9; ++i) if (8 * i + r8 < 68) *(LAS u32x4*)(XT + (8 * i + r8) * LT + 8 * pc) = raw[i];
                  LDS_WAIT(); asm volatile("" ::: "memory");
                  float x0 = 0.f, x1 = 0.f, x2 = 0.f;
                  if (c > 0) { x0 = bf2f(XT[0 * LT + lane]); x1 = bf2f(XT[1 * LT + lane]); x2 = bf2f(XT[2 * LT + lane]); }
#pragma unroll 16
                  for (int t = 0; t < 64; ++t) { const float x3 = bf2f(XT[(t + 3) * LT + lane]);
                      XT[(t + 3) * LT + lane] = (bf16)f2bf(cw0 * x0 + cw1 * x1 + cw2 * x2 + cw3 * x3 + cbias); x0 = x1; x1 = x2; x2 = x3; } }
                float hst = 0.f, cum = 1.f;
                if (pass == 1) {
                    for (int c0 = 0; c0 < c; c0 += 8) {
                        f32x2 sv[8];
#pragma unroll
                        for (int k = 0; k < 8; ++k) { const int cc = (c0 + k < c) ? c0 + k : c0; sv[k] = ((const f32x2*)LSUM)[(size_t)(b * 64 + cc) * 512 + ch]; }
#pragma unroll
                        for (int k = 0; k < 8; ++k) if (c0 + k < c) hst = sv[k].x * hst + sv[k].y;
                    }
                }
                LDS_WAIT(); asm volatile("" ::: "memory");
                for (int sb = 0; sb < 4; ++sb) {
                    bf16 gv[16];
                    if (pass == 1) {
#pragma unroll
                        for (int tl = 0; tl < 16; ++tl) gv[tl] = ACTB[(row0 + 16 * sb + tl) * ODD_IN + XG_OFF + ch]; }
                    f32x4 aR[4], aX[4];
#pragma unroll
                    for (int tj = 0; tj < 4; ++tj) { aR[tj] = (f32x4){0.f, 0.f, 0.f, 0.f}; aX[tj] = aR[tj]; }
#pragma unroll
                    for (int ks = 0; ks < 2; ++ks) { const bf16x8 af = *(const LAS bf16x8*)(XR + (16 * sb + fr) * LT + 32 * ks + 8 * fq);
#pragma unroll
                        for (int tj = 0; tj < 4; ++tj) { aR[tj] = __builtin_amdgcn_mfma_f32_16x16x32_bf16(af, Bwa[tj][ks], aR[tj], 0, 0, 0); aX[tj] = __builtin_amdgcn_mfma_f32_16x16x32_bf16(af, Bwx[tj][ks], aX[tj], 0, 0, 0); } }
#pragma unroll
                    for (int tj = 0; tj < 4; ++tj)
#pragma unroll
                        for (int r = 0; r < 4; ++r) { const int tl = 4 * fq + r, j = 16 * tj + fr;
                            const float rg = sigmoidf_(aR[tj][r] + cba[tj]), ig = sigmoidf_(aX[tj][r] + cbx[tj]);
                            const float a = __builtin_amdgcn_exp2f(rg * csp[tj]);
                            const float mult = __builtin_amdgcn_sqrtf(fmaxf(1.0f - a * a, 0.0f));
                            const float xv = bf2f(XR[(16 * sb + tl) * LT + j]);
                            AB[tl * 64 + j] = a; AB[1024 + tl * 64 + j] = mult * ig * xv; }
                    LDS_WAIT(); asm volatile("" ::: "memory");
                    if (pass == 1) {
#pragma unroll
                        for (int tl = 0; tl < 16; ++tl) { const float a = AB[tl * 64 + lane], bb = AB[1024 + tl * 64 + lane]; hst = a * hst + bb;
                            const float xg = bf2f(gv[tl]);
                            const float u3 = 0.7978845608028654f * (xg + 0.044715f * xg * xg * xg); const float th = 1.0f - 2.0f * __builtin_amdgcn_rcpf(1.0f + __builtin_amdgcn_exp2f(u3 * 2.8853900817779268f));
                            ACTA[(row0 + 16 * sb + tl) * D + 512 + ch] = (bf16)f2bf(hst * 0.5f * xg * (1.0f + th)); }
                    } else {
#pragma unroll
                        for (int tl = 0; tl < 16; ++tl) { const float a = AB[tl * 64 + lane], bb = AB[1024 + tl * 64 + lane]; hst = a * hst + bb; cum *= a; }
                    }
                    LDS_WAIT(); asm volatile("" ::: "memory");
                }
                if (pass == 0) { f32x2 sv; sv.x = cum; sv.y = hst; ((f32x2*)LSUM)[(size_t)(b * 64 + c) * 512 + ch] = sv; }
            }
            if (pass == 1) {
#pragma unroll 2
                for (int idx = bid * 512 + tid; idx < M * 64; idx += G * 512) {
                    const int row = idx >> 6, c8 = (idx & 63) * 8; const int t = row & (SEQ - 1);
                    const bf16* p = ACTB + (size_t)row * ODD_IN;
                    float acc8[8];
#pragma unroll
                    for (int x = 0; x < 8; ++x) acc8[x] = 0.f;
#pragma unroll
                    for (int k = 0; k < 3; ++k) { const int dt = 2 - k; if (t - dt >= 0) { const bf16* pr = p - (size_t)dt * ODD_IN;
                            const u32x4 gc = *(const u32x4*)(pr + CC_OFF + c8), uu = *(const u32x4*)(pr + CU_OFF + c8); const unsigned gw_[4] = {gc.x, gc.y, gc.z, gc.w}, uw[4] = {uu.x, uu.y, uu.z, uu.w};
#pragma unroll
                            for (int x = 0; x < 4; ++x) { acc8[2 * x] += args.in[11][k * 512 + c8 + 2 * x] * bf2f(gw_[x]) * bf2f(uw[x]); acc8[2 * x + 1] += args.in[11][k * 512 + c8 + 2 * x + 1] * bf2f(gw_[x] >> 16) * bf2f(uw[x] >> 16); } } }
                    const u32x4 gb = *(const u32x4*)(p + CB_OFF + c8); const unsigned gbw[4] = {gb.x, gb.y, gb.z, gb.w};
                    u32x4 w; unsigned ww[4];
#pragma unroll
                    for (int x = 0; x < 4; ++x) ww[x] = pk2(bf2f(gbw[x]) * acc8[2 * x], bf2f(gbw[x] >> 16) * acc8[2 * x + 1]);
                    w.x = ww[0]; w.y = ww[1]; w.z = ww[2]; w.w = ww[3];
                    *(u32x4*)(ACTA + (size_t)row * D + c8) = w;
                }
            }
        }
        SEAM(10 + pass);
    }

    if (IN(12)) {
        pg8::DenseSched S; S.init(ACTA, (const bf16*)(ws + WT_OUT1), M, D, D, G, bid);
        pg8::EpiStoreBf16 E{ACTB, D};
        pg8::gemm_phase<pg8::EpiStoreBf16, pg8::DenseSched, false>(scrb, 2 * D, S, E);
    }
    SEAM(12);

    int* const LTOK = (int*)(ws + SCR_LTOK); unsigned* const REC = (unsigned*)(ws + SCR_REC); unsigned* const REC2 = (unsigned*)(ws + SCR_REC + MiB);
    if (IN(13)) {
        LAS int* const lcnt = (LAS int*)(scrb);
        LAS int* const lbase = (LAS int*)(scrb + 64);
        LAS int* const recE = (LAS int*)(scrb + 128);
        LAS int* const recR = (LAS int*)(scrb + 128 + 1024);
        LAS float* const recW = (LAS float*)(scrb + 128 + 2048);
        float wr_[4][4][8];
#pragma unroll
        for (int j = 0; j < 4; ++j)
#pragma unroll
            for (int x = 0; x < 4; ++x) { const int col = 4 * (lane + 64 * j) + x; const f32x4 w0 = *(const f32x4*)(args.in[20] + (size_t)col * 8), w1 = *(const f32x4*)(args.in[20] + (size_t)col * 8 + 4);
                wr_[j][x][0] = w0.x; wr_[j][x][1] = w0.y; wr_[j][x][2] = w0.z; wr_[j][x][3] = w0.w; wr_[j][x][4] = w1.x; wr_[j][x][5] = w1.y; wr_[j][x][6] = w1.z; wr_[j][x][7] = w1.w; }
        for (int base = bid * 128; base < M; base += G * 128) {
            if (tid < 16) lcnt[tid] = 0;
            __syncthreads();
            f32x4 vn[4]; u32x2 dn[4];
            { const int m = base + wave * 16;
#pragma unroll
              for (int j = 0; j < 4; ++j) { vn[j] = ((const f32x4*)(out + (size_t)m * D) + lane)[64 * j]; dn[j] = ((const u32x2*)(ACTB + (size_t)m * D) + lane)[64 * j]; } }
            for (int rr = 0; rr < 16; ++rr) {
                const int lr = wave * 16 + rr, m = base + lr;
                f32x4* xr = (f32x4*)(out + (size_t)m * D) + lane; const f32x4* gr = (const f32x4*)(args.in[2] + D) + lane;
                f32x4 v[4]; u32x2 dcur[4]; float s = 0.f;
#pragma unroll
                for (int j = 0; j < 4; ++j) { v[j] = vn[j]; dcur[j] = dn[j]; }
                if (rr < 15) {
#pragma unroll
                    for (int j = 0; j < 4; ++j) { vn[j] = ((const f32x4*)(out + (size_t)(m + 1) * D) + lane)[64 * j]; dn[j] = ((const u32x2*)(ACTB + (size_t)(m + 1) * D) + lane)[64 * j]; } }
#pragma unroll
                for (int j = 0; j < 4; ++j) { const u32x2 dv = dcur[j]; v[j].x += bf2f(dv.x); v[j].y += bf2f(dv.x >> 16); v[j].z += bf2f(dv.y); v[j].w += bf2f(dv.y >> 16); xr[64 * j] = v[j];
                    s += (v[j].x * v[j].x + v[j].y * v[j].y) + (v[j].z * v[j].z + v[j].w * v[j].w); }
                const float rstd = rsqrtf(wave_sum(s) * (1.f / D) + EPS);
                float lg[8];
#pragma unroll
                for (int e = 0; e < 8; ++e) lg[e] = 0.f;
                unsigned* o8 = (unsigned*)((unsigned char*)ACTA + (size_t)m * D) + lane;
#pragma unroll
                for (int j = 0; j < 4; ++j) { const f32x4 gv = gr[64 * j]; float y[4] = {v[j].x * rstd * gv.x, v[j].y * rstd * gv.y, v[j].z * rstd * gv.z, v[j].w * rstd * gv.w};
                    { int w = __builtin_amdgcn_cvt_pk_fp8_f32(__builtin_amdgcn_fmed3f(y[0], -448.f, 448.f), __builtin_amdgcn_fmed3f(y[1], -448.f, 448.f), 0, false);
                      w = __builtin_amdgcn_cvt_pk_fp8_f32(__builtin_amdgcn_fmed3f(y[2], -448.f, 448.f), __builtin_amdgcn_fmed3f(y[3], -448.f, 448.f), w, true); o8[64 * j] = (unsigned)w; }
#pragma unroll
                    for (int x = 0; x < 4; ++x)
#pragma unroll
                        for (int e = 0; e < 8; ++e) lg[e] += y[x] * wr_[j][x][e]; }
#pragma unroll
                for (int e = 0; e < 8; ++e) lg[e] = wave_sum(lg[e]) + args.in[21][e];
                int e1 = 0; float l1 = lg[0];
#pragma unroll
                for (int e = 1; e < 8; ++e) if (lg[e] > l1) { l1 = lg[e]; e1 = e; }
                int e2 = -1; float l2 = -3.0e38f;
#pragma unroll
                for (int e = 0; e < 8; ++e) if (e != e1 && lg[e] > l2) { l2 = lg[e]; e2 = e; }
                const float w2 = 1.0f / (1.0f + __expf(l1 - l2)), w1 = 1.0f - w2;
                if (lane == 0) { recE[lr * 2] = e1; recE[lr * 2 + 1] = e2; recW[lr * 2] = w1; recW[lr * 2 + 1] = w2;
                    recR[lr * 2] = __hip_atomic_fetch_add(&lcnt[e1], 1, __ATOMIC_RELAXED, __HIP_MEMORY_SCOPE_WORKGROUP); recR[lr * 2 + 1] = __hip_atomic_fetch_add(&lcnt[8 + e2], 1, __ATOMIC_RELAXED, __HIP_MEMORY_SCOPE_WORKGROUP); }
            }
            __syncthreads();
            if (tid < 16) lbase[tid] = (int)__hip_atomic_fetch_add(ctl + CW_CNT + 64 * tid, (unsigned)lcnt[tid], RLX_AGENT);
            __syncthreads();
            if (tid < 256) { const int lr = tid >> 1, k = tid & 1; const int e = recE[tid]; const int pos = lbase[k * 8 + e] + recR[tid];
                if (pos < LIST_CAP) LTOK[(size_t)(k * 8 + e) * LIST_CAP + pos] = base + lr;
                unsigned* rec = REC + (size_t)(base + lr) * 8 + 3 * k; rec[0] = (unsigned)(k * 8 + e); rec[1] = (unsigned)pos; rec[2] = __builtin_bit_cast(unsigned, recW[tid]); }
            __syncthreads();
        }
    }
    SEAM(13);

    if (IN(14)) {
        pg8::MoeSched S; S.init(ACTA, ws + WT_GU1, LTOK, ctl + CW_CNT, 0, 2 * D_EXP / 256, D, 0, (size_t)2 * D_EXP * D, G, bid);
        if (bid == 0 && tid == 0) { unsigned* tbw = ctl + CW_TB; tbw[0] = 0u; tbw[1] = S.t1; tbw[2] = S.t2; tbw[3] = S.t3; tbw[4] = S.t4; tbw[5] = S.t5; tbw[6] = S.t6; tbw[7] = S.t7; tbw[8] = S.t8;
            tbw[9] = S.t9; tbw[10] = S.t10; tbw[11] = S.t11; tbw[12] = S.t12; tbw[13] = S.t13; tbw[14] = S.t14; tbw[15] = S.t15; }
        pg8::EpiSwiGLU8 E{(unsigned char*)ACTB, D_EXP, 1.0f / 64.0f, 4.0f};
        pg8::gemm_phase<pg8::EpiSwiGLU8, pg8::MoeSched, true, true>(scrb, D, S, E);
    }
    SEAM(14);
    bf16* const YB = (bf16*)(ws + WS_Y);
    if (IN(15)) {
        for (int m = bid * 512 + tid; m < M; m += G * 512) {
            const u32x4 r0 = *(const u32x4*)(REC + (size_t)m * 8), r1 = *(const u32x4*)(REC + (size_t)m * 8 + 4);
            const unsigned ke0 = r0.x, rk0 = r0.y, w0b = r0.z, ke1 = r0.w, rk1 = r1.x, w1b = r1.y;
            u32x4 o; o.x = ctl[CW_TB + ke0] * 256u + rk0; o.y = ctl[CW_TB + ke1] * 256u + rk1; o.z = w0b; o.w = w1b;
            *(u32x4*)(REC2 + (size_t)m * 4) = o; }
        pg8::MoeSched S; S.init(ACTB, ws + WT_DN1, LTOK, ctl + CW_CNT, 0, D / 256, D_EXP, (size_t)256 * D_EXP, (size_t)D * D_EXP, G, bid);
        pg8::EpiStoreBf16 E{YB, D};
        pg8::gemm_phase<pg8::EpiStoreBf16, pg8::MoeSched, false, true>(scrb, D_EXP, S, E);
    }
    SEAM(15);

    if (IN(16)) {
        const f32x4* gr = (const f32x4*)args.in[3] + lane;
        for (int m0 = gw; m0 < M; m0 += 2 * NGW) {
            const int NR = (m0 + NGW < M) ? NGW : 0;
            u32x4 rc[2];
#pragma unroll
            for (int r = 0; r < 2; ++r) rc[r] = *(const u32x4*)(REC2 + (size_t)(m0 + r * NR) * 4);
            f32x4 v[2][4]; u32x2 ya[2][4], yb[2][4];
#pragma unroll
            for (int r = 0; r < 2; ++r) { const unsigned row0 = rc[r].x, row1 = rc[r].y;
                const u32x2* y0 = (const u32x2*)(YB + (size_t)row0 * D) + lane; const u32x2* y1 = (const u32x2*)(YB + (size_t)row1 * D) + lane; const f32x4* xr = (const f32x4*)(out + (size_t)(m0 + r * NR) * D) + lane;
#pragma unroll
                for (int j = 0; j < 4; ++j) { v[r][j] = xr[64 * j]; ya[r][j] = y0[64 * j]; yb[r][j] = y1[64 * j]; } }
#pragma unroll
            for (int r = 0; r < 2; ++r) { const unsigned w0u = rc[r].z, w1u = rc[r].w; const float w0 = __uint_as_float(w0u) * (1.0f / 256.0f), w1 = __uint_as_float(w1u) * (1.0f / 256.0f);
                float s = 0.f;
#pragma unroll
                for (int j = 0; j < 4; ++j) { const u32x2 a = ya[r][j], b = yb[r][j];
                    v[r][j].x += w0 * bf2f(a.x) + w1 * bf2f(b.x); v[r][j].y += w0 * bf2f(a.x >> 16) + w1 * bf2f(b.x >> 16); v[r][j].z += w0 * bf2f(a.y) + w1 * bf2f(b.y); v[r][j].w += w0 * bf2f(a.y >> 16) + w1 * bf2f(b.y >> 16);
                    s += (v[r][j].x * v[r][j].x + v[r][j].y * v[r][j].y) + (v[r][j].z * v[r][j].z + v[r][j].w * v[r][j].w); }
                const float rstd = rsqrtf(wave_sum(s) * (1.f / D) + EPS);
                f32x4* xw = (f32x4*)(out + (size_t)(m0 + r * NR) * D) + lane;
#pragma unroll
                for (int j = 0; j < 4; ++j) { const f32x4 gv = gr[64 * j]; xw[64 * j] = v[r][j] * rstd * gv; } }
        }
    }
    if (PROBE_A_LO >= 0 && bid == 0 && tid == 0) {
        const unsigned long long t_end = wall_clock64();
        const unsigned long long wait = (unsigned long long)(MISC[9] - MISC[8]) * 4ull + ((PROBE_B_LO >= 0) ? (unsigned long long)(MISC[11] - MISC[10]) * 4ull : 0ull);
        while (wall_clock64() - t_end < wait) __builtin_amdgcn_s_sleep(32);
    }
#undef IN
#undef SEAM
#undef PSTAMP
}

extern "C" void kernel_launch(void* const* d_in, const int* in_sizes, int n_in, void* d_out, int out_size, void* d_ws, size_t ws_size, hipStream_t stream) {
    static int grid = 0;
    if (grid == 0) {
        if (n_in != 25 || in_sizes[0] != M * D || out_size != M * D || ws_size < WS_END) { fprintf(stderr, "kernel_launch: unexpected shapes / workspace (n_in %d, ws %zu, need %zu)\n", n_in, ws_size, (size_t)WS_END); grid = -1; return; }
        int dev = 0, cus = 0, per_cu = 0;
        if (hipGetDevice(&dev) != hipSuccess || hipDeviceGetAttribute(&cus, hipDeviceAttributeMultiprocessorCount, dev) != hipSuccess) { grid = -1; return; }
        if (hipFuncSetAttribute((const void*)fwd_kernel, hipFuncAttributeMaxDynamicSharedMemorySize, LDS_BYTES) != hipSuccess) { fprintf(stderr, "kernel_launch: hipFuncSetAttribute failed\n"); grid = -1; return; }
        if (hipOccupancyMaxActiveBlocksPerMultiprocessor(&per_cu, (const void*)fwd_kernel, 512, LDS_BYTES) != hipSuccess || per_cu < 1) { fprintf(stderr, "kernel_launch: occupancy query says %d\n", per_cu); }
        (void)hipGetLastError();
        grid = cus;
    }
    if (grid < 0) return;
    if (hipMemsetAsync((char*)d_ws + WS_CTL, 0, CTL_ZERO_BYTES, stream) != hipSuccess) return;
    Args a{};
    for (int i = 0; i < 25; ++i) a.in[i] = (const float*)d_in[i];
    a.out = (float*)d_out; a.ws = (unsigned char*)d_ws;
#if MK_N_LAUNCHES == 1
    a.ph_lo = 0; a.ph_hi = NPHASE;
    hipLaunchKernelGGL(fwd_kernel, dim3(grid), dim3(512), LDS_BYTES, stream, a);
#else
    for (int p = 0; p < NPHASE; ++p) { a.ph_lo = p; a.ph_hi = p + 1; hipLaunchKernelGGL(fwd_kernel, dim3(grid), dim3(512), LDS_BYTES, stream, a); }
#endif
}
```

```cpp
#include <hip/hip_runtime.h>
#include <cstdio>
#include <cstdint>

#ifndef MK_N_LAUNCHES
#define MK_N_LAUNCHES 1
#endif

#ifndef PROBE_A_LO
#define PROBE_A_LO (-1)
#define PROBE_A_HI (-1)
#define PROBE_B_LO (-1)
#define PROBE_B_HI (-1)
#endif
#define GAS __attribute__((address_space(1)))
#define LAS __attribute__((address_space(3)))
typedef unsigned short bf16;
typedef short bf16x8 __attribute__((ext_vector_type(8)));
typedef float f32x4 __attribute__((ext_vector_type(4)));
typedef float f32x2 __attribute__((ext_vector_type(2)));
typedef unsigned u32x4 __attribute__((ext_vector_type(4)));
typedef unsigned u32x2 __attribute__((ext_vector_type(2)));
typedef int v4i_t __attribute__((ext_vector_type(4)));
typedef short v4s_t __attribute__((ext_vector_type(4)));
typedef int v8i_t __attribute__((ext_vector_type(8)));

constexpr int D = 1024, NB = 8, SEQ = 4096, M = NB * SEQ;
constexpr int EVEN_IN = 3584, ODD_IN = 2560, D_FF = 2816, D_EXP = 3584, NEXP = 8;
constexpr int RQ_OFF = 0, RK_OFF = 512, RV_OFF = 1024, RGATE_OFF = 1536, SQ_OFF = 2048, SK_OFF = 2560, SV_OFF = 3072;
constexpr int CB_OFF = 0, CC_OFF = 512, CU_OFF = 1024, XR_OFF = 1536, XG_OFF = 2048;
constexpr float EPS = 1e-6f;
constexpr int LIST_CAP = 32768;
constexpr int MAX_TILES = 135;

constexpr size_t MiB = 1u << 20;
constexpr size_t WS_CTL = 0, CTL_ZERO_BYTES = 1 * MiB;
constexpr size_t WS_ROT = 1 * MiB;
constexpr size_t WS_SCR = 3 * MiB;
constexpr size_t WS_WB = 19 * MiB;
constexpr size_t WT_DN1 = WS_WB;
constexpr size_t WT_IN0 = 47 * MiB;
constexpr size_t WT_OUT0 = WT_IN0 + (size_t)EVEN_IN * D * 2;
constexpr size_t WT_GU0 = WT_OUT0 + (size_t)D * D * 2;
constexpr size_t WT_DN0 = WT_GU0 + (size_t)2 * D_FF * D * 2;
constexpr size_t WT_IN1 = WT_DN0 + (size_t)D * D_FF * 2;
constexpr size_t WT_OUT1 = WT_IN1 + (size_t)ODD_IN * D * 2;
constexpr size_t WT_GU1 = WT_OUT1 + (size_t)D * D * 2;
constexpr size_t WB_END = WT_GU1 + (size_t)NEXP * 2 * D_EXP * D;
constexpr size_t WS_ACTA = 136 * MiB;
constexpr size_t WS_ACTB = 200 * MiB;
constexpr size_t WS_END = WS_ACTB + (size_t)MAX_TILES * 256 * D_EXP * 2;
constexpr size_t WS_Y = WT_IN0;
static_assert(WT_DN1 + (size_t)NEXP * D * D_EXP <= WT_IN0 && WB_END <= WS_ACTA && WS_ACTA + (size_t)M * D * 2 <= WS_ACTB, "weights overlap");
static_assert(WS_Y + (size_t)2 * MAX_TILES * 256 * D * 2 <= WS_ACTB, "y overlay");
static_assert((size_t)M * EVEN_IN * 2 <= (size_t)MAX_TILES * 256 * D_EXP * 2, "ACTB size");
constexpr size_t SCR_LTOK = WS_SCR, SCR_REC = WS_SCR + 4 * MiB;
constexpr int CW_BAR = 4096;
constexpr int CW_TB = 16384;
constexpr int CW_CNT = 8192;

constexpr int LDS_MISC = 0;
constexpr int LDS_SCR = 256;
constexpr int LDS_BYTES = 147456;

#define RLX_AGENT __ATOMIC_RELAXED, __HIP_MEMORY_SCOPE_AGENT
#define LDS_WAIT() asm volatile("s_waitcnt lgkmcnt(0)" ::: "memory")
__device__ __forceinline__ unsigned pk2(float lo, float hi) { unsigned r; asm("v_cvt_pk_bf16_f32 %0, %1, %2" : "=v"(r) : "v"(lo), "v"(hi)); return r; }
__device__ __forceinline__ unsigned f2bf(float f) { return pk2(f, 0.0f) & 0xffffu; }
__device__ __forceinline__ float bf2f(unsigned b) { return __builtin_bit_cast(float, (b & 0xffffu) << 16); }
__device__ __forceinline__ float wave_sum(float v) {
#pragma unroll
    for (int o = 1; o < 64; o <<= 1) v += __shfl_xor(v, o);
    return v;
}
__device__ __forceinline__ float sigmoidf_(float x) { return __builtin_amdgcn_rcpf(1.0f + __builtin_amdgcn_exp2f(x * -1.4426950408889634f)); }

#define XB_TMO      128
#define XB_XCNT(j)  (256  + 64 * (j))
#define XB_XSUB(j)  (1280 + 64 * (j))
#define XB_XGEN(j)  (2304 + 64 * (j))
#define XB_TOP      3328
#define XB_TOPGEN   3392
#define XCD_BAR_WORDS 3456
#define XB_SPIN_CAP (1u << 18)

__device__ __forceinline__ unsigned xb_ld(unsigned* p)              { return __hip_atomic_load(p, __ATOMIC_RELAXED, __HIP_MEMORY_SCOPE_AGENT); }
__device__ __forceinline__ unsigned xb_add(unsigned* p, unsigned v) { return __hip_atomic_fetch_add(p, v, __ATOMIC_RELAXED, __HIP_MEMORY_SCOPE_AGENT); }
__device__ __forceinline__ unsigned xb_xcc_id() { return (unsigned)__builtin_amdgcn_s_getreg((3 << 11) | 20) & 0xFu; }
#define XB_SPIN(cond, bar) do { unsigned _sp = 0; while (cond) { __builtin_amdgcn_s_sleep(1); \
    if ((++_sp & 255u) == 0u) { if (xb_ld(&(bar)[XB_TMO])) break; if (_sp > XB_SPIN_CAP) { atomicAdd(&(bar)[XB_TMO], 1u); break; } } } } while (0)

struct XcdBarrier { unsigned* bar; unsigned x; volatile LAS unsigned* st; };

__device__ __forceinline__ XcdBarrier xcd_barrier_post(unsigned* bar, volatile LAS unsigned* st) {
    XcdBarrier b; b.bar = bar; b.x = xb_xcc_id(); b.st = st;
    if (threadIdx.x == 0) (void)xb_add(&bar[XB_XCNT(b.x)], 1u);
    return b;
}
__device__ __forceinline__ void xcd_barrier_complete(unsigned* bar, unsigned x, unsigned& nloc, unsigned& nx) {
    const unsigned G = gridDim.x * gridDim.y * gridDim.z;
    unsigned sum, cnt, mine, sp = 0u;
    for (;;) {
        sum = 0u; cnt = 0u; mine = 0u;
#pragma unroll
        for (unsigned j = 0; j < 16; ++j) { const unsigned c = xb_ld(&bar[XB_XCNT(j)]); sum += c; cnt += (c > 0u) ? 1u : 0u; mine = (j == x) ? c : mine; }
        if (sum == G) break;
        __builtin_amdgcn_s_sleep(1);
        if ((++sp & 255u) == 0u) { if (xb_ld(&bar[XB_TMO])) break; if (sp > XB_SPIN_CAP) { atomicAdd(&bar[XB_TMO], 1u); break; } }
    }
    nloc = mine > 0u ? mine : 1u; nx = cnt > 0u ? cnt : 1u;
}
__device__ __forceinline__ void xcd_barrier(const XcdBarrier& b) {
    asm volatile("s_waitcnt vmcnt(0)" ::: "memory");
    __syncthreads();
    if (threadIdx.x == 0) {
        unsigned* bar = b.bar;
        __builtin_amdgcn_s_waitcnt(0);
        unsigned nloc = b.st[0], nx = b.st[1];
        if (nloc == 0u) { xcd_barrier_complete(bar, b.x, nloc, nx); b.st[0] = nloc; b.st[1] = nx; }
        const unsigned old = xb_add(&bar[XB_XSUB(b.x)], 1u);
        const unsigned gen = old / nloc;
        if (old + 1u == (gen + 1u) * nloc) {
            __builtin_amdgcn_fence(__ATOMIC_RELEASE, "agent");
            asm volatile("s_waitcnt vmcnt(0)" ::: "memory");
            const unsigned og = xb_add(&bar[XB_TOP], 1u);
            const unsigned tg = og / nx;
            if (og + 1u == (tg + 1u) * nx) xb_add(&bar[XB_TOPGEN], 1u);
            else XB_SPIN(xb_ld(&bar[XB_TOPGEN]) == tg, bar);
            __builtin_amdgcn_fence(__ATOMIC_ACQUIRE, "agent");
            xb_add(&bar[XB_XGEN(b.x)], 1u);
            asm volatile("s_waitcnt vmcnt(0)" ::: "memory");
        } else {
            XB_SPIN(xb_ld(&bar[XB_XGEN(b.x)]) == gen, bar);
            __builtin_amdgcn_fence(__ATOMIC_ACQUIRE, "agent");
            asm volatile("s_waitcnt vmcnt(0)" ::: "memory");
        }
    }
    __syncthreads();
}

namespace pg8 {
constexpr int BM = 256, BK = 64, HALF = 128, HTB = HALF * BK * 2, STAGE_BYTES = 8 * HTB, NXCD = 8, WGM = 8;
__device__ __forceinline__ int lds_byte(int r, int c) { const int st = (r >> 4) * 2 + (c >> 5), rr = r & 15, cc = c & 31, ob = rr * 64 + cc * 2; return st * 1024 + (ob ^ (((ob >> 9) & 1) << 5)); }
__device__ __forceinline__ void stage_rc(int b, int& R, int& C) { const int st = b / 1024, sb = b % 1024, swz = sb ^ (((sb >> 9) & 1) << 5); R = (st >> 1) * 16 + swz / 64; C = (st & 1) * 32 + (swz % 64) / 2; }
__device__ __forceinline__ int perm32(int rho) { const int n = rho >> 4, i = rho & 15; return 8 * (i >> 2) + 4 * n + (i & 3); }

struct Unit { int pm, pn, e, lt, cn; };

struct StaticOrder {
    int nM, nN, nwg, G, c;
    __device__ __forceinline__ void init_tiles(int nM_, int nN_, int G_, int c_) { nM = nM_; nN = nN_; nwg = nM * nN; G = G_; c = c_; }
    __device__ __forceinline__ bool next_tile(int i, int& pm, int& pn) const {
        const long L = (long)i * G + c; if (L >= nwg) return false;
        int wgid = (int)L; { const int q = nwg / NXCD, r = nwg % NXCD, xcd = wgid % NXCD, off = wgid / NXCD; wgid = (xcd < r ? xcd * (q + 1) : r * (q + 1) + (xcd - r) * q) + off; }
        const int nig = WGM * nN, gid = wgid / nig, fm = gid * WGM, gsz = (nM - fm) < WGM ? (nM - fm) : WGM;
        pm = fm + ((wgid % nig) % gsz); pn = (wgid % nig) / gsz; return true;
    }
};
struct DenseSched : StaticOrder {
    const char* A; const char* Bt; size_t tstep;
    __device__ __forceinline__ void init(const bf16* A_, const bf16* Bt_, int Mr, int N, int K, int G_, int c_) { A = (const char*)A_; Bt = (const char*)Bt_; tstep = (size_t)BM * K * 2; init_tiles(Mr / BM, N / BM, G_, c_); }
    __device__ __forceinline__ bool next(int i, Unit& u) const { u.e = 0; u.lt = 0; u.cn = 0; return next_tile(i, u.pm, u.pn); }
    __device__ __forceinline__ const char* a_base(const Unit& u) const { return A + (size_t)u.pm * tstep; }
    __device__ __forceinline__ const char* b_base(const Unit& u) const { return Bt + (size_t)u.pn * tstep; }
    __device__ __forceinline__ void a_rows(const Unit&, const int (&)[2], const int (&)[2], unsigned (&)[2][2]) const {}
    __device__ __forceinline__ const int* tok_src(const Unit&) const { return nullptr; }
};
struct MoeSched : StaticOrder {
    const char* A; const char* Bt; size_t a_tstep, b_estep, b_tstep; const int* ltok; int rowb, toff;
    int c0, c1, c2, c3, c4, c5, c6, c7, c8, c9, c10, c11, c12, c13, c14, c15, t1, t2, t3, t4, t5, t6, t7, t8, t9, t10, t11, t12, t13, t14, t15, t16;
    __device__ __forceinline__ static int ldc_(const unsigned* cntw, int e) { int c = (int)__builtin_amdgcn_readfirstlane(__hip_atomic_load(cntw + 64 * e, RLX_AGENT)); return c > LIST_CAP ? LIST_CAP : c; }
    __device__ __forceinline__ void init(const void* A_, const void* Bt_, const int* ltok_, const unsigned* cntw, int which, int nN_, int rowb_, size_t a_tstep_, size_t b_estep_, int G_, int c_) {
        A = (const char*)A_; Bt = (const char*)Bt_; ltok = ltok_; rowb = rowb_; a_tstep = a_tstep_; b_estep = b_estep_; b_tstep = (size_t)BM * rowb_;
        c0 = ldc_(cntw, 0); c1 = ldc_(cntw, 1); c2 = ldc_(cntw, 2); c3 = ldc_(cntw, 3); c4 = ldc_(cntw, 4); c5 = ldc_(cntw, 5); c6 = ldc_(cntw, 6); c7 = ldc_(cntw, 7);
        c8 = ldc_(cntw, 8); c9 = ldc_(cntw, 9); c10 = ldc_(cntw, 10); c11 = ldc_(cntw, 11); c12 = ldc_(cntw, 12); c13 = ldc_(cntw, 13); c14 = ldc_(cntw, 14); c15 = ldc_(cntw, 15);
        t1 = (c0 + 255) >> 8; t2 = t1 + ((c1 + 255) >> 8); t3 = t2 + ((c2 + 255) >> 8); t4 = t3 + ((c3 + 255) >> 8); t5 = t4 + ((c4 + 255) >> 8); t6 = t5 + ((c5 + 255) >> 8); t7 = t6 + ((c6 + 255) >> 8); t8 = t7 + ((c7 + 255) >> 8);
        t9 = t8 + ((c8 + 255) >> 8); t10 = t9 + ((c9 + 255) >> 8); t11 = t10 + ((c10 + 255) >> 8); t12 = t11 + ((c11 + 255) >> 8); t13 = t12 + ((c12 + 255) >> 8); t14 = t13 + ((c13 + 255) >> 8); t15 = t14 + ((c14 + 255) >> 8); t16 = t15 + ((c15 + 255) >> 8);
        toff = which == 2 ? t8 : 0;
        init_tiles(which == 0 ? t16 : (which == 1 ? t8 : t16 - t8), nN_, G_, c_);
    }
    __device__ __forceinline__ bool next(int i, Unit& u) const {
        int pml; if (!next_tile(i, pml, u.pn)) return false;
        const int pm = pml + toff; u.pm = pm;
        const int m1 = pm >= t1, m2 = pm >= t2, m3 = pm >= t3, m4 = pm >= t4, m5 = pm >= t5, m6 = pm >= t6, m7 = pm >= t7, m8 = pm >= t8, m9 = pm >= t9, m10 = pm >= t10, m11 = pm >= t11, m12 = pm >= t12, m13 = pm >= t13, m14 = pm >= t14, m15 = pm >= t15;
        const int e = m1 + m2 + m3 + m4 + m5 + m6 + m7 + m8 + m9 + m10 + m11 + m12 + m13 + m14 + m15;
        const int base = m1 * t1 + m2 * (t2 - t1) + m3 * (t3 - t2) + m4 * (t4 - t3) + m5 * (t5 - t4) + m6 * (t6 - t5) + m7 * (t7 - t6) + m8 * (t8 - t7) + m9 * (t9 - t8) + m10 * (t10 - t9) + m11 * (t11 - t10) + m12 * (t12 - t11) + m13 * (t13 - t12) + m14 * (t14 - t13) + m15 * (t15 - t14);
        const int cn = c0 + m1 * (c1 - c0) + m2 * (c2 - c1) + m3 * (c3 - c2) + m4 * (c4 - c3) + m5 * (c5 - c4) + m6 * (c6 - c5) + m7 * (c7 - c6) + m8 * (c8 - c7) + m9 * (c9 - c8) + m10 * (c10 - c9) + m11 * (c11 - c10) + m12 * (c12 - c11) + m13 * (c13 - c12) + m14 * (c14 - c13) + m15 * (c15 - c14);
        u.e = e; u.lt = pm - base; u.cn = cn; return true;
    }
    __device__ __forceinline__ const char* a_base(const Unit& u) const { return A + (size_t)u.pm * a_tstep; }
    __device__ __forceinline__ const char* b_base(const Unit& u) const { return Bt + (size_t)(u.e & 7) * b_estep + (size_t)u.pn * b_tstep; }
    __device__ __forceinline__ const int* tok_src(const Unit& u) const { return ltok + (size_t)u.e * LIST_CAP + u.lt * 256; }
    __device__ __forceinline__ void a_rows(const Unit& u, const int (&R)[2], const int (&C)[2], unsigned (&off)[2][2]) const {
#pragma unroll
        for (int h = 0; h < 2; ++h)
#pragma unroll
            for (int i = 0; i < 2; ++i) { int rank = u.lt * 256 + h * HALF + R[i]; rank = rank < u.cn ? rank : u.cn - 1;
                const int tok = ltok[(size_t)u.e * LIST_CAP + rank]; off[h][i] = (unsigned)tok * (unsigned)rowb + (unsigned)(C[i] * 2); }
    }
};

__device__ __forceinline__ unsigned cvt_pk_bf16(float lo, float hi) { unsigned r; asm volatile("v_cvt_pk_bf16_f32 %0, %1, %2" : "=v"(r) : "v"(lo), "v"(hi)); return r; }

struct EpiStoreBf16 {
    static constexpr bool PERM = true; static constexpr int NVM = 16;
    bf16* O; int ldc;
    __device__ __forceinline__ void operator()(const f32x4 (&acc)[2][2][4][2], const Unit& u, int wr, int wc, int fr, int fq) const {
        const int row0 = u.pm * BM + wr * 64 + fr, col0 = u.pn * BM + wc * 32 + 8 * fq;
#pragma unroll
        for (int ai = 0; ai < 2; ++ai)
#pragma unroll
            for (int m = 0; m < 4; ++m) { bf16* rowp = O + (size_t)(row0 + ai * HALF + m * 16) * ldc + col0;
#pragma unroll
                for (int bj = 0; bj < 2; ++bj) { const f32x4 v0 = acc[ai][bj][m][0], v1 = acc[ai][bj][m][1];
                    u32x4 w; w.x = cvt_pk_bf16(v0[0], v0[1]); w.y = cvt_pk_bf16(v0[2], v0[3]); w.z = cvt_pk_bf16(v1[0], v1[1]); w.w = cvt_pk_bf16(v1[2], v1[3]);
                    *(u32x4*)(rowp + bj * HALF) = w; } }
    }
};
struct EpiResF32 {
    static constexpr bool PERM = false; static constexpr int NVM = 0;
    const float* base; float* out; int ldc;
    __device__ __forceinline__ void operator()(const f32x4 (&acc)[2][2][4][2], const Unit& u, int wr, int wc, int fr, int fq) const {
        const int row0 = u.pm * BM + wr * 64 + fr, col0 = u.pn * BM + wc * 32 + 4 * fq;
#pragma unroll
        for (int ai = 0; ai < 2; ++ai)
#pragma unroll
            for (int m = 0; m < 4; ++m) { const size_t off = (size_t)(row0 + ai * HALF + m * 16) * ldc + col0;
#pragma unroll
                for (int bj = 0; bj < 2; ++bj)
#pragma unroll
                    for (int n = 0; n < 2; ++n) { const f32x4 bs = *(const f32x4*)(base + off + bj * HALF + n * 16); *(f32x4*)(out + off + bj * HALF + n * 16) = bs + acc[ai][bj][m][n]; } }
    }
};
struct EpiSwiGLU {
    static constexpr bool PERM = true; static constexpr int NVM = 8;
    bf16* H; int ldh;
    __device__ __forceinline__ void operator()(const f32x4 (&acc)[2][2][4][2], const Unit& u, int wr, int wc, int fr, int fq) const {
        const int row0 = u.pm * BM + wr * 64 + fr, col0 = u.pn * HALF + wc * 32 + 8 * fq;
#pragma unroll
        for (int ai = 0; ai < 2; ++ai)
#pragma unroll
            for (int m = 0; m < 4; ++m) { bf16* rowp = H + (size_t)(row0 + ai * HALF + m * 16) * ldh + col0;
                float h[8];
#pragma unroll
                for (int n = 0; n < 2; ++n)
#pragma unroll
                    for (int x = 0; x < 2; ++x) { const f32x2 g = {acc[ai][0][m][n][2 * x], acc[ai][0][m][n][2 * x + 1]}, up = {acc[ai][1][m][n][2 * x], acc[ai][1][m][n][2 * x + 1]};
                        const f32x2 t = g * -1.4426950408889634f; f32x2 e; e.x = __builtin_amdgcn_exp2f(t.x); e.y = __builtin_amdgcn_exp2f(t.y);
                        const f32x2 d = e + 1.0f; f32x2 r; r.x = __builtin_amdgcn_rcpf(d.x); r.y = __builtin_amdgcn_rcpf(d.y);
                        const f32x2 hh = (g * up) * r; h[4 * n + 2 * x] = hh.x; h[4 * n + 2 * x + 1] = hh.y; }
                u32x4 w; w.x = cvt_pk_bf16(h[0], h[1]); w.y = cvt_pk_bf16(h[2], h[3]); w.z = cvt_pk_bf16(h[4], h[5]); w.w = cvt_pk_bf16(h[6], h[7]);
                *(u32x4*)rowp = w; }
    }
};
struct EpiSwiGLU8 {
    static constexpr bool PERM = true; static constexpr int NVM = 8;
    unsigned char* H; int ldh; float iscale, oscale;
    __device__ __forceinline__ void operator()(const f32x4 (&acc)[2][2][4][2], const Unit& u, int wr, int wc, int fr, int fq) const {
        const int row0 = u.pm * BM + wr * 64 + fr, col0 = u.pn * HALF + wc * 32 + 8 * fq;
#pragma unroll
        for (int ai = 0; ai < 2; ++ai)
#pragma unroll
            for (int m = 0; m < 4; ++m) { unsigned char* rowp = H + (size_t)(row0 + ai * HALF + m * 16) * ldh + col0;
                float h[8];
#pragma unroll
                for (int n = 0; n < 2; ++n)
#pragma unroll
                    for (int x = 0; x < 2; ++x) { const f32x2 ga = {acc[ai][0][m][n][2 * x], acc[ai][0][m][n][2 * x + 1]}, ua = {acc[ai][1][m][n][2 * x], acc[ai][1][m][n][2 * x + 1]};
                        const f32x2 t = ga * (-1.4426950408889634f * iscale); f32x2 e; e.x = __builtin_amdgcn_exp2f(t.x); e.y = __builtin_amdgcn_exp2f(t.y);
                        const f32x2 d = e + 1.0f; f32x2 r; r.x = __builtin_amdgcn_rcpf(d.x); r.y = __builtin_amdgcn_rcpf(d.y);
                        const f32x2 hh = ((ga * ua) * (iscale * iscale * oscale)) * r;
                        h[4 * n + 2 * x] = __builtin_amdgcn_fmed3f(hh.x, -448.0f, 448.0f); h[4 * n + 2 * x + 1] = __builtin_amdgcn_fmed3f(hh.y, -448.0f, 448.0f); }
                int w0 = __builtin_amdgcn_cvt_pk_fp8_f32(h[0], h[1], 0, false); w0 = __builtin_amdgcn_cvt_pk_fp8_f32(h[2], h[3], w0, true);
                int w1 = __builtin_amdgcn_cvt_pk_fp8_f32(h[4], h[5], 0, false); w1 = __builtin_amdgcn_cvt_pk_fp8_f32(h[6], h[7], w1, true);
                u32x2 w; w.x = (unsigned)w0; w.y = (unsigned)w1; *(u32x2*)rowp = w; }
    }
};
struct EpiMoeDown {
    static constexpr bool PERM = false; static constexpr int NVM = 0;
    float* out; const int* ltok; const float* lw; float scale;
    __device__ __forceinline__ void operator()(const f32x4 (&acc)[2][2][4][2], const Unit& u, int wr, int wc, int fr, int fq) const {
        const int col0 = u.pn * BM + wc * 32 + 4 * fq;
#pragma unroll
        for (int ai = 0; ai < 2; ++ai)
#pragma unroll
            for (int m = 0; m < 4; ++m) { const int rank = u.lt * 256 + ai * HALF + wr * 64 + m * 16 + fr;
                if (rank < u.cn) { const int tok = ltok[(size_t)u.e * LIST_CAP + rank]; const float w = lw[(size_t)u.e * LIST_CAP + rank] * scale; float* rowp = out + (size_t)tok * D + col0;
#pragma unroll
                    for (int bj = 0; bj < 2; ++bj)
#pragma unroll
                        for (int n = 0; n < 2; ++n) { const f32x4 bs = *(const f32x4*)(rowp + bj * HALF + n * 16); *(f32x4*)(rowp + bj * HALF + n * 16) = bs + acc[ai][bj][m][n] * w; } } }
    }
};

template <class Epi, class Sched, bool GATHER, bool F8 = false>
__device__ __forceinline__ void gemm_phase(LAS unsigned char* lds, const int rowb, const Sched& S, const Epi& E) {
    const int tid = threadIdx.x, wid = __builtin_amdgcn_readfirstlane(tid >> 6), lane = tid & 63, wr = wid >> 2, wc = wid & 3, fr = lane & 15, fq = lane >> 4;
    const int nt = rowb / 128;
    unsigned voffA[2], voffB[2]; int Rr[2], Cc[2];
#pragma unroll
    for (int i = 0; i < 2; ++i) { int R, C; stage_rc(tid * 16 + i * 8192, R, C); const int Rb = Epi::PERM ? ((R & ~31) + perm32(R & 31)) : R;
        voffA[i] = (unsigned)(R * rowb + C * 2); voffB[i] = (unsigned)(Rb * rowb + C * 2); Rr[i] = R; Cc[i] = C; }
    const size_t kstep = (size_t)(BK * 2);
    const size_t hstep = (size_t)HALF * rowb;
    const unsigned ldsw = (unsigned)wid * 1024u;
    const int aoff = lds_byte(wr * 64 + fr, fq * 8), boff = lds_byte(wc * 32 + fr, fq * 8);
#define PG8_SA(b, h) (((b) * 2 + (h)) * HTB)
#define PG8_SB(b, h) ((4 + (b) * 2 + (h)) * HTB)
#define PG8_STAGE(bufoff, gbase, voff) do { _Pragma("unroll") for (int _i = 0; _i < 2; ++_i) \
        __builtin_amdgcn_global_load_lds((const unsigned*)((const char*)(gbase) + (voff)[_i]), (LAS unsigned*)(lds + (bufoff) + ldsw + _i * 8192), 16, 0, 0); } while (0)
#define PG8_STAGE_A(bufoff, kptr, h) do { if constexpr (GATHER) PG8_STAGE(bufoff, kptr, gA[h]); else PG8_STAGE(bufoff, (kptr) + (h) * hstep, voffA); } while (0)
#define PG8_LD8(base) __builtin_shufflevector(*(const LAS v4i_t*)(base), *(const LAS v4i_t*)((base) + 1024), 0, 1, 2, 3, 4, 5, 6, 7)
#define PG8_LDA(dst, b, h) do { _Pragma("unroll") for (int m = 0; m < 4; ++m) { if constexpr (F8) dst##8[m] = PG8_LD8(lds + PG8_SA(b, h) + aoff + m * 2048); else { _Pragma("unroll") for (int k = 0; k < 2; ++k) dst[m][k] = *(const LAS bf16x8*)(lds + PG8_SA(b, h) + aoff + m * 2048 + k * 1024); } } } while (0)
#define PG8_LDB(dst, b, h) do { _Pragma("unroll") for (int n = 0; n < 2; ++n) { if constexpr (F8) dst##8[n] = PG8_LD8(lds + PG8_SB(b, h) + boff + n * 2048); else { _Pragma("unroll") for (int k = 0; k < 2; ++k) dst[n][k] = *(const LAS bf16x8*)(lds + PG8_SB(b, h) + boff + n * 2048 + k * 1024); } } } while (0)
#define PG8_MMA(ai, bj, At, Bt) do { __builtin_amdgcn_s_setprio(1); \
        if constexpr (F8) { _Pragma("unroll") for (int m = 0; m < 4; ++m) _Pragma("unroll") for (int n = 0; n < 2; ++n) \
            asm volatile("v_mfma_f32_16x16x128_f8f6f4 %0, %1, %2, %0" : "+v"(acc[ai][bj][m][n]) : "v"(Bt##8[n]), "v"(At##8[m])); } \
        else { _Pragma("unroll") for (int k = 0; k < 2; ++k) _Pragma("unroll") for (int m = 0; m < 4; ++m) _Pragma("unroll") for (int n = 0; n < 2; ++n) \
            asm volatile("v_mfma_f32_16x16x32_bf16 %0, %1, %2, %0" : "+v"(acc[ai][bj][m][n]) : "v"(Bt[n][k]), "v"(At[m][k])); } \
        __builtin_amdgcn_s_setprio(0); } while (0)
#define PG8_MMA0(ai, bj, At, Bt) do { __builtin_amdgcn_s_setprio(1); \
        if constexpr (F8) { _Pragma("unroll") for (int m = 0; m < 4; ++m) _Pragma("unroll") for (int n = 0; n < 2; ++n) \
            asm volatile("v_mfma_f32_16x16x128_f8f6f4 %0, %1, %2, 0" : "=v"(acc[ai][bj][m][n]) : "v"(Bt##8[n]), "v"(At##8[m])); } \
        else { _Pragma("unroll") for (int m = 0; m < 4; ++m) _Pragma("unroll") for (int n = 0; n < 2; ++n) \
            asm volatile("v_mfma_f32_16x16x32_bf16 %0, %1, %2, 0" : "=v"(acc[ai][bj][m][n]) : "v"(Bt[n][0]), "v"(At[m][0])); \
          _Pragma("unroll") for (int m = 0; m < 4; ++m) _Pragma("unroll") for (int n = 0; n < 2; ++n) \
            asm volatile("v_mfma_f32_16x16x32_bf16 %0, %1, %2, %0" : "+v"(acc[ai][bj][m][n]) : "v"(Bt[n][1]), "v"(At[m][1])); } \
        __builtin_amdgcn_s_setprio(0); } while (0)
#define PG8_WAIT_V(n) asm volatile("s_waitcnt vmcnt(" #n ")" ::: "memory")
#define PG8_WAIT_SEL(flag, n) asm volatile("v_cmp_eq_u32_e32 vcc, 0, %0\n\ts_nop 4\n\ts_cbranch_vccnz .Lw8_%=\n\ts_waitcnt vmcnt(%1)\n\ts_branch .Lwd_%=\n.Lw8_%=:\n\ts_waitcnt vmcnt(8)\n.Lwd_%=:" :: "v"(flag), "n"(n) : "memory", "vcc")
#define PG8_WAIT_FIRST do { if constexpr (Epi::NVM > 0) PG8_WAIT_SEL(after_epi, 8 + Epi::NVM); else PG8_WAIT_V(8); } while (0)
#define PG8_ITER_BODY(MMX, WAITX) \
            const bool last = (t == nt - 2); \
            const char* a1 = cA + (size_t)(t + 1) * kstep; \
            const char* a2 = last ? nA : cA + (size_t)(t + 2) * kstep; const char* b2 = last ? nB : cB + (size_t)(t + 2) * kstep; \
            const char* a3 = a2 + kstep; const char* b3 = b2 + kstep; \
            PG8_LDB(B0, 0, 0); PG8_LDB(B1, 0, 1); PG8_SCHED; PG8_LDA(At, 0, 0); PG8_STAGE_A(PG8_SA(1, 1), a1, 1); \
            if constexpr (GATHER) { if (last && has_next) { asm volatile("" ::: "memory"); \
                _Pragma("unroll") \
                for (int h = 0; h < 2; ++h) \
                _Pragma("unroll") \
                    for (int i = 0; i < 2; ++i) { unsigned tk = *(const LAS unsigned*)(lds + TOKTAB + 4 * (h * HALF + Rr[i])); tk = tk < (unsigned)(M - 1) ? tk : (unsigned)(M - 1); gA[h][i] = tk * (unsigned)rowb + (unsigned)(Cc[i] * 2); } } } \
            WAITX; \
            PG8_WAIT_L(0); PG8_BAR; MMX(0, 0, At, B0); MMX(0, 1, At, B1); PG8_BAR; PG8_SCHED; \
            PG8_LDA(At, 0, 1); PG8_STAGE(PG8_SB(0, 0), b2, voffB); PG8_STAGE(PG8_SB(0, 1), b2 + hstep, voffB); PG8_STAGE_A(PG8_SA(0, 0), a2, 0); \
            WAITX; \
            PG8_WAIT_L(0); PG8_BAR; MMX(1, 0, At, B0); MMX(1, 1, At, B1); PG8_BAR; PG8_SCHED; \
            PG8_LDB(B0, 1, 0); PG8_LDB(B1, 1, 1); PG8_SCHED; PG8_LDA(At, 1, 0); PG8_STAGE_A(PG8_SA(0, 1), a2, 1); \
            PG8_WAIT_V(8); PG8_WAIT_L(0); PG8_BAR; PG8_MMA(0, 0, At, B0); PG8_MMA(0, 1, At, B1); PG8_BAR; PG8_SCHED; \
            PG8_LDA(At, 1, 1); PG8_STAGE(PG8_SB(1, 0), b3, voffB); PG8_STAGE(PG8_SB(1, 1), b3 + hstep, voffB); PG8_STAGE_A(PG8_SA(1, 0), a3, 0); \
            PG8_WAIT_V(8); PG8_WAIT_L(0); PG8_BAR; PG8_MMA(1, 0, At, B0); PG8_MMA(1, 1, At, B1); PG8_BAR; PG8_SCHED;
#define PG8_WAIT_L(n) asm volatile("s_waitcnt lgkmcnt(" #n ")" ::: "memory")
#define PG8_BAR __builtin_amdgcn_s_barrier()
#define PG8_SCHED __builtin_amdgcn_sched_barrier(0)
    Unit cur, nxt; int ui = 0;
    if (!S.next(0, cur)) return;
    f32x4 acc[2][2][4][2];
    bf16x8 At[4][2], B0[2][2], B1[2][2]; v8i_t At8[4], B08[2], B18[2];
    const char* cA = S.a_base(cur); const char* cB = S.b_base(cur);
    unsigned gA[2][2] = {{0u, 0u}, {0u, 0u}};
    if constexpr (GATHER) S.a_rows(cur, Rr, Cc, gA);
    constexpr int TOKTAB = STAGE_BYTES;
    PG8_STAGE(PG8_SB(0, 0), cB, voffB); PG8_STAGE(PG8_SB(0, 1), cB + hstep, voffB); PG8_STAGE_A(PG8_SA(0, 0), cA, 0); PG8_STAGE_A(PG8_SA(0, 1), cA, 1);
    if (wr == 1) PG8_BAR;
    PG8_WAIT_V(2); PG8_BAR;
    PG8_STAGE(PG8_SB(1, 0), cB + kstep, voffB); PG8_STAGE_A(PG8_SA(1, 0), cA + kstep, 0); PG8_STAGE(PG8_SB(1, 1), cB + hstep + kstep, voffB);
    PG8_WAIT_V(6); PG8_BAR;
    for (;;) {
        const bool has_next = S.next(ui + 1, nxt);
        const char* nA = has_next ? S.a_base(nxt) : cA; const char* nB = has_next ? S.b_base(nxt) : cB;
        if constexpr (GATHER) { if (has_next && wid == 0) __builtin_amdgcn_global_load_lds((const unsigned*)(S.tok_src(nxt) + lane * 4), (LAS unsigned*)(lds + TOKTAB), 16, 0, 0); }
        { const int t = 0; const int after_epi = (ui > 0) ? 1 : 0; (void)after_epi;
          PG8_ITER_BODY(PG8_MMA0, PG8_WAIT_FIRST) }
        for (int t = 2; t < nt; t += 2) {
          PG8_ITER_BODY(PG8_MMA, PG8_WAIT_V(8))
        }
        if (wr == 0) PG8_BAR;
        asm volatile("s_nop 15\n\ts_nop 15" ::: "memory");
        E(acc, cur, wr, wc, fr, fq);
        if (!has_next) break;
        cur = nxt; cA = nA; cB = nB; ++ui;
        if (wr == 1) PG8_BAR;
    }
    PG8_WAIT_V(0);
    PG8_BAR;
#undef PG8_SA
#undef PG8_SB
#undef PG8_STAGE
#undef PG8_STAGE_A
#undef PG8_LDA
#undef PG8_LDB
#undef PG8_MMA
#undef PG8_LD8
#undef PG8_WAIT_V
#undef PG8_WAIT_SEL
#undef PG8_WAIT_FIRST
#undef PG8_ITER_BODY
#undef PG8_MMA0
#undef PG8_WAIT_L
#undef PG8_BAR
#undef PG8_SCHED
}
}

template <int Mr, int Nc, int K, bool ACCUM>
__device__ __forceinline__ void mm_lds(const LAS bf16* A, int lda, const LAS bf16* Bt, int ldb, f32x4 (&acc)[(Mr / 16) * (Nc / 16) / 8], int wave, int lane) {
    constexpr int NT = Nc / 16, TPW = (Mr / 16) * NT / 8;
    const int fr = lane & 15, fq = lane >> 4;
#pragma unroll
    for (int q = 0; q < TPW; ++q) {
        const int t = wave + 8 * q, ti = t / NT, tj = t % NT;
        f32x4 c = ACCUM ? acc[q] : (f32x4){0.f, 0.f, 0.f, 0.f};
#pragma unroll
        for (int k0 = 0; k0 < K; k0 += 32) {
            const bf16x8 a = *(const LAS bf16x8*)(A + (16 * ti + fr) * lda + k0 + 8 * fq);
            const bf16x8 b = *(const LAS bf16x8*)(Bt + (16 * tj + fr) * ldb + k0 + 8 * fq);
            c = __builtin_amdgcn_mfma_f32_16x16x32_bf16(a, b, c, 0, 0, 0);
        }
        acc[q] = c;
        if (TPW > 2) asm volatile("" ::: "memory");
    }
}
#define MM_ROW(NT, q, r) (16 * ((wave + 8 * (q)) / (NT)) + 4 * fq + (r))
#define MM_COL(NT, q)    (16 * ((wave + 8 * (q)) % (NT)) + fr)

struct Args { const float* in[25]; float* out; unsigned char* ws; int ph_lo, ph_hi; };
constexpr int NPHASE = 17;

template <bool F8>
__device__ __forceinline__ void p0_tile(const float* W, int K, int N, void* WTv, int mode, float scale, LAS unsigned* T, int item, int lane) {
    const int nblk = N / 64, kb = item / nblk, nb = item % nblk, k0 = 64 * kb, n0 = 64 * nb;
    const int row0 = mode == 0 ? n0 : ((n0 >> 7) << 8) + (n0 & 127) + (mode == 2 ? 128 : 0);
    const int g = lane >> 4, m = lane & 15;
    constexpr int P = F8 ? 17 : 33;
    f32x4 v[16];
#pragma unroll
    for (int L = 0; L < 16; ++L) { const int kk = F8 ? (16 * (L >> 2) + 4 * g + (L & 3)) : (8 * (L >> 1) + 2 * g + (L & 1)); v[L] = *(const f32x4*)(W + (size_t)(k0 + kk) * N + n0 + 4 * m); }
    if constexpr (F8) {
#pragma unroll
        for (int i = 0; i < 4; ++i)
#pragma unroll
            for (int j = 0; j < 4; ++j) { const float q0 = __builtin_amdgcn_fmed3f(v[4 * i][j] * scale, -448.f, 448.f), q1 = __builtin_amdgcn_fmed3f(v[4 * i + 1][j] * scale, -448.f, 448.f), q2 = __builtin_amdgcn_fmed3f(v[4 * i + 2][j] * scale, -448.f, 448.f), q3 = __builtin_amdgcn_fmed3f(v[4 * i + 3][j] * scale, -448.f, 448.f);
                int w = __builtin_amdgcn_cvt_pk_fp8_f32(q0, q1, 0, false); w = __builtin_amdgcn_cvt_pk_fp8_f32(q2, q3, w, true);
                T[(4 * m + j) * P + 4 * i + g] = (unsigned)w; }
    } else {
#pragma unroll
        for (int i = 0; i < 8; ++i)
#pragma unroll
            for (int j = 0; j < 4; ++j) T[(4 * m + j) * P + 4 * i + g] = pk2(v[2 * i][j], v[2 * i + 1][j]);
    }
    LDS_WAIT(); asm volatile("" ::: "memory");
    if constexpr (F8) {
        unsigned char* WT = (unsigned char*)WTv;
#pragma unroll
        for (int p = 0; p < 4; ++p) { const int n = (lane >> 2) + 16 * p, c = lane & 3; const LAS unsigned* t = T + n * P + 4 * c; u32x4 o; o.x = t[0]; o.y = t[1]; o.z = t[2]; o.w = t[3];
            *(u32x4*)(WT + (size_t)(row0 + n) * K + k0 + 16 * c) = o; }
    } else {
        bf16* WT = (bf16*)WTv;
#pragma unroll
        for (int p = 0; p < 8; ++p) { const int n = (lane >> 3) + 8 * p, c = lane & 7; const LAS unsigned* t = T + n * P + 4 * c; u32x4 o; o.x = t[0]; o.y = t[1]; o.z = t[2]; o.w = t[3];
            *(u32x4*)(WT + (size_t)(row0 + n) * K + k0 + 8 * c) = o; }
    }
    LDS_WAIT(); asm volatile("" ::: "memory");
}
struct TileDesc { const float* W; unsigned char* WT; int K, N, mode, f8, item; float scale; };
__device__ __forceinline__ TileDesc p0_desc(const Args& a, unsigned char* ws, int r) {
    constexpr int I_OUT = 16 * 16, I_FF = 16 * 44, I_DN0 = 44 * 16, I_IN1 = 16 * 40, I_EXP = 16 * 56, I_EDN = 56 * 16;
    TileDesc d; d.scale = 64.f; d.f8 = 1;
    if (r < 8 * I_EXP) { const int e = r / I_EXP; d.W = a.in[22] + (size_t)e * D * D_EXP; d.WT = ws + WT_GU1 + (size_t)e * 2 * D_EXP * D; d.K = D; d.N = D_EXP; d.mode = 1; d.item = r % I_EXP; return d; } r -= 8 * I_EXP;
    if (r < 8 * I_EXP) { const int e = r / I_EXP; d.W = a.in[23] + (size_t)e * D * D_EXP; d.WT = ws + WT_GU1 + (size_t)e * 2 * D_EXP * D; d.K = D; d.N = D_EXP; d.mode = 2; d.item = r % I_EXP; return d; } r -= 8 * I_EXP;
    if (r < 8 * I_EDN) { const int e = r / I_EDN; d.W = a.in[24] + (size_t)e * D_EXP * D; d.WT = ws + WT_DN1 + (size_t)e * D * D_EXP; d.K = D_EXP; d.N = D; d.mode = 0; d.item = r % I_EDN; return d; } r -= 8 * I_EDN;
    d.scale = 1.f; d.f8 = 0; d.mode = 0; d.item = r;
    if (r < I_OUT) { d.W = a.in[6]; d.WT = ws + WT_OUT0; d.K = D; d.N = D; return d; } r -= I_OUT;
    if (r < I_FF) { d.W = a.in[7]; d.WT = ws + WT_GU0; d.K = D; d.N = D_FF; d.mode = 1; d.item = r; return d; } r -= I_FF;
    if (r < I_FF) { d.W = a.in[8]; d.WT = ws + WT_GU0; d.K = D; d.N = D_FF; d.mode = 2; d.item = r; return d; } r -= I_FF;
    if (r < I_DN0) { d.W = a.in[9]; d.WT = ws + WT_DN0; d.K = D_FF; d.N = D; d.item = r; return d; } r -= I_DN0;
    if (r < I_IN1) { d.W = a.in[10]; d.WT = ws + WT_IN1; d.K = D; d.N = ODD_IN; d.item = r; return d; } r -= I_IN1;
    d.W = a.in[19]; d.WT = ws + WT_OUT1; d.K = D; d.N = D; d.item = r; return d;
}
constexpr int P0_NREST = 2 * 8 * 16 * 56 + 8 * 56 * 16 + 16 * 16 + 2 * 16 * 44 + 44 * 16 + 16 * 40 + 16 * 16;
__device__ __forceinline__ void p0_load(f32x4 (&v)[16], const TileDesc& d, int lane) {
    const int nblk = d.N / 64, kb = d.item / nblk, nb = d.item % nblk, k0 = 64 * kb, n0 = 64 * nb, g = lane >> 4, m = lane & 15;
#pragma unroll
    for (int L = 0; L < 16; ++L) { const int kk = d.f8 ? (16 * (L >> 2) + 4 * g + (L & 3)) : (8 * (L >> 1) + 2 * g + (L & 1)); v[L] = *(const f32x4*)(d.W + (size_t)(k0 + kk) * d.N + n0 + 4 * m); }
}
__device__ __forceinline__ void p0_finish(const f32x4 (&v)[16], const TileDesc& d, LAS unsigned* T, int lane) {
    const int nblk = d.N / 64, kb = d.item / nblk, nb = d.item % nblk, k0 = 64 * kb, n0 = 64 * nb, g = lane >> 4, m = lane & 15;
    const int row0 = d.mode == 0 ? n0 : ((n0 >> 7) << 8) + (n0 & 127) + (d.mode == 2 ? 128 : 0);
    if (d.f8) {
        constexpr int P = 17;
#pragma unroll
        for (int i = 0; i < 4; ++i)
#pragma unroll
            for (int j = 0; j < 4; ++j) { const float q0 = __builtin_amdgcn_fmed3f(v[4 * i][j] * d.scale, -448.f, 448.f), q1 = __builtin_amdgcn_fmed3f(v[4 * i + 1][j] * d.scale, -448.f, 448.f), q2 = __builtin_amdgcn_fmed3f(v[4 * i + 2][j] * d.scale, -448.f, 448.f), q3 = __builtin_amdgcn_fmed3f(v[4 * i + 3][j] * d.scale, -448.f, 448.f);
                int w = __builtin_amdgcn_cvt_pk_fp8_f32(q0, q1, 0, false); w = __builtin_amdgcn_cvt_pk_fp8_f32(q2, q3, w, true);
                T[(4 * m + j) * P + 4 * i + g] = (unsigned)w; }
        LDS_WAIT(); asm volatile("" ::: "memory");
#pragma unroll
        for (int p = 0; p < 4; ++p) { const int n = (lane >> 2) + 16 * p, c = lane & 3; const LAS unsigned* t = T + n * P + 4 * c; u32x4 o; o.x = t[0]; o.y = t[1]; o.z = t[2]; o.w = t[3];
            *(u32x4*)(d.WT + (size_t)(row0 + n) * d.K + k0 + 16 * c) = o; }
    } else {
        constexpr int P = 33;
#pragma unroll
        for (int i = 0; i < 8; ++i)
#pragma unroll
            for (int j = 0; j < 4; ++j) T[(4 * m + j) * P + 4 * i + g] = pk2(v[2 * i][j], v[2 * i + 1][j]);
        LDS_WAIT(); asm volatile("" ::: "memory");
#pragma unroll
        for (int p = 0; p < 8; ++p) { const int n = (lane >> 3) + 8 * p, c = lane & 7; const LAS unsigned* t = T + n * P + 4 * c; u32x4 o; o.x = t[0]; o.y = t[1]; o.z = t[2]; o.w = t[3];
            *(u32x4*)((bf16*)d.WT + (size_t)(row0 + n) * d.K + k0 + 8 * c) = o; }
    }
    LDS_WAIT(); asm volatile("" ::: "memory");
}
__device__ __forceinline__ void rms_row_bf16(const float* xrow, const float* g, bf16* orow, int lane) {
    const f32x4* xr = (const f32x4*)xrow + lane; const f32x4* gr = (const f32x4*)g + lane;
    f32x4 v[4]; float s = 0.f;
#pragma unroll
    for (int j = 0; j < 4; ++j) { v[j] = xr[64 * j]; s += (v[j].x * v[j].x + v[j].y * v[j].y) + (v[j].z * v[j].z + v[j].w * v[j].w); }
    const float rstd = rsqrtf(wave_sum(s) * (1.f / D) + EPS);
    u32x2* o8 = (u32x2*)orow + lane;
#pragma unroll
    for (int j = 0; j < 4; ++j) { const f32x4 gv = gr[64 * j]; u32x2 w; w.x = pk2(v[j].x * rstd * gv.x, v[j].y * rstd * gv.y); w.y = pk2(v[j].z * rstd * gv.z, v[j].w * rstd * gv.w); o8[64 * j] = w; }
}

__device__ __forceinline__ void rms_res_row_bf16(const float* xin, const bf16* drow, float* xout, const float* g, bf16* orow, int lane) {
    const f32x4* xr = (const f32x4*)xin + lane; const f32x4* gr = (const f32x4*)g + lane; const u32x2* dr = (const u32x2*)drow + lane;
    f32x4 v[4]; u32x2 dv[4]; float s = 0.f;
#pragma unroll
    for (int j = 0; j < 4; ++j) { v[j] = xr[64 * j]; dv[j] = dr[64 * j]; }
#pragma unroll
    for (int j = 0; j < 4; ++j) { v[j].x += bf2f(dv[j].x); v[j].y += bf2f(dv[j].x >> 16); v[j].z += bf2f(dv[j].y); v[j].w += bf2f(dv[j].y >> 16);
        ((f32x4*)xout + lane)[64 * j] = v[j]; s += (v[j].x * v[j].x + v[j].y * v[j].y) + (v[j].z * v[j].z + v[j].w * v[j].w); }
    const float rstd = rsqrtf(wave_sum(s) * (1.f / D) + EPS);
    u32x2* o8 = (u32x2*)orow + lane;
#pragma unroll
    for (int j = 0; j < 4; ++j) { const f32x4 gv = gr[64 * j]; u32x2 w; w.x = pk2(v[j].x * rstd * gv.x, v[j].y * rstd * gv.y); w.y = pk2(v[j].z * rstd * gv.z, v[j].w * rstd * gv.w); o8[64 * j] = w; }
}
__device__ __forceinline__ void rms_res_row2_bf16(const float* xin, const bf16* drow, float* xout, const float* g, bf16* orow, size_t rstride, int lane) {
    const f32x4* gr = (const f32x4*)g + lane;
    f32x4 v[2][4]; u32x2 dv[2][4]; float s[2] = {0.f, 0.f};
#pragma unroll
    for (int r = 0; r < 2; ++r)
#pragma unroll
        for (int j = 0; j < 4; ++j) { v[r][j] = ((const f32x4*)(xin + r * rstride) + lane)[64 * j]; dv[r][j] = ((const u32x2*)(drow + r * rstride) + lane)[64 * j]; }
#pragma unroll
    for (int r = 0; r < 2; ++r)
#pragma unroll
        for (int j = 0; j < 4; ++j) { v[r][j].x += bf2f(dv[r][j].x); v[r][j].y += bf2f(dv[r][j].x >> 16); v[r][j].z += bf2f(dv[r][j].y); v[r][j].w += bf2f(dv[r][j].y >> 16);
            ((f32x4*)(xout + r * rstride) + lane)[64 * j] = v[r][j]; s[r] += (v[r][j].x * v[r][j].x + v[r][j].y * v[r][j].y) + (v[r][j].z * v[r][j].z + v[r][j].w * v[r][j].w); }
#pragma unroll
    for (int r = 0; r < 2; ++r) { const float rstd = rsqrtf(wave_sum(s[r]) * (1.f / D) + EPS);
        u32x2* o8 = (u32x2*)(orow + r * rstride) + lane;
#pragma unroll
        for (int j = 0; j < 4; ++j) { const f32x4 gv = gr[64 * j]; u32x2 w; w.x = pk2(v[r][j].x * rstd * gv.x, v[r][j].y * rstd * gv.y); w.y = pk2(v[r][j].z * rstd * gv.z, v[r][j].w * rstd * gv.w); o8[64 * j] = w; } }
}

struct RetPf { u32x4 q1, q2, k1, k2, v1, v2, g1, g2; f32x4 r0, r1, r2, r3; };
template <bool NEEDQ>
__device__ __forceinline__ void ret_load(RetPf& pf, const bf16* proj, const f32x2* ROT, size_t row0, int tpos0, int h, int tid) {
    const int j = tid >> 3, seg = tid & 7;
    const bf16* prow = proj + (row0 + j) * EVEN_IN + 128 * h;
    pf.k1 = *(const u32x4*)(prow + RK_OFF + 8 * seg); pf.k2 = *(const u32x4*)(prow + RK_OFF + 64 + 8 * seg);
    pf.v1 = *(const u32x4*)(prow + RV_OFF + 16 * seg); pf.v2 = *(const u32x4*)(prow + RV_OFF + 16 * seg + 8);
    if constexpr (NEEDQ) { pf.q1 = *(const u32x4*)(prow + RQ_OFF + 8 * seg); pf.q2 = *(const u32x4*)(prow + RQ_OFF + 64 + 8 * seg);
        pf.g1 = *(const u32x4*)(prow + RGATE_OFF + 16 * seg); pf.g2 = *(const u32x4*)(prow + RGATE_OFF + 16 * seg + 8); }
    const f32x4* rp = (const f32x4*)(ROT + (size_t)(tpos0 + j) * 64 + 8 * seg);
    pf.r0 = rp[0]; pf.r1 = rp[1]; pf.r2 = rp[2]; pf.r3 = rp[3];
}
template <bool NEEDQ>
__device__ __forceinline__ void ret_write(const RetPf& pf, float l2g, LAS bf16* rQ, LAS bf16* rK, LAS bf16* rKdT, LAS bf16* rVT, LAS bf16* rG, int tid) {
    constexpr int LQ = 136, LT = 72;
    const int j = tid >> 3, seg = tid & 7;
    const float cs[16] = {pf.r0.x, pf.r0.y, pf.r0.z, pf.r0.w, pf.r1.x, pf.r1.y, pf.r1.z, pf.r1.w, pf.r2.x, pf.r2.y, pf.r2.z, pf.r2.w, pf.r3.x, pf.r3.y, pf.r3.z, pf.r3.w};
    const unsigned k1w[4] = {pf.k1.x, pf.k1.y, pf.k1.z, pf.k1.w}, k2w[4] = {pf.k2.x, pf.k2.y, pf.k2.z, pf.k2.w}, v1w[4] = {pf.v1.x, pf.v1.y, pf.v1.z, pf.v1.w}, v2w[4] = {pf.v2.x, pf.v2.y, pf.v2.z, pf.v2.w};
    const float dec = exp2f((float)(63 - j) * l2g);
    unsigned qa[4], qb[4], ka[4], kb[4];
#pragma unroll
    for (int w = 0; w < 4; ++w) {
        float kr1[2], kr2[2], qr1[2] = {0.f, 0.f}, qr2[2] = {0.f, 0.f};
#pragma unroll
        for (int x = 0; x < 2; ++x) { const int c = 2 * w + x; const float co = cs[2 * c], si = cs[2 * c + 1];
            const float a = bf2f(k1w[w] >> (16 * x)) * 0.08838834764831845f, b = bf2f(k2w[w] >> (16 * x)) * 0.08838834764831845f;
            kr1[x] = a * co - b * si; kr2[x] = a * si + b * co;
            rKdT[(8 * seg + c) * LT + j] = (bf16)f2bf(kr1[x] * dec); rKdT[(64 + 8 * seg + c) * LT + j] = (bf16)f2bf(kr2[x] * dec);
            if constexpr (NEEDQ) { const unsigned q1w = w == 0 ? pf.q1.x : (w == 1 ? pf.q1.y : (w == 2 ? pf.q1.z : pf.q1.w)), q2w = w == 0 ? pf.q2.x : (w == 1 ? pf.q2.y : (w == 2 ? pf.q2.z : pf.q2.w));
                const float qa_ = bf2f(q1w >> (16 * x)), qb_ = bf2f(q2w >> (16 * x)); qr1[x] = qa_ * co - qb_ * si; qr2[x] = qa_ * si + qb_ * co; }
            rVT[(16 * seg + c) * LT + j] = (bf16)((v1w[w] >> (16 * x)) & 0xffffu); rVT[(16 * seg + 8 + c) * LT + j] = (bf16)((v2w[w] >> (16 * x)) & 0xffffu); }
        if constexpr (NEEDQ) { ka[w] = pk2(kr1[0], kr1[1]); kb[w] = pk2(kr2[0], kr2[1]); qa[w] = pk2(qr1[0], qr1[1]); qb[w] = pk2(qr2[0], qr2[1]); }
    }
    if constexpr (NEEDQ) {
        u32x4 t; t.x = qa[0]; t.y = qa[1]; t.z = qa[2]; t.w = qa[3]; *(LAS u32x4*)(rQ + j * LQ + 8 * seg) = t;
        t.x = qb[0]; t.y = qb[1]; t.z = qb[2]; t.w = qb[3]; *(LAS u32x4*)(rQ + j * LQ + 64 + 8 * seg) = t;
        t.x = ka[0]; t.y = ka[1]; t.z = ka[2]; t.w = ka[3]; *(LAS u32x4*)(rK + j * LQ + 8 * seg) = t;
        t.x = kb[0]; t.y = kb[1]; t.z = kb[2]; t.w = kb[3]; *(LAS u32x4*)(rK + j * LQ + 64 + 8 * seg) = t;
        *(LAS u32x4*)(rG + j * LQ + 16 * seg) = pf.g1; *(LAS u32x4*)(rG + j * LQ + 16 * seg + 8) = pf.g2;
    }
}

__global__ void __launch_bounds__(512, 2) fwd_kernel(Args args) {
    extern __shared__ __attribute__((aligned(16))) unsigned char lds_raw[];
    LAS unsigned char* lds = (LAS unsigned char*)lds_raw;
    volatile LAS unsigned* MISC = (volatile LAS unsigned*)(lds + LDS_MISC);
    LAS unsigned char* scrb = lds + LDS_SCR;
    const int tid = threadIdx.x, lane = tid & 63, wave = __builtin_amdgcn_readfirstlane(tid >> 6);
    const int G = gridDim.x, bid = blockIdx.x;
    const int fr = lane & 15, fq = lane >> 4;
    unsigned char* ws = args.ws;
    unsigned* ctl = (unsigned*)(ws + WS_CTL);
    float* out = args.out;
    const int lo = args.ph_lo, hi = args.ph_hi;

    if (tid < 64) MISC[tid] = 0u;
    __syncthreads();
    XcdBarrier bar; bar.bar = ctl + CW_BAR; bar.x = 0; bar.st = MISC;
    if (hi - lo > 1) bar = xcd_barrier_post(ctl + CW_BAR, MISC);
#ifndef PHASE_MASK
#define PHASE_MASK 0x1ffff
#endif
#define IN(k) ((((PHASE_MASK) >> (k)) & 1) && lo <= (k) && (k) < hi)
#define SEAM(k) do { if (IN(k) && IN((k) + 1)) xcd_barrier(bar); PSTAMP((k) + 1); } while (0)
#define PSTAMP(k) do { if (PROBE_A_LO >= 0 && bid == 0 && tid == 0) { const unsigned _t = (unsigned)wall_clock64(); if ((k) == PROBE_A_LO) MISC[8] = _t; if ((k) == PROBE_A_HI + 1) MISC[9] = _t; if ((k) == PROBE_B_LO) MISC[10] = _t; if ((k) == PROBE_B_HI + 1) MISC[11] = _t; } } while (0)
    PSTAMP(0);

    bf16* const ACTA = (bf16*)(ws + WS_ACTA);
    bf16* const ACTB = (bf16*)(ws + WS_ACTB);
    const f32x2* const ROT = (const f32x2*)(ws + WS_ROT);
    const int gw = bid * 8 + wave, NGW = G * 8;

    if (IN(0)) {
        LAS unsigned* scr = (LAS unsigned*)(scrb + wave * 16384);
        constexpr int I_IN0 = 16 * 56;
        for (int it = gw; it < I_IN0; it += NGW) p0_tile<false>(args.in[4], D, EVEN_IN, (bf16*)(ws + WT_IN0), 0, 1.f, scr, it, lane);
        for (int idx = bid * 512 + tid; idx < SEQ * 64; idx += G * 512) {
            const int t = idx >> 6, i = idx & 63;
            const float inv_freq = exp2f(-(float)i * (13.287712379549449f / 64.0f));
            double rev = (double)t * (double)inv_freq * 0.15915494309189535; rev -= floor(rev);
            const float rv = (float)rev;
            f32x2 cs; cs.x = __builtin_amdgcn_cosf(rv); cs.y = __builtin_amdgcn_sinf(rv);
            ((f32x2*)(ws + WS_ROT))[idx] = cs;
        }
        for (int m = gw; m < M; m += NGW) rms_row_bf16(args.in[0] + (size_t)m * D, args.in[1], ACTA + (size_t)m * D, lane);
    }
    SEAM(0);

    if (IN(1)) {
        pg8::DenseSched S; S.init(ACTA, (const bf16*)(ws + WT_IN0), M, EVEN_IN, D, G, bid);
        pg8::EpiStoreBf16 E{ACTB, EVEN_IN};
        pg8::gemm_phase<pg8::EpiStoreBf16, pg8::DenseSched, false>(scrb, 2 * D, S, E);
    }
    SEAM(1);

    constexpr int LQ = 136, LT = 72;
    LAS bf16* const rQ = (LAS bf16*)(scrb);
    LAS bf16* const rK = (LAS bf16*)(scrb + 17408);
    LAS bf16* const rKdT = (LAS bf16*)(scrb + 34816);
    LAS bf16* const rVT = (LAS bf16*)(scrb + 53248);
    LAS bf16* const rS = (LAS bf16*)(scrb + 71680);
    LAS bf16* const rStT = (LAS bf16*)(scrb + 80896);
    LAS float* const rStat = (LAS float*)(scrb + 115712);
    LAS bf16* const rG = (LAS bf16*)(scrb + 120320);
    float* const RGS = (float*)(ws + WS_SCR);

    if (IN(2)) {
        for (int item = bid; item < 256; item += G) {
            const int b = item >> 5, h = (item >> 3) & 3, g = item & 7;
            const float l2g = log2f(1.0f - exp2f(-5.0f - (float)h));
            const float g64 = exp2f(64.0f * l2g);
            f32x4 st[8];
#pragma unroll
            for (int q = 0; q < 8; ++q) st[q] = (f32x4){0.f, 0.f, 0.f, 0.f};
            RetPf pf;
            ret_load<false>(pf, ACTB, ROT, (size_t)b * SEQ + (g * 8) * 64, (g * 8) * 64, h, tid);
            f32x4 cva[16]; TileDesc cda = p0_desc(args, ws, 0); bool ha = false;
            LAS unsigned* const Ta = (LAS unsigned*)(scrb + 71680 + wave * 8448);
            for (int n = 0; n < 8; ++n) {
                ret_write<false>(pf, l2g, rQ, rK, rKdT, rVT, rG, tid);
                if (n < 7) { const int tposn = (g * 8 + n + 1) * 64; ret_load<false>(pf, ACTB, ROT, (size_t)b * SEQ + tposn, tposn, h, tid); }
                if (item < G) {
                    if (ha) p0_finish(cva, cda, Ta, lane);
                    if (n & 1) { const int rb = gw + (8 + (n >> 1)) * NGW; if (rb < P0_NREST) { cda = p0_desc(args, ws, rb); p0_load(cva, cda, lane); p0_finish(cva, cda, Ta, lane); } }
                    const int ra = gw + n * NGW; ha = ra < P0_NREST;
                    if (ha) { cda = p0_desc(args, ws, ra); p0_load(cva, cda, lane); } }
                __syncthreads();
#pragma unroll
                for (int q = 0; q < 8; ++q) st[q] = st[q] * g64;
                mm_lds<128, 128, 64, true>(rKdT, LT, rVT, LT, st, wave, lane);
                __syncthreads();
            }
            if (item < G) { if (ha) p0_finish(cva, cda, Ta, lane);
                for (int r = gw + 12 * NGW; r < P0_NREST; r += NGW) { cda = p0_desc(args, ws, r); p0_load(cva, cda, lane); p0_finish(cva, cda, Ta, lane); } }
            float* gp = RGS + (size_t)item * 16384 + tid;
#pragma unroll
            for (int q = 0; q < 8; ++q)
#pragma unroll
                for (int r = 0; r < 4; ++r) gp[(q * 4 + r) * 512] = st[q][r];
        }
        {
            __syncthreads();
            constexpr int PV = 80;
            LAS bf16* const sV = (LAS bf16*)(scrb + wave * 10240);
            const int vkey = lane >> 3, vpc = lane & 7;
            for (int wi = bid * 8 + wave; wi < NB * 8 * 256; wi += G * 8) {
                const int qt = 255 - (wi & 255), h = (wi >> 8) & 7, b = wi >> 11;
                const size_t brow = (size_t)b * SEQ;
                const int tq = 16 * qt + fr;
                bf16x8 qf[2];
#pragma unroll
                for (int ks = 0; ks < 2; ++ks) qf[ks] = *(const bf16x8*)(ACTB + (brow + tq) * EVEN_IN + SQ_OFF + 64 * h + 32 * ks + 8 * fq);
                f32x4 ot[4];
#pragma unroll
                for (int dt = 0; dt < 4; ++dt) ot[dt] = (f32x4){0.f, 0.f, 0.f, 0.f};
                float C = 1.0f;
                int kt = qt >> 2;
                bf16x8 kf[4][2]; u32x4 vr[8];
#pragma unroll
                for (int tj = 0; tj < 4; ++tj)
#pragma unroll
                    for (int ks = 0; ks < 2; ++ks) kf[tj][ks] = *(const bf16x8*)(ACTB + (brow + 64 * kt + 16 * tj + fr) * EVEN_IN + SK_OFF + 64 * h + 32 * ks + 8 * fq);
#pragma unroll
                for (int i = 0; i < 8; ++i) vr[i] = *(const u32x4*)(ACTB + (brow + 64 * kt + 8 * i + vkey) * EVEN_IN + SV_OFF + 64 * h + 8 * vpc);
                for (;;) {
#pragma unroll
                    for (int i = 0; i < 8; ++i) { LAS u32x2* d = (LAS u32x2*)(sV + (8 * i + vkey) * PV + 8 * vpc); u32x2 lo, hi; lo.x = vr[i].x; lo.y = vr[i].y; hi.x = vr[i].z; hi.y = vr[i].w; d[0] = lo; d[1] = hi; }
                    f32x4 zt[4];
#pragma unroll
                    for (int tj = 0; tj < 4; ++tj) { zt[tj] = __builtin_amdgcn_mfma_f32_16x16x32_bf16(kf[tj][0], qf[0], (f32x4){0.f, 0.f, 0.f, 0.f}, 0, 0, 0); zt[tj] = __builtin_amdgcn_mfma_f32_16x16x32_bf16(kf[tj][1], qf[1], zt[tj], 0, 0, 0); }
                    const int ktn = kt - 1;
                    if (ktn >= 0) {
#pragma unroll
                        for (int tj = 0; tj < 4; ++tj)
#pragma unroll
                            for (int ks = 0; ks < 2; ++ks) kf[tj][ks] = *(const bf16x8*)(ACTB + (brow + 64 * ktn + 16 * tj + fr) * EVEN_IN + SK_OFF + 64 * h + 32 * ks + 8 * fq);
#pragma unroll
                        for (int i = 0; i < 8; ++i) vr[i] = *(const u32x4*)(ACTB + (brow + 64 * ktn + 8 * i + vkey) * EVEN_IN + SV_OFF + 64 * h + 8 * vpc);
                    }
                    float a[4][4], pseg[4];
#pragma unroll
                    for (int tj = 0; tj < 4; ++tj) { float suf = 1.0f;
#pragma unroll
                        for (int r = 3; r >= 0; --r) { const int sk = 64 * kt + 16 * tj + 4 * fq + r; const bool valid = sk < tq;
                            const float pp = __builtin_amdgcn_rcpf(1.0f + __builtin_amdgcn_exp2f(zt[tj][r] * (0.125f * 1.4426950408889634f)));
                            const float p = valid ? pp : 1.0f, be = valid ? 1.0f - pp : 0.0f; a[tj][r] = be * suf; suf *= p; }
                        pseg[tj] = suf; }
                    float run = C;
#pragma unroll
                    for (int tj = 3; tj >= 0; --tj) { const float y = __shfl_xor(pseg[tj], 16); const float pair = pseg[tj] * y; const float zz = __shfl_xor(pair, 32);
                        const float S = ((fq & 1) ? 1.0f : y) * ((fq & 2) ? 1.0f : zz); const float sc = S * run;
#pragma unroll
                        for (int r = 0; r < 4; ++r) a[tj][r] *= sc;
                        run *= pair * zz; }
                    C = run;
                    bf16x8 af[2];
#pragma unroll
                    for (int ks = 0; ks < 2; ++ks) { u32x4 w; w.x = pk2(a[2 * ks][0], a[2 * ks][1]); w.y = pk2(a[2 * ks][2], a[2 * ks][3]); w.z = pk2(a[2 * ks + 1][0], a[2 * ks + 1][1]); w.w = pk2(a[2 * ks + 1][2], a[2 * ks + 1][3]); af[ks] = __builtin_bit_cast(bf16x8, w); }
                    LDS_WAIT(); asm volatile("" ::: "memory");
#pragma unroll
                    for (int dt = 0; dt < 4; ++dt)
#pragma unroll
                        for (int ks = 0; ks < 2; ++ks) {
                            const LAS v4s_t* tp = (const LAS v4s_t*)(sV + (32 * ks + 4 * fq + (fr >> 2)) * PV + 16 * dt + 4 * (fr & 3));
                            const v4s_t lo = __builtin_amdgcn_ds_read_tr16_b64_v4i16((LAS v4s_t*)tp), hi = __builtin_amdgcn_ds_read_tr16_b64_v4i16((LAS v4s_t*)(tp + 4 * PV));
                            const bf16x8 vf = __builtin_shufflevector(lo, hi, 0, 1, 2, 3, 4, 5, 6, 7);
                            ot[dt] = __builtin_amdgcn_mfma_f32_16x16x32_bf16(vf, af[ks], ot[dt], 0, 0, 0); }
                    LDS_WAIT(); asm volatile("" ::: "memory");
                    if (ktn < 0 || __all(C < 1e-30f)) break;
                    kt = ktn;
                }
#pragma unroll
                for (int dt = 0; dt < 4; ++dt) { u32x2 w; w.x = pk2(ot[dt][0], ot[dt][1]); w.y = pk2(ot[dt][2], ot[dt][3]);
                    *(u32x2*)(ACTA + (brow + tq) * D + 512 + 64 * h + 16 * dt + 4 * fq) = w; }
            }

        }
    }
    SEAM(2);

    if (IN(3)) {
        const int fr0 = fr, fq0 = fq;
        for (int item = bid; item < 256; item += G) {
            const int b = item >> 5, h = (item >> 3) & 3, g = item & 7;
            const float l2g = log2f(1.0f - exp2f(-5.0f - (float)h));
            const float g64 = exp2f(64.0f * l2g), g512 = exp2f(512.0f * l2g);
            f32x4 st[8];
#pragma unroll
            for (int q = 0; q < 8; ++q) st[q] = (f32x4){0.f, 0.f, 0.f, 0.f};
            for (int gp_ = 0; gp_ < g; ++gp_) {
                const float* gp = RGS + (size_t)(item - g + gp_) * 16384 + tid;
#pragma unroll
                for (int q = 0; q < 8; ++q)
#pragma unroll
                    for (int r = 0; r < 4; ++r) st[q][r] = st[q][r] * g512 + gp[(q * 4 + r) * 512];
            }
            RetPf pf;
            ret_load<true>(pf, ACTB, ROT, (size_t)b * SEQ + (g * 8) * 64, (g * 8) * 64, h, tid);
            for (int n = 0; n < 8; ++n) {
                int tid_l = tid, fr_l = fr0, fq_l = fq0;
                asm volatile("" : "+v"(tid_l), "+v"(fr_l), "+v"(fq_l));
                { const int fr = fr_l, fq = fq_l, lane = (fq_l << 4) | fr_l;
                const int tpos0 = (g * 8 + n) * 64; const size_t row0 = (size_t)b * SEQ + tpos0;
                __syncthreads();
                ret_write<true>(pf, l2g, rQ, rK, rKdT, rVT, rG, tid_l);
                if (n < 7) { const int tposn = tpos0 + 64; ret_load<true>(pf, ACTB, ROT, (size_t)b * SEQ + tposn, tposn, h, tid_l); }
#pragma unroll
                for (int q = 0; q < 8; ++q) { u32x2 w; w.x = pk2(st[q][0], st[q][1]); w.y = pk2(st[q][2], st[q][3]);
                    *(LAS u32x2*)(rStT + MM_COL(8, q) * LQ + 16 * q + 4 * fq) = w; }
                __syncthreads();
                { f32x4 sT[2]; mm_lds<64, 64, 128, false>(rK, LQ, rQ, LQ, sT, wave, lane);
                  const int i = MM_COL(4, 0);
#pragma unroll
                  for (int q = 0; q < 2; ++q) { const int j0 = MM_ROW(4, q, 0); float e4[4];
#pragma unroll
                      for (int r = 0; r < 4; ++r) { const int dd = i > j0 + r ? i - j0 - r : j0 + r - i; e4[r] = sT[q][r] * exp2f((float)dd * l2g); }
                      u32x2 w; w.x = pk2(e4[0], e4[1]); w.y = pk2(e4[2], e4[3]); *(LAS u32x2*)(rS + i * LT + j0) = w; } }
                __syncthreads();
                f32x4 oi[4];
                mm_lds<128, 64, 128, false>(rStT, LQ, rQ, LQ, oi, wave, lane);
                const int io = MM_COL(4, 0);
                { const float gi1 = exp2f((float)(io + 1) * l2g);
#pragma unroll
                  for (int q = 0; q < 4; ++q) oi[q] = oi[q] * gi1; }
                mm_lds<128, 64, 64, true>(rVT, LT, rS, LT, oi, wave, lane);
                { float s1 = 0.f, s2 = 0.f;
#pragma unroll
                  for (int q = 0; q < 4; ++q)
#pragma unroll
                      for (int r = 0; r < 4; ++r) { s1 += oi[q][r]; s2 += oi[q][r] * oi[q][r]; }
                  s1 += __shfl_xor(s1, 16); s2 += __shfl_xor(s2, 16); s1 += __shfl_xor(s1, 32); s2 += __shfl_xor(s2, 32);
                  if (fq == 0) { rStat[(io * 2 + (wave >> 2)) * 2] = s1; rStat[(io * 2 + (wave >> 2)) * 2 + 1] = s2; } }
                __syncthreads();
                { const float s1 = rStat[(io * 2) * 2] + rStat[(io * 2 + 1) * 2], s2 = rStat[(io * 2) * 2 + 1] + rStat[(io * 2 + 1) * 2 + 1];
                  const float mu = s1 * (1.0f / 128.0f); float var = s2 * (1.0f / 128.0f) - mu * mu; var = var < 0.f ? 0.f : var; const float rstd = rsqrtf(var + EPS);
#pragma unroll
                  for (int q = 0; q < 4; ++q) { const int e0 = MM_ROW(4, q, 0);
                      const u32x2 gt = *(const LAS u32x2*)(rG + io * LQ + e0); const f32x4 gw4 = *(const f32x4*)(args.in[5] + 128 * h + e0);
                      const float g0 = bf2f(gt.x), g1 = bf2f(gt.x >> 16), g2 = bf2f(gt.y), g3 = bf2f(gt.y >> 16);
                      u32x2 w; w.x = pk2((oi[q][0] - mu) * rstd * gw4.x * g0 * sigmoidf_(g0), (oi[q][1] - mu) * rstd * gw4.y * g1 * sigmoidf_(g1));
                      w.y = pk2((oi[q][2] - mu) * rstd * gw4.z * g2 * sigmoidf_(g2), (oi[q][3] - mu) * rstd * gw4.w * g3 * sigmoidf_(g3));
                      *(LAS u32x2*)(rQ + io * LQ + e0) = w; } }
#pragma unroll
                for (int q = 0; q < 8; ++q) st[q] = st[q] * g64;
                mm_lds<128, 128, 64, true>(rKdT, LT, rVT, LT, st, wave, lane);
                __syncthreads();
                { const int j = tid_l >> 3, seg = tid_l & 7; bf16* yp = ACTA + (row0 + j) * D + 128 * h + 16 * seg;
                  *(u32x4*)yp = *(const LAS u32x4*)(rQ + j * LQ + 16 * seg); *(u32x4*)(yp + 8) = *(const LAS u32x4*)(rQ + j * LQ + 16 * seg + 8); }
                }
            }
        }
    }
    SEAM(3);

    if (IN(4)) {
        pg8::DenseSched S; S.init(ACTA, (const bf16*)(ws + WT_OUT0), M, D, D, G, bid);
        pg8::EpiStoreBf16 E{ACTB, D};
        pg8::gemm_phase<pg8::EpiStoreBf16, pg8::DenseSched, false>(scrb, 2 * D, S, E);
    }
    SEAM(4);
    if (IN(5)) { for (int m = gw; m < M; m += 2 * NGW) { if (m + NGW < M) rms_res_row2_bf16(args.in[0] + (size_t)m * D, ACTB + (size_t)m * D, out + (size_t)m * D, args.in[2], ACTA + (size_t)m * D, (size_t)NGW * D, lane);
            else rms_res_row_bf16(args.in[0] + (size_t)m * D, ACTB + (size_t)m * D, out + (size_t)m * D, args.in[2], ACTA + (size_t)m * D, lane); } }
    SEAM(5);
    if (IN(6)) {
        pg8::DenseSched S; S.init(ACTA, (const bf16*)(ws + WT_GU0), M, 2 * D_FF, D, G, bid);
        pg8::EpiSwiGLU E{ACTB, D_FF};
        pg8::gemm_phase<pg8::EpiSwiGLU, pg8::DenseSched, false>(scrb, 2 * D, S, E);
    }
    SEAM(6);
    if (IN(7)) {
        pg8::DenseSched S; S.init(ACTB, (const bf16*)(ws + WT_DN0), M, D, D_FF, G, bid);
        pg8::EpiStoreBf16 E{ACTA, D};
        pg8::gemm_phase<pg8::EpiStoreBf16, pg8::DenseSched, false>(scrb, 2 * D_FF, S, E);
    }
    SEAM(7);
    if (IN(8)) { for (int m = gw; m < M; m += 2 * NGW) { if (m + NGW < M) rms_res_row2_bf16(out + (size_t)m * D, ACTA + (size_t)m * D, out + (size_t)m * D, args.in[1] + D, ACTA + (size_t)m * D, (size_t)NGW * D, lane);
            else rms_res_row_bf16(out + (size_t)m * D, ACTA + (size_t)m * D, out + (size_t)m * D, args.in[1] + D, ACTA + (size_t)m * D, lane); } }
    SEAM(8);
    if (IN(9)) {
        pg8::DenseSched S; S.init(ACTA, (const bf16*)(ws + WT_IN1), M, ODD_IN, D, G, bid);
        pg8::EpiStoreBf16 E{ACTB, ODD_IN};
        pg8::gemm_phase<pg8::EpiStoreBf16, pg8::DenseSched, false>(scrb, 2 * D, S, E);
    }
    SEAM(9);

    float* const LSUM = (float*)(ws + WS_SCR);
#pragma unroll
    for (int pass = 0; pass < 2; ++pass) {
        if (IN(10 + pass)) {
            LAS bf16* const XT = (LAS bf16*)(scrb + wave * 17984);
            LAS bf16* const XR = XT + 3 * LT;
            LAS float* const AB = (LAS float*)(scrb + wave * 17984 + 9792);
            const int head = wave, ch = 64 * head + lane;
            bf16x8 Bwa[4][2], Bwx[4][2];
#pragma unroll
            for (int tj = 0; tj < 4; ++tj)
#pragma unroll
                for (int ks = 0; ks < 2; ++ks) { bf16x8 va, vx;
#pragma unroll
                    for (int e = 0; e < 8; ++e) { const int i = 32 * ks + 8 * fq + e, j = 16 * tj + fr; va[e] = (short)f2bf(args.in[14][(size_t)(head * 64 + i) * 64 + j]); vx[e] = (short)f2bf(args.in[16][(size_t)(head * 64 + i) * 64 + j]); }
                    Bwa[tj][ks] = va; Bwx[tj][ks] = vx; }
            float cba[4], cbx[4], csp[4];
#pragma unroll
            for (int tj = 0; tj < 4; ++tj) { const int c = 64 * head + 16 * tj + fr; cba[tj] = args.in[15][c]; cbx[tj] = args.in[17][c]; csp[tj] = -8.0f * 1.4426950408889634f * log1pf(__expf(-args.in[18][c])); }
            const float cw0 = args.in[12][ch], cw1 = args.in[12][512 + ch], cw2 = args.in[12][1024 + ch], cw3 = args.in[12][1536 + ch], cbias = args.in[13][ch];
            for (int it = bid; it < NB * 64; it += G) {
                const int b = it >> 6, c = it & 63; const size_t row0 = (size_t)b * SEQ + 64 * c;
                { const int r8 = lane >> 3, pc = lane & 7;
                  u32x4 raw[9];
#pragma unroll
                  for (int i = 0; i < 9; ++i) raw[i] = *(const u32x4*)(ACTB + (row0 + 8 * i + r8 - 3) * ODD_IN + XR_OFF + 64 * head + 8 * pc);
#pragma unroll
                  for (int i = 0; i < 9; ++i) if (8 * i + r8 < 68) *(LAS u32x4*)(XT + (8 * i + r8) * LT + 8 * pc) = raw[i];
                  LDS_WAIT(); asm volatile("" ::: "memory");
                  float x0 = 0.f, x1 = 0.f, x2 = 0.f;
                  if (c > 0) { x0 = bf2f(XT[0 * LT + lane]); x1 = bf2f(XT[1 * LT + lane]); x2 = bf2f(XT[2 * LT + lane]); }
#pragma unroll 16
                  for (int t = 0; t < 64; ++t) { const float x3 = bf2f(XT[(t + 3) * LT + lane]);
                      XT[(t + 3) * LT + lane] = (bf16)f2bf(cw0 * x0 + cw1 * x1 + cw2 * x2 + cw3 * x3 + cbias); x0 = x1; x1 = x2; x2 = x3; } }
                float hst = 0.f, cum = 1.f;
                if (pass == 1) {
                    for (int c0 = 0; c0 < c; c0 += 8) {
                        f32x2 sv[8];
#pragma unroll
                        for (int k = 0; k < 8; ++k) { const int cc = (c0 + k < c) ? c0 + k : c0; sv[k] = ((const f32x2*)LSUM)[(size_t)(b * 64 + cc) * 512 + ch]; }
#pragma unroll
                        for (int k = 0; k < 8; ++k) if (c0 + k < c) hst = sv[k].x * hst + sv[k].y;
                    }
                }
                LDS_WAIT(); asm volatile("" ::: "memory");
                for (int sb = 0; sb < 4; ++sb) {
                    bf16 gv[16];
                    if (pass == 1) {
#pragma unroll
                        for (int tl = 0; tl < 16; ++tl) gv[tl] = ACTB[(row0 + 16 * sb + tl) * ODD_IN + XG_OFF + ch]; }
                    f32x4 aR[4], aX[4];
#pragma unroll
                    for (int tj = 0; tj < 4; ++tj) { aR[tj] = (f32x4){0.f, 0.f, 0.f, 0.f}; aX[tj] = aR[tj]; }
#pragma unroll
                    for (int ks = 0; ks < 2; ++ks) { const bf16x8 af = *(const LAS bf16x8*)(XR + (16 * sb + fr) * LT + 32 * ks + 8 * fq);
#pragma unroll
                        for (int tj = 0; tj < 4; ++tj) { aR[tj] = __builtin_amdgcn_mfma_f32_16x16x32_bf16(af, Bwa[tj][ks], aR[tj], 0, 0, 0); aX[tj] = __builtin_amdgcn_mfma_f32_16x16x32_bf16(af, Bwx[tj][ks], aX[tj], 0, 0, 0); } }
#pragma unroll
                    for (int tj = 0; tj < 4; ++tj)
#pragma unroll
                        for (int r = 0; r < 4; ++r) { const int tl = 4 * fq + r, j = 16 * tj + fr;
                            const float rg = sigmoidf_(aR[tj][r] + cba[tj]), ig = sigmoidf_(aX[tj][r] + cbx[tj]);
                            const float a = __builtin_amdgcn_exp2f(rg * csp[tj]);
                            const float mult = __builtin_amdgcn_sqrtf(fmaxf(1.0f - a * a, 0.0f));
                            const float xv = bf2f(XR[(16 * sb + tl) * LT + j]);
                            AB[tl * 64 + j] = a; AB[1024 + tl * 64 + j] = mult * ig * xv; }
                    LDS_WAIT(); asm volatile("" ::: "memory");
                    if (pass == 1) {
#pragma unroll
                        for (int tl = 0; tl < 16; ++tl) { const float a = AB[tl * 64 + lane], bb = AB[1024 + tl * 64 + lane]; hst = a * hst + bb;
                            const float xg = bf2f(gv[tl]);
                            const float u3 = 0.7978845608028654f * (xg + 0.044715f * xg * xg * xg); const float th = 1.0f - 2.0f * __builtin_amdgcn_rcpf(1.0f + __builtin_amdgcn_exp2f(u3 * 2.8853900817779268f));
                            ACTA[(row0 + 16 * sb + tl) * D + 512 + ch] = (bf16)f2bf(hst * 0.5f * xg * (1.0f + th)); }
                    } else {
#pragma unroll
                        for (int tl = 0; tl < 16; ++tl) { const float a = AB[tl * 64 + lane], bb = AB[1024 + tl * 64 + lane]; hst = a * hst + bb; cum *= a; }
                    }
                    LDS_WAIT(); asm volatile("" ::: "memory");
                }
                if (pass == 0) { f32x2 sv; sv.x = cum; sv.y = hst; ((f32x2*)LSUM)[(size_t)(b * 64 + c) * 512 + ch] = sv; }
            }
            if (pass == 1) {
#pragma unroll 2
                for (int idx = bid * 512 + tid; idx < M * 64; idx += G * 512) {
                    const int row = idx >> 6, c8 = (idx & 63) * 8; const int t = row & (SEQ - 1);
                    const bf16* p = ACTB + (size_t)row * ODD_IN;
                    float acc8[8];
#pragma unroll
                    for (int x = 0; x < 8; ++x) acc8[x] = 0.f;
#pragma unroll
                    for (int k = 0; k < 3; ++k) { const int dt = 2 - k; if (t - dt >= 0) { const bf16* pr = p - (size_t)dt * ODD_IN;
                            const u32x4 gc = *(const u32x4*)(pr + CC_OFF + c8), uu = *(const u32x4*)(pr + CU_OFF + c8); const unsigned gw_[4] = {gc.x, gc.y, gc.z, gc.w}, uw[4] = {uu.x, uu.y, uu.z, uu.w};
#pragma unroll
                            for (int x = 0; x < 4; ++x) { acc8[2 * x] += args.in[11][k * 512 + c8 + 2 * x] * bf2f(gw_[x]) * bf2f(uw[x]); acc8[2 * x + 1] += args.in[11][k * 512 + c8 + 2 * x + 1] * bf2f(gw_[x] >> 16) * bf2f(uw[x] >> 16); } } }
                    const u32x4 gb = *(const u32x4*)(p + CB_OFF + c8); const unsigned gbw[4] = {gb.x, gb.y, gb.z, gb.w};
                    u32x4 w; unsigned ww[4];
#pragma unroll
                    for (int x = 0; x < 4; ++x) ww[x] = pk2(bf2f(gbw[x]) * acc8[2 * x], bf2f(gbw[x] >> 16) * acc8[2 * x + 1]);
                    w.x = ww[0]; w.y = ww[1]; w.z = ww[2]; w.w = ww[3];
                    *(u32x4*)(ACTA + (size_t)row * D + c8) = w;
                }
            }
        }
        SEAM(10 + pass);
    }

    if (IN(12)) {
        pg8::DenseSched S; S.init(ACTA, (const bf16*)(ws + WT_OUT1), M, D, D, G, bid);
        pg8::EpiStoreBf16 E{ACTB, D};
        pg8::gemm_phase<pg8::EpiStoreBf16, pg8::DenseSched, false>(scrb, 2 * D, S, E);
    }
    SEAM(12);

    int* const LTOK = (int*)(ws + SCR_LTOK); unsigned* const REC = (unsigned*)(ws + SCR_REC); unsigned* const REC2 = (unsigned*)(ws + SCR_REC + MiB);
    if (IN(13)) {
        LAS int* const lcnt = (LAS int*)(scrb);
        LAS int* const lbase = (LAS int*)(scrb + 64);
        LAS int* const recE = (LAS int*)(scrb + 128);
        LAS int* const recR = (LAS int*)(scrb + 128 + 1024);
        LAS float* const recW = (LAS float*)(scrb + 128 + 2048);
        float wr_[4][4][8];
#pragma unroll
        for (int j = 0; j < 4; ++j)
#pragma unroll
            for (int x = 0; x < 4; ++x) { const int col = 4 * (lane + 64 * j) + x; const f32x4 w0 = *(const f32x4*)(args.in[20] + (size_t)col * 8), w1 = *(const f32x4*)(args.in[20] + (size_t)col * 8 + 4);
                wr_[j][x][0] = w0.x; wr_[j][x][1] = w0.y; wr_[j][x][2] = w0.z; wr_[j][x][3] = w0.w; wr_[j][x][4] = w1.x; wr_[j][x][5] = w1.y; wr_[j][x][6] = w1.z; wr_[j][x][7] = w1.w; }
        for (int base = bid * 128; base < M; base += G * 128) {
            if (tid < 16) lcnt[tid] = 0;
            __syncthreads();
            f32x4 vn[4]; u32x2 dn[4];
            { const int m = base + wave * 16;
#pragma unroll
              for (int j = 0; j < 4; ++j) { vn[j] = ((const f32x4*)(out + (size_t)m * D) + lane)[64 * j]; dn[j] = ((const u32x2*)(ACTB + (size_t)m * D) + lane)[64 * j]; } }
            for (int rr = 0; rr < 16; ++rr) {
                const int lr = wave * 16 + rr, m = base + lr;
                f32x4* xr = (f32x4*)(out + (size_t)m * D) + lane; const f32x4* gr = (const f32x4*)(args.in[2] + D) + lane;
                f32x4 v[4]; u32x2 dcur[4]; float s = 0.f;
#pragma unroll
                for (int j = 0; j < 4; ++j) { v[j] = vn[j]; dcur[j] = dn[j]; }
                if (rr < 15) {
#pragma unroll
                    for (int j = 0; j < 4; ++j) { vn[j] = ((const f32x4*)(out + (size_t)(m + 1) * D) + lane)[64 * j]; dn[j] = ((const u32x2*)(ACTB + (size_t)(m + 1) * D) + lane)[64 * j]; } }
#pragma unroll
                for (int j = 0; j < 4; ++j) { const u32x2 dv = dcur[j]; v[j].x += bf2f(dv.x); v[j].y += bf2f(dv.x >> 16); v[j].z += bf2f(dv.y); v[j].w += bf2f(dv.y >> 16); xr[64 * j] = v[j];
                    s += (v[j].x * v[j].x + v[j].y * v[j].y) + (v[j].z * v[j].z + v[j].w * v[j].w); }
                const float rstd = rsqrtf(wave_sum(s) * (1.f / D) + EPS);
                float lg[8];
#pragma unroll
                for (int e = 0; e < 8; ++e) lg[e] = 0.f;
                unsigned* o8 = (unsigned*)((unsigned char*)ACTA + (size_t)m * D) + lane;
#pragma unroll
                for (int j = 0; j < 4; ++j) { const f32x4 gv = gr[64 * j]; float y[4] = {v[j].x * rstd * gv.x, v[j].y * rstd * gv.y, v[j].z * rstd * gv.z, v[j].w * rstd * gv.w};
                    { int w = __builtin_amdgcn_cvt_pk_fp8_f32(__builtin_amdgcn_fmed3f(y[0], -448.f, 448.f), __builtin_amdgcn_fmed3f(y[1], -448.f, 448.f), 0, false);
                      w = __builtin_amdgcn_cvt_pk_fp8_f32(__builtin_amdgcn_fmed3f(y[2], -448.f, 448.f), __builtin_amdgcn_fmed3f(y[3], -448.f, 448.f), w, true); o8[64 * j] = (unsigned)w; }
#pragma unroll
                    for (int x = 0; x < 4; ++x)
#pragma unroll
                        for (int e = 0; e < 8; ++e) lg[e] += y[x] * wr_[j][x][e]; }
#pragma unroll
                for (int e = 0; e < 8; ++e) lg[e] = wave_sum(lg[e]) + args.in[21][e];
                int e1 = 0; float l1 = lg[0];
#pragma unroll
                for (int e = 1; e < 8; ++e) if (lg[e] > l1) { l1 = lg[e]; e1 = e; }
                int e2 = -1; float l2 = -3.0e38f;
#pragma unroll
                for (int e = 0; e < 8; ++e) if (e != e1 && lg[e] > l2) { l2 = lg[e]; e2 = e; }
                const float w2 = 1.0f / (1.0f + __expf(l1 - l2)), w1 = 1.0f - w2;
                if (lane == 0) { recE[lr * 2] = e1; recE[lr * 2 + 1] = e2; recW[lr * 2] = w1; recW[lr * 2 + 1] = w2;
                    recR[lr * 2] = __hip_atomic_fetch_add(&lcnt[e1], 1, __ATOMIC_RELAXED, __HIP_MEMORY_SCOPE_WORKGROUP); recR[lr * 2 + 1] = __hip_atomic_fetch_add(&lcnt[8 + e2], 1, __ATOMIC_RELAXED, __HIP_MEMORY_SCOPE_WORKGROUP); }
            }
            __syncthreads();
            if (tid < 16) lbase[tid] = (int)__hip_atomic_fetch_add(ctl + CW_CNT + 64 * tid, (unsigned)lcnt[tid], RLX_AGENT);
            __syncthreads();
            if (tid < 256) { const int lr = tid >> 1, k = tid & 1; const int e = recE[tid]; const int pos = lbase[k * 8 + e] + recR[tid];
                if (pos < LIST_CAP) LTOK[(size_t)(k * 8 + e) * LIST_CAP + pos] = base + lr;
                unsigned* rec = REC + (size_t)(base + lr) * 8 + 3 * k; rec[0] = (unsigned)(k * 8 + e); rec[1] = (unsigned)pos; rec[2] = __builtin_bit_cast(unsigned, recW[tid]); }
            __syncthreads();
        }
    }
    SEAM(13);

    if (IN(14)) {
        pg8::MoeSched S; S.init(ACTA, ws + WT_GU1, LTOK, ctl + CW_CNT, 0, 2 * D_EXP / 256, D, 0, (size_t)2 * D_EXP * D, G, bid);
        if (bid == 0 && tid == 0) { unsigned* tbw = ctl + CW_TB; tbw[0] = 0u; tbw[1] = S.t1; tbw[2] = S.t2; tbw[3] = S.t3; tbw[4] = S.t4; tbw[5] = S.t5; tbw[6] = S.t6; tbw[7] = S.t7; tbw[8] = S.t8;
            tbw[9] = S.t9; tbw[10] = S.t10; tbw[11] = S.t11; tbw[12] = S.t12; tbw[13] = S.t13; tbw[14] = S.t14; tbw[15] = S.t15; }
        pg8::EpiSwiGLU8 E{(unsigned char*)ACTB, D_EXP, 1.0f / 64.0f, 4.0f};
        pg8::gemm_phase<pg8::EpiSwiGLU8, pg8::MoeSched, true, true>(scrb, D, S, E);
    }
    SEAM(14);
    bf16* const YB = (bf16*)(ws + WS_Y);
    if (IN(15)) {
        for (int m = bid * 512 + tid; m < M; m += G * 512) {
            const u32x4 r0 = *(const u32x4*)(REC + (size_t)m * 8), r1 = *(const u32x4*)(REC + (size_t)m * 8 + 4);
            const unsigned ke0 = r0.x, rk0 = r0.y, w0b = r0.z, ke1 = r0.w, rk1 = r1.x, w1b = r1.y;
            u32x4 o; o.x = ctl[CW_TB + ke0] * 256u + rk0; o.y = ctl[CW_TB + ke1] * 256u + rk1; o.z = w0b; o.w = w1b;
            *(u32x4*)(REC2 + (size_t)m * 4) = o; }
        pg8::MoeSched S; S.init(ACTB, ws + WT_DN1, LTOK, ctl + CW_CNT, 0, D / 256, D_EXP, (size_t)256 * D_EXP, (size_t)D * D_EXP, G, bid);
        pg8::EpiStoreBf16 E{YB, D};
        pg8::gemm_phase<pg8::EpiStoreBf16, pg8::MoeSched, false, true>(scrb, D_EXP, S, E);
    }
    SEAM(15);

    if (IN(16)) {
        const f32x4* gr = (const f32x4*)args.in[3] + lane;
        for (int m0 = gw; m0 < M; m0 += 2 * NGW) {
            const int NR = (m0 + NGW < M) ? NGW : 0;
            u32x4 rc[2];
#pragma unroll
            for (int r = 0; r < 2; ++r) rc[r] = *(const u32x4*)(REC2 + (size_t)(m0 + r * NR) * 4);
            f32x4 v[2][4]; u32x2 ya[2][4], yb[2][4];
#pragma unroll
            for (int r = 0; r < 2; ++r) { const unsigned row0 = rc[r].x, row1 = rc[r].y;
                const u32x2* y0 = (const u32x2*)(YB + (size_t)row0 * D) + lane; const u32x2* y1 = (const u32x2*)(YB + (size_t)row1 * D) + lane; const f32x4* xr = (const f32x4*)(out + (size_t)(m0 + r * NR) * D) + lane;
#pragma unroll
                for (int j = 0; j < 4; ++j) { v[r][j] = xr[64 * j]; ya[r][j] = y0[64 * j]; yb[r][j] = y1[64 * j]; } }
#pragma unroll
            for (int r = 0; r < 2; ++r) { const unsigned w0u = rc[r].z, w1u = rc[r].w; const float w0 = __uint_as_float(w0u) * (1.0f / 256.0f), w1 = __uint_as_float(w1u) * (1.0f / 256.0f);
                float s = 0.f;
#pragma unroll
                for (int j = 0; j < 4; ++j) { const u32x2 a = ya[r][j], b = yb[r][j];
                    v[r][j].x += w0 * bf2f(a.x) + w1 * bf2f(b.x); v[r][j].y += w0 * bf2f(a.x >> 16) + w1 * bf2f(b.x >> 16); v[r][j].z += w0 * bf2f(a.y) + w1 * bf2f(b.y); v[r][j].w += w0 * bf2f(a.y >> 16) + w1 * bf2f(b.y >> 16);
                    s += (v[r][j].x * v[r][j].x + v[r][j].y * v[r][j].y) + (v[r][j].z * v[r][j].z + v[r][j].w * v[r][j].w); }
                const float rstd = rsqrtf(wave_sum(s) * (1.f / D) + EPS);
                f32x4* xw = (f32x4*)(out + (size_t)(m0 + r * NR) * D) + lane;
#pragma unroll
                for (int j = 0; j < 4; ++j) { const f32x4 gv = gr[64 * j]; xw[64 * j] = v[r][j] * rstd * gv; } }
        }
    }
    if (PROBE_A_LO >= 0 && bid == 0 && tid == 0) {
        const unsigned long long t_end = wall_clock64();
        const unsigned long long wait = (unsigned long long)(MISC[9] - MISC[8]) * 4ull + ((PROBE_B_LO >= 0) ? (unsigned long long)(MISC[11] - MISC[10]) * 4ull : 0ull);
        while (wall_clock64() - t_end < wait) __builtin_amdgcn_s_sleep(32);
    }
#undef IN
#undef SEAM
#undef PSTAMP
}

extern "C" void kernel_launch(void* const* d_in, const int* in_sizes, int n_in, void* d_out, int out_size, void* d_ws, size_t ws_size, hipStream_t stream) {
    static int grid = 0;
    if (grid == 0) {
        if (n_in != 25 || in_sizes[0] != M * D || out_size != M * D || ws_size < WS_END) { fprintf(stderr, "kernel_launch: unexpected shapes / workspace (n_in %d, ws %zu, need %zu)\n", n_in, ws_size, (size_t)WS_END); grid = -1; return; }
        int dev = 0, cus = 0, per_cu = 0;
        if (hipGetDevice(&dev) != hipSuccess || hipDeviceGetAttribute(&cus, hipDeviceAttributeMultiprocessorCount, dev) != hipSuccess) { grid = -1; return; }
        if (hipFuncSetAttribute((const void*)fwd_kernel, hipFuncAttributeMaxDynamicSharedMemorySize, LDS_BYTES) != hipSuccess) { fprintf(stderr, "kernel_launch: hipFuncSetAttribute failed\n"); grid = -1; return; }
        if (hipOccupancyMaxActiveBlocksPerMultiprocessor(&per_cu, (const void*)fwd_kernel, 512, LDS_BYTES) != hipSuccess || per_cu < 1) { fprintf(stderr, "kernel_launch: occupancy query says %d\n", per_cu); }
        (void)hipGetLastError();
        grid = cus;
    }
    if (grid < 0) return;
    if (hipMemsetAsync((char*)d_ws + WS_CTL, 0, CTL_ZERO_BYTES, stream) != hipSuccess) return;
    Args a{};
    for (int i = 0; i < 25; ++i) a.in[i] = (const float*)d_in[i];
    a.out = (float*)d_out; a.ws = (unsigned char*)d_ws;
#if MK_N_LAUNCHES == 1
    a.ph_lo = 0; a.ph_hi = NPHASE;
    hipLaunchKernelGGL(fwd_kernel, dim3(grid), dim3(512), LDS_BYTES, stream, a);
#else
    for (int p = 0; p < NPHASE; ++p) { a.ph_lo = p; a.ph_hi = p + 1; hipLaunchKernelGGL(fwd_kernel, dim3(grid), dim3(512), LDS_BYTES, stream, a); }
#endif
}
```
